# Optimizing an MI355X kernel written in HIP

```python
import jax, jax.numpy as jnp
from jax import lax
import numpy as np

D_MODEL = 2048
BATCH = 4
SEQ = 2048
DEPTH = 1

DIL_CONFIGS = ((128, 1), (512, 4), (2048, 16))
N_DIL_GROUPS = len(DIL_CONFIGS)
HEADS_PER_GROUP = 4
HEAD_DIM_A = 128
ATT_BLOCK = 128
ROPE_THETA = 10000.0
A_GROUP_W = HEADS_PER_GROUP * HEAD_DIM_A
A_QKV_W = N_DIL_GROUPS * A_GROUP_W
M_HEADS = 4
M_HEAD_DIM = 256
M_W = M_HEADS * M_HEAD_DIM
M_CHUNK = 128
CONV_K = 4
OFF_QA = 0
OFF_KA = OFF_QA + A_QKV_W
OFF_VA = OFF_KA + A_QKV_W
OFF_QKM = OFF_VA + A_QKV_W
OFF_VM = OFF_QKM + 2 * M_W
OFF_OM = OFF_VM + M_W
OFF_IF = OFF_OM + M_W
N_IN = OFF_IF + 2 * M_HEADS
N_EXPERT_GROUPS = 4
EXPERTS_PER_GROUP = 8
TOP_K_IN_GROUP = 2
D_FF_EXPERT = 1024
DEEPNORM_ALPHA = (2 * DEPTH) ** 0.25
DEEPNORM_BETA = (8 * DEPTH) ** -0.25
LN_EPS = 1e-5

kernel_name = "hybrid_dilated_attn_mlstm_hmoe_block"


def _normalize(x):
    xf = x.astype(jnp.float32)
    mu = jnp.mean(xf, axis=-1, keepdims=True)
    var = jnp.mean(jnp.square(xf - mu), axis=-1, keepdims=True)
    return (xf - mu) * lax.rsqrt(var + LN_EPS)


def layer_norm(x, g, b):
    return (_normalize(x) * g + b).astype(x.dtype)


def rope(x):
    S, E = x.shape[1], x.shape[-1]
    inv = ROPE_THETA ** (-jnp.arange(0, E, 2, dtype=jnp.float32) / E)
    ang = jnp.arange(S, dtype=jnp.float32)[:, None] * inv[None, :]
    cos = jnp.cos(ang)[None, :, None, :]
    sin = jnp.sin(ang)[None, :, None, :]
    xf = x.astype(jnp.float32)
    x1, x2 = xf[..., : E // 2], xf[..., E // 2:]
    return jnp.concatenate([x1 * cos - x2 * sin, x2 * cos + x1 * sin], axis=-1).astype(x.dtype)


def dilated_attention_group(q, k, v, window, dilation):
    Bn, S, H, E = q.shape
    L = S // dilation
    nb = -(-L // ATT_BLOCK)
    Lp = nb * ATT_BLOCK
    steps = window // dilation

    def to_sub(a):
        a = a.reshape(Bn, L, dilation, H, E).transpose(0, 2, 3, 1, 4)
        a = jnp.pad(a, ((0, 0), (0, 0), (0, 0), (0, Lp - L), (0, 0)))
        return a.reshape(Bn, dilation, H, nb, ATT_BLOCK, E)

    def with_prev(a):
        prev = jnp.pad(a, ((0, 0), (0, 0), (0, 0), (1, 0), (0, 0), (0, 0)))[:, :, :, :-1]
        return jnp.concatenate([prev, a], axis=4)

    qs = to_sub(q)
    kw = with_prev(to_sub(k))
    vw = with_prev(to_sub(v))
    scores = jnp.einsum('brhnqe,brhnke->brhnqk', qs, kw).astype(jnp.float32) * (E ** -0.5)
    blk = jnp.arange(nb)[:, None, None]
    qi = blk * ATT_BLOCK + jnp.arange(ATT_BLOCK)[None, :, None]
    ki = (blk - 1) * ATT_BLOCK + jnp.arange(2 * ATT_BLOCK)[None, None, :]
    dist = qi - ki
    valid = (dist >= 0) & (dist <= steps) & (ki >= 0)
    scores = jnp.where(valid, scores, -jnp.inf)
    mx = jnp.max(scores, axis=-1, keepdims=True)
    p = jnp.exp(scores - mx)
    den = jnp.sum(p, axis=-1)
    o = jnp.einsum('brhnqk,brhnke->brhnqe', p, vw.astype(jnp.float32)) / den[..., None]
    lse = mx[..., 0] + jnp.log(den)
    o = o.reshape(Bn, dilation, H, Lp, E)[:, :, :, :L].transpose(0, 3, 1, 2, 4).reshape(Bn, S, H, E)
    lse = lse.reshape(Bn, dilation, H, Lp)[..., :L].transpose(0, 3, 1, 2).reshape(Bn, S, H)
    return o, lse


def causal_conv(x, w, b):
    C = x.shape[-1]
    y = lax.conv_general_dilated(x, w[:, None, :], (1,), [(CONV_K - 1, 0)],
                                 dimension_numbers=('NWC', 'WIO', 'NWC'),
                                 feature_group_count=C)
    return y + b


def mlstm_chunkwise(q, k, v, i_pre, f_pre):
    Bn, H, S, Dh = q.shape
    L = M_CHUNK
    nc = S // L
    k = k * (Dh ** -0.5)
    log_f = jax.nn.log_sigmoid(f_pre)

    def to_chunks(a):
        return jnp.moveaxis(a.reshape(a.shape[:2] + (nc, L) + a.shape[3:]), 2, 0)

    causal = jnp.tril(jnp.ones((L, L), dtype=bool))

    def step(carry, inp):
        C, n, m = carry
        qb, kb, vb, ib, fb = inp
        b = jnp.cumsum(fb, axis=-1)
        log_d = jnp.where(causal, b[..., :, None] - b[..., None, :] + ib[..., None, :], -jnp.inf)
        log_inter = b + m[..., None]
        m_t = jnp.maximum(jnp.max(log_d, axis=-1), log_inter)
        s = jnp.einsum('bhtd,bhsd->bhts', qb, kb) * jnp.exp(log_d - m_t[..., None])
        inter = jnp.exp(log_inter - m_t)
        num = jnp.einsum('bhts,bhsd->bhtd', s, vb) + inter[..., None] * jnp.einsum('bhvk,bhtk->bhtv', C, qb)
        den = jnp.sum(s, axis=-1) + inter * jnp.einsum('bhk,bhtk->bht', n, qb)
        h = num / jnp.maximum(jnp.abs(den), jnp.exp(-m_t))[..., None]
        m_new = m_t[..., -1]
        w_state = jnp.exp(b[..., -1:] - b + ib - m_new[..., None])
        decay = jnp.exp(b[..., -1] + m - m_new)
        C_new = decay[..., None, None] * C + jnp.einsum('bhs,bhsv,bhsk->bhvk', w_state, vb, kb)
        n_new = decay[..., None] * n + jnp.einsum('bhs,bhsk->bhk', w_state, kb)
        return (C_new, n_new, m_new), h

    init = (jnp.zeros((Bn, H, Dh, Dh), jnp.float32),
            jnp.zeros((Bn, H, Dh), jnp.float32),
            jnp.zeros((Bn, H), jnp.float32))
    xs = (to_chunks(q), to_chunks(k), to_chunks(v), to_chunks(i_pre), to_chunks(log_f))
    _, hs = lax.scan(step, init, xs)
    return jnp.moveaxis(hs, 0, 2).reshape(Bn, H, S, Dh)


def token_mixer(u, w_in, b_mgate, conv_w, conv_b, m_norm_g, w_proj_a, w_proj_m, w_gate, b_gate, w_out):
    Bn, S, D = u.shape
    proj = u @ w_in
    n_a_heads = N_DIL_GROUPS * HEADS_PER_GROUP
    qa = rope(proj[..., OFF_QA:OFF_KA].reshape(Bn, S, n_a_heads, HEAD_DIM_A))
    ka = rope(proj[..., OFF_KA:OFF_VA].reshape(Bn, S, n_a_heads, HEAD_DIM_A))
    va = proj[..., OFF_VA:OFF_QKM].reshape(Bn, S, n_a_heads, HEAD_DIM_A)
    outs, lses = [], []
    for g, (window, dilation) in enumerate(DIL_CONFIGS):
        hs = slice(g * HEADS_PER_GROUP, (g + 1) * HEADS_PER_GROUP)
        o, lse = dilated_attention_group(qa[:, :, hs], ka[:, :, hs], va[:, :, hs], window, dilation)
        outs.append(o)
        lses.append(lse)
    mix_w = jax.nn.softmax(jnp.stack(lses, axis=0), axis=0)[..., None]
    y_a = jnp.sum(mix_w * jnp.stack(outs, axis=0), axis=0).reshape(Bn, S, A_GROUP_W).astype(u.dtype)

    qk = jax.nn.silu(causal_conv(proj[..., OFF_QKM:OFF_VM], conv_w, conv_b))
    gates = (proj[..., OFF_IF:N_IN] + b_mgate).astype(jnp.float32)

    def to_bhsd(a):
        return a.reshape(Bn, S, M_HEADS, M_HEAD_DIM).transpose(0, 2, 1, 3).astype(jnp.float32)

    h = mlstm_chunkwise(to_bhsd(qk[..., :M_W]), to_bhsd(qk[..., M_W:]),
                        to_bhsd(proj[..., OFF_VM:OFF_OM]),
                        gates[..., :M_HEADS].transpose(0, 2, 1),
                        gates[..., M_HEADS:].transpose(0, 2, 1))
    o_gate = jax.nn.sigmoid(proj[..., OFF_OM:OFF_IF].astype(jnp.float32)).reshape(Bn, S, M_HEADS, M_HEAD_DIM)
    h = o_gate * h.transpose(0, 2, 1, 3)
    h = _normalize(h) * m_norm_g.reshape(M_HEADS, M_HEAD_DIM)
    y_m = h.reshape(Bn, S, M_W).astype(u.dtype)

    g_br = jax.nn.sigmoid((u @ w_gate + b_gate).astype(jnp.float32)).reshape(Bn, S, 2, D)
    merged = g_br[..., 0, :] * (y_a @ w_proj_a) + g_br[..., 1, :] * (y_m @ w_proj_m)
    return merged.astype(u.dtype) @ w_out


def hier_moe(u, w_rg, b_rg, w_re, b_re, w_eg, w_eu, w_ed):
    Bn, S, D = u.shape
    G, E = N_EXPERT_GROUPS, EXPERTS_PER_GROUP
    t = u.reshape(-1, D)
    g_prob = jax.nn.softmax((t @ w_rg + b_rg).astype(jnp.float32), axis=-1)
    g_top = jnp.argmax(g_prob, axis=-1)
    g_w = jnp.max(g_prob, axis=-1)
    e_logits = (t @ w_re + b_re).astype(jnp.float32).reshape(-1, G, E)
    e_sel = jnp.take_along_axis(e_logits, g_top[:, None, None], axis=1)[:, 0]
    top_v, top_i = lax.top_k(jax.nn.softmax(e_sel, axis=-1), TOP_K_IN_GROUP)
    top_v = top_v / jnp.sum(top_v, axis=-1, keepdims=True)
    e_w = jnp.sum(jax.nn.one_hot(top_i, E, dtype=jnp.float32) * top_v[..., None], axis=1)
    combine = (g_w[:, None] * jax.nn.one_hot(g_top, G, dtype=jnp.float32))[:, :, None] * e_w[:, None, :]
    y = jnp.zeros(t.shape, jnp.float32)
    for gi in range(G):
        hg = jax.nn.silu(jnp.einsum('td,edf->tef', t, w_eg[gi])) * jnp.einsum('td,edf->tef', t, w_eu[gi])
        y = y + jnp.einsum('tef,efd->td', hg * combine[:, gi, :, None].astype(hg.dtype), w_ed[gi])
    return y.reshape(Bn, S, D).astype(u.dtype)


def setup_inputs(seed: int = 0) -> dict:
    key = jax.random.key(seed)
    ks = jax.random.split(key, 28)
    D, L = D_MODEL, DEPTH
    G, E, F = N_EXPERT_GROUPS, EXPERTS_PER_GROUP, D_FF_EXPERT

    def nrm(k, shape, std):
        return jax.random.normal(k, shape, jnp.float32) * std

    b_mgate = jnp.concatenate([
        nrm(ks[4], (L, M_HEADS), 0.1),
        3.0 + 3.0 * jax.random.uniform(ks[5], (L, M_HEADS), jnp.float32)], axis=-1)
    return {
        "x": nrm(ks[0], (BATCH, SEQ, D), 1.0),
        "c": nrm(ks[1], (BATCH, D), 1.0),
        "w_ada": nrm(ks[2], (L, D, 6 * D), 0.5 * D ** -0.5),
        "b_ada": nrm(ks[3], (L, 6 * D), 0.01),
        "w_in": nrm(ks[6], (L, D, N_IN), D ** -0.5),
        "b_mgate": b_mgate,
        "conv_w": nrm(ks[7], (L, CONV_K, 2 * M_W), CONV_K ** -0.5),
        "conv_b": nrm(ks[8], (L, 2 * M_W), 0.01),
        "m_norm_g": 1.0 + nrm(ks[9], (L, M_W), 0.02),
        "w_proj_a": nrm(ks[10], (L, A_GROUP_W, D), DEEPNORM_BETA * A_GROUP_W ** -0.5),
        "w_proj_m": nrm(ks[11], (L, M_W, D), DEEPNORM_BETA * M_W ** -0.5),
        "w_gate": nrm(ks[12], (L, D, 2 * D), D ** -0.5),
        "b_gate": nrm(ks[13], (L, 2 * D), 0.01),
        "w_out": nrm(ks[14], (L, D, D), DEEPNORM_BETA * D ** -0.5),
        "ln1_g": 1.0 + nrm(ks[15], (L, D), 0.02),
        "ln1_b": nrm(ks[16], (L, D), 0.01),
        "w_rg": nrm(ks[17], (L, D, G), D ** -0.5),
        "b_rg": nrm(ks[18], (L, G), 0.01),
        "w_re": nrm(ks[19], (L, D, G * E), D ** -0.5),
        "b_re": nrm(ks[20], (L, G * E), 0.01),
        "w_eg": nrm(ks[21], (L, G, E, D, F), D ** -0.5),
        "w_eu": nrm(ks[22], (L, G, E, D, F), D ** -0.5),
        "w_ed": nrm(ks[23], (L, G, E, F, D), DEEPNORM_BETA * F ** -0.5),
        "ln2_g": 1.0 + nrm(ks[24], (L, D), 0.02),
        "ln2_b": nrm(ks[25], (L, D), 0.01),
    }


def reference(x, c, w_ada, b_ada, w_in, b_mgate, conv_w, conv_b, m_norm_g, w_proj_a, w_proj_m,
              w_gate, b_gate, w_out, ln1_g, ln1_b, w_rg, b_rg, w_re, b_re, w_eg, w_eu, w_ed,
              ln2_g, ln2_b):
    for l in range(DEPTH):
        mod = (jax.nn.silu(c) @ w_ada[l] + b_ada[l]).reshape(c.shape[0], 6, D_MODEL)[:, :, None, :]
        shift1, scale1, gate1, shift2, scale2, gate2 = [mod[:, j] for j in range(6)]
        u = (_normalize(x) * (1.0 + scale1) + shift1).astype(x.dtype)
        mix = token_mixer(u, w_in[l], b_mgate[l], conv_w[l], conv_b[l], m_norm_g[l], w_proj_a[l],
                          w_proj_m[l], w_gate[l], b_gate[l], w_out[l])
        x = layer_norm(DEEPNORM_ALPHA * x + gate1 * mix, ln1_g[l], ln1_b[l])
        u = (_normalize(x) * (1.0 + scale2) + shift2).astype(x.dtype)
        ffn = hier_moe(u, w_rg[l], b_rg[l], w_re[l], b_re[l], w_eg[l], w_eu[l], w_ed[l])
        x = layer_norm(DEEPNORM_ALPHA * x + gate2 * ffn, ln2_g[l], ln2_b[l])
    return x
```

```cpp
#include <hip/hip_runtime.h>
#include <stdint.h>
#include <math.h>

namespace {
constexpr int D = 2048, NB = 4, S = 2048, T = NB * S, NIN = 8712;
constexpr int OFF_QA = 0, OFF_KA = 1536, OFF_VA = 3072, OFF_QKM = 4608, OFF_VM = 6656, OFF_OM = 7680, OFF_IF = 8704;
constexpr int FF = 1024, NEXP = 32;
constexpr float ALPHA = 1.189207115002721f;
constexpr float LN_EPS = 1e-5f;

__device__ __forceinline__ float silu_f(float x) { return x / (1.f + expf(-x)); }
__device__ __forceinline__ float sigmoid_f(float x) { return 1.f / (1.f + expf(-x)); }
__device__ __forceinline__ float wave_sum(float v) { for (int o = 32; o >= 1; o >>= 1) v += __shfl_xor(v, o); return v; }

__device__ __forceinline__ float block_sum256(float v, float* sh) {
    v = wave_sum(v);
    __syncthreads();
    if ((threadIdx.x & 63) == 0) sh[threadIdx.x >> 6] = v;
    __syncthreads();
    return sh[0] + sh[1] + sh[2] + sh[3];
}

__global__ void k_mod(const float* c, const float* w_ada, const float* b_ada, float* mod) {
    __shared__ float sc[NB][D];
    for (int i = threadIdx.x; i < NB * D; i += blockDim.x) sc[i / D][i % D] = silu_f(c[i]);
    __syncthreads();
    const int j = blockIdx.x * blockDim.x + threadIdx.x;
    float a0 = 0, a1 = 0, a2 = 0, a3 = 0;
    for (int k = 0; k < D; ++k) { const float w = w_ada[(size_t)k * (6 * D) + j]; a0 += sc[0][k] * w; a1 += sc[1][k] * w; a2 += sc[2][k] * w; a3 += sc[3][k] * w; }
    const float bb = b_ada[j];
    mod[0 * 6 * D + j] = a0 + bb; mod[1 * 6 * D + j] = a1 + bb; mod[2 * 6 * D + j] = a2 + bb; mod[3 * 6 * D + j] = a3 + bb;
}

__global__ void k_lnmod(const float* x, const float* mod, int shiftIdx, int scaleIdx, float* out) {
    __shared__ float sh[4];
    const int t = blockIdx.x, b = t / S;
    const float* xr = x + (size_t)t * D;
    float v[8]; float s = 0;
    for (int i = 0; i < 8; ++i) { v[i] = xr[threadIdx.x + 256 * i]; s += v[i]; }
    const float mu = block_sum256(s, sh) * (1.f / D);
    float q = 0; for (int i = 0; i < 8; ++i) { const float d = v[i] - mu; q += d * d; }
    const float var = block_sum256(q, sh) * (1.f / D);
    const float rstd = rsqrtf(var + LN_EPS);
    const float* sc = mod + (size_t)b * 6 * D + scaleIdx * D; const float* sf = mod + (size_t)b * 6 * D + shiftIdx * D;
    for (int i = 0; i < 8; ++i) { const int d = threadIdx.x + 256 * i; out[(size_t)t * D + d] = (v[i] - mu) * rstd * (1.f + sc[d]) + sf[d]; }
}

struct GemmP { const float* A; int lda; const float* B; int ldb; float* C; int ldc; int M, N, K; const int* idx; int idxStride; int shiftA; const int* cnt; long strideB; };
__global__ void __launch_bounds__(256) k_gemm(GemmP p) {
    const int z = blockIdx.z; const int M = p.cnt ? p.cnt[z] : p.M;
    const int m0 = blockIdx.y * 64, n0 = blockIdx.x * 64; if (m0 >= M) return;
    const float* B = p.B + (size_t)z * p.strideB; const int* idx = p.idx ? p.idx + (size_t)z * p.idxStride : nullptr;
    __shared__ float As[16][68], Bs[16][68];
    const int t = threadIdx.x, ty = t / 16, tx = t % 16;
    const int ar = t / 4, ak = (t % 4) * 4; const int am = m0 + ar; int arow = -1;
    if (am < M) arow = idx ? (idx[am] >> p.shiftA) : am;
    const int bk = t / 16, bn = (t % 16) * 4;
    float acc[4][4] = {};
    for (int k0 = 0; k0 < p.K; k0 += 16) {
        float4 av = make_float4(0, 0, 0, 0); if (arow >= 0) av = *(const float4*)(p.A + (size_t)arow * p.lda + k0 + ak);
        float4 bv = make_float4(0, 0, 0, 0); if (n0 + bn < p.N) bv = *(const float4*)(B + (size_t)(k0 + bk) * p.ldb + n0 + bn);
        __syncthreads();
        As[ak + 0][ar] = av.x; As[ak + 1][ar] = av.y; As[ak + 2][ar] = av.z; As[ak + 3][ar] = av.w;
        Bs[bk][bn + 0] = bv.x; Bs[bk][bn + 1] = bv.y; Bs[bk][bn + 2] = bv.z; Bs[bk][bn + 3] = bv.w;
        __syncthreads();
#pragma unroll
        for (int k = 0; k < 16; ++k) {
            float a[4], b[4];
#pragma unroll
            for (int i = 0; i < 4; ++i) { a[i] = As[k][ty * 4 + i]; b[i] = Bs[k][tx * 4 + i]; }
#pragma unroll
            for (int i = 0; i < 4; ++i)
#pragma unroll
                for (int j = 0; j < 4; ++j) acc[i][j] += a[i] * b[j];
        }
    }
    for (int i = 0; i < 4; ++i) { const int m = m0 + ty * 4 + i; if (m >= M) continue; const int crow = idx ? idx[m] : m;
        for (int j = 0; j < 4; ++j) { const int n = n0 + tx * 4 + j; if (n < p.N) p.C[(size_t)crow * p.ldc + n] = acc[i][j]; } }
}

__global__ void k_rope(float* proj) {
    const size_t gid = (size_t)blockIdx.x * blockDim.x + threadIdx.x;
    const int i = gid % 64; const int hd = (gid / 64) % 24; const int t = gid / (64 * 24);
    const int pos = t % S;
    const float inv = powf(10000.f, -(float)(2 * i) / 128.f);
    const float ang = (float)pos * inv; const float cs = cosf(ang), sn = sinf(ang);
    float* p = proj + (size_t)t * NIN + hd * 128;
    const float x1 = p[i], x2 = p[i + 64];
    p[i] = x1 * cs - x2 * sn; p[i + 64] = x2 * cs + x1 * sn;
}

__global__ void __launch_bounds__(256) k_attn(const float* proj, float* ya) {
    const int t = blockIdx.x, h = threadIdx.x >> 6, lane = threadIdx.x & 63;
    const int b = t / S, pos = t % S;
    float og[3][2], lse[3];
    for (int g = 0; g < 3; ++g) {
        const int d = (g == 0) ? 1 : (g == 1 ? 4 : 16);
        const int head = 4 * g + h;
        const float* qp = proj + (size_t)t * NIN + OFF_QA + head * 128;
        const float q0 = qp[lane], q1 = qp[lane + 64];
        float mx = -INFINITY, den = 0, o0 = 0, o1 = 0;
        for (int j = 0; j <= 128; ++j) {
            const int tk = pos - j * d; if (tk < 0) break;
            const float* kp = proj + (size_t)(b * S + tk) * NIN + OFF_KA + head * 128;
            const float* vp = proj + (size_t)(b * S + tk) * NIN + OFF_VA + head * 128;
            float dot = wave_sum(q0 * kp[lane] + q1 * kp[lane + 64]) * 0.08838834764831845f;
            const float nm = fmaxf(mx, dot); const float sc = expf(mx - nm), pe = expf(dot - nm);
            den = den * sc + pe; o0 = o0 * sc + pe * vp[lane]; o1 = o1 * sc + pe * vp[lane + 64]; mx = nm;
        }
        og[g][0] = o0 / den; og[g][1] = o1 / den; lse[g] = mx + logf(den);
    }
    const float ml = fmaxf(lse[0], fmaxf(lse[1], lse[2]));
    const float w0 = expf(lse[0] - ml), w1 = expf(lse[1] - ml), w2 = expf(lse[2] - ml); const float ws = 1.f / (w0 + w1 + w2);
    ya[(size_t)t * 512 + h * 128 + lane] = (w0 * og[0][0] + w1 * og[1][0] + w2 * og[2][0]) * ws;
    ya[(size_t)t * 512 + h * 128 + lane + 64] = (w0 * og[0][1] + w1 * og[1][1] + w2 * og[2][1]) * ws;
}

__global__ void k_conv(const float* proj, const float* conv_w, const float* conv_b, float* qk) {
    const size_t gid = (size_t)blockIdx.x * blockDim.x + threadIdx.x;
    const int c = gid % 2048; const int t = gid / 2048; const int pos = t % S;
    float y = conv_b[c];
    for (int j = 0; j < 4; ++j) { const int pp = pos + j - 3; if (pp >= 0) y += conv_w[j * 2048 + c] * proj[(size_t)(t + j - 3) * NIN + OFF_QKM + c]; }
    qk[gid] = silu_f(y);
}

__global__ void __launch_bounds__(1024) k_mlstm(const float* qk, const float* proj, const float* b_mgate, float* hbuf) {
    const int b = blockIdx.x / 4, h = blockIdx.x % 4;
    const int tid = threadIdx.x, v = tid >> 2, kq = tid & 3;
    __shared__ float qs[256], ks[256], vs[256], ns[256], nq[256];
    float C[64];
    for (int i = 0; i < 64; ++i) C[i] = 0.f;
    if (tid < 256) ns[tid] = 0.f;
    float m = 0.f;
    const float bi = b_mgate[h], bf = b_mgate[4 + h];
    for (int pos = 0; pos < S; ++pos) {
        const size_t t = (size_t)b * S + pos;
        __syncthreads();
        if (tid < 256) { qs[tid] = qk[t * 2048 + h * 256 + tid]; ks[tid] = qk[t * 2048 + 1024 + h * 256 + tid] * 0.0625f; vs[tid] = proj[t * NIN + OFF_VM + h * 256 + tid]; }
        const float ip = proj[t * NIN + OFF_IF + h] + bi; const float fp = proj[t * NIN + OFF_IF + 4 + h] + bf;
        const float lf = fminf(fp, 0.f) - log1pf(expf(-fabsf(fp)));
        const float mn = fmaxf(lf + m, ip);
        const float iw = expf(ip - mn), fw = expf(lf + m - mn);
        m = mn;
        __syncthreads();
        if (tid < 256) { const float nn = fw * ns[tid] + iw * ks[tid]; ns[tid] = nn; nq[tid] = nn * qs[tid]; }
        __syncthreads();
        const float vv = vs[v] * iw;
        float num = 0.f, den = 0.f;
#pragma unroll
        for (int i = 0; i < 64; ++i) { const int k = 4 * i + kq; const float cc = fw * C[i] + vv * ks[k]; C[i] = cc; num += cc * qs[k]; den += nq[k]; }
        num += __shfl_xor(num, 1); num += __shfl_xor(num, 2); den += __shfl_xor(den, 1); den += __shfl_xor(den, 2);
        if (kq == 0) hbuf[t * 1024 + h * 256 + v] = num / fmaxf(fabsf(den), expf(-mn));
    }
}

__global__ void k_mnorm(const float* proj, const float* hbuf, const float* g, float* ym) {
    __shared__ float sh[4];
    const int t = blockIdx.x / 4, h = blockIdx.x % 4, v = threadIdx.x;
    const float val = sigmoid_f(proj[(size_t)t * NIN + OFF_OM + h * 256 + v]) * hbuf[(size_t)t * 1024 + h * 256 + v];
    const float mu = block_sum256(val, sh) * (1.f / 256.f);
    const float d = val - mu; const float var = block_sum256(d * d, sh) * (1.f / 256.f);
    ym[(size_t)t * 1024 + h * 256 + v] = d * rsqrtf(var + LN_EPS) * g[h * 256 + v];
}

__global__ void k_merge(const float* gateb, const float* b_gate, const float* PA, float* PM) {
    const size_t gid = (size_t)blockIdx.x * blockDim.x + threadIdx.x; const int d = gid % D; const size_t t = gid / D;
    const float g0 = sigmoid_f(gateb[t * 4096 + d] + b_gate[d]), g1 = sigmoid_f(gateb[t * 4096 + 2048 + d] + b_gate[2048 + d]);
    PM[gid] = g0 * PA[gid] + g1 * PM[gid];
}

__global__ void k_resln(const float* x, const float* f, const float* f2, const float* wslot, const float* mod, int gateIdx, const float* lg, const float* lb, float* x1, float* u2) {
    __shared__ float sh[4];
    const int t = blockIdx.x, b = t / S;
    const float* gate = mod + (size_t)b * 6 * D + gateIdx * D;
    float v[8]; float s = 0;
    for (int i = 0; i < 8; ++i) { const int d = threadIdx.x + 256 * i;
        float ff;
        if (f2) ff = wslot[2 * t] * f[(size_t)(2 * t) * D + d] + wslot[2 * t + 1] * f[(size_t)(2 * t + 1) * D + d]; else ff = f[(size_t)t * D + d];
        v[i] = ALPHA * x[(size_t)t * D + d] + gate[d] * ff; s += v[i]; }
    float mu = block_sum256(s, sh) * (1.f / D);
    float q = 0; for (int i = 0; i < 8; ++i) { const float d = v[i] - mu; q += d * d; }
    float rstd = rsqrtf(block_sum256(q, sh) * (1.f / D) + LN_EPS);
    s = 0;
    for (int i = 0; i < 8; ++i) { const int d = threadIdx.x + 256 * i; v[i] = (v[i] - mu) * rstd * lg[d] + lb[d]; x1[(size_t)t * D + d] = v[i]; s += v[i]; }
    if (!u2) return;
    mu = block_sum256(s, sh) * (1.f / D);
    q = 0; for (int i = 0; i < 8; ++i) { const float d = v[i] - mu; q += d * d; }
    rstd = rsqrtf(block_sum256(q, sh) * (1.f / D) + LN_EPS);
    const float* sc = mod + (size_t)b * 6 * D + 4 * D; const float* sf = mod + (size_t)b * 6 * D + 3 * D;
    for (int i = 0; i < 8; ++i) { const int d = threadIdx.x + 256 * i; u2[(size_t)t * D + d] = (v[i] - mu) * rstd * (1.f + sc[d]) + sf[d]; }
}

__global__ void __launch_bounds__(64) k_router(const float* u2, const float* w_rg, const float* b_rg, const float* w_re, const float* b_re, int* cnt, int* idx, float* wslot) {
    const int t = blockIdx.x, lane = threadIdx.x;
    float acc[36];
    for (int j = 0; j < 36; ++j) acc[j] = 0.f;
    for (int k = lane; k < D; k += 64) { const float uv = u2[(size_t)t * D + k];
        for (int j = 0; j < 4; ++j) acc[j] += uv * w_rg[k * 4 + j];
        for (int j = 0; j < 32; ++j) acc[4 + j] += uv * w_re[k * 32 + j]; }
    __shared__ float sl[36];
#pragma unroll
    for (int j = 0; j < 36; ++j) { const float r = wave_sum(acc[j]); if (lane == 0) sl[j] = r; }
    __syncthreads();
    if (lane == 0) {
        int gt = 0; float lgt = sl[0] + b_rg[0];
        for (int j = 1; j < 4; ++j) { const float l = sl[j] + b_rg[j]; if (l > lgt) { lgt = l; gt = j; } }
        float se = 0; for (int j = 0; j < 4; ++j) se += expf(sl[j] + b_rg[j] - lgt);
        const float gw = 1.f / se;
        int a = 0; float la = sl[4 + gt * 8] + b_re[gt * 8];
        for (int j = 1; j < 8; ++j) { const float l = sl[4 + gt * 8 + j] + b_re[gt * 8 + j]; if (l > la) { la = l; a = j; } }
        int bb = -1; float lb = -INFINITY;
        for (int j = 0; j < 8; ++j) { const float l = sl[4 + gt * 8 + j] + b_re[gt * 8 + j]; if (j != a && l > lb) { lb = l; bb = j; } }
        const float wa = 1.f / (1.f + expf(lb - la)); const float wb = 1.f - wa;
        const int ea = gt * 8 + a, eb = gt * 8 + bb;
        const int pa = atomicAdd(&cnt[ea], 1); idx[(size_t)ea * (2 * T) + pa] = 2 * t; wslot[2 * t] = gw * wa;
        const int pb = atomicAdd(&cnt[eb], 1); idx[(size_t)eb * (2 * T) + pb] = 2 * t + 1; wslot[2 * t + 1] = gw * wb;
    }
}

__global__ void k_swiglu(const float* G, float* U) {
    const size_t gid = (size_t)blockIdx.x * blockDim.x + threadIdx.x; U[gid] = silu_f(G[gid]) * U[gid];
}
}

extern "C" void kernel_launch(void* const* d_in, const int* in_sizes, int n_in, void* d_out, int out_size, void* d_ws, size_t ws_size, hipStream_t stream) {
    const float* x = (const float*)d_in[0]; const float* c = (const float*)d_in[1]; const float* w_ada = (const float*)d_in[2]; const float* b_ada = (const float*)d_in[3];
    const float* w_in = (const float*)d_in[4]; const float* b_mgate = (const float*)d_in[5]; const float* conv_w = (const float*)d_in[6]; const float* conv_b = (const float*)d_in[7];
    const float* m_norm_g = (const float*)d_in[8]; const float* w_proj_a = (const float*)d_in[9]; const float* w_proj_m = (const float*)d_in[10]; const float* w_gate = (const float*)d_in[11];
    const float* b_gate = (const float*)d_in[12]; const float* w_out = (const float*)d_in[13]; const float* ln1_g = (const float*)d_in[14]; const float* ln1_b = (const float*)d_in[15];
    const float* w_rg = (const float*)d_in[16]; const float* b_rg = (const float*)d_in[17]; const float* w_re = (const float*)d_in[18]; const float* b_re = (const float*)d_in[19];
    const float* w_eg = (const float*)d_in[20]; const float* w_eu = (const float*)d_in[21]; const float* w_ed = (const float*)d_in[22]; const float* ln2_g = (const float*)d_in[23]; const float* ln2_b = (const float*)d_in[24];
    float* out = (float*)d_out;
    char* ws = (char*)d_ws; size_t off = 0;
    auto carve = [&](size_t bytes) { char* p = ws + off; off += (bytes + 255) & ~(size_t)255; return p; };
    int* cnt = (int*)carve(256); float* mod = (float*)carve((size_t)NB * 6 * D * 4); float* wslot = (float*)carve((size_t)2 * T * 4); int* idx = (int*)carve((size_t)NEXP * 2 * T * 4);
    float* projR = (float*)carve((size_t)T * NIN * 4);
    float* u = (float*)carve((size_t)T * D * 4);
    float* gateb = (float*)carve((size_t)T * 4096 * 4);
    float* qkc = (float*)carve((size_t)T * 2048 * 4);
    float* ya = (float*)carve((size_t)T * 512 * 4);
    float* hbuf = (float*)carve((size_t)T * 1024 * 4);
    float* ym = (float*)carve((size_t)T * 1024 * 4);
    float* PA = (float*)carve((size_t)T * D * 4);
    float* PM = (float*)carve((size_t)T * D * 4);
    float* mix = (float*)carve((size_t)T * D * 4);
    float* x1 = (float*)carve((size_t)T * D * 4);
    if (off > ws_size) return;
    float* Gb = projR; float* Ub = projR + (size_t)2 * T * FF; float* Y2 = projR + (size_t)4 * T * FF;

    hipMemsetAsync(cnt, 0, 256, stream);
    k_mod<<<6 * D / 256, 256, 0, stream>>>(c, w_ada, b_ada, mod);
    k_lnmod<<<T, 256, 0, stream>>>(x, mod, 0, 1, u);
    { GemmP p{u, D, w_in, NIN, projR, NIN, T, NIN, D, nullptr, 0, 0, nullptr, 0}; k_gemm<<<dim3((NIN + 63) / 64, T / 64, 1), 256, 0, stream>>>(p); }
    { GemmP p{u, D, w_gate, 4096, gateb, 4096, T, 4096, D, nullptr, 0, 0, nullptr, 0}; k_gemm<<<dim3(4096 / 64, T / 64, 1), 256, 0, stream>>>(p); }
    k_rope<<<(size_t)T * 24 * 64 / 256, 256, 0, stream>>>(projR);
    k_attn<<<T, 256, 0, stream>>>(projR, ya);
    k_conv<<<(size_t)T * 2048 / 256, 256, 0, stream>>>(projR, conv_w, conv_b, qkc);
    k_mlstm<<<16, 1024, 0, stream>>>(qkc, projR, b_mgate, hbuf);
    k_mnorm<<<T * 4, 256, 0, stream>>>(projR, hbuf, m_norm_g, ym);
    { GemmP p{ya, 512, w_proj_a, D, PA, D, T, D, 512, nullptr, 0, 0, nullptr, 0}; k_gemm<<<dim3(D / 64, T / 64, 1), 256, 0, stream>>>(p); }
    { GemmP p{ym, 1024, w_proj_m, D, PM, D, T, D, 1024, nullptr, 0, 0, nullptr, 0}; k_gemm<<<dim3(D / 64, T / 64, 1), 256, 0, stream>>>(p); }
    k_merge<<<(size_t)T * D / 256, 256, 0, stream>>>(gateb, b_gate, PA, PM);
    { GemmP p{PM, D, w_out, D, mix, D, T, D, D, nullptr, 0, 0, nullptr, 0}; k_gemm<<<dim3(D / 64, T / 64, 1), 256, 0, stream>>>(p); }
    k_resln<<<T, 256, 0, stream>>>(x, mix, nullptr, nullptr, mod, 2, ln1_g, ln1_b, x1, u);
    k_router<<<T, 64, 0, stream>>>(u, w_rg, b_rg, w_re, b_re, cnt, idx, wslot);
    { GemmP p{u, D, w_eg, FF, Gb, FF, 0, FF, D, idx, 2 * T, 1, cnt, (long)D * FF}; k_gemm<<<dim3(FF / 64, 2 * T / 64, NEXP), 256, 0, stream>>>(p); }
    { GemmP p{u, D, w_eu, FF, Ub, FF, 0, FF, D, idx, 2 * T, 1, cnt, (long)D * FF}; k_gemm<<<dim3(FF / 64, 2 * T / 64, NEXP), 256, 0, stream>>>(p); }
    k_swiglu<<<(size_t)2 * T * FF / 256, 256, 0, stream>>>(Gb, Ub);
    { GemmP p{Ub, FF, w_ed, D, Y2, D, 0, D, FF, idx, 2 * T, 0, cnt, (long)FF * D}; k_gemm<<<dim3(D / 64, 2 * T / 64, NEXP), 256, 0, stream>>>(p); }
    k_resln<<<T, 256, 0, stream>>>(x1, Y2, Y2, wslot, mod, 5, ln2_g, ln2_b, out, nullptr);
}
```

```cpp
#include <hip/hip_runtime.h>
#include <stdint.h>
#include <math.h>
#include <stdio.h>

#ifndef MK_DEBUG
#define MK_DEBUG 0
#endif
#ifndef MK_PER_PHASE
#define MK_PER_PHASE 0
#endif

#define LAS __attribute__((address_space(3)))
typedef unsigned short bf16_t;
typedef short bf16x8 __attribute__((ext_vector_type(8)));
typedef short s16x4 __attribute__((ext_vector_type(4)));
typedef float f32x4 __attribute__((ext_vector_type(4)));
typedef float f32x2 __attribute__((ext_vector_type(2)));
typedef unsigned u32x4 __attribute__((ext_vector_type(4)));
typedef unsigned u32x2 __attribute__((ext_vector_type(2)));

constexpr int D = 2048, NB = 4, S = 2048, T = NB * S, NIN = 8712;
constexpr int OFF_QA = 0, OFF_KA = 1536, OFF_VA = 3072, OFF_QKM = 4608, OFF_VM = 6656, OFF_OM = 7680, OFF_IF = 8704;
constexpr int FF = 1024, NEXP = 32, NBIG = 12800;
constexpr float ALPHA = 1.189207115002721f, LN_EPS = 1e-5f;
constexpr float LOG2E = 1.4426950408889634f, LN2 = 0.6931471805599453f;
constexpr float QSCALE = 0.08838834764831845f * 1.4426950408889634f;
constexpr int NTHR = 512, NWAVES = 8;
constexpr int SORT_ROWS = 24576;

constexpr size_t al256(size_t x) { return (x + 255) & ~(size_t)255; }
constexpr size_t WS_CTL = 0, CTL_ZERO_BYTES = 65536;
constexpr int CW_BAR = 0;
constexpr int CW_CNT = 4096;
constexpr int CW_DBG = 4224;
constexpr size_t WS_MOD = 65536;
constexpr size_t WS_ROPE = WS_MOD + al256((size_t)NB * 6 * D * 4);
constexpr size_t WS_WIF = WS_ROPE + (size_t)S * 64 * 2 * 4;
constexpr size_t WS_GPRE = WS_WIF + (size_t)8 * D * 4;
constexpr size_t WS_BCUM = WS_GPRE + (size_t)T * 8 * 4;
constexpr size_t WS_MCUM = WS_BCUM + (size_t)16 * S * 4;
constexpr size_t WS_WRT = WS_MCUM + (size_t)16 * S * 4;
constexpr size_t WS_LSE = WS_WRT + (size_t)2 * 48 * D * 2;
constexpr size_t WS_IDX = WS_LSE + (size_t)T * 12 * 4;
constexpr size_t WS_WL = WS_IDX + (size_t)NEXP * T * 4;
constexpr size_t WS_TOK = WS_WL + (size_t)NEXP * T * 4;
constexpr size_t WS_DN = WS_TOK + (size_t)T * 16;
constexpr size_t WS_NST = WS_DN + (size_t)256 * 256 * 4;
constexpr size_t WS_WBIG = al256(WS_NST + (size_t)256 * 256 * 4);
constexpr size_t WS_WPA = WS_WBIG + (size_t)NBIG * D * 2;
constexpr size_t WS_WPM = WS_WPA + (size_t)D * 512 * 2;
constexpr size_t WS_WO = WS_WPM + (size_t)D * 1024 * 2;
constexpr size_t WS_W1T = WS_WO + (size_t)D * D * 2;
constexpr size_t WS_W2T = WS_W1T + (size_t)NEXP * 2048 * D * 2;
constexpr size_t WS_U = WS_W2T + (size_t)NEXP * D * FF * 2;
constexpr size_t WS_QB = WS_U + (size_t)T * D * 2;
constexpr size_t WS_KB = WS_QB + (size_t)T * 1536 * 2;
constexpr size_t WS_VB = WS_KB + (size_t)T * 1536 * 2;
constexpr size_t WS_QKP = WS_VB + (size_t)T * 1536 * 2;
constexpr size_t WS_VMB = WS_QKP + (size_t)T * 2048 * 2;
constexpr size_t WS_OGB = WS_VMB + (size_t)T * 1024 * 2;
constexpr size_t WS_GB = WS_OGB + (size_t)T * 1024 * 2;
constexpr size_t WS_QM = WS_GB + (size_t)T * 4096 * 2;
constexpr size_t WS_KM = WS_QM + (size_t)T * 1024 * 2;
constexpr size_t WS_OATT = WS_KM + (size_t)T * 1024 * 2;
constexpr size_t WS_YA = WS_OATT + (size_t)T * 1536 * 2;
constexpr size_t WS_YM = WS_YA + (size_t)T * 512 * 2;
constexpr size_t WS_DC = WS_YM + (size_t)T * 1024 * 2;
constexpr size_t WS_CST = WS_DC + (size_t)256 * 65536 * 4;
constexpr size_t WS_MG = WS_CST + (size_t)256 * 65536 * 2;
constexpr size_t WS_PRE = WS_MG + (size_t)T * D * 2;
constexpr size_t WS_END = WS_PRE + (size_t)T * D * 4;
constexpr size_t WS_H = WS_QB;
constexpr size_t WS_Y2 = WS_H + (size_t)SORT_ROWS * FF * 2;
static_assert(WS_Y2 + (size_t)SORT_ROWS * D * 2 <= WS_QM, "overlay");
constexpr size_t WS_DBG0 = WS_END;

constexpr int LDS_MISC = 162816;
constexpr int LDS_BYTES = LDS_MISC + 1024;

__device__ __forceinline__ unsigned cvt_pk_bf16(float lo, float hi) { unsigned r; asm volatile("v_cvt_pk_bf16_f32 %0, %1, %2" : "=v"(r) : "v"(lo), "v"(hi)); return r; }
__device__ __forceinline__ float bf_lo(unsigned w) { return __uint_as_float(w << 16); }
__device__ __forceinline__ float bf_hi(unsigned w) { return __uint_as_float(w & 0xffff0000u); }
__device__ __forceinline__ float bf2f(bf16_t b) { return __uint_as_float(((unsigned)b) << 16); }
__device__ __forceinline__ bf16_t f2bf(float f) { return (bf16_t)(cvt_pk_bf16(f, 0.f) & 0xffffu); }
__device__ __forceinline__ float fast_exp2(float x) { return __builtin_amdgcn_exp2f(x); }
__device__ __forceinline__ float fast_rcp(float x) { return __builtin_amdgcn_rcpf(x); }
__device__ __forceinline__ float sigmoid_fast(float x) { return fast_rcp(1.f + fast_exp2(-x * LOG2E)); }
__device__ __forceinline__ float silu_fast(float x) { return x * sigmoid_fast(x); }
__device__ __forceinline__ float wave_sum(float v) {
#pragma unroll
    for (int o = 32; o >= 1; o >>= 1) v += __shfl_xor(v, o);
    return v; }
__device__ __forceinline__ float wave_max(float v) {
#pragma unroll
    for (int o = 32; o >= 1; o >>= 1) v = fmaxf(v, __shfl_xor(v, o));
    return v; }
__device__ __forceinline__ s16x4 tr_read(unsigned addr) { s16x4 r; asm volatile("ds_read_b64_tr_b16 %0, %1" : "=&v"(r) : "v"(addr) : "memory"); return r; }
__device__ __forceinline__ s16x4 tr_read_o(unsigned base, const int off) { s16x4 r; asm volatile("ds_read_b64_tr_b16 %0, %1 offset:%2" : "=&v"(r) : "v"(base), "n"(off) : "memory"); return r; }
#define LGKM_WAIT0() do { asm volatile("s_waitcnt lgkmcnt(0)" ::: "memory"); __builtin_amdgcn_sched_barrier(0); } while (0)
#define PK8(L, H) ((bf16x8){L[0], L[1], L[2], L[3], H[0], H[1], H[2], H[3]})

#define XB_TMO      128
#define XB_XCNT(j)  (256  + 64 * (j))
#define XB_XSUB(j)  (1280 + 64 * (j))
#define XB_XGEN(j)  (2304 + 64 * (j))
#define XB_TOP      3328
#define XB_TOPGEN   3392
#define XCD_BAR_WORDS 3456
#define XB_SPIN_CAP (1u << 18)
__device__ __forceinline__ unsigned xb_ld(unsigned* p)              { return __hip_atomic_load(p, __ATOMIC_RELAXED, __HIP_MEMORY_SCOPE_AGENT); }
__device__ __forceinline__ unsigned xb_add(unsigned* p, unsigned v) { return __hip_atomic_fetch_add(p, v, __ATOMIC_RELAXED, __HIP_MEMORY_SCOPE_AGENT); }
__device__ __forceinline__ unsigned xb_xcc_id() { return (unsigned)__builtin_amdgcn_s_getreg((3 << 11) | 20) & 0xFu; }
#define XB_SPIN(cond, bar) do { unsigned _sp = 0; while (cond) { __builtin_amdgcn_s_sleep(1); \
    if ((++_sp & 255u) == 0u) { if (xb_ld(&(bar)[XB_TMO])) break; if (_sp > XB_SPIN_CAP) { atomicAdd(&(bar)[XB_TMO], 1u); break; } } } } while (0)
struct XcdBarrier { unsigned* bar; unsigned x; volatile LAS unsigned* st; };
__device__ __forceinline__ XcdBarrier xcd_barrier_post(unsigned* bar, volatile LAS unsigned* st) {
    XcdBarrier b; b.bar = bar; b.x = xb_xcc_id(); b.st = st;
    if (threadIdx.x == 0) (void)xb_add(&bar[XB_XCNT(b.x)], 1u);
    return b;
}
__device__ __forceinline__ void xcd_barrier_complete(unsigned* bar, unsigned x, unsigned& nloc, unsigned& nx) {
    const unsigned G = gridDim.x * gridDim.y * gridDim.z;
    unsigned sum, cnt, mine, sp = 0u;
    for (;;) {
        sum = 0u; cnt = 0u; mine = 0u;
#pragma unroll
        for (unsigned j = 0; j < 16; ++j) { const unsigned c = xb_ld(&bar[XB_XCNT(j)]); sum += c; cnt += (c > 0u) ? 1u : 0u; mine = (j == x) ? c : mine; }
        if (sum == G) break;
        __builtin_amdgcn_s_sleep(1);
        if ((++sp & 255u) == 0u) { if (xb_ld(&bar[XB_TMO])) break; if (sp > XB_SPIN_CAP) { atomicAdd(&bar[XB_TMO], 1u); break; } }
    }
    nloc = mine > 0u ? mine : 1u; nx = cnt > 0u ? cnt : 1u;
}
__device__ __forceinline__ void xcd_barrier(const XcdBarrier& b) {
    asm volatile("s_waitcnt vmcnt(0)" ::: "memory");
    __syncthreads();
    if (threadIdx.x == 0) {
        unsigned* bar = b.bar;
        __builtin_amdgcn_s_waitcnt(0);
        unsigned nloc = b.st[0], nx = b.st[1];
        if (nloc == 0u) { xcd_barrier_complete(bar, b.x, nloc, nx); b.st[0] = nloc; b.st[1] = nx; }
        const unsigned old = xb_add(&bar[XB_XSUB(b.x)], 1u);
        const unsigned gen = old / nloc;
        if (old + 1u == (gen + 1u) * nloc) {
            __builtin_amdgcn_fence(__ATOMIC_RELEASE, "agent");
            asm volatile("s_waitcnt vmcnt(0)" ::: "memory");
            const unsigned og = xb_add(&bar[XB_TOP], 1u);
            const unsigned tg = og / nx;
            if (og + 1u == (tg + 1u) * nx) xb_add(&bar[XB_TOPGEN], 1u);
            else XB_SPIN(xb_ld(&bar[XB_TOPGEN]) == tg, bar);
            __builtin_amdgcn_fence(__ATOMIC_ACQUIRE, "agent");
            xb_add(&bar[XB_XGEN(b.x)], 1u);
            asm volatile("s_waitcnt vmcnt(0)" ::: "memory");
        } else {
            XB_SPIN(xb_ld(&bar[XB_XGEN(b.x)]) == gen, bar);
            __builtin_amdgcn_fence(__ATOMIC_ACQUIRE, "agent");
            asm volatile("s_waitcnt vmcnt(0)" ::: "memory");
        }
    }
    __syncthreads();
}

namespace pg8 {
constexpr int BM = 256, BK = 64, HALF = 128, HTB = HALF * BK * 2, STAGE_BYTES = 8 * HTB, NXCD = 8, WGM = 8;
__host__ __device__ __forceinline__ int lds_byte(int r, int c) { const int st = (r >> 4) * 2 + (c >> 5), rr = r & 15, cc = c & 31, ob = rr * 64 + cc * 2; return st * 1024 + (ob ^ (((ob >> 9) & 1) << 5)); }
__host__ __device__ __forceinline__ void stage_rc(int b, int& R, int& C) { const int st = b / 1024, sb = b % 1024, swz = sb ^ (((sb >> 9) & 1) << 5); R = (st >> 1) * 16 + swz / 64; C = (st & 1) * 32 + (swz % 64) / 2; }
__host__ __device__ __forceinline__ int perm32(int rho) { const int n = rho >> 4, i = rho & 15; return 8 * (i >> 2) + 4 * n + (i & 3); }

struct Unit { int pm, pn, e, it, cnt; };

struct StaticOrder {
    int nM, nN, nwg, G, c;
    __device__ void init(int M, int N, int G_, int c_) { nM = M / BM; nN = N / BM; nwg = nM * nN; G = G_; c = c_; }
    __device__ bool next(int i, Unit& u) const {
        const long L = (long)i * G + c; if (L >= nwg) return false;
        int wgid = (int)L; { const int q = nwg / NXCD, r = nwg % NXCD, xcd = wgid % NXCD, off = wgid / NXCD; wgid = (xcd < r ? xcd * (q + 1) : r * (q + 1) + (xcd - r) * q) + off; }
        const int nig = WGM * nN, gid = wgid / nig, fm = gid * WGM, gsz = (nM - fm) < WGM ? (nM - fm) : WGM;
        u.pm = fm + ((wgid % nig) % gsz); u.pn = (wgid % nig) / gsz; u.e = 0; u.it = 0; u.cnt = 0; return true;
    }
    __device__ __forceinline__ int arow(const Unit&, int r) const { return r; }
};

template <class Epi, class Sched, bool GATHER>
__device__ __forceinline__ void gemm_phase(LAS unsigned char* lds, const bf16_t* Ap, const bf16_t* Btp, const int K, const Sched& S, const Epi& E) {
    const int tid = threadIdx.x, wid = __builtin_amdgcn_readfirstlane(tid >> 6), lane = tid & 63, wr = wid >> 2, wc = wid & 3, fr = lane & 15, fq = lane >> 4;
    const int nt = K / BK;
    unsigned voffA[2], voffB[2]; int RA[2], CA[2];
#pragma unroll
    for (int i = 0; i < 2; ++i) { int R, C; stage_rc(tid * 16 + i * 8192, R, C); const int Rb = Epi::PERM ? ((R & ~31) + perm32(R & 31)) : R;
        RA[i] = R; CA[i] = C; voffA[i] = (unsigned)(R * K + C) * 2u; voffB[i] = (unsigned)(Rb * K + C) * 2u; }
    const size_t kstep = (size_t)(BK * 2);
    const size_t hstep = (size_t)HALF * K * 2;
    const size_t tstep = 2 * hstep;
    const unsigned ldsw = (unsigned)wid * 1024u;
    const int aoff = lds_byte(wr * 64 + fr, fq * 8), boff = lds_byte(wc * 32 + fr, fq * 8);
    unsigned vC[2][2], vN[2][2], v2[2][2];
#define PG8_SA(b, h) (((b) * 2 + (h)) * HTB)
#define PG8_SB(b, h) ((4 + (b) * 2 + (h)) * HTB)
#define PG8_STAGE(bufoff, gbase, voff) do { _Pragma("unroll") for (int _i = 0; _i < 2; ++_i) \
        __builtin_amdgcn_global_load_lds((const unsigned*)((const char*)(gbase) + (voff)[_i]), (LAS unsigned*)(lds + (bufoff) + ldsw + _i * 8192), 16, 0, 0); } while (0)
#define PG8_STAGE_A(bufoff, gbase, h, vsel) do { if constexpr (GATHER) { PG8_STAGE(bufoff, gbase, (vsel)[h]); } else { PG8_STAGE(bufoff, (gbase) + (h) * hstep, voffA); } } while (0)
#define PG8_GVOFF(u, v) do { _Pragma("unroll") for (int _h = 0; _h < 2; ++_h) _Pragma("unroll") for (int _i = 0; _i < 2; ++_i) \
        (v)[_h][_i] = (unsigned)(S.arow(u, _h * HALF + RA[_i]) * K + CA[_i]) * 2u; } while (0)
#define PG8_LDA(dst, b, h) do { _Pragma("unroll") for (int m = 0; m < 4; ++m) _Pragma("unroll") for (int k = 0; k < 2; ++k) dst[m][k] = *(const LAS bf16x8*)(lds + PG8_SA(b, h) + aoff + m * 2048 + k * 1024); } while (0)
#define PG8_LDB(dst, b, h) do { _Pragma("unroll") for (int n = 0; n < 2; ++n) _Pragma("unroll") for (int k = 0; k < 2; ++k) dst[n][k] = *(const LAS bf16x8*)(lds + PG8_SB(b, h) + boff + n * 2048 + k * 1024); } while (0)
#define PG8_MMA(ai, bj, At, Bt) do { __builtin_amdgcn_s_setprio(1); _Pragma("unroll") for (int m = 0; m < 4; ++m) _Pragma("unroll") for (int n = 0; n < 2; ++n) _Pragma("unroll") for (int k = 0; k < 2; ++k) \
        acc[ai][bj][m][n] = __builtin_amdgcn_mfma_f32_16x16x32_bf16(Bt[n][k], At[m][k], acc[ai][bj][m][n], 0, 0, 0); __builtin_amdgcn_s_setprio(0); } while (0)
#define PG8_WAIT_V(n) asm volatile("s_waitcnt vmcnt(" #n ")" ::: "memory")
#define PG8_WAIT_L(n) asm volatile("s_waitcnt lgkmcnt(" #n ")" ::: "memory")
#define PG8_BAR __builtin_amdgcn_s_barrier()
#define PG8_SCHED __builtin_amdgcn_sched_barrier(0)
    Unit cur, nxt; int ui = 0;
    if (!S.next(0, cur)) return;
    f32x4 acc[2][2][4][2];
#pragma unroll
    for (int a = 0; a < 2; ++a)
#pragma unroll
        for (int b = 0; b < 2; ++b)
#pragma unroll
            for (int m = 0; m < 4; ++m)
#pragma unroll
                for (int n = 0; n < 2; ++n) acc[a][b][m][n] = (f32x4){0.f, 0.f, 0.f, 0.f};
    bf16x8 At[4][2], B0[2][2], B1[2][2];
    const char* cA = GATHER ? (const char*)Ap : (const char*)Ap + (size_t)cur.pm * tstep; const char* cB = (const char*)Btp + (size_t)cur.pn * tstep;
    if constexpr (GATHER) { PG8_GVOFF(cur, vC); }
    PG8_STAGE(PG8_SB(0, 0), cB, voffB); PG8_STAGE(PG8_SB(0, 1), cB + hstep, voffB); PG8_STAGE_A(PG8_SA(0, 0), cA, 0, vC); PG8_STAGE_A(PG8_SA(0, 1), cA, 1, vC);
    if (wr == 1) PG8_BAR;
    PG8_WAIT_V(2); PG8_BAR;
    PG8_STAGE(PG8_SB(1, 0), cB + kstep, voffB); PG8_STAGE_A(PG8_SA(1, 0), cA + kstep, 0, vC); PG8_STAGE(PG8_SB(1, 1), cB + hstep + kstep, voffB);
    PG8_WAIT_V(6); PG8_BAR;
    for (;;) {
        const bool has_next = S.next(ui + 1, nxt);
        const char* nA = GATHER ? (const char*)Ap : (has_next ? (const char*)Ap + (size_t)nxt.pm * tstep : cA);
        const char* nB = has_next ? (const char*)Btp + (size_t)nxt.pn * tstep : cB;
        if constexpr (GATHER) { if (has_next) { PG8_GVOFF(nxt, vN); } else {
#pragma unroll
            for (int h = 0; h < 2; ++h) { vN[h][0] = vC[h][0]; vN[h][1] = vC[h][1]; } } }
        for (int t = 0; t < nt; t += 2) {
            const bool last = (t == nt - 2);
            const char* a1 = cA + (size_t)(t + 1) * kstep;
            const char* a2 = last ? nA : cA + (size_t)(t + 2) * kstep; const char* b2 = last ? nB : cB + (size_t)(t + 2) * kstep;
            const char* a3 = a2 + kstep; const char* b3 = b2 + kstep;
            if constexpr (GATHER) {
#pragma unroll
                for (int h = 0; h < 2; ++h) { v2[h][0] = last ? vN[h][0] : vC[h][0]; v2[h][1] = last ? vN[h][1] : vC[h][1]; } }
            PG8_LDB(B0, 0, 0); PG8_LDB(B1, 0, 1); PG8_SCHED; PG8_LDA(At, 0, 0); PG8_STAGE_A(PG8_SA(1, 1), a1, 1, vC);
            PG8_WAIT_V(8); PG8_WAIT_L(0); PG8_BAR; PG8_MMA(0, 0, At, B0); PG8_MMA(0, 1, At, B1); PG8_BAR; PG8_SCHED;
            PG8_LDA(At, 0, 1); PG8_STAGE(PG8_SB(0, 0), b2, voffB); PG8_STAGE(PG8_SB(0, 1), b2 + hstep, voffB); PG8_STAGE_A(PG8_SA(0, 0), a2, 0, v2);
            PG8_WAIT_V(8); PG8_WAIT_L(0); PG8_BAR; PG8_MMA(1, 0, At, B0); PG8_MMA(1, 1, At, B1); PG8_BAR; PG8_SCHED;
            PG8_LDB(B0, 1, 0); PG8_LDB(B1, 1, 1); PG8_SCHED; PG8_LDA(At, 1, 0); PG8_STAGE_A(PG8_SA(0, 1), a2, 1, v2);
            PG8_WAIT_V(8); PG8_WAIT_L(0); PG8_BAR; PG8_MMA(0, 0, At, B0); PG8_MMA(0, 1, At, B1); PG8_BAR; PG8_SCHED;
            PG8_LDA(At, 1, 1); PG8_STAGE(PG8_SB(1, 0), b3, voffB); PG8_STAGE(PG8_SB(1, 1), b3 + hstep, voffB); PG8_STAGE_A(PG8_SA(1, 0), a3, 0, v2);
            PG8_WAIT_V(8); PG8_WAIT_L(0); PG8_BAR; PG8_MMA(1, 0, At, B0); PG8_MMA(1, 1, At, B1); PG8_BAR; PG8_SCHED;
        }
        if (wr == 0) PG8_BAR;
        E(acc, cur, wr, wc, fr, fq);
        if (!has_next) break;
#pragma unroll
        for (int a = 0; a < 2; ++a)
#pragma unroll
            for (int b = 0; b < 2; ++b)
#pragma unroll
                for (int m = 0; m < 4; ++m)
#pragma unroll
                    for (int n = 0; n < 2; ++n) acc[a][b][m][n] = (f32x4){0.f, 0.f, 0.f, 0.f};
        cur = nxt; cA = nA; cB = nB; ++ui;
        if constexpr (GATHER) {
#pragma unroll
            for (int h = 0; h < 2; ++h) { vC[h][0] = vN[h][0]; vC[h][1] = vN[h][1]; } }
        if (wr == 1) PG8_BAR;
    }
    PG8_WAIT_V(0);
    PG8_BAR;
#undef PG8_SA
#undef PG8_SB
#undef PG8_STAGE
#undef PG8_STAGE_A
#undef PG8_GVOFF
#undef PG8_LDA
#undef PG8_LDB
#undef PG8_MMA
#undef PG8_WAIT_V
#undef PG8_WAIT_L
#undef PG8_BAR
#undef PG8_SCHED
}
}

struct Params { const float* in[25]; float* out; unsigned char* ws; int ph_lo, ph_hi; };
struct Frame {
    LAS unsigned char* lds; int G, bx;
    unsigned char* ws;
    const float *x, *c, *w_ada, *b_ada, *w_in, *b_mgate, *conv_w, *conv_b, *m_norm_g, *w_proj_a, *w_proj_m, *w_gate, *b_gate, *w_out, *ln1_g, *ln1_b, *w_rg, *b_rg, *w_re, *b_re, *w_eg, *w_eu, *w_ed, *ln2_g, *ln2_b;
    float* out;
};
__device__ __forceinline__ int otid() { int t = threadIdx.x; asm volatile("" : "+v"(t)); return t; }
#define FTID otid()
#define FLANE (otid() & 63)
#define FWAVE __builtin_amdgcn_readfirstlane(otid() >> 6)
#define WSP(T_, off) ((T_*)(F.ws + (off)))

template <class RowMap>
__device__ __forceinline__ void cvt_tile(const Frame& F, const float* src, int lds_src, int k0, int n0, bf16_t* dst, int Kdst, const RowMap& rm) {
    LAS bf16_t* tl = (LAS bf16_t*)F.lds;
    const int t = FTID;
    f32x4 v[8];
#pragma unroll
    for (int p = 0; p < 8; ++p) { const int k = (t >> 6) + 8 * p, n4 = (t & 63) * 4; v[p] = *(const f32x4*)(src + (size_t)(k0 + k) * lds_src + n0 + n4); }
    __syncthreads();
#pragma unroll
    for (int p = 0; p < 8; ++p) { const int k = (t >> 6) + 8 * p, n4 = (t & 63) * 4;
#pragma unroll
        for (int j = 0; j < 4; ++j) tl[(n4 + j) * 72 + k] = f2bf(v[p][j]); }
    __syncthreads();
#pragma unroll
    for (int p = 0; p < 4; ++p) { const int id = t + 512 * p; const int n = id >> 3, kc = (id & 7) * 8;
        const u32x4 w = *(const LAS u32x4*)(tl + n * 72 + kc);
        *(u32x4*)(dst + (size_t)rm(n0 + n) * Kdst + k0 + kc) = w; }
}
struct RmWin { __device__ int operator()(int n) const { if (n < 3072) { const int hd = n >> 7, lc = n & 127; return hd * 128 + 2 * (lc & 63) + (lc >> 6); } return n; } };
struct RmOff { int off; __device__ int operator()(int n) const { return n + off; } };
struct RmW1 { int up; __device__ int operator()(int f) const { return 256 * (f >> 7) + 128 * up + (f & 127); } };

__device__ __forceinline__ void p0_prologue(const Frame& F) {
    const int G = F.G, bx = F.bx;
    bf16_t* WBIG = WSP(bf16_t, WS_WBIG); bf16_t* WPA = WSP(bf16_t, WS_WPA); bf16_t* WPM = WSP(bf16_t, WS_WPM); bf16_t* WO = WSP(bf16_t, WS_WO);
    bf16_t* W1T = WSP(bf16_t, WS_W1T); bf16_t* W2T = WSP(bf16_t, WS_W2T);
    constexpr int T_WIN = 32 * 34, T_WG = 32 * 16, T_PA = 8 * 8, T_PM = 16 * 8, T_WO = 32 * 8, T_EG = 32 * 4 * 32, T_ED = 16 * 8 * 32;
    constexpr int E0 = T_WIN, E1 = E0 + T_WG, E2 = E1 + T_PA, E3 = E2 + T_PM, E4 = E3 + T_WO, E5 = E4 + T_EG, E6 = E5 + T_EG, E7 = E6 + T_ED;
    for (int ti = bx; ti < E7; ti += G) {
        if (ti < E0) { const int kt = ti % 32, ntl = ti / 32; cvt_tile(F, F.w_in, NIN, kt * 64, ntl * 256, WBIG, D, RmWin{}); }
        else if (ti < E1) { const int q = ti - E0; const int kt = q % 32, ntl = q / 32; cvt_tile(F, F.w_gate, 4096, kt * 64, ntl * 256, WBIG, D, RmOff{8704}); }
        else if (ti < E2) { const int q = ti - E1; const int kt = q % 8, ntl = q / 8; cvt_tile(F, F.w_proj_a, D, kt * 64, ntl * 256, WPA, 512, RmOff{0}); }
        else if (ti < E3) { const int q = ti - E2; const int kt = q % 16, ntl = q / 16; cvt_tile(F, F.w_proj_m, D, kt * 64, ntl * 256, WPM, 1024, RmOff{0}); }
        else if (ti < E4) { const int q = ti - E3; const int kt = q % 32, ntl = q / 32; cvt_tile(F, F.w_out, D, kt * 64, ntl * 256, WO, D, RmOff{0}); }
        else if (ti < E5) { const int q = ti - E4; const int kt = q % 32, ntl = (q / 32) % 4, e = q / 128; cvt_tile(F, F.w_eg + (size_t)e * D * FF, FF, kt * 64, ntl * 256, W1T + (size_t)e * 2048 * D, D, RmW1{0}); }
        else if (ti < E6) { const int q = ti - E5; const int kt = q % 32, ntl = (q / 32) % 4, e = q / 128; cvt_tile(F, F.w_eu + (size_t)e * D * FF, FF, kt * 64, ntl * 256, W1T + (size_t)e * 2048 * D, D, RmW1{1}); }
        else { const int q = ti - E6; const int kt = q % 16, ntl = (q / 16) % 8, e = q / 128; cvt_tile(F, F.w_ed + (size_t)e * FF * D, D, kt * 64, ntl * 256, W2T + (size_t)e * D * FF, FF, RmOff{0}); }
    }
    __syncthreads();
    {
        LAS float* sc = (LAS float*)F.lds;
        LAS float* red = (LAS float*)(F.lds + 32768);
        float* mod = WSP(float, WS_MOD);
        for (int i = FTID; i < NB * D; i += NTHR) { const float cv = F.c[i]; sc[i] = cv / (1.f + expf(-cv)); }
        __syncthreads();
        for (int cb = bx; cb < 6 * D / 48; cb += G) {
            const int cg = FTID % 12, kl = FTID / 12;
            float a[4][4] = {};
            if (kl < 42) {
                for (int k = kl; k < D; k += 42) { const f32x4 w = *(const f32x4*)(F.w_ada + (size_t)k * (6 * D) + cb * 48 + cg * 4);
#pragma unroll
                    for (int b = 0; b < 4; ++b) { const float s = sc[b * D + k];
#pragma unroll
                        for (int j = 0; j < 4; ++j) a[b][j] += s * w[j]; } }
#pragma unroll
                for (int b = 0; b < 4; ++b)
#pragma unroll
                    for (int j = 0; j < 4; ++j) red[(kl * 12 + cg) * 16 + b * 4 + j] = a[b][j];
            }
            __syncthreads();
            if (FTID < 192) { const int cgi = FTID / 16, bj = FTID % 16; float s = 0.f; for (int q = 0; q < 42; ++q) s += red[(q * 12 + cgi) * 16 + bj];
                const int b = bj / 4, j = bj % 4; const int col = cb * 48 + cgi * 4 + j; mod[(size_t)b * 6 * D + col] = s + F.b_ada[col]; }
            __syncthreads();
        }
    }
    {
        float* rope = WSP(float, WS_ROPE);
        for (int i = bx * NTHR + FTID; i < S * 64; i += G * NTHR) { const int pos = i >> 6, fi = i & 63;
            const float inv = powf(10000.f, -(float)(2 * fi) / 128.f); const float ang = (float)pos * inv; rope[2 * i] = cosf(ang); rope[2 * i + 1] = sinf(ang); }
        float* wif = WSP(float, WS_WIF);
        for (int i = bx * NTHR + FTID; i < 8 * D; i += G * NTHR) { const int j = i / D, k = i % D; wif[i] = F.w_in[(size_t)k * NIN + OFF_IF + j]; }
        bf16_t* wrt = WSP(bf16_t, WS_WRT);
        for (int i = bx * NTHR + FTID; i < 48 * D; i += G * NTHR) { const int j = i / D, k = i % D;
            const float w = (j < 4) ? F.w_rg[k * 4 + j] : (j < 36 ? F.w_re[k * 32 + (j - 4)] : 0.f);
            const bf16_t hi = f2bf(w); const bf16_t lo = f2bf(w - bf2f(hi)); wrt[i] = hi; wrt[48 * D + i] = lo; }
    }
}

__device__ __forceinline__ void p1_lnmod(const Frame& F) {
    const float* mod = WSP(float, WS_MOD); const float* wif = WSP(float, WS_WIF); bf16_t* U = WSP(bf16_t, WS_U); float* gpre = WSP(float, WS_GPRE);
    const int gw = F.bx * NWAVES + FWAVE, NGW = F.G * NWAVES, lane = FLANE;
    for (int t = gw; t < T; t += NGW) {
        const int b = t / S;
        f32x4 v[8]; float s = 0.f;
#pragma unroll
        for (int i = 0; i < 8; ++i) { v[i] = *(const f32x4*)(F.x + (size_t)t * D + 4 * (lane + 64 * i)); s += (v[i][0] + v[i][1]) + (v[i][2] + v[i][3]); }
        const float mu = wave_sum(s) * (1.f / D);
        float q = 0.f;
#pragma unroll
        for (int i = 0; i < 8; ++i) { v[i] = v[i] - mu; q += (v[i][0] * v[i][0] + v[i][1] * v[i][1]) + (v[i][2] * v[i][2] + v[i][3] * v[i][3]); }
        const float rstd = rsqrtf(wave_sum(q) * (1.f / D) + LN_EPS);
        const float* sc = mod + (size_t)b * 6 * D + 1 * D; const float* sf = mod + (size_t)b * 6 * D;
#pragma unroll
        for (int i = 0; i < 8; ++i) { const int d = 4 * (lane + 64 * i); const f32x4 a = *(const f32x4*)(sc + d), bb = *(const f32x4*)(sf + d);
            v[i] = v[i] * rstd * (a + 1.f) + bb;
            u32x2 w; w.x = cvt_pk_bf16(v[i][0], v[i][1]); w.y = cvt_pk_bf16(v[i][2], v[i][3]); *(u32x2*)(U + (size_t)t * D + d) = w; }
        float g[8];
#pragma unroll
        for (int j = 0; j < 8; ++j) { float a = 0.f;
#pragma unroll
            for (int i = 0; i < 8; ++i) { const f32x4 w = *(const f32x4*)(wif + (size_t)j * D + 4 * (lane + 64 * i)); a += (v[i][0] * w[0] + v[i][1] * w[1]) + (v[i][2] * w[2] + v[i][3] * w[3]); }
            g[j] = wave_sum(a); }
        if (lane < 8) { float val = 0.f;
#pragma unroll
            for (int j = 0; j < 8; ++j) val = (lane == j) ? g[j] : val;
            val += F.b_mgate[lane];
            if (lane >= 4) val = fminf(val, 0.f) - log1pf(expf(-fabsf(val)));
            gpre[(size_t)t * 8 + lane] = val; }
    }
}

struct EpiP2 {
    static constexpr bool PERM = true;
    bf16_t *Q, *Kb, *V, *QKP, *VM, *OG, *GB; const float* rope; const float* b_gate;
    __device__ __forceinline__ void operator()(const f32x4 (&acc)[2][2][4][2], const pg8::Unit& u, int wr, int wc, int fr, int fq) const {
        const int pn = u.pn; int kind, coff, ldc; bf16_t* base;
        if (pn < 6) { kind = 0; base = Q; ldc = 1536; coff = pn * 256; }
        else if (pn < 12) { kind = 1; base = Kb; ldc = 1536; coff = (pn - 6) * 256; }
        else if (pn < 18) { kind = 2; base = V; ldc = 1536; coff = (pn - 12) * 256; }
        else if (pn < 26) { kind = 2; base = QKP; ldc = 2048; coff = (pn - 18) * 256; }
        else if (pn < 30) { kind = 2; base = VM; ldc = 1024; coff = (pn - 26) * 256; }
        else if (pn < 34) { kind = 3; base = OG; ldc = 1024; coff = (pn - 30) * 256; }
        else { kind = 4; base = GB; ldc = 4096; coff = (pn - 34) * 256; }
        const int row0 = u.pm * 256 + wr * 64 + fr, colL = wc * 32 + 8 * fq;
#pragma unroll
        for (int ai = 0; ai < 2; ++ai)
#pragma unroll
            for (int m = 0; m < 4; ++m) { const int r = row0 + ai * 128 + m * 16; const int pos = r & (S - 1);
#pragma unroll
                for (int bj = 0; bj < 2; ++bj) { f32x4 v0 = acc[ai][bj][m][0], v1 = acc[ai][bj][m][1]; const int col = coff + bj * 128 + colL;
                    if (kind <= 1) {
                        const float* rp = rope + ((size_t)pos * 64 + (16 * wc + 4 * fq)) * 2;
                        const f32x4 c0 = *(const f32x4*)rp, c1 = *(const f32x4*)(rp + 4);
                        const float sc = (kind == 0) ? QSCALE : 1.f;
                        f32x4 o0, o1;
                        o0[0] = (v0[0] * c0[0] - v0[1] * c0[1]) * sc; o0[1] = (v0[1] * c0[0] + v0[0] * c0[1]) * sc;
                        o0[2] = (v0[2] * c0[2] - v0[3] * c0[3]) * sc; o0[3] = (v0[3] * c0[2] + v0[2] * c0[3]) * sc;
                        o1[0] = (v1[0] * c1[0] - v1[1] * c1[1]) * sc; o1[1] = (v1[1] * c1[0] + v1[0] * c1[1]) * sc;
                        o1[2] = (v1[2] * c1[2] - v1[3] * c1[3]) * sc; o1[3] = (v1[3] * c1[2] + v1[2] * c1[3]) * sc;
                        v0 = o0; v1 = o1;
                    } else if (kind >= 3) {
                        if (kind == 4) { v0 = v0 + *(const f32x4*)(b_gate + col); v1 = v1 + *(const f32x4*)(b_gate + col + 4); }
#pragma unroll
                        for (int j = 0; j < 4; ++j) { v0[j] = sigmoid_fast(v0[j]); v1[j] = sigmoid_fast(v1[j]); }
                    }
                    u32x4 w; w.x = cvt_pk_bf16(v0[0], v0[1]); w.y = cvt_pk_bf16(v0[2], v0[3]); w.z = cvt_pk_bf16(v1[0], v1[1]); w.w = cvt_pk_bf16(v1[2], v1[3]);
                    *(u32x4*)(base + (size_t)r * ldc + col) = w; } }
    }
};

__device__ __forceinline__ void scan_bh(const Frame& F, int bh) {
    const float* gpre = WSP(float, WS_GPRE); float* bc = WSP(float, WS_BCUM) + (size_t)bh * S; float* mc = WSP(float, WS_MCUM) + (size_t)bh * S;
    const int b = bh >> 2, h = bh & 3, lane = FLANE;
    float lf[32], iv[32];
#pragma unroll
    for (int j = 0; j < 32; ++j) { const size_t t = (size_t)b * S + lane * 32 + j; iv[j] = gpre[t * 8 + h]; lf[j] = gpre[t * 8 + 4 + h]; }
    float run = 0.f;
#pragma unroll
    for (int j = 0; j < 32; ++j) { run += lf[j]; lf[j] = run; }
    float tot = run, incl = run;
#pragma unroll
    for (int o = 1; o < 64; o <<= 1) { const float n = __shfl_up(incl, o); if (lane >= o) incl += n; }
    const float excl = incl - tot;
    float mx = -INFINITY;
#pragma unroll
    for (int j = 0; j < 32; ++j) { lf[j] += excl; mx = fmaxf(mx, iv[j] - lf[j]); iv[j] = mx; }
    float mincl = mx;
#pragma unroll
    for (int o = 1; o < 64; o <<= 1) { const float n = __shfl_up(mincl, o); if (lane >= o) mincl = fmaxf(mincl, n); }
    float mexcl = __shfl_up(mincl, 1); if (lane == 0) mexcl = -INFINITY;
#pragma unroll
    for (int j = 0; j < 32; ++j) { const float cm = fmaxf(0.f, fmaxf(mexcl, iv[j])); bc[lane * 32 + j] = lf[j]; mc[lane * 32 + j] = lf[j] + cm; }
}

__device__ __forceinline__ void p3_conv(const Frame& F) {
    const bf16_t* QKP = WSP(bf16_t, WS_QKP); bf16_t* QM = WSP(bf16_t, WS_QM); bf16_t* KM = WSP(bf16_t, WS_KM);
    for (int item = F.bx * NTHR + FTID; item < 256 * 512; item += F.G * NTHR) {
        const int cc = item & 255, rs = item >> 8; const int c0 = cc * 8, t0 = rs * 16;
        float w[4][8], bias[8];
#pragma unroll
        for (int j = 0; j < 4; ++j) { const f32x4 a = *(const f32x4*)(F.conv_w + j * 2048 + c0), b = *(const f32x4*)(F.conv_w + j * 2048 + c0 + 4);
#pragma unroll
            for (int e = 0; e < 4; ++e) { w[j][e] = a[e]; w[j][4 + e] = b[e]; } }
        { const f32x4 a = *(const f32x4*)(F.conv_b + c0), b = *(const f32x4*)(F.conv_b + c0 + 4);
#pragma unroll
            for (int e = 0; e < 4; ++e) { bias[e] = a[e]; bias[4 + e] = b[e]; } }
        float x1[8], x2[8], x3[8];
        const int pos0 = t0 & (S - 1);
        auto ldrow = [&](int t, float (&dst)[8]) { const u32x4 v = *(const u32x4*)(QKP + (size_t)t * 2048 + c0);
            dst[0] = bf_lo(v.x); dst[1] = bf_hi(v.x); dst[2] = bf_lo(v.y); dst[3] = bf_hi(v.y); dst[4] = bf_lo(v.z); dst[5] = bf_hi(v.z); dst[6] = bf_lo(v.w); dst[7] = bf_hi(v.w); };
        if (pos0 >= 3) { ldrow(t0 - 1, x1); ldrow(t0 - 2, x2); ldrow(t0 - 3, x3); }
        else {
#pragma unroll
            for (int e = 0; e < 8; ++e) { x1[e] = 0.f; x2[e] = 0.f; x3[e] = 0.f; } }
        const bool isk = c0 >= 1024; bf16_t* dst = isk ? (KM + (c0 - 1024)) : (QM + c0); const float osc = isk ? 0.0625f : 1.f;
#pragma unroll 4
        for (int r = 0; r < 16; ++r) { float x0[8]; ldrow(t0 + r, x0); float y[8];
#pragma unroll
            for (int e = 0; e < 8; ++e) { y[e] = bias[e] + w[3][e] * x0[e] + w[2][e] * x1[e] + w[1][e] * x2[e] + w[0][e] * x3[e]; y[e] = silu_fast(y[e]) * osc; x3[e] = x2[e]; x2[e] = x1[e]; x1[e] = x0[e]; }
            u32x4 o; o.x = cvt_pk_bf16(y[0], y[1]); o.y = cvt_pk_bf16(y[2], y[3]); o.z = cvt_pk_bf16(y[4], y[5]); o.w = cvt_pk_bf16(y[6], y[7]);
            *(u32x4*)(dst + (size_t)(t0 + r) * 1024) = o; }
    }
}

constexpr int AT_KP = 272, AT_VP = 288, AT_VOFF = 256 * AT_KP;
__device__ __forceinline__ void attn_unit(const Frame& F, int unit) {
    const bf16_t* QB = WSP(bf16_t, WS_QB); const bf16_t* KB = WSP(bf16_t, WS_KB); const bf16_t* VB = WSP(bf16_t, WS_VB); bf16_t* OA = WSP(bf16_t, WS_OATT); float* LSE = WSP(float, WS_LSE);
    const int b = unit / 192, rem = unit % 192, head = rem >> 4, blk = rem & 15;
    const int g = head >> 2; const int dl = (g == 0) ? 0 : (g == 1 ? 2 : 4); const int d = 1 << dl; const int nbr = 16 >> dl;
    const int r = blk / nbr, n = blk % nbr;
    const int tid = FTID, lane = FLANE, w = FWAVE, jl = lane & 15, g4 = lane >> 4;
    LAS unsigned char* Ks = F.lds; LAS unsigned char* Vs = F.lds + AT_VOFF;
    __syncthreads();
#pragma unroll
    for (int pass = 0; pass < 2; ++pass) {
        u32x4 v[8];
#pragma unroll
        for (int i = 0; i < 8; ++i) { const int id = tid + NTHR * i; const int row = id >> 4, ch = id & 15; const int bn = (row < 128) ? n - 1 : n; const int lr = row & 127;
            const int pos = ((bn * 128 + lr) << dl) + r;
            const bf16_t* src = (pass == 0 ? KB : VB) + (size_t)(b * S + pos) * 1536 + head * 128 + ch * 8;
            v[i] = (bn >= 0) ? *(const u32x4*)src : (u32x4){0u, 0u, 0u, 0u}; }
#pragma unroll
        for (int i = 0; i < 8; ++i) { const int id = tid + NTHR * i; const int row = id >> 4, ch = id & 15;
            if (pass == 0) *(LAS u32x4*)(Ks + row * AT_KP + ch * 16) = v[i]; else *(LAS u32x4*)(Vs + row * AT_VP + ch * 16) = v[i]; }
    }
    const int posq = (((n * 128 + 16 * w + jl)) << dl) + r;
    const size_t tq = (size_t)b * S + posq;
    bf16x8 qf[4];
#pragma unroll
    for (int ks = 0; ks < 4; ++ks) qf[ks] = *(const bf16x8*)(QB + tq * 1536 + head * 128 + ks * 32 + 8 * g4);
    __syncthreads();
    f32x4 sT[10];
#pragma unroll
    for (int u = 0; u < 9; ++u) { f32x4 a = {0.f, 0.f, 0.f, 0.f};
#pragma unroll
        for (int ks = 0; ks < 4; ++ks) { const bf16x8 kf = *(const LAS bf16x8*)(Ks + (16 * (w + u) + jl) * AT_KP + (ks * 32 + 8 * g4) * 2); a = __builtin_amdgcn_mfma_f32_16x16x32_bf16(kf, qf[ks], a, 0, 0, 0); }
        sT[u] = a; }
    sT[9] = (f32x4){0.f, 0.f, 0.f, 0.f};
    float mx = -INFINITY;
#pragma unroll
    for (int u = 0; u < 9; ++u)
#pragma unroll
        for (int rg = 0; rg < 4; ++rg) { const int kin = 4 * g4 + rg; bool valid;
            if (u == 0) valid = (n > 0) && (kin >= jl); else if (u == 8) valid = (kin <= jl); else valid = (w + u >= 8) || (n > 0);
            const float s = valid ? sT[u][rg] : -INFINITY; sT[u][rg] = s; mx = fmaxf(mx, s); }
    mx = fmaxf(mx, __shfl_xor(mx, 16)); mx = fmaxf(mx, __shfl_xor(mx, 32));
    float den = 0.f;
#pragma unroll
    for (int u = 0; u < 9; ++u)
#pragma unroll
        for (int rg = 0; rg < 4; ++rg) { const float p = fast_exp2(sT[u][rg] - mx); sT[u][rg] = p; den += p; }
    den += __shfl_xor(den, 16); den += __shfl_xor(den, 32);
    f32x4 oT[8];
#pragma unroll
    for (int et = 0; et < 8; ++et) oT[et] = (f32x4){0.f, 0.f, 0.f, 0.f};
    const unsigned vbase = (unsigned)(uintptr_t)(Vs) + (unsigned)((4 * g4 + (jl >> 2)) * AT_VP + (jl & 3) * 8);
#pragma unroll
    for (int c = 0; c < 5; ++c) {
        const int kt0 = w + 2 * c, kt1 = (c == 4) ? kt0 : kt0 + 1;
        union { bf16x8 v; unsigned u[4]; } pf;
        pf.u[0] = cvt_pk_bf16(sT[2 * c][0], sT[2 * c][1]); pf.u[1] = cvt_pk_bf16(sT[2 * c][2], sT[2 * c][3]);
        pf.u[2] = cvt_pk_bf16(sT[2 * c + 1][0], sT[2 * c + 1][1]); pf.u[3] = cvt_pk_bf16(sT[2 * c + 1][2], sT[2 * c + 1][3]);
        s16x4 t0[8], t1[8];
        const unsigned vb0 = vbase + kt0 * 16 * AT_VP, vb1 = vbase + kt1 * 16 * AT_VP;
#pragma unroll
        for (int et = 0; et < 8; ++et) { t0[et] = tr_read_o(vb0, et * 32); t1[et] = tr_read_o(vb1, et * 32); }
        LGKM_WAIT0();
#pragma unroll
        for (int et = 0; et < 8; ++et) oT[et] = __builtin_amdgcn_mfma_f32_16x16x32_bf16(PK8(t0[et], t1[et]), pf.v, oT[et], 0, 0, 0);
    }
    const float inv = 1.f / den;
#pragma unroll
    for (int et = 0; et < 8; ++et) { u32x2 o; o.x = cvt_pk_bf16(oT[et][0] * inv, oT[et][1] * inv); o.y = cvt_pk_bf16(oT[et][2] * inv, oT[et][3] * inv);
        *(u32x2*)(OA + tq * 1536 + head * 128 + 16 * et + 4 * g4) = o; }
    if (g4 == 0) LSE[tq * 12 + head] = (mx + log2f(den)) * LN2;
}

constexpr int ML_P = 544;
__device__ __forceinline__ void mlstm_dc_unit(const Frame& F, int unit) {
    const bf16_t* KM = WSP(bf16_t, WS_KM); const bf16_t* VM = WSP(bf16_t, WS_VMB); const float* gpre = WSP(float, WS_GPRE);
    const float* bcum = WSP(float, WS_BCUM); const float* mcum = WSP(float, WS_MCUM); float* DC = WSP(float, WS_DC) + (size_t)unit * 65536; float* DN = WSP(float, WS_DN) + (size_t)unit * 256;
    const int bh = unit >> 4, c = unit & 15, b = bh >> 2, h = bh & 3; const size_t t0 = (size_t)b * S + c * 128;
    const int tid = FTID, lane = FLANE, w = FWAVE, jl = lane & 15, g4 = lane >> 4;
    LAS unsigned char* Ks = F.lds; LAS unsigned char* Vs = F.lds + 128 * ML_P; LAS float* wt = (LAS float*)(F.lds + 2 * 128 * ML_P);
    __syncthreads();
    if (tid < 128) { const float Be = bcum[bh * S + c * 128 + 127], me = mcum[bh * S + c * 128 + 127];
        wt[tid] = expf(Be - bcum[bh * S + c * 128 + tid] + gpre[(t0 + tid) * 8 + h] - me); }
    __syncthreads();
    {
        u32x4 v[8];
#pragma unroll
        for (int i = 0; i < 8; ++i) { const int id = tid + NTHR * i; const int row = id >> 5, ch = id & 31; v[i] = *(const u32x4*)(KM + (t0 + row) * 1024 + h * 256 + ch * 8); }
#pragma unroll
        for (int i = 0; i < 8; ++i) { const int id = tid + NTHR * i; const int row = id >> 5, ch = id & 31; *(LAS u32x4*)(Ks + row * ML_P + ch * 16) = v[i]; }
#pragma unroll
        for (int i = 0; i < 8; ++i) { const int id = tid + NTHR * i; const int row = id >> 5, ch = id & 31; v[i] = *(const u32x4*)(VM + (t0 + row) * 1024 + h * 256 + ch * 8); }
#pragma unroll
        for (int i = 0; i < 8; ++i) { const int id = tid + NTHR * i; const int row = id >> 5, ch = id & 31; const float ws_ = wt[row]; u32x4 o;
            o.x = cvt_pk_bf16(bf_lo(v[i].x) * ws_, bf_hi(v[i].x) * ws_); o.y = cvt_pk_bf16(bf_lo(v[i].y) * ws_, bf_hi(v[i].y) * ws_);
            o.z = cvt_pk_bf16(bf_lo(v[i].z) * ws_, bf_hi(v[i].z) * ws_); o.w = cvt_pk_bf16(bf_lo(v[i].w) * ws_, bf_hi(v[i].w) * ws_);
            *(LAS u32x4*)(Vs + row * ML_P + ch * 16) = o; }
    }
    __syncthreads();
    if (tid < 256) { float a = 0.f; for (int s = 0; s < 128; ++s) a += wt[s] * bf2f(*(const LAS bf16_t*)(Ks + s * ML_P + tid * 2)); DN[tid] = a; }
    const int vr = w >> 1, kr = w & 1;
    f32x4 acc[4][8];
#pragma unroll
    for (int i = 0; i < 4; ++i)
#pragma unroll
        for (int j = 0; j < 8; ++j) acc[i][j] = (f32x4){0.f, 0.f, 0.f, 0.f};
    const unsigned rowoff = (unsigned)((4 * g4 + (jl >> 2)) * ML_P + (jl & 3) * 8);
    const unsigned kb = (unsigned)(uintptr_t)Ks + rowoff + kr * 256, vb = (unsigned)(uintptr_t)Vs + rowoff + vr * 128;
#pragma unroll 1
    for (int ks = 0; ks < 4; ++ks) {
        s16x4 a0[4], a1[4], b0[8], b1[8];
#pragma unroll
        for (int i = 0; i < 4; ++i) { a0[i] = tr_read_o(vb + ks * 32 * ML_P, i * 32); a1[i] = tr_read_o(vb + ks * 32 * ML_P, 16 * ML_P + i * 32); }
#pragma unroll
        for (int j = 0; j < 8; ++j) { b0[j] = tr_read_o(kb + ks * 32 * ML_P, j * 32); b1[j] = tr_read_o(kb + ks * 32 * ML_P, 16 * ML_P + j * 32); }
        LGKM_WAIT0();
#pragma unroll
        for (int i = 0; i < 4; ++i)
#pragma unroll
            for (int j = 0; j < 8; ++j) acc[i][j] = __builtin_amdgcn_mfma_f32_16x16x32_bf16(PK8(a0[i], a1[i]), PK8(b0[j], b1[j]), acc[i][j], 0, 0, 0);
    }
#pragma unroll
    for (int i = 0; i < 4; ++i)
#pragma unroll
        for (int j = 0; j < 8; ++j)
#pragma unroll
            for (int rg = 0; rg < 4; ++rg) DC[(size_t)(16 * (4 * vr + i) + 4 * g4 + rg) * 256 + 16 * (8 * kr + j) + jl] = acc[i][j][rg];
}

__device__ __forceinline__ float chunk_decay(const float* bcum, const float* mcum, int bh, int c) {
    const float Be = bcum[bh * S + c * 128 + 127], me = mcum[bh * S + c * 128 + 127];
    const float Bp = (c > 0) ? bcum[bh * S + c * 128 - 1] : 0.f, mp = (c > 0) ? mcum[bh * S + c * 128 - 1] : 0.f;
    return expf(Be - Bp + mp - me);
}
__device__ __forceinline__ void p5_scan_mix(const Frame& F) {
    const float* bcum = WSP(float, WS_BCUM); const float* mcum = WSP(float, WS_MCUM);
    const float* DC = WSP(float, WS_DC); bf16_t* CST = WSP(bf16_t, WS_CST); const float* DN = WSP(float, WS_DN); float* NST = WSP(float, WS_NST);
    const int gt = F.bx * NTHR + FTID, NG = F.G * NTHR;
    for (int item = gt; item < 16 * 8192; item += NG) {
        const int bh = item >> 13, e8 = item & 8191;
        f32x4 c0 = {0.f, 0.f, 0.f, 0.f}, c1 = {0.f, 0.f, 0.f, 0.f};
#pragma unroll 5
        for (int c = 0; c < 15; ++c) { const float dec = chunk_decay(bcum, mcum, bh, c);
            const float* p = DC + (size_t)(bh * 16 + c) * 65536 + e8 * 8; const f32x4 d0 = *(const f32x4*)p, d1 = *(const f32x4*)(p + 4);
            c0 = c0 * dec + d0; c1 = c1 * dec + d1;
            u32x4 o; o.x = cvt_pk_bf16(c0[0], c0[1]); o.y = cvt_pk_bf16(c0[2], c0[3]); o.z = cvt_pk_bf16(c1[0], c1[1]); o.w = cvt_pk_bf16(c1[2], c1[3]);
            *(u32x4*)(CST + (size_t)(bh * 16 + c + 1) * 65536 + e8 * 8) = o; }
    }
    for (int item = gt; item < 16 * 256; item += NG) { const int bh = item >> 8, k = item & 255; float n = 0.f;
        for (int c = 0; c < 15; ++c) { n = n * chunk_decay(bcum, mcum, bh, c) + DN[(size_t)(bh * 16 + c) * 256 + k]; NST[(size_t)(bh * 16 + c + 1) * 256 + k] = n; } }
    const bf16_t* OA = WSP(bf16_t, WS_OATT); const float* LSE = WSP(float, WS_LSE); bf16_t* YA = WSP(bf16_t, WS_YA);
    for (int item = gt; item < T * 64; item += NG) { const int t = item >> 6, h = (item >> 4) & 3, e8 = item & 15;
        const float l0 = LSE[(size_t)t * 12 + h], l1 = LSE[(size_t)t * 12 + 4 + h], l2 = LSE[(size_t)t * 12 + 8 + h];
        const float ml = fmaxf(l0, fmaxf(l1, l2)); float w0 = expf(l0 - ml), w1 = expf(l1 - ml), w2 = expf(l2 - ml); const float ws_ = 1.f / (w0 + w1 + w2); w0 *= ws_; w1 *= ws_; w2 *= ws_;
        const u32x4 a = *(const u32x4*)(OA + (size_t)t * 1536 + h * 128 + e8 * 8), bq = *(const u32x4*)(OA + (size_t)t * 1536 + (4 + h) * 128 + e8 * 8), cq = *(const u32x4*)(OA + (size_t)t * 1536 + (8 + h) * 128 + e8 * 8);
        u32x4 o;
        o.x = cvt_pk_bf16(w0 * bf_lo(a.x) + w1 * bf_lo(bq.x) + w2 * bf_lo(cq.x), w0 * bf_hi(a.x) + w1 * bf_hi(bq.x) + w2 * bf_hi(cq.x));
        o.y = cvt_pk_bf16(w0 * bf_lo(a.y) + w1 * bf_lo(bq.y) + w2 * bf_lo(cq.y), w0 * bf_hi(a.y) + w1 * bf_hi(bq.y) + w2 * bf_hi(cq.y));
        o.z = cvt_pk_bf16(w0 * bf_lo(a.z) + w1 * bf_lo(bq.z) + w2 * bf_lo(cq.z), w0 * bf_hi(a.z) + w1 * bf_hi(bq.z) + w2 * bf_hi(cq.z));
        o.w = cvt_pk_bf16(w0 * bf_lo(a.w) + w1 * bf_lo(bq.w) + w2 * bf_lo(cq.w), w0 * bf_hi(a.w) + w1 * bf_hi(bq.w) + w2 * bf_hi(cq.w));
        *(u32x4*)(YA + (size_t)t * 512 + h * 128 + e8 * 8) = o; }
}

constexpr int MO_KP = 528, MO_VOFF = 128 * MO_KP, MO_TAB = MO_VOFF + 128 * ML_P;
__device__ __forceinline__ void mlstm_out_unit(const Frame& F, int unit) {
    const bf16_t* QM = WSP(bf16_t, WS_QM); const bf16_t* KM = WSP(bf16_t, WS_KM); const bf16_t* VM = WSP(bf16_t, WS_VMB); const bf16_t* OG = WSP(bf16_t, WS_OGB);
    const bf16_t* CST = WSP(bf16_t, WS_CST) + (size_t)unit * 65536; const float* NST = WSP(float, WS_NST) + (size_t)unit * 256; bf16_t* YM = WSP(bf16_t, WS_YM);
    const float* gpre = WSP(float, WS_GPRE); const float* bcum = WSP(float, WS_BCUM); const float* mcum = WSP(float, WS_MCUM);
    const int bh = unit >> 4, c = unit & 15, b = bh >> 2, h = bh & 3; const size_t t0 = (size_t)b * S + c * 128;
    const int tid = FTID, lane = FLANE, w = FWAVE, jl = lane & 15, g4 = lane >> 4;
    LAS unsigned char* RA = F.lds; LAS unsigned char* RB = F.lds + MO_VOFF; LAS float* cs = (LAS float*)(F.lds + MO_TAB); LAS float* ntab = cs + 128;
    __syncthreads();
    {
        u32x4 v[8];
#pragma unroll
        for (int i = 0; i < 8; ++i) { const int id = tid + NTHR * i; const int row = id >> 5, ch = id & 31; v[i] = *(const u32x4*)(KM + (t0 + row) * 1024 + h * 256 + ch * 8); }
#pragma unroll
        for (int i = 0; i < 8; ++i) { const int id = tid + NTHR * i; const int row = id >> 5, ch = id & 31; *(LAS u32x4*)(RA + row * MO_KP + ch * 16) = v[i]; }
#pragma unroll
        for (int i = 0; i < 8; ++i) { const int id = tid + NTHR * i; const int row = id >> 5, ch = id & 31; v[i] = *(const u32x4*)(VM + (t0 + row) * 1024 + h * 256 + ch * 8); }
#pragma unroll
        for (int i = 0; i < 8; ++i) { const int id = tid + NTHR * i; const int row = id >> 5, ch = id & 31; *(LAS u32x4*)(RB + row * ML_P + ch * 16) = v[i]; }
        if (tid < 128) cs[tid] = (gpre[(t0 + tid) * 8 + h] - bcum[bh * S + c * 128 + tid]) * LOG2E;
        if (tid >= 128 && tid < 384) ntab[tid - 128] = (c > 0) ? NST[tid - 128] : 0.f;
    }
    const int tl = 16 * w + jl; const size_t t = t0 + tl;
    const float Bt = bcum[bh * S + c * 128 + tl], mt = mcum[bh * S + c * 128 + tl];
    const float Bp = (c > 0) ? bcum[bh * S + c * 128 - 1] : 0.f, mp = (c > 0) ? mcum[bh * S + c * 128 - 1] : 0.f;
    const float at = (Bt - mt) * LOG2E; const float inter = fast_exp2((Bt - Bp + mp - mt) * LOG2E);
    union QF { bf16x8 v; unsigned u[4]; }; QF qf[8];
#pragma unroll
    for (int ks = 0; ks < 8; ++ks) qf[ks].v = *(const bf16x8*)(QM + t * 1024 + h * 256 + ks * 32 + 8 * g4);
    __syncthreads();
    f32x4 sT[8];
#pragma unroll
    for (int st = 0; st < 8; ++st) { f32x4 a = {0.f, 0.f, 0.f, 0.f};
        if (st <= w) {
#pragma unroll
            for (int ks = 0; ks < 8; ++ks) { const bf16x8 kf = *(const LAS bf16x8*)(RA + (16 * st + jl) * MO_KP + (ks * 32 + 8 * g4) * 2); a = __builtin_amdgcn_mfma_f32_16x16x32_bf16(kf, qf[ks].v, a, 0, 0, 0); } }
        sT[st] = a; __builtin_amdgcn_sched_barrier(0); }
    float dsum = 0.f;
#pragma unroll
    for (int st = 0; st < 8; ++st) { const f32x4 cv = *(const LAS f32x4*)(cs + 16 * st + 4 * g4);
#pragma unroll
        for (int rg = 0; rg < 4; ++rg) { const bool valid = (st < w) || (st == w && (4 * g4 + rg) <= jl); const float f = valid ? fast_exp2(fminf(at + cv[rg], 0.f)) : 0.f; const float sv = sT[st][rg] * f; sT[st][rg] = sv; dsum += sv; } }
    dsum += __shfl_xor(dsum, 16); dsum += __shfl_xor(dsum, 32);
    float nq = 0.f;
#pragma unroll
    for (int ks = 0; ks < 8; ++ks) { const f32x4 n0 = *(const LAS f32x4*)(ntab + ks * 32 + 8 * g4), n1 = *(const LAS f32x4*)(ntab + ks * 32 + 8 * g4 + 4);
        nq += bf_lo(qf[ks].u[0]) * n0[0] + bf_hi(qf[ks].u[0]) * n0[1] + bf_lo(qf[ks].u[1]) * n0[2] + bf_hi(qf[ks].u[1]) * n0[3]
            + bf_lo(qf[ks].u[2]) * n1[0] + bf_hi(qf[ks].u[2]) * n1[1] + bf_lo(qf[ks].u[3]) * n1[2] + bf_hi(qf[ks].u[3]) * n1[3]; }
    nq += __shfl_xor(nq, 16); nq += __shfl_xor(nq, 32);
    const float den = dsum + inter * nq;
    f32x4 acc[16];
#pragma unroll
    for (int vt = 0; vt < 16; ++vt) acc[vt] = (f32x4){0.f, 0.f, 0.f, 0.f};
    const unsigned vbase = (unsigned)(uintptr_t)RB + (unsigned)((4 * g4 + (jl >> 2)) * ML_P + (jl & 3) * 8);
#pragma unroll
    for (int c4 = 0; c4 < 4; ++c4) {
        if (2 * c4 <= w) {
            union { bf16x8 v; unsigned u[4]; } pf;
            pf.u[0] = cvt_pk_bf16(sT[2 * c4][0], sT[2 * c4][1]); pf.u[1] = cvt_pk_bf16(sT[2 * c4][2], sT[2 * c4][3]);
            pf.u[2] = cvt_pk_bf16(sT[2 * c4 + 1][0], sT[2 * c4 + 1][1]); pf.u[3] = cvt_pk_bf16(sT[2 * c4 + 1][2], sT[2 * c4 + 1][3]);
#pragma unroll
            for (int hb = 0; hb < 2; ++hb) {
                s16x4 a0[8], a1[8];
#pragma unroll
                for (int i = 0; i < 8; ++i) { a0[i] = tr_read_o(vbase, c4 * 32 * ML_P + (hb * 8 + i) * 32); a1[i] = tr_read_o(vbase, (c4 * 32 + 16) * ML_P + (hb * 8 + i) * 32); }
                LGKM_WAIT0();
#pragma unroll
                for (int i = 0; i < 8; ++i) acc[hb * 8 + i] = __builtin_amdgcn_mfma_f32_16x16x32_bf16(PK8(a0[i], a1[i]), pf.v, acc[hb * 8 + i], 0, 0, 0);
            }
        }
    }
    if (c > 0) {
#pragma unroll
        for (int ks = 0; ks < 8; ++ks)
#pragma unroll
            for (int j = 0; j < 4; ++j) qf[ks].u[j] = cvt_pk_bf16(bf_lo(qf[ks].u[j]) * inter, bf_hi(qf[ks].u[j]) * inter);
#pragma unroll
        for (int half = 0; half < 2; ++half) {
            __syncthreads();
            u32x4 v[8];
#pragma unroll
            for (int i = 0; i < 8; ++i) { const int id = tid + NTHR * i; const int row = id >> 5, ch = id & 31; v[i] = *(const u32x4*)(CST + (size_t)(half * 128 + row) * 256 + ch * 8); }
#pragma unroll
            for (int i = 0; i < 8; ++i) { const int id = tid + NTHR * i; const int row = id >> 5, ch = id & 31; *(LAS u32x4*)(RA + row * MO_KP + ch * 16) = v[i]; }
            __syncthreads();
#pragma unroll
            for (int vt = 0; vt < 8; ++vt)
#pragma unroll
                for (int ks = 0; ks < 8; ++ks) { const bf16x8 cf = *(const LAS bf16x8*)(RA + (16 * vt + jl) * MO_KP + (ks * 32 + 8 * g4) * 2);
                    acc[half * 8 + vt] = __builtin_amdgcn_mfma_f32_16x16x32_bf16(cf, qf[ks].v, acc[half * 8 + vt], 0, 0, 0); if (ks == 7) __builtin_amdgcn_sched_barrier(0); }
        }
    }
    const float rden = 1.f / fmaxf(fabsf(den), fast_exp2(-mt * LOG2E));
    float sm = 0.f;
#pragma unroll
    for (int vt = 0; vt < 16; ++vt) { const u32x2 og = *(const u32x2*)(OG + t * 1024 + h * 256 + 16 * vt + 4 * g4);
        acc[vt][0] *= rden * bf_lo(og.x); acc[vt][1] *= rden * bf_hi(og.x); acc[vt][2] *= rden * bf_lo(og.y); acc[vt][3] *= rden * bf_hi(og.y);
        sm += (acc[vt][0] + acc[vt][1]) + (acc[vt][2] + acc[vt][3]); }
    sm += __shfl_xor(sm, 16); sm += __shfl_xor(sm, 32);
    const float mu = sm * (1.f / 256.f); float sq = 0.f;
#pragma unroll
    for (int vt = 0; vt < 16; ++vt) { acc[vt] = acc[vt] - mu; sq += (acc[vt][0] * acc[vt][0] + acc[vt][1] * acc[vt][1]) + (acc[vt][2] * acc[vt][2] + acc[vt][3] * acc[vt][3]); }
    sq += __shfl_xor(sq, 16); sq += __shfl_xor(sq, 32);
    const float rstd = rsqrtf(sq * (1.f / 256.f) + LN_EPS);
#pragma unroll
    for (int vt = 0; vt < 16; ++vt) { const f32x4 gg = *(const f32x4*)(F.m_norm_g + h * 256 + 16 * vt + 4 * g4); const f32x4 o = acc[vt] * rstd * gg;
        u32x2 ow; ow.x = cvt_pk_bf16(o[0], o[1]); ow.y = cvt_pk_bf16(o[2], o[3]); *(u32x2*)(YM + t * 1024 + h * 256 + 16 * vt + 4 * g4) = ow; }
}

struct EpiMerge {
    static constexpr bool PERM = true;
    bf16_t* MG; const bf16_t* GB; int step;
    __device__ __forceinline__ void operator()(const f32x4 (&acc)[2][2][4][2], const pg8::Unit& u, int wr, int wc, int fr, int fq) const {
        const int row0 = u.pm * 256 + wr * 64 + fr, col0 = u.pn * 256 + wc * 32 + 8 * fq;
#pragma unroll
        for (int ai = 0; ai < 2; ++ai)
#pragma unroll
            for (int m = 0; m < 4; ++m) { const size_t r = row0 + ai * 128 + m * 16;
#pragma unroll
                for (int bj = 0; bj < 2; ++bj) { const int col = col0 + bj * 128; const f32x4 v0 = acc[ai][bj][m][0], v1 = acc[ai][bj][m][1];
                    const u32x4 gq = *(const u32x4*)(GB + r * 4096 + step * 2048 + col);
                    float o[8] = {v0[0] * bf_lo(gq.x), v0[1] * bf_hi(gq.x), v0[2] * bf_lo(gq.y), v0[3] * bf_hi(gq.y), v1[0] * bf_lo(gq.z), v1[1] * bf_hi(gq.z), v1[2] * bf_lo(gq.w), v1[3] * bf_hi(gq.w)};
                    if (step) { const u32x4 pq = *(const u32x4*)(MG + r * 2048 + col);
                        o[0] += bf_lo(pq.x); o[1] += bf_hi(pq.x); o[2] += bf_lo(pq.y); o[3] += bf_hi(pq.y); o[4] += bf_lo(pq.z); o[5] += bf_hi(pq.z); o[6] += bf_lo(pq.w); o[7] += bf_hi(pq.w); }
                    u32x4 wv; wv.x = cvt_pk_bf16(o[0], o[1]); wv.y = cvt_pk_bf16(o[2], o[3]); wv.z = cvt_pk_bf16(o[4], o[5]); wv.w = cvt_pk_bf16(o[6], o[7]);
                    *(u32x4*)(MG + r * 2048 + col) = wv; } }
    }
};
struct EpiWout {
    static constexpr bool PERM = false;
    const float* x; const float* mod; float* PRE;
    __device__ __forceinline__ void operator()(const f32x4 (&acc)[2][2][4][2], const pg8::Unit& u, int wr, int wc, int fr, int fq) const {
        const int row0 = u.pm * 256 + wr * 64 + fr, col0 = u.pn * 256 + wc * 32 + 4 * fq;
        const float* gate = mod + (size_t)((u.pm * 256) / S) * 6 * D + 2 * D;
        f32x4 gv[2][2];
#pragma unroll
        for (int bj = 0; bj < 2; ++bj)
#pragma unroll
            for (int n = 0; n < 2; ++n) gv[bj][n] = *(const f32x4*)(gate + col0 + bj * 128 + n * 16);
#pragma unroll
        for (int ai = 0; ai < 2; ++ai)
#pragma unroll
            for (int m = 0; m < 4; ++m) { const size_t off = (size_t)(row0 + ai * 128 + m * 16) * D + col0;
#pragma unroll
                for (int bj = 0; bj < 2; ++bj)
#pragma unroll
                    for (int n = 0; n < 2; ++n) { const f32x4 xv = *(const f32x4*)(x + off + bj * 128 + n * 16); *(f32x4*)(PRE + off + bj * 128 + n * 16) = xv * ALPHA + gv[bj][n] * acc[ai][bj][m][n]; } }
    }
};

constexpr int R_UP = 4112, R_LO = 16 * R_UP, R_PART = 2 * 16 * R_UP, R_LOG = R_PART + 8 * 16 * 48 * 4;
__device__ __forceinline__ void p9_ln_router(const Frame& F) {
    const float* PRE = WSP(float, WS_PRE); const float* mod = WSP(float, WS_MOD); bf16_t* U2 = WSP(bf16_t, WS_U); const bf16_t* WRT = WSP(bf16_t, WS_WRT);
    int* cnt = (int*)(F.ws + WS_CTL) + CW_CNT; int* idx = WSP(int, WS_IDX); float* wl = WSP(float, WS_WL); int* tok = WSP(int, WS_TOK);
    const int lane = FLANE, w = FWAVE, tid = FTID, jl = lane & 15, g4 = lane >> 4;
    LAS unsigned char* Uhi = F.lds; LAS unsigned char* Ulo = F.lds + R_LO; LAS float* part = (LAS float*)(F.lds + R_PART); LAS float* lg = (LAS float*)(F.lds + R_LOG);
    for (int rgp = F.bx; rgp < T / 16; rgp += F.G) {
        __syncthreads();
#pragma unroll 1
        for (int rr = 0; rr < 2; ++rr) {
            const int lr = 2 * w + rr; const int t = rgp * 16 + lr; const int b = t / S;
            f32x4 v[8]; float s = 0.f;
#pragma unroll
            for (int i = 0; i < 8; ++i) { v[i] = *(const f32x4*)(PRE + (size_t)t * D + 4 * (lane + 64 * i)); s += (v[i][0] + v[i][1]) + (v[i][2] + v[i][3]); }
            float mu = wave_sum(s) * (1.f / D); float q = 0.f;
#pragma unroll
            for (int i = 0; i < 8; ++i) { v[i] = v[i] - mu; q += (v[i][0] * v[i][0] + v[i][1] * v[i][1]) + (v[i][2] * v[i][2] + v[i][3] * v[i][3]); }
            float rstd = rsqrtf(wave_sum(q) * (1.f / D) + LN_EPS);
            s = 0.f;
#pragma unroll
            for (int i = 0; i < 8; ++i) { const int d = 4 * (lane + 64 * i); const f32x4 gg = *(const f32x4*)(F.ln1_g + d), bb = *(const f32x4*)(F.ln1_b + d);
                v[i] = v[i] * rstd * gg + bb; *(f32x4*)(F.out + (size_t)t * D + d) = v[i]; s += (v[i][0] + v[i][1]) + (v[i][2] + v[i][3]); }
            mu = wave_sum(s) * (1.f / D); q = 0.f;
#pragma unroll
            for (int i = 0; i < 8; ++i) { v[i] = v[i] - mu; q += (v[i][0] * v[i][0] + v[i][1] * v[i][1]) + (v[i][2] * v[i][2] + v[i][3] * v[i][3]); }
            rstd = rsqrtf(wave_sum(q) * (1.f / D) + LN_EPS);
            const float* sc = mod + (size_t)b * 6 * D + 4 * D; const float* sf = mod + (size_t)b * 6 * D + 3 * D;
#pragma unroll
            for (int i = 0; i < 8; ++i) { const int d = 4 * (lane + 64 * i); const f32x4 a = *(const f32x4*)(sc + d), bb = *(const f32x4*)(sf + d);
                v[i] = v[i] * rstd * (a + 1.f) + bb;
                u32x2 hi; hi.x = cvt_pk_bf16(v[i][0], v[i][1]); hi.y = cvt_pk_bf16(v[i][2], v[i][3]);
                *(u32x2*)(U2 + (size_t)t * D + d) = hi;
                u32x2 lo; lo.x = cvt_pk_bf16(v[i][0] - bf_lo(hi.x), v[i][1] - bf_hi(hi.x)); lo.y = cvt_pk_bf16(v[i][2] - bf_lo(hi.y), v[i][3] - bf_hi(hi.y));
                *(LAS u32x2*)(Uhi + lr * R_UP + d * 2) = hi; *(LAS u32x2*)(Ulo + lr * R_UP + d * 2) = lo; }
        }
        __syncthreads();
        {
            f32x4 a3[3] = {{0.f, 0.f, 0.f, 0.f}, {0.f, 0.f, 0.f, 0.f}, {0.f, 0.f, 0.f, 0.f}};
#pragma unroll 2
            for (int ks = 0; ks < 8; ++ks) { const int k0 = 256 * w + 32 * ks + 8 * g4;
                const bf16x8 ah = *(const LAS bf16x8*)(Uhi + jl * R_UP + k0 * 2), al = *(const LAS bf16x8*)(Ulo + jl * R_UP + k0 * 2);
#pragma unroll
                for (int nt = 0; nt < 3; ++nt) { const bf16x8 bh = *(const bf16x8*)(WRT + (size_t)(16 * nt + jl) * D + k0), bl = *(const bf16x8*)(WRT + (size_t)48 * D + (size_t)(16 * nt + jl) * D + k0);
                    a3[nt] = __builtin_amdgcn_mfma_f32_16x16x32_bf16(ah, bh, a3[nt], 0, 0, 0); a3[nt] = __builtin_amdgcn_mfma_f32_16x16x32_bf16(ah, bl, a3[nt], 0, 0, 0); a3[nt] = __builtin_amdgcn_mfma_f32_16x16x32_bf16(al, bh, a3[nt], 0, 0, 0); } }
#pragma unroll
            for (int nt = 0; nt < 3; ++nt)
#pragma unroll
                for (int rg = 0; rg < 4; ++rg) part[(w * 16 + 4 * g4 + rg) * 48 + 16 * nt + jl] = a3[nt][rg];
        }
        __syncthreads();
        for (int i = tid; i < 16 * 48; i += NTHR) { float s = 0.f;
#pragma unroll
            for (int ww = 0; ww < 8; ++ww) s += part[ww * 768 + i];
            lg[i] = s; }
        __syncthreads();
        if (tid < 16) { const int t = rgp * 16 + tid; const LAS float* l = lg + tid * 48;
            int gt = 0; float lgt = l[0] + F.b_rg[0];
            for (int j = 1; j < 4; ++j) { const float x = l[j] + F.b_rg[j]; if (x > lgt) { lgt = x; gt = j; } }
            float se = 0.f; for (int j = 0; j < 4; ++j) se += expf(l[j] + F.b_rg[j] - lgt);
            const float gw = 1.f / se;
            int a = 0; float la = l[4 + gt * 8] + F.b_re[gt * 8];
            for (int j = 1; j < 8; ++j) { const float x = l[4 + gt * 8 + j] + F.b_re[gt * 8 + j]; if (x > la) { la = x; a = j; } }
            int bb = -1; float lb = -INFINITY;
            for (int j = 0; j < 8; ++j) { const float x = l[4 + gt * 8 + j] + F.b_re[gt * 8 + j]; if (j != a && x > lb) { lb = x; bb = j; } }
            const float wa = 1.f / (1.f + expf(lb - la)), wb = 1.f - wa;
            const int ea = gt * 8 + a, eb = gt * 8 + bb;
            const int pa = atomicAdd(&cnt[ea], 1); idx[ea * T + pa] = t; wl[ea * T + pa] = gw * wa;
            const int pb = atomicAdd(&cnt[eb], 1); idx[eb * T + pb] = t; wl[eb * T + pb] = gw * wb;
            *(int4*)(tok + (size_t)t * 4) = make_int4(ea, pa, eb, pb); }
    }
}

struct MoeSched {
    const int* idx; const LAS int* tb; const LAS int* cn; int G, c;
    __device__ bool next(int i, pg8::Unit& u) const {
        const int total = tb[32] * 8; const long L = (long)i * G + c; if (L >= total) return false;
        const int l = (int)L; int e = 0;
        for (int k = 1; k < 32; ++k) if (l >= tb[k] * 8) e = k;
        const int nt = tb[e + 1] - tb[e], r = l - tb[e] * 8; const int j = r / nt, it = r - j * nt;
        u.e = __builtin_amdgcn_readfirstlane(e); u.it = __builtin_amdgcn_readfirstlane(it); u.pm = __builtin_amdgcn_readfirstlane(tb[e] + it); u.pn = __builtin_amdgcn_readfirstlane(e * 8 + j); u.cnt = __builtin_amdgcn_readfirstlane(cn[e]); return true;
    }
    __device__ __forceinline__ int arow(const pg8::Unit& u, int r) const { int p = u.it * 256 + r; p = p < u.cnt ? p : u.cnt - 1; return idx[u.e * T + p]; }
};
__device__ __forceinline__ void moe_tables(const Frame& F, LAS int* tb, LAS int* cn) {
    const int* cnt = (const int*)(F.ws + WS_CTL) + CW_CNT;
    __syncthreads();
    if (FTID == 0) { int acc = 0; for (int e = 0; e < 32; ++e) { const int c = cnt[e]; cn[e] = c; tb[e] = acc; acc += (c + 255) >> 8; } tb[32] = acc; }
    __syncthreads();
}
struct EpiMoe1 {
    static constexpr bool PERM = true;
    bf16_t* H;
    __device__ __forceinline__ void operator()(const f32x4 (&acc)[2][2][4][2], const pg8::Unit& u, int wr, int wc, int fr, int fq) const {
        const int row0 = u.pm * 256 + wr * 64 + fr, col0 = (u.pn & 7) * 128 + wc * 32 + 8 * fq;
#pragma unroll
        for (int ai = 0; ai < 2; ++ai)
#pragma unroll
            for (int m = 0; m < 4; ++m) { const size_t r = row0 + ai * 128 + m * 16; float o[8];
#pragma unroll
                for (int n = 0; n < 2; ++n)
#pragma unroll
                    for (int j = 0; j < 4; ++j) o[4 * n + j] = silu_fast(acc[ai][0][m][n][j]) * acc[ai][1][m][n][j];
                u32x4 wv; wv.x = cvt_pk_bf16(o[0], o[1]); wv.y = cvt_pk_bf16(o[2], o[3]); wv.z = cvt_pk_bf16(o[4], o[5]); wv.w = cvt_pk_bf16(o[6], o[7]);
                *(u32x4*)(H + r * FF + col0) = wv; }
    }
};
struct EpiMoe2 {
    static constexpr bool PERM = true;
    bf16_t* Y2; const float* wl;
    __device__ __forceinline__ void operator()(const f32x4 (&acc)[2][2][4][2], const pg8::Unit& u, int wr, int wc, int fr, int fq) const {
        const int lrow0 = wr * 64 + fr, col0 = (u.pn & 7) * 256 + wc * 32 + 8 * fq;
#pragma unroll
        for (int ai = 0; ai < 2; ++ai)
#pragma unroll
            for (int m = 0; m < 4; ++m) { const int lr = lrow0 + ai * 128 + m * 16; const int p = u.it * 256 + lr; const float cw = (p < u.cnt) ? wl[u.e * T + p] : 0.f; const size_t r = (size_t)u.pm * 256 + lr;
#pragma unroll
                for (int bj = 0; bj < 2; ++bj) { const f32x4 v0 = acc[ai][bj][m][0] * cw, v1 = acc[ai][bj][m][1] * cw;
                    u32x4 wv; wv.x = cvt_pk_bf16(v0[0], v0[1]); wv.y = cvt_pk_bf16(v0[2], v0[3]); wv.z = cvt_pk_bf16(v1[0], v1[1]); wv.w = cvt_pk_bf16(v1[2], v1[3]);
                    *(u32x4*)(Y2 + r * D + col0 + bj * 128) = wv; } }
    }
};

__device__ __forceinline__ void p12_final(const Frame& F, const LAS int* tb) {
    const float* mod = WSP(float, WS_MOD); const bf16_t* Y2 = WSP(bf16_t, WS_Y2); const int* tok = WSP(int, WS_TOK);
    const int gw = F.bx * NWAVES + FWAVE, NGW = F.G * NWAVES, lane = FLANE;
    for (int t = gw; t < T; t += NGW) {
        const int b = t / S; const int4 ti = *(const int4*)(tok + (size_t)t * 4);
        const size_t r0 = (size_t)tb[ti.x] * 256 + ti.y, r1 = (size_t)tb[ti.z] * 256 + ti.w;
        const float* gate = mod + (size_t)b * 6 * D + 5 * D;
        f32x4 v[8]; float s = 0.f;
#pragma unroll
        for (int i = 0; i < 8; ++i) { const int d = 4 * (lane + 64 * i); const f32x4 xv = *(const f32x4*)(F.out + (size_t)t * D + d), gv = *(const f32x4*)(gate + d);
            const u32x2 ya = *(const u32x2*)(Y2 + r0 * D + d), yb = *(const u32x2*)(Y2 + r1 * D + d);
            f32x4 f; f[0] = bf_lo(ya.x) + bf_lo(yb.x); f[1] = bf_hi(ya.x) + bf_hi(yb.x); f[2] = bf_lo(ya.y) + bf_lo(yb.y); f[3] = bf_hi(ya.y) + bf_hi(yb.y);
            v[i] = xv * ALPHA + gv * f; s += (v[i][0] + v[i][1]) + (v[i][2] + v[i][3]); }
        const float mu = wave_sum(s) * (1.f / D); float q = 0.f;
#pragma unroll
        for (int i = 0; i < 8; ++i) { v[i] = v[i] - mu; q += (v[i][0] * v[i][0] + v[i][1] * v[i][1]) + (v[i][2] * v[i][2] + v[i][3] * v[i][3]); }
        const float rstd = rsqrtf(wave_sum(q) * (1.f / D) + LN_EPS);
#pragma unroll
        for (int i = 0; i < 8; ++i) { const int d = 4 * (lane + 64 * i); const f32x4 gg = *(const f32x4*)(F.ln2_g + d), bb = *(const f32x4*)(F.ln2_b + d);
            *(f32x4*)(F.out + (size_t)t * D + d) = v[i] * rstd * gg + bb; }
    }
}

#if MK_DEBUG
__device__ __forceinline__ void dbg_acc(float* slot, double num, double den) { atomicAdd(slot, (float)num); atomicAdd(slot + 1, (float)den); }
__global__ void k_chk_u(Params p, float* res) {
    __shared__ float sh[8]; __shared__ float ush[D];
    const int t = (blockIdx.x * 37) % T, b = t / S; const float* x = p.in[0] + (size_t)t * D; const float* mod = (const float*)(p.ws + WS_MOD);
    float s = 0; for (int i = threadIdx.x; i < D; i += 256) s += x[i]; s = wave_sum(s); if ((threadIdx.x & 63) == 0) sh[threadIdx.x >> 6] = s; __syncthreads();
    const float mu = (sh[0] + sh[1] + sh[2] + sh[3]) / D; __syncthreads();
    float q = 0; for (int i = threadIdx.x; i < D; i += 256) { const float d = x[i] - mu; q += d * d; } q = wave_sum(q); if ((threadIdx.x & 63) == 0) sh[threadIdx.x >> 6] = q; __syncthreads();
    const float rstd = rsqrtf((sh[0] + sh[1] + sh[2] + sh[3]) / D + LN_EPS);
    const bf16_t* U = (const bf16_t*)(p.ws + WS_U); double num = 0, den = 0;
    for (int i = threadIdx.x; i < D; i += 256) {
        float sc = p.in[3][1 * D + i], sf = p.in[3][0 * D + i];
        if (i < 64) { for (int k = 0; k < D; ++k) { const float cv = p.in[1][b * D + k]; const float sl = cv / (1.f + expf(-cv)); sc += sl * p.in[2][(size_t)k * 6 * D + D + i]; sf += sl * p.in[2][(size_t)k * 6 * D + i]; } }
        else { sc = mod[(size_t)b * 6 * D + D + i]; sf = mod[(size_t)b * 6 * D + i]; }
        const float ref = (x[i] - mu) * rstd * (1.f + sc) + sf; ush[i] = ref; const float got = bf2f(U[(size_t)t * D + i]); num += (double)(got - ref) * (got - ref); den += (double)ref * ref; }
    __syncthreads();
    if (threadIdx.x < 8) { const int j = threadIdx.x; float a = 0; for (int k = 0; k < D; ++k) a += ush[k] * p.in[4][(size_t)k * NIN + OFF_IF + j]; a += p.in[5][j];
        if (j >= 4) a = fminf(a, 0.f) - log1pf(expf(-fabsf(a))); const float got = ((const float*)(p.ws + WS_GPRE))[(size_t)t * 8 + j]; num += (double)(got - a) * (got - a) * 1000.0; den += (double)a * a * 1000.0; }
    dbg_acc(res, num, den);
}
__global__ void k_chk_p2(Params p, float* res) {
    const int gid = blockIdx.x * blockDim.x + threadIdx.x;
    const int t = (gid * 131 + 7) % T; const int col = (gid * 977 + 13) % (NIN - 8 + 4096);
    const bf16_t* U = (const bf16_t*)(p.ws + WS_U) + (size_t)t * D;
    const int pos = t % S; float ref, got; unsigned char* ws = p.ws;
    auto dot = [&](const float* w, int ld, int c) { float a = 0; for (int k = 0; k < D; ++k) a += bf2f(U[k]) * w[(size_t)k * ld + c]; return a; };
    if (col < 3072) { const int hd = col / 128, lc = col % 128, i = lc % 64; const int c1 = hd * 128 + i, c2 = c1 + 64; const float x1 = dot(p.in[4], NIN, c1), x2 = dot(p.in[4], NIN, c2);
        const float inv = powf(10000.f, -(float)(2 * i) / 128.f), ang = (float)pos * inv, cs = cosf(ang), sn = sinf(ang);
        ref = (lc < 64) ? (x1 * cs - x2 * sn) : (x2 * cs + x1 * sn); const int pc = hd * 128 + 2 * i + (lc >= 64);
        if (col < 1536) { ref *= QSCALE; got = bf2f(((const bf16_t*)(ws + WS_QB))[(size_t)t * 1536 + pc]); } else got = bf2f(((const bf16_t*)(ws + WS_KB))[(size_t)t * 1536 + pc - 1536]); }
    else if (col < 4608) { ref = dot(p.in[4], NIN, col); got = bf2f(((const bf16_t*)(ws + WS_VB))[(size_t)t * 1536 + col - 3072]); }
    else if (col < 6656) { ref = dot(p.in[4], NIN, col); got = bf2f(((const bf16_t*)(ws + WS_QKP))[(size_t)t * 2048 + col - 4608]); }
    else if (col < 7680) { ref = dot(p.in[4], NIN, col); got = bf2f(((const bf16_t*)(ws + WS_VMB))[(size_t)t * 1024 + col - 6656]); }
    else if (col < 8704) { ref = dot(p.in[4], NIN, col); ref = 1.f / (1.f + expf(-ref)); got = bf2f(((const bf16_t*)(ws + WS_OGB))[(size_t)t * 1024 + col - 7680]); }
    else { const int c = col - 8704; ref = dot(p.in[11], 4096, c) + p.in[12][c]; ref = 1.f / (1.f + expf(-ref)); got = bf2f(((const bf16_t*)(ws + WS_GB))[(size_t)t * 4096 + c]); }
    double num = (double)(got - ref) * (got - ref), den = (double)ref * ref;
    for (int o = 32; o >= 1; o >>= 1) { num += __shfl_xor(num, o); den += __shfl_xor(den, o); }
    if ((threadIdx.x & 63) == 0) dbg_acc(res, num, den);
}

__global__ void __launch_bounds__(256) k_chk_attn(Params p, float* res) {
    const int t = (blockIdx.x * 1543 + 11) % T, h = threadIdx.x >> 6, lane = threadIdx.x & 63; const int b = t / S, pos = t % S;
    const bf16_t* QB = (const bf16_t*)(p.ws + WS_QB); const bf16_t* KB = (const bf16_t*)(p.ws + WS_KB); const bf16_t* VB = (const bf16_t*)(p.ws + WS_VB); const bf16_t* YA = (const bf16_t*)(p.ws + WS_YA);
    float og[3][2], lse[3];
    for (int g = 0; g < 3; ++g) { const int d = (g == 0) ? 1 : (g == 1 ? 4 : 16); const int head = 4 * g + h;
        const bf16_t* qp = QB + (size_t)t * 1536 + head * 128; const float q0 = bf2f(qp[lane]), q1 = bf2f(qp[lane + 64]);
        float mx = -INFINITY, den = 0, o0 = 0, o1 = 0;
        for (int j = 0; j <= 128; ++j) { const int tk = pos - j * d; if (tk < 0) break;
            const bf16_t* kp = KB + (size_t)(b * S + tk) * 1536 + head * 128; const bf16_t* vp = VB + (size_t)(b * S + tk) * 1536 + head * 128;
            const float dot = wave_sum(q0 * bf2f(kp[lane]) + q1 * bf2f(kp[lane + 64]));
            const float nm = fmaxf(mx, dot); const float sc = exp2f(mx - nm), pe = exp2f(dot - nm);
            den = den * sc + pe; o0 = o0 * sc + pe * bf2f(vp[lane]); o1 = o1 * sc + pe * bf2f(vp[lane + 64]); mx = nm; }
        og[g][0] = o0 / den; og[g][1] = o1 / den; lse[g] = (mx + log2f(den)) * LN2; }
    const float ml = fmaxf(lse[0], fmaxf(lse[1], lse[2])); const float w0 = expf(lse[0] - ml), w1 = expf(lse[1] - ml), w2 = expf(lse[2] - ml); const float ws_ = 1.f / (w0 + w1 + w2);
    const float r0 = (w0 * og[0][0] + w1 * og[1][0] + w2 * og[2][0]) * ws_, r1 = (w0 * og[0][1] + w1 * og[1][1] + w2 * og[2][1]) * ws_;
    const float g0 = bf2f(YA[(size_t)t * 512 + h * 128 + lane]), g1 = bf2f(YA[(size_t)t * 512 + h * 128 + lane + 64]);
    double num = (double)(g0 - r0) * (g0 - r0) + (double)(g1 - r1) * (g1 - r1), den2 = (double)r0 * r0 + (double)r1 * r1;
    for (int o = 32; o >= 1; o >>= 1) { num += __shfl_xor(num, o); den2 += __shfl_xor(den2, o); }
    if (lane == 0) dbg_acc(res, num, den2);
}
__global__ void __launch_bounds__(1024) k_chk_mlstm(Params p, float* hb) {
    const int b = blockIdx.x / 4, h = blockIdx.x % 4; const int tid = threadIdx.x, v = tid >> 2, kq = tid & 3;
    const bf16_t* QKP = (const bf16_t*)(p.ws + WS_QKP); const bf16_t* VM = (const bf16_t*)(p.ws + WS_VMB);
    const float* gpre = (const float*)(p.ws + WS_GPRE); const float* conv_w = p.in[6]; const float* conv_b = p.in[7];
    __shared__ float qs[256], ks[256], vs[256], ns[256], nq[256];
    float C[64];
#pragma unroll
    for (int i = 0; i < 64; ++i) C[i] = 0.f;
    if (tid < 256) ns[tid] = 0.f;
    float m = 0.f;
    for (int pos = 0; pos < S; ++pos) { const int t = b * S + pos;
        __syncthreads();
        if (tid < 256) { float yq = conv_b[h * 256 + tid], yk = conv_b[1024 + h * 256 + tid];
            for (int j = 0; j < 4; ++j) { const int pp = pos + j - 3; if (pp >= 0) { yq += conv_w[j * 2048 + h * 256 + tid] * bf2f(QKP[(size_t)(t + j - 3) * 2048 + h * 256 + tid]); yk += conv_w[j * 2048 + 1024 + h * 256 + tid] * bf2f(QKP[(size_t)(t + j - 3) * 2048 + 1024 + h * 256 + tid]); } }
            qs[tid] = yq / (1.f + expf(-yq)); ks[tid] = yk / (1.f + expf(-yk)) * 0.0625f; vs[tid] = bf2f(VM[(size_t)t * 1024 + h * 256 + tid]); }
        const float ip = gpre[(size_t)t * 8 + h], lf = gpre[(size_t)t * 8 + 4 + h];
        const float mn = fmaxf(lf + m, ip); const float iw = expf(ip - mn), fw = expf(lf + m - mn); m = mn;
        __syncthreads();
        if (tid < 256) { const float nn = fw * ns[tid] + iw * ks[tid]; ns[tid] = nn; nq[tid] = nn * qs[tid]; }
        __syncthreads();
        const float vv = vs[v] * iw; float nu = 0.f, de = 0.f;
#pragma unroll
        for (int i = 0; i < 64; ++i) { const int k = 4 * i + kq; const float cc = fw * C[i] + vv * ks[k]; C[i] = cc; nu += cc * qs[k]; de += nq[k]; }
        nu += __shfl_xor(nu, 1); nu += __shfl_xor(nu, 2); de += __shfl_xor(de, 1); de += __shfl_xor(de, 2);
        if (kq == 0) hb[(size_t)t * 1024 + h * 256 + v] = nu / fmaxf(fabsf(de), expf(-mn));
    }
}
__global__ void __launch_bounds__(256) k_chk_mnorm(Params p, const float* hb, float* res) {
    __shared__ float red[8];
    const int t = blockIdx.x / 4, h = blockIdx.x % 4, tid = threadIdx.x;
    const bf16_t* OG = (const bf16_t*)(p.ws + WS_OGB); const bf16_t* YM = (const bf16_t*)(p.ws + WS_YM); const float* mg = p.in[8];
    const float val = bf2f(OG[(size_t)t * 1024 + h * 256 + tid]) * hb[(size_t)t * 1024 + h * 256 + tid];
    float s = wave_sum(val); if ((tid & 63) == 0) red[tid >> 6] = s; __syncthreads();
    const float mu = (red[0] + red[1] + red[2] + red[3]) * (1.f / 256.f); const float d = val - mu;
    s = wave_sum(d * d); if ((tid & 63) == 0) red[4 + (tid >> 6)] = s; __syncthreads();
    const float rstd = rsqrtf((red[4] + red[5] + red[6] + red[7]) * (1.f / 256.f) + LN_EPS); const float ref = d * rstd * mg[h * 256 + tid];
    const float got = bf2f(YM[(size_t)t * 1024 + h * 256 + tid]);
    double num = (double)(got - ref) * (got - ref), den = (double)ref * ref;
    for (int o = 32; o >= 1; o >>= 1) { num += __shfl_xor(num, o); den += __shfl_xor(den, o); }
    if ((tid & 63) == 0) dbg_acc(res, num, den);
}
__global__ void k_chk_fin(const float* res, int nchk, float* out, int n) {
    const int i = blockIdx.x * blockDim.x + threadIdx.x; if (i >= n) return;
    float code = 0.f;
    for (int k = 0; k < nchk; ++k) { const float rv = res[2 * k] / fmaxf(res[2 * k + 1], 1e-30f); int s;
        if (!(rv == rv) || !(res[2 * k + 1] > 0.f)) s = 9; else { s = (int)floorf(log10f(fmaxf(rv, 1e-12f)) + 6.f); s = s < 0 ? 0 : (s > 8 ? 8 : s); }
        if (s >= 3 && code == 0.f) code = ((k + 1) * 10 + s) * 100.f; }
    out[i] = (i == 0) ? code : 0.f;
}
#endif

__global__ void __launch_bounds__(NTHR, 2) mk_fwd(Params args) {
    extern __shared__ __attribute__((aligned(16))) unsigned char lds_raw[];
    Frame F;
    F.lds = (LAS unsigned char*)lds_raw; F.G = gridDim.x; F.bx = blockIdx.x; F.ws = args.ws;
    F.x = args.in[0]; F.c = args.in[1]; F.w_ada = args.in[2]; F.b_ada = args.in[3]; F.w_in = args.in[4]; F.b_mgate = args.in[5]; F.conv_w = args.in[6]; F.conv_b = args.in[7];
    F.m_norm_g = args.in[8]; F.w_proj_a = args.in[9]; F.w_proj_m = args.in[10]; F.w_gate = args.in[11]; F.b_gate = args.in[12]; F.w_out = args.in[13]; F.ln1_g = args.in[14]; F.ln1_b = args.in[15];
    F.w_rg = args.in[16]; F.b_rg = args.in[17]; F.w_re = args.in[18]; F.b_re = args.in[19]; F.w_eg = args.in[20]; F.w_eu = args.in[21]; F.w_ed = args.in[22]; F.ln2_g = args.in[23]; F.ln2_b = args.in[24];
    F.out = args.out;
    volatile LAS unsigned* misc = (volatile LAS unsigned*)(F.lds + LDS_MISC);
    if (FTID < 64) misc[FTID] = 0u;
    __syncthreads();
    const int lo = args.ph_lo, hi = args.ph_hi;
    XcdBarrier bar; bar.bar = (unsigned*)(F.ws + WS_CTL) + CW_BAR; bar.x = 0; bar.st = nullptr;
    if (hi - lo > 1) bar = xcd_barrier_post((unsigned*)(F.ws + WS_CTL) + CW_BAR, misc + 8);
#define IN(k) (lo <= (k) && (k) < hi)
#define BOTH(k) (IN(k) && IN((k) + 1))
#define SEAM(k) do { if (BOTH(k)) xcd_barrier(bar); } while (0)

    if (IN(0)) { p0_prologue(F); SEAM(0); }
    if (IN(1)) { p1_lnmod(F); SEAM(1); }
    if (IN(2)) {
        pg8::StaticOrder So; So.init(T, NBIG, F.G, F.bx);
        EpiP2 E{WSP(bf16_t, WS_QB), WSP(bf16_t, WS_KB), WSP(bf16_t, WS_VB), WSP(bf16_t, WS_QKP), WSP(bf16_t, WS_VMB), WSP(bf16_t, WS_OGB), WSP(bf16_t, WS_GB), WSP(float, WS_ROPE), F.b_gate};
        pg8::gemm_phase<EpiP2, pg8::StaticOrder, false>(F.lds, WSP(bf16_t, WS_U), WSP(bf16_t, WS_WBIG), D, So, E);
        if (F.bx >= F.G - 16 && FWAVE == 0) scan_bh(F, F.bx - (F.G - 16));
        SEAM(2);
    }
    if (IN(3)) { p3_conv(F); for (int u = F.bx; u < 768; u += F.G) attn_unit(F, u); SEAM(3); }
    if (IN(4)) { for (int u = F.bx; u < 256; u += F.G) mlstm_dc_unit(F, u); SEAM(4); }
    if (IN(5)) { p5_scan_mix(F); SEAM(5); }
    if (IN(6)) { for (int u = F.bx; u < 256; u += F.G) mlstm_out_unit(F, u); SEAM(6); }
    if (IN(7)) {
        pg8::StaticOrder So; So.init(T, D, F.G, F.bx);
        EpiMerge E0{WSP(bf16_t, WS_MG), WSP(bf16_t, WS_GB), 0}, E1{WSP(bf16_t, WS_MG), WSP(bf16_t, WS_GB), 1};
        pg8::gemm_phase<EpiMerge, pg8::StaticOrder, false>(F.lds, WSP(bf16_t, WS_YA), WSP(bf16_t, WS_WPA), 512, So, E0);
        pg8::gemm_phase<EpiMerge, pg8::StaticOrder, false>(F.lds, WSP(bf16_t, WS_YM), WSP(bf16_t, WS_WPM), 1024, So, E1);
        SEAM(7);
    }
    if (IN(8)) {
        pg8::StaticOrder So; So.init(T, D, F.G, F.bx);
        EpiWout E{F.x, WSP(float, WS_MOD), WSP(float, WS_PRE)};
        pg8::gemm_phase<EpiWout, pg8::StaticOrder, false>(F.lds, WSP(bf16_t, WS_MG), WSP(bf16_t, WS_WO), D, So, E);
        SEAM(8);
    }
    if (IN(9)) { p9_ln_router(F); SEAM(9); }
    LAS int* tb = (LAS int*)(F.lds + LDS_MISC) + 64; LAS int* cn = tb + 40;
    const int vcu = (F.G % 8 == 0) ? (F.bx % 8) * (F.G / 8) + F.bx / 8 : F.bx;
    if (IN(10)) {
        moe_tables(F, tb, cn);
        MoeSched Sm{WSP(int, WS_IDX), tb, cn, F.G, vcu}; EpiMoe1 E{WSP(bf16_t, WS_H)};
        pg8::gemm_phase<EpiMoe1, MoeSched, true>(F.lds, WSP(bf16_t, WS_U), WSP(bf16_t, WS_W1T), D, Sm, E);
        SEAM(10);
    }
    if (IN(11)) {
        moe_tables(F, tb, cn);
        MoeSched Sm{WSP(int, WS_IDX), tb, cn, F.G, vcu}; EpiMoe2 E{WSP(bf16_t, WS_Y2), WSP(float, WS_WL)};
        pg8::gemm_phase<EpiMoe2, MoeSched, false>(F.lds, WSP(bf16_t, WS_H), WSP(bf16_t, WS_W2T), FF, Sm, E);
        SEAM(11);
    }
    if (IN(12)) { moe_tables(F, tb, cn); p12_final(F, tb); }
#undef IN
#undef BOTH
#undef SEAM
}

extern "C" void kernel_launch(void* const* d_in, const int* in_sizes, int n_in, void* d_out, int out_size, void* d_ws, size_t ws_size, hipStream_t stream) {
    static int grid = 0;
    if (grid == 0) {
        size_t need = WS_END;
#if MK_DEBUG
        need += (1 << 20) + (size_t)T * 1024 * 4;
#endif
        if (n_in != 25 || out_size != T * D || ws_size < need) { fprintf(stderr, "kernel_launch: unexpected shapes / workspace (%zu < %zu)\n", ws_size, need); grid = -1; return; }
        int dev = 0, cus = 0, per_cu = 0;
        if (hipGetDevice(&dev) != hipSuccess || hipDeviceGetAttribute(&cus, hipDeviceAttributeMultiprocessorCount, dev) != hipSuccess) { grid = -1; return; }
        if (hipFuncSetAttribute((const void*)mk_fwd, hipFuncAttributeMaxDynamicSharedMemorySize, LDS_BYTES) != hipSuccess) { fprintf(stderr, "kernel_launch: hipFuncSetAttribute failed\n"); grid = -1; return; }
        if (hipOccupancyMaxActiveBlocksPerMultiprocessor(&per_cu, (const void*)mk_fwd, NTHR, LDS_BYTES) != hipSuccess || per_cu < 1) { fprintf(stderr, "kernel_launch: occupancy query says %d\n", per_cu); (void)hipGetLastError(); grid = -1; return; }
        grid = cus;
    }
    if (grid < 0) return;
    (void)hipMemsetAsync((char*)d_ws + WS_CTL, 0, CTL_ZERO_BYTES, stream);
    Params a{};
    for (int i = 0; i < 25; ++i) a.in[i] = (const float*)d_in[i];
    a.out = (float*)d_out; a.ws = (unsigned char*)d_ws;
#if MK_DEBUG
    constexpr int NPH = 7;
#else
    constexpr int NPH = 13;
#endif
#if MK_PER_PHASE
    for (int p = 0; p < NPH; ++p) { a.ph_lo = p; a.ph_hi = p + 1; hipLaunchKernelGGL(mk_fwd, dim3(grid), dim3(NTHR), LDS_BYTES, stream, a); }
#else
    a.ph_lo = 0; a.ph_hi = NPH; hipLaunchKernelGGL(mk_fwd, dim3(grid), dim3(NTHR), LDS_BYTES, stream, a);
#endif
#if MK_DEBUG
    float* res = (float*)((char*)d_ws + WS_DBG0);
    (void)hipMemsetAsync(res, 0, 256, stream);
    k_chk_u<<<64, 256, 0, stream>>>(a, res);
    k_chk_p2<<<32, 64, 0, stream>>>(a, res + 2);
    k_chk_attn<<<256, 256, 0, stream>>>(a, res + 4);
    float* hb = (float*)((char*)d_ws + WS_DBG0 + (1 << 20));
    k_chk_mlstm<<<16, 1024, 0, stream>>>(a, hb);
    k_chk_mnorm<<<T * 4, 256, 0, stream>>>(a, hb, res + 6);
    k_chk_fin<<<(T * D + 255) / 256, 256, 0, stream>>>(res, 4, (float*)d_out, T * D);
#endif
}
```

```cpp
#include <hip/hip_runtime.h>
#include <stdint.h>
#include <math.h>
#include <stdio.h>

#ifndef MK_DEBUG
#define MK_DEBUG 0
#endif
#ifndef MK_DUP
#define MK_DUP 0
#endif
#ifndef MK_PER_PHASE
#define MK_PER_PHASE 0
#endif

#define LAS __attribute__((address_space(3)))
typedef unsigned short bf16_t;
typedef short bf16x8 __attribute__((ext_vector_type(8)));
typedef short s16x4 __attribute__((ext_vector_type(4)));
typedef float f32x4 __attribute__((ext_vector_type(4)));
typedef float f32x2 __attribute__((ext_vector_type(2)));
typedef unsigned u32x4 __attribute__((ext_vector_type(4)));
typedef unsigned u32x2 __attribute__((ext_vector_type(2)));

constexpr int D = 2048, NB = 4, S = 2048, T = NB * S, NIN = 8712;
constexpr int OFF_QA = 0, OFF_KA = 1536, OFF_VA = 3072, OFF_QKM = 4608, OFF_VM = 6656, OFF_OM = 7680, OFF_IF = 8704;
constexpr int FF = 1024, NEXP = 32, NBIG = 12800;
constexpr float ALPHA = 1.189207115002721f, LN_EPS = 1e-5f;
constexpr float LOG2E = 1.4426950408889634f, LN2 = 0.6931471805599453f;
constexpr float QSCALE = 0.08838834764831845f * 1.4426950408889634f;
constexpr int NTHR = 512, NWAVES = 8;
constexpr int SORT_ROWS = 24576;

constexpr size_t al256(size_t x) { return (x + 255) & ~(size_t)255; }
constexpr size_t WS_CTL = 0, CTL_ZERO_BYTES = 65536;
constexpr int CW_BAR = 0;
constexpr int CW_CNT = 4096;
constexpr int CW_DBG = 4224;
constexpr size_t WS_MOD = 65536;
constexpr size_t WS_ROPE = WS_MOD + al256((size_t)NB * 6 * D * 4);
constexpr size_t WS_WIF = WS_ROPE + (size_t)S * 64 * 2 * 4;
constexpr size_t WS_GPRE = WS_WIF + (size_t)8 * D * 4;
constexpr size_t WS_BCUM = WS_GPRE + (size_t)T * 8 * 4;
constexpr size_t WS_MCUM = WS_BCUM + (size_t)16 * S * 4;
constexpr size_t WS_WRT = WS_MCUM + (size_t)16 * S * 4;
constexpr size_t WS_LSE = WS_WRT + (size_t)2 * 48 * D * 2;
constexpr size_t WS_IDX = WS_LSE + (size_t)T * 12 * 4;
constexpr size_t WS_WL = WS_IDX + (size_t)NEXP * T * 4;
constexpr size_t WS_TOK = WS_WL + (size_t)NEXP * T * 4;
constexpr size_t WS_DN = WS_TOK + (size_t)T * 16;
constexpr size_t WS_NST = WS_DN + (size_t)256 * 256 * 4;
constexpr size_t WS_WBIG = al256(WS_NST + (size_t)256 * 256 * 4);
constexpr size_t WS_WPA = WS_WBIG + (size_t)NBIG * D * 2;
constexpr size_t WS_WPM = WS_WPA + (size_t)D * 512 * 2;
constexpr size_t WS_WO = WS_WPM + (size_t)D * 1024 * 2;
constexpr size_t WS_W1T = WS_WO + (size_t)D * D * 2;
constexpr size_t WS_W2T = WS_W1T + (size_t)NEXP * 2048 * D * 2;
constexpr size_t WS_U = WS_W2T + (size_t)NEXP * D * FF * 2;
constexpr size_t WS_QB = WS_U + (size_t)T * D * 2;
constexpr size_t WS_KB = WS_QB + (size_t)T * 1536 * 2;
constexpr size_t WS_VB = WS_KB + (size_t)T * 1536 * 2;
constexpr size_t WS_QKP = WS_VB + (size_t)T * 1536 * 2;
constexpr size_t WS_VMB = WS_QKP + (size_t)T * 2048 * 2;
constexpr size_t WS_OGB = WS_VMB + (size_t)T * 1024 * 2;
constexpr size_t WS_GB = WS_OGB + (size_t)T * 1024 * 2;
constexpr size_t WS_QM = WS_GB + (size_t)T * 4096 * 2;
constexpr size_t WS_KM = WS_QM + (size_t)T * 1024 * 2;
constexpr size_t WS_OATT = WS_KM + (size_t)T * 1024 * 2;
constexpr size_t WS_YA = WS_OATT + (size_t)T * 1536 * 2;
constexpr size_t WS_YM = WS_YA + (size_t)T * 512 * 2;
constexpr size_t WS_DC = WS_YM + (size_t)T * 1024 * 2;
constexpr size_t WS_CST = WS_DC + (size_t)256 * 65536 * 4;
constexpr size_t WS_MG = WS_CST + (size_t)256 * 65536 * 2;
constexpr size_t WS_PRE = WS_MG + (size_t)T * D * 2;
constexpr size_t WS_END = WS_PRE + (size_t)T * D * 4;
constexpr size_t WS_H = WS_QB;
constexpr size_t WS_Y2 = WS_H + (size_t)SORT_ROWS * FF * 2;
static_assert(WS_Y2 + (size_t)SORT_ROWS * D * 2 <= WS_QM, "overlay");
constexpr size_t WS_DBG0 = WS_END;

constexpr int LDS_MISC = 162816;
constexpr int LDS_BYTES = LDS_MISC + 1024;

__device__ __forceinline__ unsigned cvt_pk_bf16(float lo, float hi) { unsigned r; asm volatile("v_cvt_pk_bf16_f32 %0, %1, %2" : "=v"(r) : "v"(lo), "v"(hi)); return r; }
__device__ __forceinline__ float bf_lo(unsigned w) { return __uint_as_float(w << 16); }
__device__ __forceinline__ float bf_hi(unsigned w) { return __uint_as_float(w & 0xffff0000u); }
__device__ __forceinline__ float bf2f(bf16_t b) { return __uint_as_float(((unsigned)b) << 16); }
__device__ __forceinline__ bf16_t f2bf(float f) { return (bf16_t)(cvt_pk_bf16(f, 0.f) & 0xffffu); }
__device__ __forceinline__ float fast_exp2(float x) { return __builtin_amdgcn_exp2f(x); }
__device__ __forceinline__ float fast_rcp(float x) { return __builtin_amdgcn_rcpf(x); }
__device__ __forceinline__ float sigmoid_fast(float x) { return fast_rcp(1.f + fast_exp2(-x * LOG2E)); }
__device__ __forceinline__ float silu_fast(float x) { return x * sigmoid_fast(x); }
__device__ __forceinline__ float wave_sum(float v) {
#pragma unroll
    for (int o = 32; o >= 1; o >>= 1) v += __shfl_xor(v, o);
    return v; }
__device__ __forceinline__ float wave_max(float v) {
#pragma unroll
    for (int o = 32; o >= 1; o >>= 1) v = fmaxf(v, __shfl_xor(v, o));
    return v; }
__device__ __forceinline__ s16x4 tr_read(unsigned addr) { s16x4 r; asm volatile("ds_read_b64_tr_b16 %0, %1" : "=&v"(r) : "v"(addr) : "memory"); return r; }
__device__ __forceinline__ s16x4 tr_read_o(unsigned base, const int off) { s16x4 r; asm volatile("ds_read_b64_tr_b16 %0, %1 offset:%2" : "=&v"(r) : "v"(base), "n"(off) : "memory"); return r; }
#define LGKM_WAIT0() do { asm volatile("s_waitcnt lgkmcnt(0)" ::: "memory"); __builtin_amdgcn_sched_barrier(0); } while (0)
#define PK8(L, H) ((bf16x8){L[0], L[1], L[2], L[3], H[0], H[1], H[2], H[3]})

#define XB_TMO      128
#define XB_XCNT(j)  (256  + 64 * (j))
#define XB_XSUB(j)  (1280 + 64 * (j))
#define XB_XGEN(j)  (2304 + 64 * (j))
#define XB_TOP      3328
#define XB_TOPGEN   3392
#define XCD_BAR_WORDS 3456
#define XB_SPIN_CAP (1u << 18)
__device__ __forceinline__ unsigned xb_ld(unsigned* p)              { return __hip_atomic_load(p, __ATOMIC_RELAXED, __HIP_MEMORY_SCOPE_AGENT); }
__device__ __forceinline__ unsigned xb_add(unsigned* p, unsigned v) { return __hip_atomic_fetch_add(p, v, __ATOMIC_RELAXED, __HIP_MEMORY_SCOPE_AGENT); }
__device__ __forceinline__ unsigned xb_xcc_id() { return (unsigned)__builtin_amdgcn_s_getreg((3 << 11) | 20) & 0xFu; }
#define XB_SPIN(cond, bar) do { unsigned _sp = 0; while (cond) { __builtin_amdgcn_s_sleep(1); \
    if ((++_sp & 255u) == 0u) { if (xb_ld(&(bar)[XB_TMO])) break; if (_sp > XB_SPIN_CAP) { atomicAdd(&(bar)[XB_TMO], 1u); break; } } } } while (0)
struct XcdBarrier { unsigned* bar; unsigned x; volatile LAS unsigned* st; };
__device__ __forceinline__ XcdBarrier xcd_barrier_post(unsigned* bar, volatile LAS unsigned* st) {
    XcdBarrier b; b.bar = bar; b.x = xb_xcc_id(); b.st = st;
    if (threadIdx.x == 0) (void)xb_add(&bar[XB_XCNT(b.x)], 1u);
    return b;
}
__device__ __forceinline__ void xcd_barrier_complete(unsigned* bar, unsigned x, unsigned& nloc, unsigned& nx) {
    const unsigned G = gridDim.x * gridDim.y * gridDim.z;
    unsigned sum, cnt, mine, sp = 0u;
    for (;;) {
        sum = 0u; cnt = 0u; mine = 0u;
#pragma unroll
        for (unsigned j = 0; j < 16; ++j) { const unsigned c = xb_ld(&bar[XB_XCNT(j)]); sum += c; cnt += (c > 0u) ? 1u : 0u; mine = (j == x) ? c : mine; }
        if (sum == G) break;
        __builtin_amdgcn_s_sleep(1);
        if ((++sp & 255u) == 0u) { if (xb_ld(&bar[XB_TMO])) break; if (sp > XB_SPIN_CAP) { atomicAdd(&bar[XB_TMO], 1u); break; } }
    }
    nloc = mine > 0u ? mine : 1u; nx = cnt > 0u ? cnt : 1u;
}
__device__ __forceinline__ void xcd_barrier(const XcdBarrier& b) {
    asm volatile("s_waitcnt vmcnt(0)" ::: "memory");
    __syncthreads();
    if (threadIdx.x == 0) {
        unsigned* bar = b.bar;
        __builtin_amdgcn_s_waitcnt(0);
        unsigned nloc = b.st[0], nx = b.st[1];
        if (nloc == 0u) { xcd_barrier_complete(bar, b.x, nloc, nx); b.st[0] = nloc; b.st[1] = nx; }
        const unsigned old = xb_add(&bar[XB_XSUB(b.x)], 1u);
        const unsigned gen = old / nloc;
        if (old + 1u == (gen + 1u) * nloc) {
            __builtin_amdgcn_fence(__ATOMIC_RELEASE, "agent");
            asm volatile("s_waitcnt vmcnt(0)" ::: "memory");
            const unsigned og = xb_add(&bar[XB_TOP], 1u);
            const unsigned tg = og / nx;
            if (og + 1u == (tg + 1u) * nx) xb_add(&bar[XB_TOPGEN], 1u);
            else XB_SPIN(xb_ld(&bar[XB_TOPGEN]) == tg, bar);
            __builtin_amdgcn_fence(__ATOMIC_ACQUIRE, "agent");
            xb_add(&bar[XB_XGEN(b.x)], 1u);
            asm volatile("s_waitcnt vmcnt(0)" ::: "memory");
        } else {
            XB_SPIN(xb_ld(&bar[XB_XGEN(b.x)]) == gen, bar);
            __builtin_amdgcn_fence(__ATOMIC_ACQUIRE, "agent");
            asm volatile("s_waitcnt vmcnt(0)" ::: "memory");
        }
    }
    __syncthreads();
}

namespace pg8 {
constexpr int BM = 256, BK = 64, HALF = 128, HTB = HALF * BK * 2, STAGE_BYTES = 8 * HTB, NXCD = 8, WGM = 8;
__host__ __device__ __forceinline__ int lds_byte(int r, int c) { const int st = (r >> 4) * 2 + (c >> 5), rr = r & 15, cc = c & 31, ob = rr * 64 + cc * 2; return st * 1024 + (ob ^ (((ob >> 9) & 1) << 5)); }
__host__ __device__ __forceinline__ void stage_rc(int b, int& R, int& C) { const int st = b / 1024, sb = b % 1024, swz = sb ^ (((sb >> 9) & 1) << 5); R = (st >> 1) * 16 + swz / 64; C = (st & 1) * 32 + (swz % 64) / 2; }
__host__ __device__ __forceinline__ int perm32(int rho) { const int n = rho >> 4, i = rho & 15; return 8 * (i >> 2) + 4 * n + (i & 3); }

struct Unit { int pm, pn, e, it, cnt; };

struct StaticOrder {
    int nM, nN, nwg, G, c;
    __device__ void init(int M, int N, int G_, int c_) { nM = M / BM; nN = N / BM; nwg = nM * nN; G = G_; c = c_; }
    __device__ bool next(int i, Unit& u) const {
        const long L = (long)i * G + c; if (L >= nwg) return false;
        int wgid = (int)L; { const int q = nwg / NXCD, r = nwg % NXCD, xcd = wgid % NXCD, off = wgid / NXCD; wgid = (xcd < r ? xcd * (q + 1) : r * (q + 1) + (xcd - r) * q) + off; }
        const int nig = WGM * nN, gid = wgid / nig, fm = gid * WGM, gsz = (nM - fm) < WGM ? (nM - fm) : WGM;
        u.pm = fm + ((wgid % nig) % gsz); u.pn = (wgid % nig) / gsz; u.e = 0; u.it = 0; u.cnt = 0; return true;
    }
    __device__ __forceinline__ int arow(const Unit&, int r) const { return r; }
};

template <class Epi, class Sched, bool GATHER>
__device__ __forceinline__ void gemm_phase(LAS unsigned char* lds, const bf16_t* Ap, const bf16_t* Btp, const int K, const Sched& S, const Epi& E) {
    const int tid = threadIdx.x, wid = __builtin_amdgcn_readfirstlane(tid >> 6), lane = tid & 63, wr = wid >> 2, wc = wid & 3, fr = lane & 15, fq = lane >> 4;
    const int nt = K / BK;
    unsigned voffA[2], voffB[2]; int RA[2], CA[2];
#pragma unroll
    for (int i = 0; i < 2; ++i) { int R, C; stage_rc(tid * 16 + i * 8192, R, C); const int Rb = Epi::PERM ? ((R & ~31) + perm32(R & 31)) : R;
        RA[i] = R; CA[i] = C; voffA[i] = (unsigned)(R * K + C) * 2u; voffB[i] = (unsigned)(Rb * K + C) * 2u; }
    const size_t kstep = (size_t)(BK * 2);
    const size_t hstep = (size_t)HALF * K * 2;
    const size_t tstep = 2 * hstep;
    const unsigned ldsw = (unsigned)wid * 1024u;
    const int aoff = lds_byte(wr * 64 + fr, fq * 8), boff = lds_byte(wc * 32 + fr, fq * 8);
    unsigned vC[2][2], vN[2][2], v2[2][2];
#define PG8_SA(b, h) (((b) * 2 + (h)) * HTB)
#define PG8_SB(b, h) ((4 + (b) * 2 + (h)) * HTB)
#define PG8_STAGE(bufoff, gbase, voff) do { _Pragma("unroll") for (int _i = 0; _i < 2; ++_i) \
        __builtin_amdgcn_global_load_lds((const unsigned*)((const char*)(gbase) + (voff)[_i]), (LAS unsigned*)(lds + (bufoff) + ldsw + _i * 8192), 16, 0, 0); } while (0)
#define PG8_STAGE_A(bufoff, gbase, h, vsel) do { if constexpr (GATHER) { PG8_STAGE(bufoff, gbase, (vsel)[h]); } else { PG8_STAGE(bufoff, (gbase) + (h) * hstep, voffA); } } while (0)
#define PG8_GVOFF(u, v) do { _Pragma("unroll") for (int _h = 0; _h < 2; ++_h) _Pragma("unroll") for (int _i = 0; _i < 2; ++_i) \
        (v)[_h][_i] = (unsigned)(S.arow(u, _h * HALF + RA[_i]) * K + CA[_i]) * 2u; } while (0)
#define PG8_LDA(dst, b, h) do { _Pragma("unroll") for (int m = 0; m < 4; ++m) _Pragma("unroll") for (int k = 0; k < 2; ++k) dst[m][k] = *(const LAS bf16x8*)(lds + PG8_SA(b, h) + aoff + m * 2048 + k * 1024); } while (0)
#define PG8_LDB(dst, b, h) do { _Pragma("unroll") for (int n = 0; n < 2; ++n) _Pragma("unroll") for (int k = 0; k < 2; ++k) dst[n][k] = *(const LAS bf16x8*)(lds + PG8_SB(b, h) + boff + n * 2048 + k * 1024); } while (0)
#define PG8_MMA(ai, bj, At, Bt) do { __builtin_amdgcn_s_setprio(1); _Pragma("unroll") for (int m = 0; m < 4; ++m) _Pragma("unroll") for (int n = 0; n < 2; ++n) _Pragma("unroll") for (int k = 0; k < 2; ++k) \
        acc[ai][bj][m][n] = __builtin_amdgcn_mfma_f32_16x16x32_bf16(Bt[n][k], At[m][k], acc[ai][bj][m][n], 0, 0, 0); __builtin_amdgcn_s_setprio(0); } while (0)
#define PG8_WAIT_V(n) asm volatile("s_waitcnt vmcnt(" #n ")" ::: "memory")
#define PG8_WAIT_L(n) asm volatile("s_waitcnt lgkmcnt(" #n ")" ::: "memory")
#define PG8_BAR __builtin_amdgcn_s_barrier()
#define PG8_SCHED __builtin_amdgcn_sched_barrier(0)
    Unit cur, nxt; int ui = 0;
    if (!S.next(0, cur)) return;
    f32x4 acc[2][2][4][2];
#pragma unroll
    for (int a = 0; a < 2; ++a)
#pragma unroll
        for (int b = 0; b < 2; ++b)
#pragma unroll
            for (int m = 0; m < 4; ++m)
#pragma unroll
                for (int n = 0; n < 2; ++n) acc[a][b][m][n] = (f32x4){0.f, 0.f, 0.f, 0.f};
    bf16x8 At[4][2], B0[2][2], B1[2][2];
    const char* cA = GATHER ? (const char*)Ap : (const char*)Ap + (size_t)cur.pm * tstep; const char* cB = (const char*)Btp + (size_t)cur.pn * tstep;
    if constexpr (GATHER) { PG8_GVOFF(cur, vC); }
    PG8_STAGE(PG8_SB(0, 0), cB, voffB); PG8_STAGE(PG8_SB(0, 1), cB + hstep, voffB); PG8_STAGE_A(PG8_SA(0, 0), cA, 0, vC); PG8_STAGE_A(PG8_SA(0, 1), cA, 1, vC);
    if (wr == 1) PG8_BAR;
    PG8_WAIT_V(2); PG8_BAR;
    PG8_STAGE(PG8_SB(1, 0), cB + kstep, voffB); PG8_STAGE_A(PG8_SA(1, 0), cA + kstep, 0, vC); PG8_STAGE(PG8_SB(1, 1), cB + hstep + kstep, voffB);
    PG8_WAIT_V(6); PG8_BAR;
    for (;;) {
        const bool has_next = S.next(ui + 1, nxt);
        const char* nA = GATHER ? (const char*)Ap : (has_next ? (const char*)Ap + (size_t)nxt.pm * tstep : cA);
        const char* nB = has_next ? (const char*)Btp + (size_t)nxt.pn * tstep : cB;
        if constexpr (GATHER) { if (has_next) { PG8_GVOFF(nxt, vN); } else {
#pragma unroll
            for (int h = 0; h < 2; ++h) { vN[h][0] = vC[h][0]; vN[h][1] = vC[h][1]; } } }
        for (int t = 0; t < nt; t += 2) {
            const bool last = (t == nt - 2);
            const char* a1 = cA + (size_t)(t + 1) * kstep;
            const char* a2 = last ? nA : cA + (size_t)(t + 2) * kstep; const char* b2 = last ? nB : cB + (size_t)(t + 2) * kstep;
            const char* a3 = a2 + kstep; const char* b3 = b2 + kstep;
            if constexpr (GATHER) {
#pragma unroll
                for (int h = 0; h < 2; ++h) { v2[h][0] = last ? vN[h][0] : vC[h][0]; v2[h][1] = last ? vN[h][1] : vC[h][1]; } }
            PG8_LDB(B0, 0, 0); PG8_LDB(B1, 0, 1); PG8_SCHED; PG8_LDA(At, 0, 0); PG8_STAGE_A(PG8_SA(1, 1), a1, 1, vC);
            PG8_WAIT_V(8); PG8_WAIT_L(0); PG8_BAR; PG8_MMA(0, 0, At, B0); PG8_MMA(0, 1, At, B1); PG8_BAR; PG8_SCHED;
            PG8_LDA(At, 0, 1); PG8_STAGE(PG8_SB(0, 0), b2, voffB); PG8_STAGE(PG8_SB(0, 1), b2 + hstep, voffB); PG8_STAGE_A(PG8_SA(0, 0), a2, 0, v2);
            PG8_WAIT_V(8); PG8_WAIT_L(0); PG8_BAR; PG8_MMA(1, 0, At, B0); PG8_MMA(1, 1, At, B1); PG8_BAR; PG8_SCHED;
            PG8_LDB(B0, 1, 0); PG8_LDB(B1, 1, 1); PG8_SCHED; PG8_LDA(At, 1, 0); PG8_STAGE_A(PG8_SA(0, 1), a2, 1, v2);
            PG8_WAIT_V(8); PG8_WAIT_L(0); PG8_BAR; PG8_MMA(0, 0, At, B0); PG8_MMA(0, 1, At, B1); PG8_BAR; PG8_SCHED;
            PG8_LDA(At, 1, 1); PG8_STAGE(PG8_SB(1, 0), b3, voffB); PG8_STAGE(PG8_SB(1, 1), b3 + hstep, voffB); PG8_STAGE_A(PG8_SA(1, 0), a3, 0, v2);
            PG8_WAIT_V(8); PG8_WAIT_L(0); PG8_BAR; PG8_MMA(1, 0, At, B0); PG8_MMA(1, 1, At, B1); PG8_BAR; PG8_SCHED;
        }
        if (wr == 0) PG8_BAR;
        E(acc, cur, wr, wc, fr, fq);
        if (!has_next) break;
#pragma unroll
        for (int a = 0; a < 2; ++a)
#pragma unroll
            for (int b = 0; b < 2; ++b)
#pragma unroll
                for (int m = 0; m < 4; ++m)
#pragma unroll
                    for (int n = 0; n < 2; ++n) acc[a][b][m][n] = (f32x4){0.f, 0.f, 0.f, 0.f};
        cur = nxt; cA = nA; cB = nB; ++ui;
        if constexpr (GATHER) {
#pragma unroll
            for (int h = 0; h < 2; ++h) { vC[h][0] = vN[h][0]; vC[h][1] = vN[h][1]; } }
        if (wr == 1) PG8_BAR;
    }
    PG8_WAIT_V(0);
    PG8_BAR;
#undef PG8_SA
#undef PG8_SB
#undef PG8_STAGE
#undef PG8_STAGE_A
#undef PG8_GVOFF
#undef PG8_LDA
#undef PG8_LDB
#undef PG8_MMA
#undef PG8_WAIT_V
#undef PG8_WAIT_L
#undef PG8_BAR
#undef PG8_SCHED
}
}

struct Params { const float* in[25]; float* out; unsigned char* ws; int ph_lo, ph_hi; };
struct Frame {
    LAS unsigned char* lds; int G, bx;
    unsigned char* ws;
    const float *x, *c, *w_ada, *b_ada, *w_in, *b_mgate, *conv_w, *conv_b, *m_norm_g, *w_proj_a, *w_proj_m, *w_gate, *b_gate, *w_out, *ln1_g, *ln1_b, *w_rg, *b_rg, *w_re, *b_re, *w_eg, *w_eu, *w_ed, *ln2_g, *ln2_b;
    float* out;
};
__device__ __forceinline__ int otid() { int t = threadIdx.x; asm volatile("" : "+v"(t)); return t; }
#define FTID otid()
#define FLANE (otid() & 63)
#define FWAVE __builtin_amdgcn_readfirstlane(otid() >> 6)
#define WSP(T_, off) ((T_*)(F.ws + (off)))

template <class RowMap>
__device__ __forceinline__ void cvt_tile(const Frame& F, const float* src, int lds_src, int k0, int n0, bf16_t* dst, int Kdst, const RowMap& rm) {
    LAS bf16_t* tl = (LAS bf16_t*)F.lds;
    const int t = FTID;
    f32x4 v[8];
#pragma unroll
    for (int p = 0; p < 8; ++p) { const int k = (t >> 6) + 8 * p, n4 = (t & 63) * 4; v[p] = *(const f32x4*)(src + (size_t)(k0 + k) * lds_src + n0 + n4); }
    __syncthreads();
#pragma unroll
    for (int p = 0; p < 8; ++p) { const int k = (t >> 6) + 8 * p, n4 = (t & 63) * 4;
#pragma unroll
        for (int j = 0; j < 4; ++j) tl[(n4 + j) * 72 + k] = f2bf(v[p][j]); }
    __syncthreads();
#pragma unroll
    for (int p = 0; p < 4; ++p) { const int id = t + 512 * p; const int n = id >> 3, kc = (id & 7) * 8;
        const u32x4 w = *(const LAS u32x4*)(tl + n * 72 + kc);
        *(u32x4*)(dst + (size_t)rm(n0 + n) * Kdst + k0 + kc) = w; }
}
struct RmWin { __device__ int operator()(int n) const { if (n < 3072) { const int hd = n >> 7, lc = n & 127; return hd * 128 + 2 * (lc & 63) + (lc >> 6); } return n; } };
struct RmOff { int off; __device__ int operator()(int n) const { return n + off; } };
struct RmW1 { int up; __device__ int operator()(int f) const { return 256 * (f >> 7) + 128 * up + (f & 127); } };

__device__ __forceinline__ void p0_prologue(const Frame& F) {
    const int G = F.G, bx = F.bx;
    bf16_t* WBIG = WSP(bf16_t, WS_WBIG); bf16_t* WPA = WSP(bf16_t, WS_WPA); bf16_t* WPM = WSP(bf16_t, WS_WPM); bf16_t* WO = WSP(bf16_t, WS_WO);
    bf16_t* W1T = WSP(bf16_t, WS_W1T); bf16_t* W2T = WSP(bf16_t, WS_W2T);
    constexpr int T_WIN = 32 * 34, T_WG = 32 * 16, T_PA = 8 * 8, T_PM = 16 * 8, T_WO = 32 * 8, T_EG = 32 * 4 * 32, T_ED = 16 * 8 * 32;
    constexpr int E0 = T_WIN, E1 = E0 + T_WG, E2 = E1 + T_PA, E3 = E2 + T_PM, E4 = E3 + T_WO, E5 = E4 + T_EG, E6 = E5 + T_EG, E7 = E6 + T_ED;
    for (int ti = bx; ti < E7; ti += G) {
        if (ti < E0) { const int kt = ti % 32, ntl = ti / 32; cvt_tile(F, F.w_in, NIN, kt * 64, ntl * 256, WBIG, D, RmWin{}); }
        else if (ti < E1) { const int q = ti - E0; const int kt = q % 32, ntl = q / 32; cvt_tile(F, F.w_gate, 4096, kt * 64, ntl * 256, WBIG, D, RmOff{8704}); }
        else if (ti < E2) { const int q = ti - E1; const int kt = q % 8, ntl = q / 8; cvt_tile(F, F.w_proj_a, D, kt * 64, ntl * 256, WPA, 512, RmOff{0}); }
        else if (ti < E3) { const int q = ti - E2; const int kt = q % 16, ntl = q / 16; cvt_tile(F, F.w_proj_m, D, kt * 64, ntl * 256, WPM, 1024, RmOff{0}); }
        else if (ti < E4) { const int q = ti - E3; const int kt = q % 32, ntl = q / 32; cvt_tile(F, F.w_out, D, kt * 64, ntl * 256, WO, D, RmOff{0}); }
        else if (ti < E5) { const int q = ti - E4; const int kt = q % 32, ntl = (q / 32) % 4, e = q / 128; cvt_tile(F, F.w_eg + (size_t)e * D * FF, FF, kt * 64, ntl * 256, W1T + (size_t)e * 2048 * D, D, RmW1{0}); }
        else if (ti < E6) { const int q = ti - E5; const int kt = q % 32, ntl = (q / 32) % 4, e = q / 128; cvt_tile(F, F.w_eu + (size_t)e * D * FF, FF, kt * 64, ntl * 256, W1T + (size_t)e * 2048 * D, D, RmW1{1}); }
        else { const int q = ti - E6; const int kt = q % 16, ntl = (q / 16) % 8, e = q / 128; cvt_tile(F, F.w_ed + (size_t)e * FF * D, D, kt * 64, ntl * 256, W2T + (size_t)e * D * FF, FF, RmOff{0}); }
    }
    __syncthreads();
    {
        LAS float* sc = (LAS float*)F.lds;
        LAS float* red = (LAS float*)(F.lds + 32768);
        float* mod = WSP(float, WS_MOD);
        for (int i = FTID; i < NB * D; i += NTHR) { const float cv = F.c[i]; sc[i] = cv / (1.f + expf(-cv)); }
        __syncthreads();
        for (int cb = bx; cb < 6 * D / 48; cb += G) {
            const int cg = FTID % 12, kl = FTID / 12;
            float a[4][4] = {};
            if (kl < 42) {
                for (int k0 = kl; k0 < D; k0 += 42 * 7) { f32x4 w[7];
#pragma unroll
                    for (int u = 0; u < 7; ++u) { const int k = k0 + 42 * u; w[u] = (k < D) ? *(const f32x4*)(F.w_ada + (size_t)k * (6 * D) + cb * 48 + cg * 4) : (f32x4){0.f, 0.f, 0.f, 0.f}; }
#pragma unroll
                    for (int u = 0; u < 7; ++u) { const int k = (k0 + 42 * u < D) ? k0 + 42 * u : 0;
#pragma unroll
                        for (int b = 0; b < 4; ++b) { const float s = sc[b * D + k];
#pragma unroll
                            for (int j = 0; j < 4; ++j) a[b][j] += s * w[u][j]; } } }
#pragma unroll
                for (int b = 0; b < 4; ++b)
#pragma unroll
                    for (int j = 0; j < 4; ++j) red[(kl * 12 + cg) * 16 + b * 4 + j] = a[b][j];
            }
            __syncthreads();
            if (FTID < 192) { const int cgi = FTID / 16, bj = FTID % 16; float s = 0.f; for (int q = 0; q < 42; ++q) s += red[(q * 12 + cgi) * 16 + bj];
                const int b = bj / 4, j = bj % 4; const int col = cb * 48 + cgi * 4 + j; mod[(size_t)b * 6 * D + col] = s + F.b_ada[col]; }
            __syncthreads();
        }
    }
    {
        float* rope = WSP(float, WS_ROPE);
        for (int i = bx * NTHR + FTID; i < S * 64; i += G * NTHR) { const int pos = i >> 6, fi = i & 63;
            const float inv = powf(10000.f, -(float)(2 * fi) / 128.f); const float ang = (float)pos * inv; rope[2 * i] = cosf(ang); rope[2 * i + 1] = sinf(ang); }
        float* wif = WSP(float, WS_WIF);
        for (int i = bx * NTHR + FTID; i < 8 * D; i += G * NTHR) { const int j = i / D, k = i % D; wif[i] = F.w_in[(size_t)k * NIN + OFF_IF + j]; }
        bf16_t* wrt = WSP(bf16_t, WS_WRT);
        for (int i = bx * NTHR + FTID; i < 48 * D; i += G * NTHR) { const int j = i / D, k = i % D;
            const float w = (j < 4) ? F.w_rg[k * 4 + j] : (j < 36 ? F.w_re[k * 32 + (j - 4)] : 0.f);
            const bf16_t hi = f2bf(w); const bf16_t lo = f2bf(w - bf2f(hi)); wrt[i] = hi; wrt[48 * D + i] = lo; }
    }
}

__device__ __forceinline__ void p1_lnmod(const Frame& F) {
    const float* mod = WSP(float, WS_MOD); const float* wif = WSP(float, WS_WIF); bf16_t* U = WSP(bf16_t, WS_U); float* gpre = WSP(float, WS_GPRE);
    const int tid = FTID; const int lane = tid & 63; const int gw = F.bx * NWAVES + __builtin_amdgcn_readfirstlane(tid >> 6), NGW = F.G * NWAVES;
    LAS float* wl = (LAS float*)F.lds;
    __syncthreads();
#pragma unroll
    for (int i = 0; i < 8; ++i) *(LAS f32x4*)(wl + 4 * (tid + NTHR * i)) = *(const f32x4*)(wif + 4 * (tid + NTHR * i));
    __syncthreads();
    f32x4 v[8], nx[8];
    if (gw < T) {
#pragma unroll
        for (int i = 0; i < 8; ++i) nx[i] = *(const f32x4*)(F.x + (size_t)gw * D + 4 * (lane + 64 * i)); }
    for (int t = gw; t < T; t += NGW) {
        const int b = t / S; float s = 0.f;
#pragma unroll
        for (int i = 0; i < 8; ++i) { v[i] = nx[i]; s += (v[i][0] + v[i][1]) + (v[i][2] + v[i][3]); }
        if (t + NGW < T) {
#pragma unroll
            for (int i = 0; i < 8; ++i) nx[i] = *(const f32x4*)(F.x + (size_t)(t + NGW) * D + 4 * (lane + 64 * i)); }
        const float mu = wave_sum(s) * (1.f / D);
        float q = 0.f;
#pragma unroll
        for (int i = 0; i < 8; ++i) { v[i] = v[i] - mu; q += (v[i][0] * v[i][0] + v[i][1] * v[i][1]) + (v[i][2] * v[i][2] + v[i][3] * v[i][3]); }
        const float rstd = rsqrtf(wave_sum(q) * (1.f / D) + LN_EPS);
        const float* sc = mod + (size_t)b * 6 * D + 1 * D; const float* sf = mod + (size_t)b * 6 * D;
#pragma unroll
        for (int i = 0; i < 8; ++i) { const int d = 4 * (lane + 64 * i); const f32x4 a = *(const f32x4*)(sc + d), bb = *(const f32x4*)(sf + d);
            v[i] = v[i] * rstd * (a + 1.f) + bb;
            u32x2 w; w.x = cvt_pk_bf16(v[i][0], v[i][1]); w.y = cvt_pk_bf16(v[i][2], v[i][3]); *(u32x2*)(U + (size_t)t * D + d) = w; }
        float g[8];
#pragma unroll
        for (int j = 0; j < 8; ++j) { float a = 0.f;
#pragma unroll
            for (int i = 0; i < 8; ++i) { const f32x4 w = *(const LAS f32x4*)(wl + j * D + 4 * (lane + 64 * i)); a += (v[i][0] * w[0] + v[i][1] * w[1]) + (v[i][2] * w[2] + v[i][3] * w[3]); }
            g[j] = wave_sum(a); }
        if (lane < 8) { float val = 0.f;
#pragma unroll
            for (int j = 0; j < 8; ++j) val = (lane == j) ? g[j] : val;
            val += F.b_mgate[lane];
            if (lane >= 4) val = fminf(val, 0.f) - log1pf(expf(-fabsf(val)));
            gpre[(size_t)t * 8 + lane] = val; }
    }
}

struct EpiP2 {
    static constexpr bool PERM = true;
    bf16_t *Q, *Kb, *V, *QKP, *VM, *OG, *GB; const float* rope; const float* b_gate;
    __device__ __forceinline__ void operator()(const f32x4 (&acc)[2][2][4][2], const pg8::Unit& u, int wr, int wc, int fr, int fq) const {
        const int pn = u.pn; int kind, coff, ldc; bf16_t* base;
        if (pn < 6) { kind = 0; base = Q; ldc = 1536; coff = pn * 256; }
        else if (pn < 12) { kind = 1; base = Kb; ldc = 1536; coff = (pn - 6) * 256; }
        else if (pn < 18) { kind = 2; base = V; ldc = 1536; coff = (pn - 12) * 256; }
        else if (pn < 26) { kind = 2; base = QKP; ldc = 2048; coff = (pn - 18) * 256; }
        else if (pn < 30) { kind = 2; base = VM; ldc = 1024; coff = (pn - 26) * 256; }
        else if (pn < 34) { kind = 3; base = OG; ldc = 1024; coff = (pn - 30) * 256; }
        else { kind = 4; base = GB; ldc = 4096; coff = (pn - 34) * 256; }
        const int row0 = u.pm * 256 + wr * 64 + fr, colL = wc * 32 + 8 * fq;
#pragma unroll
        for (int ai = 0; ai < 2; ++ai)
#pragma unroll
            for (int m = 0; m < 4; ++m) { const int r = row0 + ai * 128 + m * 16; const int pos = r & (S - 1);
#pragma unroll
                for (int bj = 0; bj < 2; ++bj) { f32x4 v0 = acc[ai][bj][m][0], v1 = acc[ai][bj][m][1]; const int col = coff + bj * 128 + colL;
                    if (kind <= 1) {
                        const float* rp = rope + ((size_t)pos * 64 + (16 * wc + 4 * fq)) * 2;
                        const f32x4 c0 = *(const f32x4*)rp, c1 = *(const f32x4*)(rp + 4);
                        const float sc = (kind == 0) ? QSCALE : 1.f;
                        f32x4 o0, o1;
                        o0[0] = (v0[0] * c0[0] - v0[1] * c0[1]) * sc; o0[1] = (v0[1] * c0[0] + v0[0] * c0[1]) * sc;
                        o0[2] = (v0[2] * c0[2] - v0[3] * c0[3]) * sc; o0[3] = (v0[3] * c0[2] + v0[2] * c0[3]) * sc;
                        o1[0] = (v1[0] * c1[0] - v1[1] * c1[1]) * sc; o1[1] = (v1[1] * c1[0] + v1[0] * c1[1]) * sc;
                        o1[2] = (v1[2] * c1[2] - v1[3] * c1[3]) * sc; o1[3] = (v1[3] * c1[2] + v1[2] * c1[3]) * sc;
                        v0 = o0; v1 = o1;
                    } else if (kind >= 3) {
                        if (kind == 4) { v0 = v0 + *(const f32x4*)(b_gate + col); v1 = v1 + *(const f32x4*)(b_gate + col + 4); }
#pragma unroll
                        for (int j = 0; j < 4; ++j) { v0[j] = sigmoid_fast(v0[j]); v1[j] = sigmoid_fast(v1[j]); }
                    }
                    u32x4 w; w.x = cvt_pk_bf16(v0[0], v0[1]); w.y = cvt_pk_bf16(v0[2], v0[3]); w.z = cvt_pk_bf16(v1[0], v1[1]); w.w = cvt_pk_bf16(v1[2], v1[3]);
                    *(u32x4*)(base + (size_t)r * ldc + col) = w; } }
    }
};

__device__ __forceinline__ void scan_bh(const Frame& F, int bh) {
    const float* gpre = WSP(float, WS_GPRE); float* bc = WSP(float, WS_BCUM) + (size_t)bh * S; float* mc = WSP(float, WS_MCUM) + (size_t)bh * S;
    const int b = bh >> 2, h = bh & 3, lane = FLANE;
    float lf[32], iv[32];
#pragma unroll
    for (int j = 0; j < 32; ++j) { const size_t t = (size_t)b * S + lane * 32 + j; iv[j] = gpre[t * 8 + h]; lf[j] = gpre[t * 8 + 4 + h]; }
    float run = 0.f;
#pragma unroll
    for (int j = 0; j < 32; ++j) { run += lf[j]; lf[j] = run; }
    float tot = run, incl = run;
#pragma unroll
    for (int o = 1; o < 64; o <<= 1) { const float n = __shfl_up(incl, o); if (lane >= o) incl += n; }
    const float excl = incl - tot;
    float mx = -INFINITY;
#pragma unroll
    for (int j = 0; j < 32; ++j) { lf[j] += excl; mx = fmaxf(mx, iv[j] - lf[j]); iv[j] = mx; }
    float mincl = mx;
#pragma unroll
    for (int o = 1; o < 64; o <<= 1) { const float n = __shfl_up(mincl, o); if (lane >= o) mincl = fmaxf(mincl, n); }
    float mexcl = __shfl_up(mincl, 1); if (lane == 0) mexcl = -INFINITY;
#pragma unroll
    for (int j = 0; j < 32; ++j) { const float cm = fmaxf(0.f, fmaxf(mexcl, iv[j])); bc[lane * 32 + j] = lf[j]; mc[lane * 32 + j] = lf[j] + cm; }
}

__device__ __forceinline__ void p3_conv(const Frame& F) {
    const bf16_t* QKP = WSP(bf16_t, WS_QKP); bf16_t* QM = WSP(bf16_t, WS_QM); bf16_t* KM = WSP(bf16_t, WS_KM);
    for (int item = F.bx * NTHR + FTID; item < 256 * 512; item += F.G * NTHR) {
        const int cc = item & 255, rs = item >> 8; const int c0 = cc * 8, t0 = rs * 16;
        float w[4][8], bias[8];
#pragma unroll
        for (int j = 0; j < 4; ++j) { const f32x4 a = *(const f32x4*)(F.conv_w + j * 2048 + c0), b = *(const f32x4*)(F.conv_w + j * 2048 + c0 + 4);
#pragma unroll
            for (int e = 0; e < 4; ++e) { w[j][e] = a[e]; w[j][4 + e] = b[e]; } }
        { const f32x4 a = *(const f32x4*)(F.conv_b + c0), b = *(const f32x4*)(F.conv_b + c0 + 4);
#pragma unroll
            for (int e = 0; e < 4; ++e) { bias[e] = a[e]; bias[4 + e] = b[e]; } }
        float x1[8], x2[8], x3[8];
        const int pos0 = t0 & (S - 1);
        auto ldrow = [&](int t, float (&dst)[8]) { const u32x4 v = *(const u32x4*)(QKP + (size_t)t * 2048 + c0);
            dst[0] = bf_lo(v.x); dst[1] = bf_hi(v.x); dst[2] = bf_lo(v.y); dst[3] = bf_hi(v.y); dst[4] = bf_lo(v.z); dst[5] = bf_hi(v.z); dst[6] = bf_lo(v.w); dst[7] = bf_hi(v.w); };
        if (pos0 >= 3) { ldrow(t0 - 1, x1); ldrow(t0 - 2, x2); ldrow(t0 - 3, x3); }
        else {
#pragma unroll
            for (int e = 0; e < 8; ++e) { x1[e] = 0.f; x2[e] = 0.f; x3[e] = 0.f; } }
        const bool isk = c0 >= 1024; bf16_t* dst = isk ? (KM + (c0 - 1024)) : (QM + c0); const float osc = isk ? 0.0625f : 1.f;
#pragma unroll 4
        for (int r = 0; r < 16; ++r) { float x0[8]; ldrow(t0 + r, x0); float y[8];
#pragma unroll
            for (int e = 0; e < 8; ++e) { y[e] = bias[e] + w[3][e] * x0[e] + w[2][e] * x1[e] + w[1][e] * x2[e] + w[0][e] * x3[e]; y[e] = silu_fast(y[e]) * osc; x3[e] = x2[e]; x2[e] = x1[e]; x1[e] = x0[e]; }
            u32x4 o; o.x = cvt_pk_bf16(y[0], y[1]); o.y = cvt_pk_bf16(y[2], y[3]); o.z = cvt_pk_bf16(y[4], y[5]); o.w = cvt_pk_bf16(y[6], y[7]);
            *(u32x4*)(dst + (size_t)(t0 + r) * 1024) = o; }
    }
}

constexpr int AT_KP = 272, AT_VP = 288, AT_VOFF = 256 * AT_KP;
__device__ __forceinline__ void attn_unit(const Frame& F, int unit) {
    const bf16_t* QB = WSP(bf16_t, WS_QB); const bf16_t* KB = WSP(bf16_t, WS_KB); const bf16_t* VB = WSP(bf16_t, WS_VB); bf16_t* OA = WSP(bf16_t, WS_OATT); float* LSE = WSP(float, WS_LSE);
    const int b = unit / 192, rem = unit % 192, head = rem >> 4, blk = rem & 15;
    const int g = head >> 2; const int dl = (g == 0) ? 0 : (g == 1 ? 2 : 4); const int d = 1 << dl; const int nbr = 16 >> dl;
    const int r = blk / nbr, n = blk % nbr;
    const int tid = FTID, lane = FLANE, w = FWAVE, jl = lane & 15, g4 = lane >> 4;
    LAS unsigned char* Ks = F.lds; LAS unsigned char* Vs = F.lds + AT_VOFF;
    __syncthreads();
#pragma unroll
    for (int pass = 0; pass < 2; ++pass) {
        u32x4 v[8];
#pragma unroll
        for (int i = 0; i < 8; ++i) { const int id = tid + NTHR * i; const int row = id >> 4, ch = id & 15; const int bn = (row < 128) ? n - 1 : n; const int lr = row & 127;
            const int pos = ((bn * 128 + lr) << dl) + r;
            const bf16_t* src = (pass == 0 ? KB : VB) + (size_t)(b * S + pos) * 1536 + head * 128 + ch * 8;
            v[i] = (bn >= 0) ? *(const u32x4*)src : (u32x4){0u, 0u, 0u, 0u}; }
#pragma unroll
        for (int i = 0; i < 8; ++i) { const int id = tid + NTHR * i; const int row = id >> 4, ch = id & 15;
            if (pass == 0) *(LAS u32x4*)(Ks + row * AT_KP + ch * 16) = v[i]; else *(LAS u32x4*)(Vs + row * AT_VP + ch * 16) = v[i]; }
    }
    const int posq = (((n * 128 + 16 * w + jl)) << dl) + r;
    const size_t tq = (size_t)b * S + posq;
    bf16x8 qf[4];
#pragma unroll
    for (int ks = 0; ks < 4; ++ks) qf[ks] = *(const bf16x8*)(QB + tq * 1536 + head * 128 + ks * 32 + 8 * g4);
    __syncthreads();
    f32x4 sT[10];
#pragma unroll
    for (int u = 0; u < 9; ++u) { f32x4 a = {0.f, 0.f, 0.f, 0.f};
#pragma unroll
        for (int ks = 0; ks < 4; ++ks) { const bf16x8 kf = *(const LAS bf16x8*)(Ks + (16 * (w + u) + jl) * AT_KP + (ks * 32 + 8 * g4) * 2); a = __builtin_amdgcn_mfma_f32_16x16x32_bf16(kf, qf[ks], a, 0, 0, 0); }
        sT[u] = a; }
    sT[9] = (f32x4){0.f, 0.f, 0.f, 0.f};
    float mx = -INFINITY;
#pragma unroll
    for (int u = 0; u < 9; ++u)
#pragma unroll
        for (int rg = 0; rg < 4; ++rg) { const int kin = 4 * g4 + rg; bool valid;
            if (u == 0) valid = (n > 0) && (kin >= jl); else if (u == 8) valid = (kin <= jl); else valid = (w + u >= 8) || (n > 0);
            const float s = valid ? sT[u][rg] : -INFINITY; sT[u][rg] = s; mx = fmaxf(mx, s); }
    mx = fmaxf(mx, __shfl_xor(mx, 16)); mx = fmaxf(mx, __shfl_xor(mx, 32));
    float den = 0.f;
#pragma unroll
    for (int u = 0; u < 9; ++u)
#pragma unroll
        for (int rg = 0; rg < 4; ++rg) { const float p = fast_exp2(sT[u][rg] - mx); sT[u][rg] = p; den += p; }
    den += __shfl_xor(den, 16); den += __shfl_xor(den, 32);
    f32x4 oT[8];
#pragma unroll
    for (int et = 0; et < 8; ++et) oT[et] = (f32x4){0.f, 0.f, 0.f, 0.f};
    const unsigned vbase = (unsigned)(uintptr_t)(Vs) + (unsigned)((4 * g4 + (jl >> 2)) * AT_VP + (jl & 3) * 8);
#pragma unroll
    for (int c = 0; c < 5; ++c) {
        const int kt0 = w + 2 * c, kt1 = (c == 4) ? kt0 : kt0 + 1;
        union { bf16x8 v; unsigned u[4]; } pf;
        pf.u[0] = cvt_pk_bf16(sT[2 * c][0], sT[2 * c][1]); pf.u[1] = cvt_pk_bf16(sT[2 * c][2], sT[2 * c][3]);
        pf.u[2] = cvt_pk_bf16(sT[2 * c + 1][0], sT[2 * c + 1][1]); pf.u[3] = cvt_pk_bf16(sT[2 * c + 1][2], sT[2 * c + 1][3]);
        s16x4 t0[8], t1[8];
        const unsigned vb0 = vbase + kt0 * 16 * AT_VP, vb1 = vbase + kt1 * 16 * AT_VP;
#pragma unroll
        for (int et = 0; et < 8; ++et) { t0[et] = tr_read_o(vb0, et * 32); t1[et] = tr_read_o(vb1, et * 32); }
        LGKM_WAIT0();
#pragma unroll
        for (int et = 0; et < 8; ++et) oT[et] = __builtin_amdgcn_mfma_f32_16x16x32_bf16(PK8(t0[et], t1[et]), pf.v, oT[et], 0, 0, 0);
    }
    const float inv = 1.f / den;
#pragma unroll
    for (int et = 0; et < 8; ++et) { u32x2 o; o.x = cvt_pk_bf16(oT[et][0] * inv, oT[et][1] * inv); o.y = cvt_pk_bf16(oT[et][2] * inv, oT[et][3] * inv);
        *(u32x2*)(OA + tq * 1536 + head * 128 + 16 * et + 4 * g4) = o; }
    if (g4 == 0) LSE[tq * 12 + head] = (mx + log2f(den)) * LN2;
}

constexpr int ML_P = 544;
__device__ __forceinline__ void mlstm_dc_unit(const Frame& F, int unit) {
    const bf16_t* KM = WSP(bf16_t, WS_KM); const bf16_t* VM = WSP(bf16_t, WS_VMB); const float* gpre = WSP(float, WS_GPRE);
    const float* bcum = WSP(float, WS_BCUM); const float* mcum = WSP(float, WS_MCUM); float* DC = WSP(float, WS_DC) + (size_t)unit * 65536; float* DN = WSP(float, WS_DN) + (size_t)unit * 256;
    const int bh = unit >> 4, c = unit & 15, b = bh >> 2, h = bh & 3; const size_t t0 = (size_t)b * S + c * 128;
    const int tid = FTID, lane = FLANE, w = FWAVE, jl = lane & 15, g4 = lane >> 4;
    LAS unsigned char* Ks = F.lds; LAS unsigned char* Vs = F.lds + 128 * ML_P; LAS float* wt = (LAS float*)(F.lds + 2 * 128 * ML_P);
    __syncthreads();
    if (tid < 128) { const float Be = bcum[bh * S + c * 128 + 127], me = mcum[bh * S + c * 128 + 127];
        wt[tid] = expf(Be - bcum[bh * S + c * 128 + tid] + gpre[(t0 + tid) * 8 + h] - me); }
    __syncthreads();
    {
        u32x4 v[8];
#pragma unroll
        for (int i = 0; i < 8; ++i) { const int id = tid + NTHR * i; const int row = id >> 5, ch = id & 31; v[i] = *(const u32x4*)(KM + (t0 + row) * 1024 + h * 256 + ch * 8); }
#pragma unroll
        for (int i = 0; i < 8; ++i) { const int id = tid + NTHR * i; const int row = id >> 5, ch = id & 31; *(LAS u32x4*)(Ks + row * ML_P + ch * 16) = v[i]; }
#pragma unroll
        for (int i = 0; i < 8; ++i) { const int id = tid + NTHR * i; const int row = id >> 5, ch = id & 31; v[i] = *(const u32x4*)(VM + (t0 + row) * 1024 + h * 256 + ch * 8); }
#pragma unroll
        for (int i = 0; i < 8; ++i) { const int id = tid + NTHR * i; const int row = id >> 5, ch = id & 31; const float ws_ = wt[row]; u32x4 o;
            o.x = cvt_pk_bf16(bf_lo(v[i].x) * ws_, bf_hi(v[i].x) * ws_); o.y = cvt_pk_bf16(bf_lo(v[i].y) * ws_, bf_hi(v[i].y) * ws_);
            o.z = cvt_pk_bf16(bf_lo(v[i].z) * ws_, bf_hi(v[i].z) * ws_); o.w = cvt_pk_bf16(bf_lo(v[i].w) * ws_, bf_hi(v[i].w) * ws_);
            *(LAS u32x4*)(Vs + row * ML_P + ch * 16) = o; }
    }
    __syncthreads();
    if (tid < 256) { float a = 0.f; for (int s = 0; s < 128; ++s) a += wt[s] * bf2f(*(const LAS bf16_t*)(Ks + s * ML_P + tid * 2)); DN[tid] = a; }
    const int vr = w >> 1, kr = w & 1;
    f32x4 acc[4][8];
#pragma unroll
    for (int i = 0; i < 4; ++i)
#pragma unroll
        for (int j = 0; j < 8; ++j) acc[i][j] = (f32x4){0.f, 0.f, 0.f, 0.f};
    const unsigned rowoff = (unsigned)((4 * g4 + (jl >> 2)) * ML_P + (jl & 3) * 8);
    const unsigned kb = (unsigned)(uintptr_t)Ks + rowoff + kr * 256, vb = (unsigned)(uintptr_t)Vs + rowoff + vr * 128;
#pragma unroll 1
    for (int ks = 0; ks < 4; ++ks) {
        s16x4 a0[4], a1[4], b0[8], b1[8];
#pragma unroll
        for (int i = 0; i < 4; ++i) { a0[i] = tr_read_o(vb + ks * 32 * ML_P, i * 32); a1[i] = tr_read_o(vb + ks * 32 * ML_P, 16 * ML_P + i * 32); }
#pragma unroll
        for (int j = 0; j < 8; ++j) { b0[j] = tr_read_o(kb + ks * 32 * ML_P, j * 32); b1[j] = tr_read_o(kb + ks * 32 * ML_P, 16 * ML_P + j * 32); }
        LGKM_WAIT0();
#pragma unroll
        for (int i = 0; i < 4; ++i)
#pragma unroll
            for (int j = 0; j < 8; ++j) acc[i][j] = __builtin_amdgcn_mfma_f32_16x16x32_bf16(PK8(a0[i], a1[i]), PK8(b0[j], b1[j]), acc[i][j], 0, 0, 0);
    }
#pragma unroll
    for (int i = 0; i < 4; ++i)
#pragma unroll
        for (int j = 0; j < 8; ++j)
#pragma unroll
            for (int rg = 0; rg < 4; ++rg) DC[(size_t)(16 * (4 * vr + i) + 4 * g4 + rg) * 256 + 16 * (8 * kr + j) + jl] = acc[i][j][rg];
}

__device__ __forceinline__ float chunk_decay(const float* bcum, const float* mcum, int bh, int c) {
    const float Be = bcum[bh * S + c * 128 + 127], me = mcum[bh * S + c * 128 + 127];
    const float Bp = (c > 0) ? bcum[bh * S + c * 128 - 1] : 0.f, mp = (c > 0) ? mcum[bh * S + c * 128 - 1] : 0.f;
    return expf(Be - Bp + mp - me);
}
__device__ __forceinline__ void p5_scan_mix(const Frame& F) {
    const float* bcum = WSP(float, WS_BCUM); const float* mcum = WSP(float, WS_MCUM);
    const float* DC = WSP(float, WS_DC); bf16_t* CST = WSP(bf16_t, WS_CST); const float* DN = WSP(float, WS_DN); float* NST = WSP(float, WS_NST);
    const int gt = F.bx * NTHR + FTID, NG = F.G * NTHR;
    for (int item = gt; item < 16 * 8192; item += NG) {
        const int bh = item >> 13, e8 = item & 8191;
        f32x4 c0 = {0.f, 0.f, 0.f, 0.f}, c1 = {0.f, 0.f, 0.f, 0.f};
#pragma unroll 5
        for (int c = 0; c < 15; ++c) { const float dec = chunk_decay(bcum, mcum, bh, c);
            const float* p = DC + (size_t)(bh * 16 + c) * 65536 + e8 * 8; const f32x4 d0 = *(const f32x4*)p, d1 = *(const f32x4*)(p + 4);
            c0 = c0 * dec + d0; c1 = c1 * dec + d1;
            u32x4 o; o.x = cvt_pk_bf16(c0[0], c0[1]); o.y = cvt_pk_bf16(c0[2], c0[3]); o.z = cvt_pk_bf16(c1[0], c1[1]); o.w = cvt_pk_bf16(c1[2], c1[3]);
            *(u32x4*)(CST + (size_t)(bh * 16 + c + 1) * 65536 + e8 * 8) = o; }
    }
    for (int item = gt; item < 16 * 256; item += NG) { const int bh = item >> 8, k = item & 255; float n = 0.f;
        for (int c = 0; c < 15; ++c) { n = n * chunk_decay(bcum, mcum, bh, c) + DN[(size_t)(bh * 16 + c) * 256 + k]; NST[(size_t)(bh * 16 + c + 1) * 256 + k] = n; } }
    const bf16_t* OA = WSP(bf16_t, WS_OATT); const float* LSE = WSP(float, WS_LSE); bf16_t* YA = WSP(bf16_t, WS_YA);
    for (int item = gt; item < T * 64; item += NG) { const int t = item >> 6, h = (item >> 4) & 3, e8 = item & 15;
        const float l0 = LSE[(size_t)t * 12 + h], l1 = LSE[(size_t)t * 12 + 4 + h], l2 = LSE[(size_t)t * 12 + 8 + h];
        const float ml = fmaxf(l0, fmaxf(l1, l2)); float w0 = expf(l0 - ml), w1 = expf(l1 - ml), w2 = expf(l2 - ml); const float ws_ = 1.f / (w0 + w1 + w2); w0 *= ws_; w1 *= ws_; w2 *= ws_;
        const u32x4 a = *(const u32x4*)(OA + (size_t)t * 1536 + h * 128 + e8 * 8), bq = *(const u32x4*)(OA + (size_t)t * 1536 + (4 + h) * 128 + e8 * 8), cq = *(const u32x4*)(OA + (size_t)t * 1536 + (8 + h) * 128 + e8 * 8);
        u32x4 o;
        o.x = cvt_pk_bf16(w0 * bf_lo(a.x) + w1 * bf_lo(bq.x) + w2 * bf_lo(cq.x), w0 * bf_hi(a.x) + w1 * bf_hi(bq.x) + w2 * bf_hi(cq.x));
        o.y = cvt_pk_bf16(w0 * bf_lo(a.y) + w1 * bf_lo(bq.y) + w2 * bf_lo(cq.y), w0 * bf_hi(a.y) + w1 * bf_hi(bq.y) + w2 * bf_hi(cq.y));
        o.z = cvt_pk_bf16(w0 * bf_lo(a.z) + w1 * bf_lo(bq.z) + w2 * bf_lo(cq.z), w0 * bf_hi(a.z) + w1 * bf_hi(bq.z) + w2 * bf_hi(cq.z));
        o.w = cvt_pk_bf16(w0 * bf_lo(a.w) + w1 * bf_lo(bq.w) + w2 * bf_lo(cq.w), w0 * bf_hi(a.w) + w1 * bf_hi(bq.w) + w2 * bf_hi(cq.w));
        *(u32x4*)(YA + (size_t)t * 512 + h * 128 + e8 * 8) = o; }
}

constexpr int MO_KP = 528, MO_VOFF = 128 * MO_KP, MO_TAB = MO_VOFF + 128 * ML_P;
__device__ __forceinline__ void mlstm_out_unit(const Frame& F, int unit) {
    const bf16_t* QM = WSP(bf16_t, WS_QM); const bf16_t* KM = WSP(bf16_t, WS_KM); const bf16_t* VM = WSP(bf16_t, WS_VMB); const bf16_t* OG = WSP(bf16_t, WS_OGB);
    const bf16_t* CST = WSP(bf16_t, WS_CST) + (size_t)unit * 65536; const float* NST = WSP(float, WS_NST) + (size_t)unit * 256; bf16_t* YM = WSP(bf16_t, WS_YM);
    const float* gpre = WSP(float, WS_GPRE); const float* bcum = WSP(float, WS_BCUM); const float* mcum = WSP(float, WS_MCUM);
    const int bh = unit >> 4, c = unit & 15, b = bh >> 2, h = bh & 3; const size_t t0 = (size_t)b * S + c * 128;
    const int tid = FTID, lane = FLANE, w = FWAVE, jl = lane & 15, g4 = lane >> 4;
    LAS unsigned char* RA = F.lds; LAS unsigned char* RB = F.lds + MO_VOFF; LAS float* cs = (LAS float*)(F.lds + MO_TAB); LAS float* ntab = cs + 128;
    __syncthreads();
    {
        u32x4 v[8];
#pragma unroll
        for (int i = 0; i < 8; ++i) { const int id = tid + NTHR * i; const int row = id >> 5, ch = id & 31; v[i] = *(const u32x4*)(KM + (t0 + row) * 1024 + h * 256 + ch * 8); }
#pragma unroll
        for (int i = 0; i < 8; ++i) { const int id = tid + NTHR * i; const int row = id >> 5, ch = id & 31; *(LAS u32x4*)(RA + row * MO_KP + ch * 16) = v[i]; }
#pragma unroll
        for (int i = 0; i < 8; ++i) { const int id = tid + NTHR * i; const int row = id >> 5, ch = id & 31; v[i] = *(const u32x4*)(VM + (t0 + row) * 1024 + h * 256 + ch * 8); }
#pragma unroll
        for (int i = 0; i < 8; ++i) { const int id = tid + NTHR * i; const int row = id >> 5, ch = id & 31; *(LAS u32x4*)(RB + row * ML_P + ch * 16) = v[i]; }
        if (tid < 128) cs[tid] = (gpre[(t0 + tid) * 8 + h] - bcum[bh * S + c * 128 + tid]) * LOG2E;
        if (tid >= 128 && tid < 384) ntab[tid - 128] = (c > 0) ? NST[tid - 128] : 0.f;
    }
    const int tl = 16 * w + jl; const size_t t = t0 + tl;
    const float Bt = bcum[bh * S + c * 128 + tl], mt = mcum[bh * S + c * 128 + tl];
    const float Bp = (c > 0) ? bcum[bh * S + c * 128 - 1] : 0.f, mp = (c > 0) ? mcum[bh * S + c * 128 - 1] : 0.f;
    const float at = (Bt - mt) * LOG2E; const float inter = fast_exp2((Bt - Bp + mp - mt) * LOG2E);
    union QF { bf16x8 v; unsigned u[4]; }; QF qf[8];
#pragma unroll
    for (int ks = 0; ks < 8; ++ks) qf[ks].v = *(const bf16x8*)(QM + t * 1024 + h * 256 + ks * 32 + 8 * g4);
    __syncthreads();
    f32x4 sT[8];
#pragma unroll
    for (int st = 0; st < 8; ++st) { f32x4 a = {0.f, 0.f, 0.f, 0.f};
        if (st <= w) {
#pragma unroll
            for (int ks = 0; ks < 8; ++ks) { const bf16x8 kf = *(const LAS bf16x8*)(RA + (16 * st + jl) * MO_KP + (ks * 32 + 8 * g4) * 2); a = __builtin_amdgcn_mfma_f32_16x16x32_bf16(kf, qf[ks].v, a, 0, 0, 0); } }
        sT[st] = a; __builtin_amdgcn_sched_barrier(0); }
    float dsum = 0.f;
#pragma unroll
    for (int st = 0; st < 8; ++st) { const f32x4 cv = *(const LAS f32x4*)(cs + 16 * st + 4 * g4);
#pragma unroll
        for (int rg = 0; rg < 4; ++rg) { const bool valid = (st < w) || (st == w && (4 * g4 + rg) <= jl); const float f = valid ? fast_exp2(fminf(at + cv[rg], 0.f)) : 0.f; const float sv = sT[st][rg] * f; sT[st][rg] = sv; dsum += sv; } }
    dsum += __shfl_xor(dsum, 16); dsum += __shfl_xor(dsum, 32);
    float nq = 0.f;
#pragma unroll
    for (int ks = 0; ks < 8; ++ks) { const f32x4 n0 = *(const LAS f32x4*)(ntab + ks * 32 + 8 * g4), n1 = *(const LAS f32x4*)(ntab + ks * 32 + 8 * g4 + 4);
        nq += bf_lo(qf[ks].u[0]) * n0[0] + bf_hi(qf[ks].u[0]) * n0[1] + bf_lo(qf[ks].u[1]) * n0[2] + bf_hi(qf[ks].u[1]) * n0[3]
            + bf_lo(qf[ks].u[2]) * n1[0] + bf_hi(qf[ks].u[2]) * n1[1] + bf_lo(qf[ks].u[3]) * n1[2] + bf_hi(qf[ks].u[3]) * n1[3]; }
    nq += __shfl_xor(nq, 16); nq += __shfl_xor(nq, 32);
    const float den = dsum + inter * nq;
    f32x4 acc[16];
#pragma unroll
    for (int vt = 0; vt < 16; ++vt) acc[vt] = (f32x4){0.f, 0.f, 0.f, 0.f};
    const unsigned vbase = (unsigned)(uintptr_t)RB + (unsigned)((4 * g4 + (jl >> 2)) * ML_P + (jl & 3) * 8);
#pragma unroll
    for (int c4 = 0; c4 < 4; ++c4) {
        if (2 * c4 <= w) {
            union { bf16x8 v; unsigned u[4]; } pf;
            pf.u[0] = cvt_pk_bf16(sT[2 * c4][0], sT[2 * c4][1]); pf.u[1] = cvt_pk_bf16(sT[2 * c4][2], sT[2 * c4][3]);
            pf.u[2] = cvt_pk_bf16(sT[2 * c4 + 1][0], sT[2 * c4 + 1][1]); pf.u[3] = cvt_pk_bf16(sT[2 * c4 + 1][2], sT[2 * c4 + 1][3]);
#pragma unroll
            for (int hb = 0; hb < 2; ++hb) {
                s16x4 a0[8], a1[8];
#pragma unroll
                for (int i = 0; i < 8; ++i) { a0[i] = tr_read_o(vbase, c4 * 32 * ML_P + (hb * 8 + i) * 32); a1[i] = tr_read_o(vbase, (c4 * 32 + 16) * ML_P + (hb * 8 + i) * 32); }
                LGKM_WAIT0();
#pragma unroll
                for (int i = 0; i < 8; ++i) acc[hb * 8 + i] = __builtin_amdgcn_mfma_f32_16x16x32_bf16(PK8(a0[i], a1[i]), pf.v, acc[hb * 8 + i], 0, 0, 0);
            }
        }
    }
    if (c > 0) {
#pragma unroll
        for (int ks = 0; ks < 8; ++ks)
#pragma unroll
            for (int j = 0; j < 4; ++j) qf[ks].u[j] = cvt_pk_bf16(bf_lo(qf[ks].u[j]) * inter, bf_hi(qf[ks].u[j]) * inter);
#pragma unroll
        for (int half = 0; half < 2; ++half) {
            __syncthreads();
            u32x4 v[8];
#pragma unroll
            for (int i = 0; i < 8; ++i) { const int id = tid + NTHR * i; const int row = id >> 5, ch = id & 31; v[i] = *(const u32x4*)(CST + (size_t)(half * 128 + row) * 256 + ch * 8); }
#pragma unroll
            for (int i = 0; i < 8; ++i) { const int id = tid + NTHR * i; const int row = id >> 5, ch = id & 31; *(LAS u32x4*)(RA + row * MO_KP + ch * 16) = v[i]; }
            __syncthreads();
#pragma unroll
            for (int vt = 0; vt < 8; ++vt)
#pragma unroll
                for (int ks = 0; ks < 8; ++ks) { const bf16x8 cf = *(const LAS bf16x8*)(RA + (16 * vt + jl) * MO_KP + (ks * 32 + 8 * g4) * 2);
                    acc[half * 8 + vt] = __builtin_amdgcn_mfma_f32_16x16x32_bf16(cf, qf[ks].v, acc[half * 8 + vt], 0, 0, 0); if (ks == 7) __builtin_amdgcn_sched_barrier(0); }
        }
    }
    const float rden = 1.f / fmaxf(fabsf(den), fast_exp2(-mt * LOG2E));
    float sm = 0.f;
#pragma unroll
    for (int vt = 0; vt < 16; ++vt) { const u32x2 og = *(const u32x2*)(OG + t * 1024 + h * 256 + 16 * vt + 4 * g4);
        acc[vt][0] *= rden * bf_lo(og.x); acc[vt][1] *= rden * bf_hi(og.x); acc[vt][2] *= rden * bf_lo(og.y); acc[vt][3] *= rden * bf_hi(og.y);
        sm += (acc[vt][0] + acc[vt][1]) + (acc[vt][2] + acc[vt][3]); }
    sm += __shfl_xor(sm, 16); sm += __shfl_xor(sm, 32);
    const float mu = sm * (1.f / 256.f); float sq = 0.f;
#pragma unroll
    for (int vt = 0; vt < 16; ++vt) { acc[vt] = acc[vt] - mu; sq += (acc[vt][0] * acc[vt][0] + acc[vt][1] * acc[vt][1]) + (acc[vt][2] * acc[vt][2] + acc[vt][3] * acc[vt][3]); }
    sq += __shfl_xor(sq, 16); sq += __shfl_xor(sq, 32);
    const float rstd = rsqrtf(sq * (1.f / 256.f) + LN_EPS);
#pragma unroll
    for (int vt = 0; vt < 16; ++vt) { const f32x4 gg = *(const f32x4*)(F.m_norm_g + h * 256 + 16 * vt + 4 * g4); const f32x4 o = acc[vt] * rstd * gg;
        u32x2 ow; ow.x = cvt_pk_bf16(o[0], o[1]); ow.y = cvt_pk_bf16(o[2], o[3]); *(u32x2*)(YM + t * 1024 + h * 256 + 16 * vt + 4 * g4) = ow; }
}

struct EpiMerge {
    static constexpr bool PERM = true;
    bf16_t* MG; const bf16_t* GB; int step;
    __device__ __forceinline__ void operator()(const f32x4 (&acc)[2][2][4][2], const pg8::Unit& u, int wr, int wc, int fr, int fq) const {
        const int row0 = u.pm * 256 + wr * 64 + fr, col0 = u.pn * 256 + wc * 32 + 8 * fq;
#pragma unroll
        for (int ai = 0; ai < 2; ++ai)
#pragma unroll
            for (int m = 0; m < 4; ++m) { const size_t r = row0 + ai * 128 + m * 16;
#pragma unroll
                for (int bj = 0; bj < 2; ++bj) { const int col = col0 + bj * 128; const f32x4 v0 = acc[ai][bj][m][0], v1 = acc[ai][bj][m][1];
                    const u32x4 gq = *(const u32x4*)(GB + r * 4096 + step * 2048 + col);
                    float o[8] = {v0[0] * bf_lo(gq.x), v0[1] * bf_hi(gq.x), v0[2] * bf_lo(gq.y), v0[3] * bf_hi(gq.y), v1[0] * bf_lo(gq.z), v1[1] * bf_hi(gq.z), v1[2] * bf_lo(gq.w), v1[3] * bf_hi(gq.w)};
                    if (step) { const u32x4 pq = *(const u32x4*)(MG + r * 2048 + col);
                        o[0] += bf_lo(pq.x); o[1] += bf_hi(pq.x); o[2] += bf_lo(pq.y); o[3] += bf_hi(pq.y); o[4] += bf_lo(pq.z); o[5] += bf_hi(pq.z); o[6] += bf_lo(pq.w); o[7] += bf_hi(pq.w); }
                    u32x4 wv; wv.x = cvt_pk_bf16(o[0], o[1]); wv.y = cvt_pk_bf16(o[2], o[3]); wv.z = cvt_pk_bf16(o[4], o[5]); wv.w = cvt_pk_bf16(o[6], o[7]);
                    *(u32x4*)(MG + r * 2048 + col) = wv; } }
    }
};
struct EpiWout {
    static constexpr bool PERM = false;
    const float* x; const float* mod; float* PRE;
    __device__ __forceinline__ void operator()(const f32x4 (&acc)[2][2][4][2], const pg8::Unit& u, int wr, int wc, int fr, int fq) const {
        const int row0 = u.pm * 256 + wr * 64 + fr, col0 = u.pn * 256 + wc * 32 + 4 * fq;
        const float* gate = mod + (size_t)((u.pm * 256) / S) * 6 * D + 2 * D;
        f32x4 gv[2][2];
#pragma unroll
        for (int bj = 0; bj < 2; ++bj)
#pragma unroll
            for (int n = 0; n < 2; ++n) gv[bj][n] = *(const f32x4*)(gate + col0 + bj * 128 + n * 16);
#pragma unroll
        for (int ai = 0; ai < 2; ++ai)
#pragma unroll
            for (int m = 0; m < 4; ++m) { const size_t off = (size_t)(row0 + ai * 128 + m * 16) * D + col0;
#pragma unroll
                for (int bj = 0; bj < 2; ++bj)
#pragma unroll
                    for (int n = 0; n < 2; ++n) { const f32x4 xv = *(const f32x4*)(x + off + bj * 128 + n * 16); *(f32x4*)(PRE + off + bj * 128 + n * 16) = xv * ALPHA + gv[bj][n] * acc[ai][bj][m][n]; } }
    }
};

constexpr int R_UP = 4112, R_LO = 16 * R_UP, R_PART = 2 * 16 * R_UP, R_LOG = R_PART + 8 * 16 * 48 * 4;
template <bool DRY> __device__ __forceinline__ void p9_ln_router(const Frame& F) {
    const float* PRE = WSP(float, WS_PRE); const float* mod = WSP(float, WS_MOD); bf16_t* U2 = WSP(bf16_t, WS_U); const bf16_t* WRT = WSP(bf16_t, WS_WRT);
    int* cnt = (int*)(F.ws + WS_CTL) + CW_CNT; int* idx = WSP(int, WS_IDX); float* wl = WSP(float, WS_WL); int* tok = WSP(int, WS_TOK);
    const int lane = FLANE, w = FWAVE, tid = FTID, jl = lane & 15, g4 = lane >> 4;
    LAS unsigned char* Uhi = F.lds; LAS unsigned char* Ulo = F.lds + R_LO; LAS float* part = (LAS float*)(F.lds + R_PART); LAS float* lg = (LAS float*)(F.lds + R_LOG);
    for (int rgp = F.bx; rgp < T / 16; rgp += F.G) {
        __syncthreads();
#pragma unroll 1
        for (int rr = 0; rr < 2; ++rr) {
            const int lr = 2 * w + rr; const int t = rgp * 16 + lr; const int b = t / S;
            f32x4 v[8]; float s = 0.f;
#pragma unroll
            for (int i = 0; i < 8; ++i) { v[i] = *(const f32x4*)(PRE + (size_t)t * D + 4 * (lane + 64 * i)); s += (v[i][0] + v[i][1]) + (v[i][2] + v[i][3]); }
            float mu = wave_sum(s) * (1.f / D); float q = 0.f;
#pragma unroll
            for (int i = 0; i < 8; ++i) { v[i] = v[i] - mu; q += (v[i][0] * v[i][0] + v[i][1] * v[i][1]) + (v[i][2] * v[i][2] + v[i][3] * v[i][3]); }
            float rstd = rsqrtf(wave_sum(q) * (1.f / D) + LN_EPS);
            s = 0.f;
#pragma unroll
            for (int i = 0; i < 8; ++i) { const int d = 4 * (lane + 64 * i); const f32x4 gg = *(const f32x4*)(F.ln1_g + d), bb = *(const f32x4*)(F.ln1_b + d);
                v[i] = v[i] * rstd * gg + bb; *(f32x4*)(F.out + (size_t)t * D + d) = v[i]; s += (v[i][0] + v[i][1]) + (v[i][2] + v[i][3]); }
            mu = wave_sum(s) * (1.f / D); q = 0.f;
#pragma unroll
            for (int i = 0; i < 8; ++i) { v[i] = v[i] - mu; q += (v[i][0] * v[i][0] + v[i][1] * v[i][1]) + (v[i][2] * v[i][2] + v[i][3] * v[i][3]); }
            rstd = rsqrtf(wave_sum(q) * (1.f / D) + LN_EPS);
            const float* sc = mod + (size_t)b * 6 * D + 4 * D; const float* sf = mod + (size_t)b * 6 * D + 3 * D;
#pragma unroll
            for (int i = 0; i < 8; ++i) { const int d = 4 * (lane + 64 * i); const f32x4 a = *(const f32x4*)(sc + d), bb = *(const f32x4*)(sf + d);
                v[i] = v[i] * rstd * (a + 1.f) + bb;
                u32x2 hi; hi.x = cvt_pk_bf16(v[i][0], v[i][1]); hi.y = cvt_pk_bf16(v[i][2], v[i][3]);
                *(u32x2*)(U2 + (size_t)t * D + d) = hi;
                u32x2 lo; lo.x = cvt_pk_bf16(v[i][0] - bf_lo(hi.x), v[i][1] - bf_hi(hi.x)); lo.y = cvt_pk_bf16(v[i][2] - bf_lo(hi.y), v[i][3] - bf_hi(hi.y));
                *(LAS u32x2*)(Uhi + lr * R_UP + d * 2) = hi; *(LAS u32x2*)(Ulo + lr * R_UP + d * 2) = lo; }
        }
        __syncthreads();
        {
            f32x4 a3[3] = {{0.f, 0.f, 0.f, 0.f}, {0.f, 0.f, 0.f, 0.f}, {0.f, 0.f, 0.f, 0.f}};
#pragma unroll 2
            for (int ks = 0; ks < 8; ++ks) { const int k0 = 256 * w + 32 * ks + 8 * g4;
                const bf16x8 ah = *(const LAS bf16x8*)(Uhi + jl * R_UP + k0 * 2), al = *(const LAS bf16x8*)(Ulo + jl * R_UP + k0 * 2);
#pragma unroll
                for (int nt = 0; nt < 3; ++nt) { const bf16x8 bh = *(const bf16x8*)(WRT + (size_t)(16 * nt + jl) * D + k0), bl = *(const bf16x8*)(WRT + (size_t)48 * D + (size_t)(16 * nt + jl) * D + k0);
                    a3[nt] = __builtin_amdgcn_mfma_f32_16x16x32_bf16(ah, bh, a3[nt], 0, 0, 0); a3[nt] = __builtin_amdgcn_mfma_f32_16x16x32_bf16(ah, bl, a3[nt], 0, 0, 0); a3[nt] = __builtin_amdgcn_mfma_f32_16x16x32_bf16(al, bh, a3[nt], 0, 0, 0); } }
#pragma unroll
            for (int nt = 0; nt < 3; ++nt)
#pragma unroll
                for (int rg = 0; rg < 4; ++rg) part[(w * 16 + 4 * g4 + rg) * 48 + 16 * nt + jl] = a3[nt][rg];
        }
        __syncthreads();
        for (int i = tid; i < 16 * 48; i += NTHR) { float s = 0.f;
#pragma unroll
            for (int ww = 0; ww < 8; ++ww) s += part[ww * 768 + i];
            lg[i] = s; }
        __syncthreads();
        if (tid < 16) { const int t = rgp * 16 + tid; const LAS float* l = lg + tid * 48;
            int gt = 0; float lgt = l[0] + F.b_rg[0];
            for (int j = 1; j < 4; ++j) { const float x = l[j] + F.b_rg[j]; if (x > lgt) { lgt = x; gt = j; } }
            float se = 0.f; for (int j = 0; j < 4; ++j) se += expf(l[j] + F.b_rg[j] - lgt);
            const float gw = 1.f / se;
            int a = 0; float la = l[4 + gt * 8] + F.b_re[gt * 8];
            for (int j = 1; j < 8; ++j) { const float x = l[4 + gt * 8 + j] + F.b_re[gt * 8 + j]; if (x > la) { la = x; a = j; } }
            int bb = -1; float lb = -INFINITY;
            for (int j = 0; j < 8; ++j) { const float x = l[4 + gt * 8 + j] + F.b_re[gt * 8 + j]; if (j != a && x > lb) { lb = x; bb = j; } }
            const float wa = 1.f / (1.f + expf(lb - la)), wb = 1.f - wa;
            const int ea = gt * 8 + a, eb = gt * 8 + bb;
            if (!DRY) {
            const int pa = atomicAdd(&cnt[ea], 1); idx[ea * T + pa] = t; wl[ea * T + pa] = gw * wa;
            const int pb = atomicAdd(&cnt[eb], 1); idx[eb * T + pb] = t; wl[eb * T + pb] = gw * wb;
            *(int4*)(tok + (size_t)t * 4) = make_int4(ea, pa, eb, pb); } }
    }
}

struct MoeSched {
    const int* idx; const LAS int* tb; const LAS int* cn; int G, c;
    __device__ bool next(int i, pg8::Unit& u) const {
        const int total = tb[32] * 8; const long L = (long)i * G + c; if (L >= total) return false;
        const int l = (int)L; int e = 0;
        for (int k = 1; k < 32; ++k) if (l >= tb[k] * 8) e = k;
        const int nt = tb[e + 1] - tb[e], r = l - tb[e] * 8; const int j = r / nt, it = r - j * nt;
        u.e = __builtin_amdgcn_readfirstlane(e); u.it = __builtin_amdgcn_readfirstlane(it); u.pm = __builtin_amdgcn_readfirstlane(tb[e] + it); u.pn = __builtin_amdgcn_readfirstlane(e * 8 + j); u.cnt = __builtin_amdgcn_readfirstlane(cn[e]); return true;
    }
    __device__ __forceinline__ int arow(const pg8::Unit& u, int r) const { int p = u.it * 256 + r; p = p < u.cnt ? p : u.cnt - 1; return idx[u.e * T + p]; }
};
__device__ __forceinline__ void moe_tables(const Frame& F, LAS int* tb, LAS int* cn) {
    const int* cnt = (const int*)(F.ws + WS_CTL) + CW_CNT;
    __syncthreads();
    if (FTID == 0) { int acc = 0; for (int e = 0; e < 32; ++e) { const int c = cnt[e]; cn[e] = c; tb[e] = acc; acc += (c + 255) >> 8; } tb[32] = acc; }
    __syncthreads();
}
struct EpiMoe1 {
    static constexpr bool PERM = true;
    bf16_t* H;
    __device__ __forceinline__ void operator()(const f32x4 (&acc)[2][2][4][2], const pg8::Unit& u, int wr, int wc, int fr, int fq) const {
        const int row0 = u.pm * 256 + wr * 64 + fr, col0 = (u.pn & 7) * 128 + wc * 32 + 8 * fq;
#pragma unroll
        for (int ai = 0; ai < 2; ++ai)
#pragma unroll
            for (int m = 0; m < 4; ++m) { const size_t r = row0 + ai * 128 + m * 16; float o[8];
#pragma unroll
                for (int n = 0; n < 2; ++n)
#pragma unroll
                    for (int j = 0; j < 4; ++j) o[4 * n + j] = silu_fast(acc[ai][0][m][n][j]) * acc[ai][1][m][n][j];
                u32x4 wv; wv.x = cvt_pk_bf16(o[0], o[1]); wv.y = cvt_pk_bf16(o[2], o[3]); wv.z = cvt_pk_bf16(o[4], o[5]); wv.w = cvt_pk_bf16(o[6], o[7]);
                *(u32x4*)(H + r * FF + col0) = wv; }
    }
};
struct EpiMoe2 {
    static constexpr bool PERM = true;
    bf16_t* Y2; const float* wl;
    __device__ __forceinline__ void operator()(const f32x4 (&acc)[2][2][4][2], const pg8::Unit& u, int wr, int wc, int fr, int fq) const {
        const int lrow0 = wr * 64 + fr, col0 = (u.pn & 7) * 256 + wc * 32 + 8 * fq;
#pragma unroll
        for (int ai = 0; ai < 2; ++ai)
#pragma unroll
            for (int m = 0; m < 4; ++m) { const int lr = lrow0 + ai * 128 + m * 16; const int p = u.it * 256 + lr; const float cw = (p < u.cnt) ? wl[u.e * T + p] : 0.f; const size_t r = (size_t)u.pm * 256 + lr;
#pragma unroll
                for (int bj = 0; bj < 2; ++bj) { const f32x4 v0 = acc[ai][bj][m][0] * cw, v1 = acc[ai][bj][m][1] * cw;
                    u32x4 wv; wv.x = cvt_pk_bf16(v0[0], v0[1]); wv.y = cvt_pk_bf16(v0[2], v0[3]); wv.z = cvt_pk_bf16(v1[0], v1[1]); wv.w = cvt_pk_bf16(v1[2], v1[3]);
                    *(u32x4*)(Y2 + r * D + col0 + bj * 128) = wv; } }
    }
};

template <bool DRY> __device__ __forceinline__ void p12_final(const Frame& F, const LAS int* tb) {
    float* dst = DRY ? WSP(float, WS_PRE) : F.out;
    const float* mod = WSP(float, WS_MOD); const bf16_t* Y2 = WSP(bf16_t, WS_Y2); const int* tok = WSP(int, WS_TOK);
    const int gw = F.bx * NWAVES + FWAVE, NGW = F.G * NWAVES, lane = FLANE;
    for (int t = gw; t < T; t += NGW) {
        const int b = t / S; const int4 ti = *(const int4*)(tok + (size_t)t * 4);
        const size_t r0 = (size_t)tb[ti.x] * 256 + ti.y, r1 = (size_t)tb[ti.z] * 256 + ti.w;
        const float* gate = mod + (size_t)b * 6 * D + 5 * D;
        f32x4 v[8]; float s = 0.f;
#pragma unroll
        for (int i = 0; i < 8; ++i) { const int d = 4 * (lane + 64 * i); const f32x4 xv = *(const f32x4*)(F.out + (size_t)t * D + d), gv = *(const f32x4*)(gate + d);
            const u32x2 ya = *(const u32x2*)(Y2 + r0 * D + d), yb = *(const u32x2*)(Y2 + r1 * D + d);
            f32x4 f; f[0] = bf_lo(ya.x) + bf_lo(yb.x); f[1] = bf_hi(ya.x) + bf_hi(yb.x); f[2] = bf_lo(ya.y) + bf_lo(yb.y); f[3] = bf_hi(ya.y) + bf_hi(yb.y);
            v[i] = xv * ALPHA + gv * f; s += (v[i][0] + v[i][1]) + (v[i][2] + v[i][3]); }
        const float mu = wave_sum(s) * (1.f / D); float q = 0.f;
#pragma unroll
        for (int i = 0; i < 8; ++i) { v[i] = v[i] - mu; q += (v[i][0] * v[i][0] + v[i][1] * v[i][1]) + (v[i][2] * v[i][2] + v[i][3] * v[i][3]); }
        const float rstd = rsqrtf(wave_sum(q) * (1.f / D) + LN_EPS);
#pragma unroll
        for (int i = 0; i < 8; ++i) { const int d = 4 * (lane + 64 * i); const f32x4 gg = *(const f32x4*)(F.ln2_g + d), bb = *(const f32x4*)(F.ln2_b + d);
            *(f32x4*)(dst + (size_t)t * D + d) = v[i] * rstd * gg + bb; }
    }
}

#if MK_DEBUG
__device__ __forceinline__ void dbg_acc(float* slot, double num, double den) { atomicAdd(slot, (float)num); atomicAdd(slot + 1, (float)den); }
__global__ void k_chk_u(Params p, float* res) {
    __shared__ float sh[8]; __shared__ float ush[D];
    const int t = (blockIdx.x * 37) % T, b = t / S; const float* x = p.in[0] + (size_t)t * D; const float* mod = (const float*)(p.ws + WS_MOD);
    float s = 0; for (int i = threadIdx.x; i < D; i += 256) s += x[i]; s = wave_sum(s); if ((threadIdx.x & 63) == 0) sh[threadIdx.x >> 6] = s; __syncthreads();
    const float mu = (sh[0] + sh[1] + sh[2] + sh[3]) / D; __syncthreads();
    float q = 0; for (int i = threadIdx.x; i < D; i += 256) { const float d = x[i] - mu; q += d * d; } q = wave_sum(q); if ((threadIdx.x & 63) == 0) sh[threadIdx.x >> 6] = q; __syncthreads();
    const float rstd = rsqrtf((sh[0] + sh[1] + sh[2] + sh[3]) / D + LN_EPS);
    const bf16_t* U = (const bf16_t*)(p.ws + WS_U); double num = 0, den = 0;
    for (int i = threadIdx.x; i < D; i += 256) {
        float sc = p.in[3][1 * D + i], sf = p.in[3][0 * D + i];
        if (i < 64) { for (int k = 0; k < D; ++k) { const float cv = p.in[1][b * D + k]; const float sl = cv / (1.f + expf(-cv)); sc += sl * p.in[2][(size_t)k * 6 * D + D + i]; sf += sl * p.in[2][(size_t)k * 6 * D + i]; } }
        else { sc = mod[(size_t)b * 6 * D + D + i]; sf = mod[(size_t)b * 6 * D + i]; }
        const float ref = (x[i] - mu) * rstd * (1.f + sc) + sf; ush[i] = ref; const float got = bf2f(U[(size_t)t * D + i]); num += (double)(got - ref) * (got - ref); den += (double)ref * ref; }
    __syncthreads();
    if (threadIdx.x < 8) { const int j = threadIdx.x; float a = 0; for (int k = 0; k < D; ++k) a += ush[k] * p.in[4][(size_t)k * NIN + OFF_IF + j]; a += p.in[5][j];
        if (j >= 4) a = fminf(a, 0.f) - log1pf(expf(-fabsf(a))); const float got = ((const float*)(p.ws + WS_GPRE))[(size_t)t * 8 + j]; num += (double)(got - a) * (got - a) * 1000.0; den += (double)a * a * 1000.0; }
    dbg_acc(res, num, den);
}
__global__ void k_chk_p2(Params p, float* res) {
    const int gid = blockIdx.x * blockDim.x + threadIdx.x;
    const int t = (gid * 131 + 7) % T; const int col = (gid * 977 + 13) % (NIN - 8 + 4096);
    const bf16_t* U = (const bf16_t*)(p.ws + WS_U) + (size_t)t * D;
    const int pos = t % S; float ref, got; unsigned char* ws = p.ws;
    auto dot = [&](const float* w, int ld, int c) { float a = 0; for (int k = 0; k < D; ++k) a += bf2f(U[k]) * w[(size_t)k * ld + c]; return a; };
    if (col < 3072) { const int hd = col / 128, lc = col % 128, i = lc % 64; const int c1 = hd * 128 + i, c2 = c1 + 64; const float x1 = dot(p.in[4], NIN, c1), x2 = dot(p.in[4], NIN, c2);
        const float inv = powf(10000.f, -(float)(2 * i) / 128.f), ang = (float)pos * inv, cs = cosf(ang), sn = sinf(ang);
        ref = (lc < 64) ? (x1 * cs - x2 * sn) : (x2 * cs + x1 * sn); const int pc = hd * 128 + 2 * i + (lc >= 64);
        if (col < 1536) { ref *= QSCALE; got = bf2f(((const bf16_t*)(ws + WS_QB))[(size_t)t * 1536 + pc]); } else got = bf2f(((const bf16_t*)(ws + WS_KB))[(size_t)t * 1536 + pc - 1536]); }
    else if (col < 4608) { ref = dot(p.in[4], NIN, col); got = bf2f(((const bf16_t*)(ws + WS_VB))[(size_t)t * 1536 + col - 3072]); }
    else if (col < 6656) { ref = dot(p.in[4], NIN, col); got = bf2f(((const bf16_t*)(ws + WS_QKP))[(size_t)t * 2048 + col - 4608]); }
    else if (col < 7680) { ref = dot(p.in[4], NIN, col); got = bf2f(((const bf16_t*)(ws + WS_VMB))[(size_t)t * 1024 + col - 6656]); }
    else if (col < 8704) { ref = dot(p.in[4], NIN, col); ref = 1.f / (1.f + expf(-ref)); got = bf2f(((const bf16_t*)(ws + WS_OGB))[(size_t)t * 1024 + col - 7680]); }
    else { const int c = col - 8704; ref = dot(p.in[11], 4096, c) + p.in[12][c]; ref = 1.f / (1.f + expf(-ref)); got = bf2f(((const bf16_t*)(ws + WS_GB))[(size_t)t * 4096 + c]); }
    double num = (double)(got - ref) * (got - ref), den = (double)ref * ref;
    for (int o = 32; o >= 1; o >>= 1) { num += __shfl_xor(num, o); den += __shfl_xor(den, o); }
    if ((threadIdx.x & 63) == 0) dbg_acc(res, num, den);
}

__global__ void __launch_bounds__(256) k_chk_attn(Params p, float* res) {
    const int t = (blockIdx.x * 1543 + 11) % T, h = threadIdx.x >> 6, lane = threadIdx.x & 63; const int b = t / S, pos = t % S;
    const bf16_t* QB = (const bf16_t*)(p.ws + WS_QB); const bf16_t* KB = (const bf16_t*)(p.ws + WS_KB); const bf16_t* VB = (const bf16_t*)(p.ws + WS_VB); const bf16_t* YA = (const bf16_t*)(p.ws + WS_YA);
    float og[3][2], lse[3];
    for (int g = 0; g < 3; ++g) { const int d = (g == 0) ? 1 : (g == 1 ? 4 : 16); const int head = 4 * g + h;
        const bf16_t* qp = QB + (size_t)t * 1536 + head * 128; const float q0 = bf2f(qp[lane]), q1 = bf2f(qp[lane + 64]);
        float mx = -INFINITY, den = 0, o0 = 0, o1 = 0;
        for (int j = 0; j <= 128; ++j) { const int tk = pos - j * d; if (tk < 0) break;
            const bf16_t* kp = KB + (size_t)(b * S + tk) * 1536 + head * 128; const bf16_t* vp = VB + (size_t)(b * S + tk) * 1536 + head * 128;
            const float dot = wave_sum(q0 * bf2f(kp[lane]) + q1 * bf2f(kp[lane + 64]));
            const float nm = fmaxf(mx, dot); const float sc = exp2f(mx - nm), pe = exp2f(dot - nm);
            den = den * sc + pe; o0 = o0 * sc + pe * bf2f(vp[lane]); o1 = o1 * sc + pe * bf2f(vp[lane + 64]); mx = nm; }
        og[g][0] = o0 / den; og[g][1] = o1 / den; lse[g] = (mx + log2f(den)) * LN2; }
    const float ml = fmaxf(lse[0], fmaxf(lse[1], lse[2])); const float w0 = expf(lse[0] - ml), w1 = expf(lse[1] - ml), w2 = expf(lse[2] - ml); const float ws_ = 1.f / (w0 + w1 + w2);
    const float r0 = (w0 * og[0][0] + w1 * og[1][0] + w2 * og[2][0]) * ws_, r1 = (w0 * og[0][1] + w1 * og[1][1] + w2 * og[2][1]) * ws_;
    const float g0 = bf2f(YA[(size_t)t * 512 + h * 128 + lane]), g1 = bf2f(YA[(size_t)t * 512 + h * 128 + lane + 64]);
    double num = (double)(g0 - r0) * (g0 - r0) + (double)(g1 - r1) * (g1 - r1), den2 = (double)r0 * r0 + (double)r1 * r1;
    for (int o = 32; o >= 1; o >>= 1) { num += __shfl_xor(num, o); den2 += __shfl_xor(den2, o); }
    if (lane == 0) dbg_acc(res, num, den2);
}
__global__ void __launch_bounds__(1024) k_chk_mlstm(Params p, float* hb) {
    const int b = blockIdx.x / 4, h = blockIdx.x % 4; const int tid = threadIdx.x, v = tid >> 2, kq = tid & 3;
    const bf16_t* QKP = (const bf16_t*)(p.ws + WS_QKP); const bf16_t* VM = (const bf16_t*)(p.ws + WS_VMB);
    const float* gpre = (const float*)(p.ws + WS_GPRE); const float* conv_w = p.in[6]; const float* conv_b = p.in[7];
    __shared__ float qs[256], ks[256], vs[256], ns[256], nq[256];
    float C[64];
#pragma unroll
    for (int i = 0; i < 64; ++i) C[i] = 0.f;
    if (tid < 256) ns[tid] = 0.f;
    float m = 0.f;
    for (int pos = 0; pos < S; ++pos) { const int t = b * S + pos;
        __syncthreads();
        if (tid < 256) { float yq = conv_b[h * 256 + tid], yk = conv_b[1024 + h * 256 + tid];
            for (int j = 0; j < 4; ++j) { const int pp = pos + j - 3; if (pp >= 0) { yq += conv_w[j * 2048 + h * 256 + tid] * bf2f(QKP[(size_t)(t + j - 3) * 2048 + h * 256 + tid]); yk += conv_w[j * 2048 + 1024 + h * 256 + tid] * bf2f(QKP[(size_t)(t + j - 3) * 2048 + 1024 + h * 256 + tid]); } }
            qs[tid] = yq / (1.f + expf(-yq)); ks[tid] = yk / (1.f + expf(-yk)) * 0.0625f; vs[tid] = bf2f(VM[(size_t)t * 1024 + h * 256 + tid]); }
        const float ip = gpre[(size_t)t * 8 + h], lf = gpre[(size_t)t * 8 + 4 + h];
        const float mn = fmaxf(lf + m, ip); const float iw = expf(ip - mn), fw = expf(lf + m - mn); m = mn;
        __syncthreads();
        if (tid < 256) { const float nn = fw * ns[tid] + iw * ks[tid]; ns[tid] = nn; nq[tid] = nn * qs[tid]; }
        __syncthreads();
        const float vv = vs[v] * iw; float nu = 0.f, de = 0.f;
#pragma unroll
        for (int i = 0; i < 64; ++i) { const int k = 4 * i + kq; const float cc = fw * C[i] + vv * ks[k]; C[i] = cc; nu += cc * qs[k]; de += nq[k]; }
        nu += __shfl_xor(nu, 1); nu += __shfl_xor(nu, 2); de += __shfl_xor(de, 1); de += __shfl_xor(de, 2);
        if (kq == 0) hb[(size_t)t * 1024 + h * 256 + v] = nu / fmaxf(fabsf(de), expf(-mn));
    }
}
__global__ void __launch_bounds__(256) k_chk_mnorm(Params p, const float* hb, float* res) {
    __shared__ float red[8];
    const int t = blockIdx.x / 4, h = blockIdx.x % 4, tid = threadIdx.x;
    const bf16_t* OG = (const bf16_t*)(p.ws + WS_OGB); const bf16_t* YM = (const bf16_t*)(p.ws + WS_YM); const float* mg = p.in[8];
    const float val = bf2f(OG[(size_t)t * 1024 + h * 256 + tid]) * hb[(size_t)t * 1024 + h * 256 + tid];
    float s = wave_sum(val); if ((tid & 63) == 0) red[tid >> 6] = s; __syncthreads();
    const float mu = (red[0] + red[1] + red[2] + red[3]) * (1.f / 256.f); const float d = val - mu;
    s = wave_sum(d * d); if ((tid & 63) == 0) red[4 + (tid >> 6)] = s; __syncthreads();
    const float rstd = rsqrtf((red[4] + red[5] + red[6] + red[7]) * (1.f / 256.f) + LN_EPS); const float ref = d * rstd * mg[h * 256 + tid];
    const float got = bf2f(YM[(size_t)t * 1024 + h * 256 + tid]);
    double num = (double)(got - ref) * (got - ref), den = (double)ref * ref;
    for (int o = 32; o >= 1; o >>= 1) { num += __shfl_xor(num, o); den += __shfl_xor(den, o); }
    if ((tid & 63) == 0) dbg_acc(res, num, den);
}
__global__ void k_chk_fin(const float* res, int nchk, float* out, int n) {
    const int i = blockIdx.x * blockDim.x + threadIdx.x; if (i >= n) return;
    float code = 0.f;
    for (int k = 0; k < nchk; ++k) { const float rv = res[2 * k] / fmaxf(res[2 * k + 1], 1e-30f); int s;
        if (!(rv == rv) || !(res[2 * k + 1] > 0.f)) s = 9; else { s = (int)floorf(log10f(fmaxf(rv, 1e-12f)) + 6.f); s = s < 0 ? 0 : (s > 8 ? 8 : s); }
        if (s >= 3 && code == 0.f) code = ((k + 1) * 10 + s) * 100.f; }
    out[i] = (i == 0) ? code : 0.f;
}
#endif

__global__ void __launch_bounds__(NTHR, 2) mk_fwd(Params args) {
    extern __shared__ __attribute__((aligned(16))) unsigned char lds_raw[];
    Frame F;
    F.lds = (LAS unsigned char*)lds_raw; F.G = gridDim.x; F.bx = blockIdx.x; F.ws = args.ws;
    F.x = args.in[0]; F.c = args.in[1]; F.w_ada = args.in[2]; F.b_ada = args.in[3]; F.w_in = args.in[4]; F.b_mgate = args.in[5]; F.conv_w = args.in[6]; F.conv_b = args.in[7];
    F.m_norm_g = args.in[8]; F.w_proj_a = args.in[9]; F.w_proj_m = args.in[10]; F.w_gate = args.in[11]; F.b_gate = args.in[12]; F.w_out = args.in[13]; F.ln1_g = args.in[14]; F.ln1_b = args.in[15];
    F.w_rg = args.in[16]; F.b_rg = args.in[17]; F.w_re = args.in[18]; F.b_re = args.in[19]; F.w_eg = args.in[20]; F.w_eu = args.in[21]; F.w_ed = args.in[22]; F.ln2_g = args.in[23]; F.ln2_b = args.in[24];
    F.out = args.out;
    volatile LAS unsigned* misc = (volatile LAS unsigned*)(F.lds + LDS_MISC);
    if (FTID < 64) misc[FTID] = 0u;
    __syncthreads();
    const int lo = args.ph_lo, hi = args.ph_hi;
    XcdBarrier bar; bar.bar = (unsigned*)(F.ws + WS_CTL) + CW_BAR; bar.x = 0; bar.st = nullptr;
    if (hi - lo > 1) bar = xcd_barrier_post((unsigned*)(F.ws + WS_CTL) + CW_BAR, misc + 8);
#define IN(k) (lo <= (k) && (k) < hi)
#define BOTH(k) (IN(k) && IN((k) + 1))
#define SEAM(k) do { if (BOTH(k)) xcd_barrier(bar); } while (0)

#define DUPRUN(k, BODY) do { BODY; if (MK_DUP & (1 << (k))) { xcd_barrier(bar); BODY; } } while (0)
#define PH0 { p0_prologue(F); }
#define PH1 { p1_lnmod(F); }
#define PH2 { pg8::StaticOrder So; So.init(T, NBIG, F.G, F.bx); \
        EpiP2 E{WSP(bf16_t, WS_QB), WSP(bf16_t, WS_KB), WSP(bf16_t, WS_VB), WSP(bf16_t, WS_QKP), WSP(bf16_t, WS_VMB), WSP(bf16_t, WS_OGB), WSP(bf16_t, WS_GB), WSP(float, WS_ROPE), F.b_gate}; \
        pg8::gemm_phase<EpiP2, pg8::StaticOrder, false>(F.lds, WSP(bf16_t, WS_U), WSP(bf16_t, WS_WBIG), D, So, E); \
        if (F.bx >= F.G - 16 && FWAVE == 0) scan_bh(F, F.bx - (F.G - 16)); }
#define PH3 { p3_conv(F); for (int u = F.bx; u < 768; u += F.G) attn_unit(F, u); }
#define PH4 { for (int u = F.bx; u < 256; u += F.G) mlstm_dc_unit(F, u); }
#define PH5 { p5_scan_mix(F); }
#define PH6 { for (int u = F.bx; u < 256; u += F.G) mlstm_out_unit(F, u); }
#define PH7 { pg8::StaticOrder So; So.init(T, D, F.G, F.bx); \
        EpiMerge E0{WSP(bf16_t, WS_MG), WSP(bf16_t, WS_GB), 0}, E1{WSP(bf16_t, WS_MG), WSP(bf16_t, WS_GB), 1}; \
        pg8::gemm_phase<EpiMerge, pg8::StaticOrder, false>(F.lds, WSP(bf16_t, WS_YA), WSP(bf16_t, WS_WPA), 512, So, E0); \
        pg8::gemm_phase<EpiMerge, pg8::StaticOrder, false>(F.lds, WSP(bf16_t, WS_YM), WSP(bf16_t, WS_WPM), 1024, So, E1); }
#define PH8 { pg8::StaticOrder So; So.init(T, D, F.G, F.bx); EpiWout E{F.x, WSP(float, WS_MOD), WSP(float, WS_PRE)}; \
        pg8::gemm_phase<EpiWout, pg8::StaticOrder, false>(F.lds, WSP(bf16_t, WS_MG), WSP(bf16_t, WS_WO), D, So, E); }
#define PH10 { moe_tables(F, tb, cn); MoeSched Sm{WSP(int, WS_IDX), tb, cn, F.G, vcu}; EpiMoe1 E{WSP(bf16_t, WS_H)}; \
        pg8::gemm_phase<EpiMoe1, MoeSched, true>(F.lds, WSP(bf16_t, WS_U), WSP(bf16_t, WS_W1T), D, Sm, E); }
#define PH11 { moe_tables(F, tb, cn); MoeSched Sm{WSP(int, WS_IDX), tb, cn, F.G, vcu}; EpiMoe2 E{WSP(bf16_t, WS_Y2), WSP(float, WS_WL)}; \
        pg8::gemm_phase<EpiMoe2, MoeSched, false>(F.lds, WSP(bf16_t, WS_H), WSP(bf16_t, WS_W2T), FF, Sm, E); }
    LAS int* tb = (LAS int*)(F.lds + LDS_MISC) + 64; LAS int* cn = tb + 40;
    const int vcu = (F.G % 8 == 0) ? (F.bx % 8) * (F.G / 8) + F.bx / 8 : F.bx;
    if (IN(0)) { DUPRUN(0, PH0); SEAM(0); }
    if (IN(1)) { DUPRUN(1, PH1); SEAM(1); }
    if (IN(2)) { DUPRUN(2, PH2); SEAM(2); }
    if (IN(3)) { DUPRUN(3, PH3); SEAM(3); }
    if (IN(4)) { DUPRUN(4, PH4); SEAM(4); }
    if (IN(5)) { DUPRUN(5, PH5); SEAM(5); }
    if (IN(6)) { DUPRUN(6, PH6); SEAM(6); }
    if (IN(7)) { DUPRUN(7, PH7); SEAM(7); }
    if (IN(8)) { DUPRUN(8, PH8); SEAM(8); }
    if (IN(9)) { if (MK_DUP & (1 << 9)) { p9_ln_router<true>(F); xcd_barrier(bar); } p9_ln_router<false>(F); SEAM(9); }
    if (IN(10)) { DUPRUN(10, PH10); SEAM(10); }
    if (IN(11)) { DUPRUN(11, PH11); SEAM(11); }
    if (IN(12)) { moe_tables(F, tb, cn); if (MK_DUP & (1 << 12)) { p12_final<true>(F, tb); xcd_barrier(bar); } p12_final<false>(F, tb); }
#undef IN
#undef BOTH
#undef SEAM
}

extern "C" void kernel_launch(void* const* d_in, const int* in_sizes, int n_in, void* d_out, int out_size, void* d_ws, size_t ws_size, hipStream_t stream) {
    static int grid = 0;
    if (grid == 0) {
        size_t need = WS_END;
#if MK_DEBUG
        need += (1 << 20) + (size_t)T * 1024 * 4;
#endif
        if (n_in != 25 || out_size != T * D || ws_size < need) { fprintf(stderr, "kernel_launch: unexpected shapes / workspace (%zu < %zu)\n", ws_size, need); grid = -1; return; }
        int dev = 0, cus = 0, per_cu = 0;
        if (hipGetDevice(&dev) != hipSuccess || hipDeviceGetAttribute(&cus, hipDeviceAttributeMultiprocessorCount, dev) != hipSuccess) { grid = -1; return; }
        if (hipFuncSetAttribute((const void*)mk_fwd, hipFuncAttributeMaxDynamicSharedMemorySize, LDS_BYTES) != hipSuccess) { fprintf(stderr, "kernel_launch: hipFuncSetAttribute failed\n"); grid = -1; return; }
        if (hipOccupancyMaxActiveBlocksPerMultiprocessor(&per_cu, (const void*)mk_fwd, NTHR, LDS_BYTES) != hipSuccess || per_cu < 1) { fprintf(stderr, "kernel_launch: occupancy query says %d\n", per_cu); (void)hipGetLastError(); grid = -1; return; }
        grid = cus;
    }
    if (grid < 0) return;
    (void)hipMemsetAsync((char*)d_ws + WS_CTL, 0, CTL_ZERO_BYTES, stream);
    Params a{};
    for (int i = 0; i < 25; ++i) a.in[i] = (const float*)d_in[i];
    a.out = (float*)d_out; a.ws = (unsigned char*)d_ws;
#if MK_DEBUG
    constexpr int NPH = 7;
#else
    constexpr int NPH = 13;
#endif
#if MK_PER_PHASE
    for (int p = 0; p < NPH; ++p) { a.ph_lo = p; a.ph_hi = p + 1; hipLaunchKernelGGL(mk_fwd, dim3(grid), dim3(NTHR), LDS_BYTES, stream, a); }
#else
    a.ph_lo = 0; a.ph_hi = NPH; hipLaunchKernelGGL(mk_fwd, dim3(grid), dim3(NTHR), LDS_BYTES, stream, a);
#endif
#if MK_DEBUG
    float* res = (float*)((char*)d_ws + WS_DBG0);
    (void)hipMemsetAsync(res, 0, 256, stream);
    k_chk_u<<<64, 256, 0, stream>>>(a, res);
    k_chk_p2<<<32, 64, 0, stream>>>(a, res + 2);
    k_chk_attn<<<256, 256, 0, stream>>>(a, res + 4);
    float* hb = (float*)((char*)d_ws + WS_DBG0 + (1 << 20));
    k_chk_mlstm<<<16, 1024, 0, stream>>>(a, hb);
    k_chk_mnorm<<<T * 4, 256, 0, stream>>>(a, hb, res + 6);
    k_chk_fin<<<(T * D + 255) / 256, 256, 0, stream>>>(res, 4, (float*)d_out, T * D);
#endif
}
```

```cpp
#include <hip/hip_runtime.h>
#include <stdint.h>
#include <math.h>
#include <stdio.h>

#ifndef MK_DEBUG
#define MK_DEBUG 0
#endif
#ifndef MK_DUP
#define MK_DUP 0
#endif
#ifndef MK_PER_PHASE
#define MK_PER_PHASE 0
#endif

#define LAS __attribute__((address_space(3)))
typedef unsigned short bf16_t;
typedef short bf16x8 __attribute__((ext_vector_type(8)));
typedef short s16x4 __attribute__((ext_vector_type(4)));
typedef float f32x4 __attribute__((ext_vector_type(4)));
typedef float f32x2 __attribute__((ext_vector_type(2)));
typedef unsigned u32x4 __attribute__((ext_vector_type(4)));
typedef unsigned u32x2 __attribute__((ext_vector_type(2)));

constexpr int D = 2048, NB = 4, S = 2048, T = NB * S, NIN = 8712;
constexpr int OFF_QA = 0, OFF_KA = 1536, OFF_VA = 3072, OFF_QKM = 4608, OFF_VM = 6656, OFF_OM = 7680, OFF_IF = 8704;
constexpr int FF = 1024, NEXP = 32, NBIG = 12800;
constexpr float ALPHA = 1.189207115002721f, LN_EPS = 1e-5f;
constexpr float LOG2E = 1.4426950408889634f, LN2 = 0.6931471805599453f;
constexpr float QSCALE = 0.08838834764831845f * 1.4426950408889634f;
constexpr int NTHR = 512, NWAVES = 8;
constexpr int SORT_ROWS = 24576;

constexpr size_t al256(size_t x) { return (x + 255) & ~(size_t)255; }
constexpr size_t WS_CTL = 0, CTL_ZERO_BYTES = 65536;
constexpr int CW_BAR = 0;
constexpr int CW_CNT = 4096;
constexpr int CW_DBG = 4224;
constexpr size_t WS_MOD = 65536;
constexpr size_t WS_ROPE = WS_MOD + al256((size_t)NB * 6 * D * 4);
constexpr size_t WS_WIF = WS_ROPE + (size_t)S * 64 * 2 * 4;
constexpr size_t WS_GPRE = WS_WIF + (size_t)8 * D * 4;
constexpr size_t WS_BCUM = WS_GPRE + (size_t)T * 8 * 4;
constexpr size_t WS_MCUM = WS_BCUM + (size_t)16 * S * 4;
constexpr size_t WS_WRT = WS_MCUM + (size_t)16 * S * 4;
constexpr size_t WS_LSE = WS_WRT + (size_t)2 * 48 * D * 2;
constexpr size_t WS_IDX = WS_LSE + (size_t)T * 12 * 4;
constexpr size_t WS_WL = WS_IDX + (size_t)NEXP * T * 4;
constexpr size_t WS_TOK = WS_WL + (size_t)NEXP * T * 4;
constexpr size_t WS_DN = WS_TOK + (size_t)T * 16;
constexpr size_t WS_NST = WS_DN + (size_t)256 * 256 * 4;
constexpr size_t WS_WBIG = al256(WS_NST + (size_t)256 * 256 * 4);
constexpr size_t WS_WPA = WS_WBIG + (size_t)NBIG * D * 2;
constexpr size_t WS_WPM = WS_WPA + (size_t)D * 512 * 2;
constexpr size_t WS_WO = WS_WPM + (size_t)D * 1024 * 2;
constexpr size_t WS_W1T = WS_WO + (size_t)D * D * 2;
constexpr size_t WS_W2T = WS_W1T + (size_t)NEXP * 2048 * D * 2;
constexpr size_t WS_U = WS_W2T + (size_t)NEXP * D * FF * 2;
constexpr size_t WS_QB = WS_U + (size_t)T * D * 2;
constexpr size_t WS_KB = WS_QB + (size_t)T * 1536 * 2;
constexpr size_t WS_VB = WS_KB + (size_t)T * 1536 * 2;
constexpr size_t WS_QKP = WS_VB + (size_t)T * 1536 * 2;
constexpr size_t WS_VMB = WS_QKP + (size_t)T * 2048 * 2;
constexpr size_t WS_OGB = WS_VMB + (size_t)T * 1024 * 2;
constexpr size_t WS_GB = WS_OGB + (size_t)T * 1024 * 2;
constexpr size_t WS_QM = WS_GB + (size_t)T * 4096 * 2;
constexpr size_t WS_KM = WS_QM + (size_t)T * 1024 * 2;
constexpr size_t WS_OATT = WS_KM + (size_t)T * 1024 * 2;
constexpr size_t WS_YA = WS_OATT + (size_t)T * 1536 * 2;
constexpr size_t WS_YM = WS_YA + (size_t)T * 512 * 2;
constexpr size_t WS_DC = WS_YM + (size_t)T * 1024 * 2;
constexpr size_t WS_CST = WS_DC + (size_t)256 * 65536 * 4;
constexpr size_t WS_MG = WS_CST + (size_t)256 * 65536 * 2;
constexpr size_t WS_PRE = WS_MG + (size_t)T * D * 2;
constexpr size_t WS_END = WS_PRE + (size_t)T * D * 4;
constexpr size_t WS_H = WS_QB;
constexpr size_t WS_Y2 = WS_H + (size_t)SORT_ROWS * FF * 2;
static_assert(WS_Y2 + (size_t)SORT_ROWS * D * 2 <= WS_QM, "overlay");
constexpr size_t WS_DBG0 = WS_END;

constexpr int LDS_MISC = 162816;
constexpr int LDS_BYTES = LDS_MISC + 1024;

__device__ __forceinline__ unsigned cvt_pk_bf16(float lo, float hi) { unsigned r; asm volatile("v_cvt_pk_bf16_f32 %0, %1, %2" : "=v"(r) : "v"(lo), "v"(hi)); return r; }
__device__ __forceinline__ float bf_lo(unsigned w) { return __uint_as_float(w << 16); }
__device__ __forceinline__ float bf_hi(unsigned w) { return __uint_as_float(w & 0xffff0000u); }
__device__ __forceinline__ float bf2f(bf16_t b) { return __uint_as_float(((unsigned)b) << 16); }
__device__ __forceinline__ bf16_t f2bf(float f) { return (bf16_t)(cvt_pk_bf16(f, 0.f) & 0xffffu); }
__device__ __forceinline__ float fast_exp2(float x) { return __builtin_amdgcn_exp2f(x); }
__device__ __forceinline__ float fast_rcp(float x) { return __builtin_amdgcn_rcpf(x); }
__device__ __forceinline__ float sigmoid_fast(float x) { return fast_rcp(1.f + fast_exp2(-x * LOG2E)); }
__device__ __forceinline__ float silu_fast(float x) { return x * sigmoid_fast(x); }
__device__ __forceinline__ float wave_sum(float v) {
#pragma unroll
    for (int o = 32; o >= 1; o >>= 1) v += __shfl_xor(v, o);
    return v; }
__device__ __forceinline__ float wave_max(float v) {
#pragma unroll
    for (int o = 32; o >= 1; o >>= 1) v = fmaxf(v, __shfl_xor(v, o));
    return v; }
__device__ __forceinline__ s16x4 tr_read(unsigned addr) { s16x4 r; asm volatile("ds_read_b64_tr_b16 %0, %1" : "=&v"(r) : "v"(addr) : "memory"); return r; }
__device__ __forceinline__ s16x4 tr_read_o(unsigned base, const int off) { s16x4 r; asm volatile("ds_read_b64_tr_b16 %0, %1 offset:%2" : "=&v"(r) : "v"(base), "n"(off) : "memory"); return r; }
#define LGKM_WAIT0() do { asm volatile("s_waitcnt lgkmcnt(0)" ::: "memory"); __builtin_amdgcn_sched_barrier(0); } while (0)
#define PK8(L, H) ((bf16x8){L[0], L[1], L[2], L[3], H[0], H[1], H[2], H[3]})

#define XB_TMO      128
#define XB_XCNT(j)  (256  + 64 * (j))
#define XB_XSUB(j)  (1280 + 64 * (j))
#define XB_XGEN(j)  (2304 + 64 * (j))
#define XB_TOP      3328
#define XB_TOPGEN   3392
#define XCD_BAR_WORDS 3456
#define XB_SPIN_CAP (1u << 18)
__device__ __forceinline__ unsigned xb_ld(unsigned* p)              { return __hip_atomic_load(p, __ATOMIC_RELAXED, __HIP_MEMORY_SCOPE_AGENT); }
__device__ __forceinline__ unsigned xb_add(unsigned* p, unsigned v) { return __hip_atomic_fetch_add(p, v, __ATOMIC_RELAXED, __HIP_MEMORY_SCOPE_AGENT); }
__device__ __forceinline__ unsigned xb_xcc_id() { return (unsigned)__builtin_amdgcn_s_getreg((3 << 11) | 20) & 0xFu; }
#define XB_SPIN(cond, bar) do { unsigned _sp = 0; while (cond) { __builtin_amdgcn_s_sleep(1); \
    if ((++_sp & 255u) == 0u) { if (xb_ld(&(bar)[XB_TMO])) break; if (_sp > XB_SPIN_CAP) { atomicAdd(&(bar)[XB_TMO], 1u); break; } } } } while (0)
struct XcdBarrier { unsigned* bar; unsigned x; volatile LAS unsigned* st; };
__device__ __forceinline__ XcdBarrier xcd_barrier_post(unsigned* bar, volatile LAS unsigned* st) {
    XcdBarrier b; b.bar = bar; b.x = xb_xcc_id(); b.st = st;
    if (threadIdx.x == 0) (void)xb_add(&bar[XB_XCNT(b.x)], 1u);
    return b;
}
__device__ __forceinline__ void xcd_barrier_complete(unsigned* bar, unsigned x, unsigned& nloc, unsigned& nx) {
    const unsigned G = gridDim.x * gridDim.y * gridDim.z;
    unsigned sum, cnt, mine, sp = 0u;
    for (;;) {
        sum = 0u; cnt = 0u; mine = 0u;
#pragma unroll
        for (unsigned j = 0; j < 16; ++j) { const unsigned c = xb_ld(&bar[XB_XCNT(j)]); sum += c; cnt += (c > 0u) ? 1u : 0u; mine = (j == x) ? c : mine; }
        if (sum == G) break;
        __builtin_amdgcn_s_sleep(1);
        if ((++sp & 255u) == 0u) { if (xb_ld(&bar[XB_TMO])) break; if (sp > XB_SPIN_CAP) { atomicAdd(&bar[XB_TMO], 1u); break; } }
    }
    nloc = mine > 0u ? mine : 1u; nx = cnt > 0u ? cnt : 1u;
}
__device__ __forceinline__ void xcd_barrier(const XcdBarrier& b) {
    asm volatile("s_waitcnt vmcnt(0)" ::: "memory");
    __syncthreads();
    if (threadIdx.x == 0) {
        unsigned* bar = b.bar;
        __builtin_amdgcn_s_waitcnt(0);
        unsigned nloc = b.st[0], nx = b.st[1];
        if (nloc == 0u) { xcd_barrier_complete(bar, b.x, nloc, nx); b.st[0] = nloc; b.st[1] = nx; }
        const unsigned old = xb_add(&bar[XB_XSUB(b.x)], 1u);
        const unsigned gen = old / nloc;
        if (old + 1u == (gen + 1u) * nloc) {
            __builtin_amdgcn_fence(__ATOMIC_RELEASE, "agent");
            asm volatile("s_waitcnt vmcnt(0)" ::: "memory");
            const unsigned og = xb_add(&bar[XB_TOP], 1u);
            const unsigned tg = og / nx;
            if (og + 1u == (tg + 1u) * nx) xb_add(&bar[XB_TOPGEN], 1u);
            else XB_SPIN(xb_ld(&bar[XB_TOPGEN]) == tg, bar);
            __builtin_amdgcn_fence(__ATOMIC_ACQUIRE, "agent");
            xb_add(&bar[XB_XGEN(b.x)], 1u);
            asm volatile("s_waitcnt vmcnt(0)" ::: "memory");
        } else {
            XB_SPIN(xb_ld(&bar[XB_XGEN(b.x)]) == gen, bar);
            __builtin_amdgcn_fence(__ATOMIC_ACQUIRE, "agent");
            asm volatile("s_waitcnt vmcnt(0)" ::: "memory");
        }
    }
    __syncthreads();
}

namespace pg8 {
constexpr int BM = 256, BK = 64, HALF = 128, HTB = HALF * BK * 2, STAGE_BYTES = 8 * HTB, NXCD = 8, WGM = 8;
__host__ __device__ __forceinline__ int lds_byte(int r, int c) { const int st = (r >> 4) * 2 + (c >> 5), rr = r & 15, cc = c & 31, ob = rr * 64 + cc * 2; return st * 1024 + (ob ^ (((ob >> 9) & 1) << 5)); }
__host__ __device__ __forceinline__ void stage_rc(int b, int& R, int& C) { const int st = b / 1024, sb = b % 1024, swz = sb ^ (((sb >> 9) & 1) << 5); R = (st >> 1) * 16 + swz / 64; C = (st & 1) * 32 + (swz % 64) / 2; }
__host__ __device__ __forceinline__ int perm32(int rho) { const int n = rho >> 4, i = rho & 15; return 8 * (i >> 2) + 4 * n + (i & 3); }

struct Unit { int pm, pn, e, it, cnt; };

struct StaticOrder {
    int nM, nN, nwg, G, c;
    __device__ void init(int M, int N, int G_, int c_) { nM = M / BM; nN = N / BM; nwg = nM * nN; G = G_; c = c_; }
    __device__ bool next(int i, Unit& u) const {
        const long L = (long)i * G + c; if (L >= nwg) return false;
        int wgid = (int)L; { const int q = nwg / NXCD, r = nwg % NXCD, xcd = wgid % NXCD, off = wgid / NXCD; wgid = (xcd < r ? xcd * (q + 1) : r * (q + 1) + (xcd - r) * q) + off; }
        const int nig = WGM * nN, gid = wgid / nig, fm = gid * WGM, gsz = (nM - fm) < WGM ? (nM - fm) : WGM;
        u.pm = fm + ((wgid % nig) % gsz); u.pn = (wgid % nig) / gsz; u.e = 0; u.it = 0; u.cnt = 0; return true;
    }
    __device__ __forceinline__ int arow(const Unit&, int r) const { return r; }
};

template <class Epi, class Sched, bool GATHER>
__device__ __forceinline__ void gemm_phase(LAS unsigned char* lds, const bf16_t* Ap, const bf16_t* Btp, const int K, const Sched& S, const Epi& E) {
    const int tid = threadIdx.x, wid = __builtin_amdgcn_readfirstlane(tid >> 6), lane = tid & 63, wr = wid >> 2, wc = wid & 3, fr = lane & 15, fq = lane >> 4;
    const int nt = K / BK;
    unsigned voffA[2], voffB[2]; int RA[2], CA[2];
#pragma unroll
    for (int i = 0; i < 2; ++i) { int R, C; stage_rc(tid * 16 + i * 8192, R, C); const int Rb = Epi::PERM ? ((R & ~31) + perm32(R & 31)) : R;
        RA[i] = R; CA[i] = C; voffA[i] = (unsigned)(R * K + C) * 2u; voffB[i] = (unsigned)(Rb * K + C) * 2u; }
    const size_t kstep = (size_t)(BK * 2);
    const size_t hstep = (size_t)HALF * K * 2;
    const size_t tstep = 2 * hstep;
    const unsigned ldsw = (unsigned)wid * 1024u;
    const int aoff = lds_byte(wr * 64 + fr, fq * 8), boff = lds_byte(wc * 32 + fr, fq * 8);
    unsigned vC[2][2], vN[2][2], v2[2][2];
#define PG8_SA(b, h) (((b) * 2 + (h)) * HTB)
#define PG8_SB(b, h) ((4 + (b) * 2 + (h)) * HTB)
#define PG8_STAGE(bufoff, gbase, voff) do { _Pragma("unroll") for (int _i = 0; _i < 2; ++_i) \
        __builtin_amdgcn_global_load_lds((const unsigned*)((const char*)(gbase) + (voff)[_i]), (LAS unsigned*)(lds + (bufoff) + ldsw + _i * 8192), 16, 0, 0); } while (0)
#define PG8_STAGE_A(bufoff, gbase, h, vsel) do { if constexpr (GATHER) { PG8_STAGE(bufoff, gbase, (vsel)[h]); } else { PG8_STAGE(bufoff, (gbase) + (h) * hstep, voffA); } } while (0)
#define PG8_GVOFF(u, v) do { _Pragma("unroll") for (int _h = 0; _h < 2; ++_h) _Pragma("unroll") for (int _i = 0; _i < 2; ++_i) \
        (v)[_h][_i] = (unsigned)(S.arow(u, _h * HALF + RA[_i]) * K + CA[_i]) * 2u; } while (0)
#define PG8_LDA(dst, b, h) do { _Pragma("unroll") for (int m = 0; m < 4; ++m) _Pragma("unroll") for (int k = 0; k < 2; ++k) dst[m][k] = *(const LAS bf16x8*)(lds + PG8_SA(b, h) + aoff + m * 2048 + k * 1024); } while (0)
#define PG8_LDB(dst, b, h) do { _Pragma("unroll") for (int n = 0; n < 2; ++n) _Pragma("unroll") for (int k = 0; k < 2; ++k) dst[n][k] = *(const LAS bf16x8*)(lds + PG8_SB(b, h) + boff + n * 2048 + k * 1024); } while (0)
#define PG8_MMA(ai, bj, At, Bt) do { __builtin_amdgcn_s_setprio(1); _Pragma("unroll") for (int m = 0; m < 4; ++m) _Pragma("unroll") for (int n = 0; n < 2; ++n) _Pragma("unroll") for (int k = 0; k < 2; ++k) \
        acc[ai][bj][m][n] = __builtin_amdgcn_mfma_f32_16x16x32_bf16(Bt[n][k], At[m][k], acc[ai][bj][m][n], 0, 0, 0); __builtin_amdgcn_s_setprio(0); } while (0)
#define PG8_WAIT_V(n) asm volatile("s_waitcnt vmcnt(" #n ")" ::: "memory")
#define PG8_WAIT_L(n) asm volatile("s_waitcnt lgkmcnt(" #n ")" ::: "memory")
#define PG8_BAR __builtin_amdgcn_s_barrier()
#define PG8_SCHED __builtin_amdgcn_sched_barrier(0)
    Unit cur, nxt; int ui = 0;
    if (!S.next(0, cur)) return;
    f32x4 acc[2][2][4][2];
#pragma unroll
    for (int a = 0; a < 2; ++a)
#pragma unroll
        for (int b = 0; b < 2; ++b)
#pragma unroll
            for (int m = 0; m < 4; ++m)
#pragma unroll
                for (int n = 0; n < 2; ++n) acc[a][b][m][n] = (f32x4){0.f, 0.f, 0.f, 0.f};
    bf16x8 At[4][2], B0[2][2], B1[2][2];
    const char* cA = GATHER ? (const char*)Ap : (const char*)Ap + (size_t)cur.pm * tstep; const char* cB = (const char*)Btp + (size_t)cur.pn * tstep;
    if constexpr (GATHER) { PG8_GVOFF(cur, vC); }
    PG8_STAGE(PG8_SB(0, 0), cB, voffB); PG8_STAGE(PG8_SB(0, 1), cB + hstep, voffB); PG8_STAGE_A(PG8_SA(0, 0), cA, 0, vC); PG8_STAGE_A(PG8_SA(0, 1), cA, 1, vC);
    if (wr == 1) PG8_BAR;
    PG8_WAIT_V(2); PG8_BAR;
    PG8_STAGE(PG8_SB(1, 0), cB + kstep, voffB); PG8_STAGE_A(PG8_SA(1, 0), cA + kstep, 0, vC); PG8_STAGE(PG8_SB(1, 1), cB + hstep + kstep, voffB);
    PG8_WAIT_V(6); PG8_BAR;
    for (;;) {
        const bool has_next = S.next(ui + 1, nxt);
        const char* nA = GATHER ? (const char*)Ap : (has_next ? (const char*)Ap + (size_t)nxt.pm * tstep : cA);
        const char* nB = has_next ? (const char*)Btp + (size_t)nxt.pn * tstep : cB;
        if constexpr (GATHER) { if (has_next) { PG8_GVOFF(nxt, vN); } else {
#pragma unroll
            for (int h = 0; h < 2; ++h) { vN[h][0] = vC[h][0]; vN[h][1] = vC[h][1]; } } }
        for (int t = 0; t < nt; t += 2) {
            const bool last = (t == nt - 2);
            const char* a1 = cA + (size_t)(t + 1) * kstep;
            const char* a2 = last ? nA : cA + (size_t)(t + 2) * kstep; const char* b2 = last ? nB : cB + (size_t)(t + 2) * kstep;
            const char* a3 = a2 + kstep; const char* b3 = b2 + kstep;
            if constexpr (GATHER) {
#pragma unroll
                for (int h = 0; h < 2; ++h) { v2[h][0] = last ? vN[h][0] : vC[h][0]; v2[h][1] = last ? vN[h][1] : vC[h][1]; } }
            PG8_LDB(B0, 0, 0); PG8_LDB(B1, 0, 1); PG8_SCHED; PG8_LDA(At, 0, 0); PG8_STAGE_A(PG8_SA(1, 1), a1, 1, vC);
            PG8_WAIT_V(8); PG8_WAIT_L(0); PG8_BAR; PG8_MMA(0, 0, At, B0); PG8_MMA(0, 1, At, B1); PG8_BAR; PG8_SCHED;
            PG8_LDA(At, 0, 1); PG8_STAGE(PG8_SB(0, 0), b2, voffB); PG8_STAGE(PG8_SB(0, 1), b2 + hstep, voffB); PG8_STAGE_A(PG8_SA(0, 0), a2, 0, v2);
            PG8_WAIT_V(8); PG8_WAIT_L(0); PG8_BAR; PG8_MMA(1, 0, At, B0); PG8_MMA(1, 1, At, B1); PG8_BAR; PG8_SCHED;
            PG8_LDB(B0, 1, 0); PG8_LDB(B1, 1, 1); PG8_SCHED; PG8_LDA(At, 1, 0); PG8_STAGE_A(PG8_SA(0, 1), a2, 1, v2);
            PG8_WAIT_V(8); PG8_WAIT_L(0); PG8_BAR; PG8_MMA(0, 0, At, B0); PG8_MMA(0, 1, At, B1); PG8_BAR; PG8_SCHED;
            PG8_LDA(At, 1, 1); PG8_STAGE(PG8_SB(1, 0), b3, voffB); PG8_STAGE(PG8_SB(1, 1), b3 + hstep, voffB); PG8_STAGE_A(PG8_SA(1, 0), a3, 0, v2);
            PG8_WAIT_V(8); PG8_WAIT_L(0); PG8_BAR; PG8_MMA(1, 0, At, B0); PG8_MMA(1, 1, At, B1); PG8_BAR; PG8_SCHED;
        }
        if (wr == 0) PG8_BAR;
        E(acc, cur, wr, wc, fr, fq);
        if (!has_next) break;
#pragma unroll
        for (int a = 0; a < 2; ++a)
#pragma unroll
            for (int b = 0; b < 2; ++b)
#pragma unroll
                for (int m = 0; m < 4; ++m)
#pragma unroll
                    for (int n = 0; n < 2; ++n) acc[a][b][m][n] = (f32x4){0.f, 0.f, 0.f, 0.f};
        cur = nxt; cA = nA; cB = nB; ++ui;
        if constexpr (GATHER) {
#pragma unroll
            for (int h = 0; h < 2; ++h) { vC[h][0] = vN[h][0]; vC[h][1] = vN[h][1]; } }
        if (wr == 1) PG8_BAR;
    }
    PG8_WAIT_V(0);
    PG8_BAR;
#undef PG8_SA
#undef PG8_SB
#undef PG8_STAGE
#undef PG8_STAGE_A
#undef PG8_GVOFF
#undef PG8_LDA
#undef PG8_LDB
#undef PG8_MMA
#undef PG8_WAIT_V
#undef PG8_WAIT_L
#undef PG8_BAR
#undef PG8_SCHED
}
}

struct Params { const float* in[25]; float* out; unsigned char* ws; int ph_lo, ph_hi; };
struct Frame {
    LAS unsigned char* lds; int G, bx;
    unsigned char* ws;
    const float *x, *c, *w_ada, *b_ada, *w_in, *b_mgate, *conv_w, *conv_b, *m_norm_g, *w_proj_a, *w_proj_m, *w_gate, *b_gate, *w_out, *ln1_g, *ln1_b, *w_rg, *b_rg, *w_re, *b_re, *w_eg, *w_eu, *w_ed, *ln2_g, *ln2_b;
    float* out;
};
__device__ __forceinline__ int otid() { int t = threadIdx.x; asm volatile("" : "+v"(t)); return t; }
#define FTID otid()
#define FLANE (otid() & 63)
#define FWAVE __builtin_amdgcn_readfirstlane(otid() >> 6)
#define WSP(T_, off) ((T_*)(F.ws + (off)))

#ifndef CVT_SWAP
#define CVT_SWAP 0
#endif
constexpr int N_IT_W1 = 2048, N_IT_BG = 3072, N_IT_P0 = 512;
constexpr int CVT_P = 544, CVT_BUF = 64 * CVT_P;
constexpr int CW_QHEAD = 4160, CW_QHEAD2 = 4352, CW_DONE2 = 4224, CW_DONE10 = 4288;
struct CvtItem { const float* src; bf16_t* dst; int ld, Kdst, kind, arg, n0, valid; };
__device__ __forceinline__ int cvt_row(int kind, int arg, int n) {
    if (kind == 1) { if (n < 3072) { const int hd = n >> 7, lc = n & 127; return hd * 128 + 2 * (lc & 63) + (lc >> 6); } return n; }
    if (kind == 2) return 256 * (n >> 7) + 128 * arg + (n & 127);
    return n + arg;
}
__device__ __forceinline__ CvtItem cvt_decode_bg(const Frame& F, int item) {
    CvtItem c; c.valid = (item < N_IT_BG);
    if (item < N_IT_W1) { const int e = item >> 6, r = item & 63, mat = r >> 5, nt = (r >> 3) & 3, kq = r & 7;
        c.src = (mat ? F.w_eu : F.w_eg) + (size_t)e * D * FF + (size_t)(kq * 256) * FF + nt * 256; c.ld = FF; c.dst = WSP(bf16_t, WS_W1T) + (size_t)e * 2048 * D + kq * 256; c.Kdst = D; c.kind = 2; c.arg = mat; c.n0 = nt * 256; }
    else { const int i2 = (item < N_IT_BG ? item : N_IT_BG - 1) - N_IT_W1; const int e = i2 >> 5, r = i2 & 31, nt = r >> 2, kq = r & 3;
        c.src = F.w_ed + (size_t)e * FF * D + (size_t)(kq * 256) * D + nt * 256; c.ld = D; c.dst = WSP(bf16_t, WS_W2T) + (size_t)e * D * FF + kq * 256; c.Kdst = FF; c.kind = 0; c.arg = 0; c.n0 = nt * 256; }
    return c;
}
__device__ __forceinline__ CvtItem cvt_decode_p0(const Frame& F, int item) {
    CvtItem c; c.valid = (item < N_IT_P0); c.kind = 0; c.arg = 0;
    if (item < 272) { const int nt = item >> 3, kq = item & 7; c.src = F.w_in + (size_t)(kq * 256) * NIN + nt * 256; c.ld = NIN; c.dst = WSP(bf16_t, WS_WBIG) + kq * 256; c.Kdst = D; c.kind = 1; c.n0 = nt * 256; }
    else if (item < 400) { const int i = item - 272; const int nt = i >> 3, kq = i & 7; c.src = F.w_gate + (size_t)(kq * 256) * 4096 + nt * 256; c.ld = 4096; c.dst = WSP(bf16_t, WS_WBIG) + kq * 256; c.Kdst = D; c.arg = 8704; c.n0 = nt * 256; }
    else if (item < 416) { const int i = item - 400; const int nt = i >> 1, kq = i & 1; c.src = F.w_proj_a + (size_t)(kq * 256) * D + nt * 256; c.ld = D; c.dst = WSP(bf16_t, WS_WPA) + kq * 256; c.Kdst = 512; c.n0 = nt * 256; }
    else if (item < 448) { const int i = item - 416; const int nt = i >> 2, kq = i & 3; c.src = F.w_proj_m + (size_t)(kq * 256) * D + nt * 256; c.ld = D; c.dst = WSP(bf16_t, WS_WPM) + kq * 256; c.Kdst = 1024; c.n0 = nt * 256; }
    else { const int i = (item < N_IT_P0 ? item : N_IT_P0 - 1) - 448; const int nt = i >> 3, kq = i & 7; c.src = F.w_out + (size_t)(kq * 256) * D + nt * 256; c.ld = D; c.dst = WSP(bf16_t, WS_WO) + kq * 256; c.Kdst = D; c.n0 = nt * 256; }
    return c;
}
__device__ __forceinline__ unsigned bg_claim(unsigned* ctl, int limit) {
    const unsigned v = atomicAdd(ctl + CW_QHEAD, 1u); if (v < (unsigned)N_IT_W1) return v;
    if (limit <= N_IT_W1) return 0x7fffffffu;
    const unsigned v2 = atomicAdd(ctl + CW_QHEAD2, 1u); return (v2 < (unsigned)(N_IT_BG - N_IT_W1)) ? (unsigned)N_IT_W1 + v2 : 0x7fffffffu;
}
#define CVT_LOAD(R, it, j) do { _Pragma("unroll") for (int _p = 0; _p < 8; ++_p) (R)[_p] = *(const f32x4*)((it).src + (size_t)(64 * (j) + kr + 8 * _p) * (it).ld + n4); } while (0)
template <int MODE>
__device__ __forceinline__ void cvt_stream(const Frame& F, int limit, unsigned* stop_word, unsigned stop_need) {
    const int tid = FTID; const int lane = tid & 63, w = __builtin_amdgcn_readfirstlane(tid >> 6), li = lane & 15, g = lane >> 4;
    const int kr = tid >> 6, n4 = 4 * (tid & 63);
    unsigned* ctl = (unsigned*)(F.ws + WS_CTL);
    volatile LAS int* mb = (volatile LAS int*)(F.lds + LDS_MISC) + 16;
    LAS unsigned char* lbuf = F.lds;
    __syncthreads();
    int i0, i1;
    if (MODE == 0) { i0 = F.bx; i1 = F.bx + F.G; }
    else { if (tid == 0) { mb[0] = (int)bg_claim(ctl, limit); mb[1] = (int)bg_claim(ctl, limit); mb[2] = 0; } __syncthreads(); i0 = mb[0]; i1 = mb[1]; if (i0 >= limit) i0 = 0x7fffffff; if (i1 >= limit) i1 = 0x7fffffff; }
    CvtItem cur = (MODE == 0) ? cvt_decode_p0(F, i0) : cvt_decode_bg(F, i0), nxt = (MODE == 0) ? cvt_decode_p0(F, i1) : cvt_decode_bg(F, i1);
    int inext = i1;
    f32x4 R0[8], R1[8], R2[8], R3[8];
    if (cur.valid) { CVT_LOAD(R0, cur, 0); CVT_LOAD(R1, cur, 1); CVT_LOAD(R2, cur, 2); CVT_LOAD(R3, cur, 3); }
    const unsigned rdbase = (unsigned)(uintptr_t)lbuf + (unsigned)((4 * g + (li >> 2)) * CVT_P + (32 * w + 4 * (li & 3)) * 2);
    while (cur.valid) {
        unsigned cl = 0u, sw = 0u;
        if (MODE == 1 && tid == 0) { const bool stop = (stop_need > 0u) && (__hip_atomic_load(stop_word, __ATOMIC_RELAXED, __HIP_MEMORY_SCOPE_AGENT) >= stop_need); sw = stop ? 1u : 0u; cl = stop ? 0x7fffffffu : bg_claim(ctl, limit); }
        size_t ro0, ro1;
        { const int nb = cur.n0 + 32 * w + li;
#if CVT_SWAP
          ro0 = (size_t)cvt_row(cur.kind, cur.arg, nb + 16 * (g & 1)) * cur.Kdst; ro1 = 0;
#else
          ro0 = (size_t)cvt_row(cur.kind, cur.arg, nb) * cur.Kdst; ro1 = (size_t)cvt_row(cur.kind, cur.arg, nb + 16) * cur.Kdst;
#endif
        }
#define CVT_PROC(R, j) do { LAS unsigned char* bw = lbuf + ((j) & 1) * CVT_BUF; \
            _Pragma("unroll") for (int _p = 0; _p < 8; ++_p) { u32x2 wv; wv.x = cvt_pk_bf16((R)[_p][0], (R)[_p][1]); wv.y = cvt_pk_bf16((R)[_p][2], (R)[_p][3]); *(LAS u32x2*)(bw + (kr + 8 * _p) * CVT_P + 2 * n4) = wv; } \
            asm volatile("s_waitcnt lgkmcnt(0)\n\ts_barrier" ::: "memory"); \
            if (nxt.valid) CVT_LOAD(R, nxt, j); \
            s16x4 tA[4], tB[4]; const unsigned rb = rdbase + ((j) & 1) * CVT_BUF; \
            _Pragma("unroll") for (int kb = 0; kb < 4; ++kb) { tA[kb] = tr_read_o(rb, kb * 16 * CVT_P); tB[kb] = tr_read_o(rb, kb * 16 * CVT_P + 32); } \
            LGKM_WAIT0(); \
            _Pragma("unroll") for (int kb = 0; kb < 4; ++kb) { CVT_STORE(j, kb); } } while (0)
#if CVT_SWAP
#define CVT_STORE(j, kb) do { union { s16x4 v; unsigned u[2]; } a, b; a.v = tA[kb]; b.v = tB[kb]; \
            auto r0 = __builtin_amdgcn_permlane16_swap(a.u[0], b.u[0], false, false); auto r1 = __builtin_amdgcn_permlane16_swap(a.u[1], b.u[1], false, false); \
            u32x4 o; o.x = r0[0]; o.y = r1[0]; o.z = r0[1]; o.w = r1[1]; \
            *(u32x4*)(cur.dst + ro0 + 64 * (j) + 16 * kb + 8 * (g >> 1)) = o; } while (0)
#else
#define CVT_STORE(j, kb) do { union { s16x4 v; u32x2 u; } a, b; a.v = tA[kb]; b.v = tB[kb]; \
            *(u32x2*)(cur.dst + ro0 + 64 * (j) + 16 * kb + 4 * g) = a.u; *(u32x2*)(cur.dst + ro1 + 64 * (j) + 16 * kb + 4 * g) = b.u; } while (0)
#endif
        CVT_PROC(R0, 0); CVT_PROC(R1, 1); CVT_PROC(R2, 2); CVT_PROC(R3, 3);
        int i2;
        if (MODE == 0) { i2 = inext + F.G; }
        else { if (tid == 0) { mb[0] = (int)cl; mb[2] = (int)sw; } asm volatile("s_waitcnt lgkmcnt(0)\n\ts_barrier" ::: "memory"); i2 = mb[0]; if (i2 >= limit || i2 < 0) i2 = 0x7fffffff; asm volatile("s_waitcnt lgkmcnt(0)\n\ts_barrier" ::: "memory"); }
        cur = nxt; inext = i2; nxt = (MODE == 0) ? cvt_decode_p0(F, i2) : cvt_decode_bg(F, i2);
    }
    __syncthreads();
#undef CVT_PROC
#undef CVT_STORE
}

__device__ __forceinline__ void p0_prologue(const Frame& F) {
    const int G = F.G, bx = F.bx;
    cvt_stream<0>(F, N_IT_P0, nullptr, 0u);
    __syncthreads();
    {
        LAS float* sc = (LAS float*)F.lds;
        LAS float* red = (LAS float*)(F.lds + 32768);
        float* mod = WSP(float, WS_MOD);
        for (int i = FTID; i < NB * D; i += NTHR) { const float cv = F.c[i]; sc[i] = cv / (1.f + expf(-cv)); }
        __syncthreads();
        for (int cb = bx; cb < 6 * D / 48; cb += G) {
            const int cg = FTID % 12, kl = FTID / 12;
            float a[4][4] = {};
            if (kl < 42) {
                for (int k0 = kl; k0 < D; k0 += 42 * 7) { f32x4 w[7];
#pragma unroll
                    for (int u = 0; u < 7; ++u) { const int k = k0 + 42 * u; w[u] = (k < D) ? *(const f32x4*)(F.w_ada + (size_t)k * (6 * D) + cb * 48 + cg * 4) : (f32x4){0.f, 0.f, 0.f, 0.f}; }
#pragma unroll
                    for (int u = 0; u < 7; ++u) { const int k = (k0 + 42 * u < D) ? k0 + 42 * u : 0;
#pragma unroll
                        for (int b = 0; b < 4; ++b) { const float s = sc[b * D + k];
#pragma unroll
                            for (int j = 0; j < 4; ++j) a[b][j] += s * w[u][j]; } } }
#pragma unroll
                for (int b = 0; b < 4; ++b)
#pragma unroll
                    for (int j = 0; j < 4; ++j) red[(kl * 12 + cg) * 16 + b * 4 + j] = a[b][j];
            }
            __syncthreads();
            if (FTID < 192) { const int cgi = FTID / 16, bj = FTID % 16; float s = 0.f; for (int q = 0; q < 42; ++q) s += red[(q * 12 + cgi) * 16 + bj];
                const int b = bj / 4, j = bj % 4; const int col = cb * 48 + cgi * 4 + j; mod[(size_t)b * 6 * D + col] = s + F.b_ada[col]; }
            __syncthreads();
        }
    }
    {
        float* rope = WSP(float, WS_ROPE);
        for (int i = bx * NTHR + FTID; i < S * 64; i += G * NTHR) { const int pos = i >> 6, fi = i & 63;
            const float inv = powf(10000.f, -(float)(2 * fi) / 128.f); const float ang = (float)pos * inv; rope[2 * i] = cosf(ang); rope[2 * i + 1] = sinf(ang); }
        float* wif = WSP(float, WS_WIF);
        for (int i = bx * NTHR + FTID; i < 8 * D; i += G * NTHR) { const int j = i / D, k = i % D; wif[i] = F.w_in[(size_t)k * NIN + OFF_IF + j]; }
        bf16_t* wrt = WSP(bf16_t, WS_WRT);
        for (int i = bx * NTHR + FTID; i < 48 * D; i += G * NTHR) { const int j = i / D, k = i % D;
            const float w = (j < 4) ? F.w_rg[k * 4 + j] : (j < 36 ? F.w_re[k * 32 + (j - 4)] : 0.f);
            const bf16_t hi = f2bf(w); const bf16_t lo = f2bf(w - bf2f(hi)); wrt[i] = hi; wrt[48 * D + i] = lo; }
    }
}

__device__ __forceinline__ void p1_lnmod(const Frame& F) {
    const float* mod = WSP(float, WS_MOD); const float* wif = WSP(float, WS_WIF); bf16_t* U = WSP(bf16_t, WS_U); float* gpre = WSP(float, WS_GPRE);
    const int tid = FTID; const int lane = tid & 63; const int gw = F.bx * NWAVES + __builtin_amdgcn_readfirstlane(tid >> 6), NGW = F.G * NWAVES;
    LAS float* wl = (LAS float*)F.lds;
    __syncthreads();
#pragma unroll
    for (int i = 0; i < 8; ++i) *(LAS f32x4*)(wl + 4 * (tid + NTHR * i)) = *(const f32x4*)(wif + 4 * (tid + NTHR * i));
    __syncthreads();
    f32x4 v[8], nx[8];
    if (gw < T) {
#pragma unroll
        for (int i = 0; i < 8; ++i) nx[i] = *(const f32x4*)(F.x + (size_t)gw * D + 4 * (lane + 64 * i)); }
    for (int t = gw; t < T; t += NGW) {
        const int b = t / S; float s = 0.f;
#pragma unroll
        for (int i = 0; i < 8; ++i) { v[i] = nx[i]; s += (v[i][0] + v[i][1]) + (v[i][2] + v[i][3]); }
        if (t + NGW < T) {
#pragma unroll
            for (int i = 0; i < 8; ++i) nx[i] = *(const f32x4*)(F.x + (size_t)(t + NGW) * D + 4 * (lane + 64 * i)); }
        const float mu = wave_sum(s) * (1.f / D);
        float q = 0.f;
#pragma unroll
        for (int i = 0; i < 8; ++i) { v[i] = v[i] - mu; q += (v[i][0] * v[i][0] + v[i][1] * v[i][1]) + (v[i][2] * v[i][2] + v[i][3] * v[i][3]); }
        const float rstd = rsqrtf(wave_sum(q) * (1.f / D) + LN_EPS);
        const float* sc = mod + (size_t)b * 6 * D + 1 * D; const float* sf = mod + (size_t)b * 6 * D;
#pragma unroll
        for (int i = 0; i < 8; ++i) { const int d = 4 * (lane + 64 * i); const f32x4 a = *(const f32x4*)(sc + d), bb = *(const f32x4*)(sf + d);
            v[i] = v[i] * rstd * (a + 1.f) + bb;
            u32x2 w; w.x = cvt_pk_bf16(v[i][0], v[i][1]); w.y = cvt_pk_bf16(v[i][2], v[i][3]); *(u32x2*)(U + (size_t)t * D + d) = w; }
        float g[8];
#pragma unroll
        for (int j = 0; j < 8; ++j) { float a = 0.f;
#pragma unroll
            for (int i = 0; i < 8; ++i) { const f32x4 w = *(const LAS f32x4*)(wl + j * D + 4 * (lane + 64 * i)); a += (v[i][0] * w[0] + v[i][1] * w[1]) + (v[i][2] * w[2] + v[i][3] * w[3]); }
            g[j] = wave_sum(a); }
        if (lane < 8) { float val = 0.f;
#pragma unroll
            for (int j = 0; j < 8; ++j) val = (lane == j) ? g[j] : val;
            val += F.b_mgate[lane];
            if (lane >= 4) val = fminf(val, 0.f) - log1pf(expf(-fabsf(val)));
            gpre[(size_t)t * 8 + lane] = val; }
    }
}

struct EpiP2 {
    static constexpr bool PERM = true;
    bf16_t *Q, *Kb, *V, *QKP, *VM, *OG, *GB; const float* rope; const float* b_gate;
    __device__ __forceinline__ void operator()(const f32x4 (&acc)[2][2][4][2], const pg8::Unit& u, int wr, int wc, int fr, int fq) const {
        const int pn = u.pn; int kind, coff, ldc; bf16_t* base;
        if (pn < 6) { kind = 0; base = Q; ldc = 1536; coff = pn * 256; }
        else if (pn < 12) { kind = 1; base = Kb; ldc = 1536; coff = (pn - 6) * 256; }
        else if (pn < 18) { kind = 2; base = V; ldc = 1536; coff = (pn - 12) * 256; }
        else if (pn < 26) { kind = 2; base = QKP; ldc = 2048; coff = (pn - 18) * 256; }
        else if (pn < 30) { kind = 2; base = VM; ldc = 1024; coff = (pn - 26) * 256; }
        else if (pn < 34) { kind = 3; base = OG; ldc = 1024; coff = (pn - 30) * 256; }
        else { kind = 4; base = GB; ldc = 4096; coff = (pn - 34) * 256; }
        const int row0 = u.pm * 256 + wr * 64 + fr, colL = wc * 32 + 8 * fq;
#pragma unroll
        for (int ai = 0; ai < 2; ++ai)
#pragma unroll
            for (int m = 0; m < 4; ++m) { const int r = row0 + ai * 128 + m * 16; const int pos = r & (S - 1);
#pragma unroll
                for (int bj = 0; bj < 2; ++bj) { f32x4 v0 = acc[ai][bj][m][0], v1 = acc[ai][bj][m][1]; const int col = coff + bj * 128 + colL;
                    if (kind <= 1) {
                        const float* rp = rope + ((size_t)pos * 64 + (16 * wc + 4 * fq)) * 2;
                        const f32x4 c0 = *(const f32x4*)rp, c1 = *(const f32x4*)(rp + 4);
                        const float sc = (kind == 0) ? QSCALE : 1.f;
                        f32x4 o0, o1;
                        o0[0] = (v0[0] * c0[0] - v0[1] * c0[1]) * sc; o0[1] = (v0[1] * c0[0] + v0[0] * c0[1]) * sc;
                        o0[2] = (v0[2] * c0[2] - v0[3] * c0[3]) * sc; o0[3] = (v0[3] * c0[2] + v0[2] * c0[3]) * sc;
                        o1[0] = (v1[0] * c1[0] - v1[1] * c1[1]) * sc; o1[1] = (v1[1] * c1[0] + v1[0] * c1[1]) * sc;
                        o1[2] = (v1[2] * c1[2] - v1[3] * c1[3]) * sc; o1[3] = (v1[3] * c1[2] + v1[2] * c1[3]) * sc;
                        v0 = o0; v1 = o1;
                    } else if (kind >= 3) {
                        if (kind == 4) { v0 = v0 + *(const f32x4*)(b_gate + col); v1 = v1 + *(const f32x4*)(b_gate + col + 4); }
#pragma unroll
                        for (int j = 0; j < 4; ++j) { v0[j] = sigmoid_fast(v0[j]); v1[j] = sigmoid_fast(v1[j]); }
                    }
                    u32x4 w; w.x = cvt_pk_bf16(v0[0], v0[1]); w.y = cvt_pk_bf16(v0[2], v0[3]); w.z = cvt_pk_bf16(v1[0], v1[1]); w.w = cvt_pk_bf16(v1[2], v1[3]);
                    *(u32x4*)(base + (size_t)r * ldc + col) = w; } }
    }
};

__device__ __forceinline__ void scan_bh(const Frame& F, int bh) {
    const float* gpre = WSP(float, WS_GPRE); float* bc = WSP(float, WS_BCUM) + (size_t)bh * S; float* mc = WSP(float, WS_MCUM) + (size_t)bh * S;
    const int b = bh >> 2, h = bh & 3, lane = FLANE;
    float lf[32], iv[32];
#pragma unroll
    for (int j = 0; j < 32; ++j) { const size_t t = (size_t)b * S + lane * 32 + j; iv[j] = gpre[t * 8 + h]; lf[j] = gpre[t * 8 + 4 + h]; }
    float run = 0.f;
#pragma unroll
    for (int j = 0; j < 32; ++j) { run += lf[j]; lf[j] = run; }
    float tot = run, incl = run;
#pragma unroll
    for (int o = 1; o < 64; o <<= 1) { const float n = __shfl_up(incl, o); if (lane >= o) incl += n; }
    const float excl = incl - tot;
    float mx = -INFINITY;
#pragma unroll
    for (int j = 0; j < 32; ++j) { lf[j] += excl; mx = fmaxf(mx, iv[j] - lf[j]); iv[j] = mx; }
    float mincl = mx;
#pragma unroll
    for (int o = 1; o < 64; o <<= 1) { const float n = __shfl_up(mincl, o); if (lane >= o) mincl = fmaxf(mincl, n); }
    float mexcl = __shfl_up(mincl, 1); if (lane == 0) mexcl = -INFINITY;
#pragma unroll
    for (int j = 0; j < 32; ++j) { const float cm = fmaxf(0.f, fmaxf(mexcl, iv[j])); bc[lane * 32 + j] = lf[j]; mc[lane * 32 + j] = lf[j] + cm; }
}

__device__ __forceinline__ void p3_conv(const Frame& F) {
    const bf16_t* QKP = WSP(bf16_t, WS_QKP); bf16_t* QM = WSP(bf16_t, WS_QM); bf16_t* KM = WSP(bf16_t, WS_KM);
    for (int item = F.bx * NTHR + FTID; item < 256 * 512; item += F.G * NTHR) {
        const int cc = item & 255, rs = item >> 8; const int c0 = cc * 8, t0 = rs * 16;
        float w[4][8], bias[8];
#pragma unroll
        for (int j = 0; j < 4; ++j) { const f32x4 a = *(const f32x4*)(F.conv_w + j * 2048 + c0), b = *(const f32x4*)(F.conv_w + j * 2048 + c0 + 4);
#pragma unroll
            for (int e = 0; e < 4; ++e) { w[j][e] = a[e]; w[j][4 + e] = b[e]; } }
        { const f32x4 a = *(const f32x4*)(F.conv_b + c0), b = *(const f32x4*)(F.conv_b + c0 + 4);
#pragma unroll
            for (int e = 0; e < 4; ++e) { bias[e] = a[e]; bias[4 + e] = b[e]; } }
        float x1[8], x2[8], x3[8];
        const int pos0 = t0 & (S - 1);
        auto ldrow = [&](int t, float (&dst)[8]) { const u32x4 v = *(const u32x4*)(QKP + (size_t)t * 2048 + c0);
            dst[0] = bf_lo(v.x); dst[1] = bf_hi(v.x); dst[2] = bf_lo(v.y); dst[3] = bf_hi(v.y); dst[4] = bf_lo(v.z); dst[5] = bf_hi(v.z); dst[6] = bf_lo(v.w); dst[7] = bf_hi(v.w); };
        if (pos0 >= 3) { ldrow(t0 - 1, x1); ldrow(t0 - 2, x2); ldrow(t0 - 3, x3); }
        else {
#pragma unroll
            for (int e = 0; e < 8; ++e) { x1[e] = 0.f; x2[e] = 0.f; x3[e] = 0.f; } }
        const bool isk = c0 >= 1024; bf16_t* dst = isk ? (KM + (c0 - 1024)) : (QM + c0); const float osc = isk ? 0.0625f : 1.f;
#pragma unroll 4
        for (int r = 0; r < 16; ++r) { float x0[8]; ldrow(t0 + r, x0); float y[8];
#pragma unroll
            for (int e = 0; e < 8; ++e) { y[e] = bias[e] + w[3][e] * x0[e] + w[2][e] * x1[e] + w[1][e] * x2[e] + w[0][e] * x3[e]; y[e] = silu_fast(y[e]) * osc; x3[e] = x2[e]; x2[e] = x1[e]; x1[e] = x0[e]; }
            u32x4 o; o.x = cvt_pk_bf16(y[0], y[1]); o.y = cvt_pk_bf16(y[2], y[3]); o.z = cvt_pk_bf16(y[4], y[5]); o.w = cvt_pk_bf16(y[6], y[7]);
            *(u32x4*)(dst + (size_t)(t0 + r) * 1024) = o; }
    }
}

constexpr int AT_KP = 272, AT_VP = 288, AT_VOFF = 256 * AT_KP;
__device__ __forceinline__ void attn_unit(const Frame& F, int unit) {
    const bf16_t* QB = WSP(bf16_t, WS_QB); const bf16_t* KB = WSP(bf16_t, WS_KB); const bf16_t* VB = WSP(bf16_t, WS_VB); bf16_t* OA = WSP(bf16_t, WS_OATT); float* LSE = WSP(float, WS_LSE);
    const int b = unit / 192, rem = unit % 192, head = rem >> 4, blk = rem & 15;
    const int g = head >> 2; const int dl = (g == 0) ? 0 : (g == 1 ? 2 : 4); const int d = 1 << dl; const int nbr = 16 >> dl;
    const int r = blk / nbr, n = blk % nbr;
    const int tid = FTID, lane = FLANE, w = FWAVE, jl = lane & 15, g4 = lane >> 4;
    LAS unsigned char* Ks = F.lds; LAS unsigned char* Vs = F.lds + AT_VOFF;
    __syncthreads();
#pragma unroll
    for (int pass = 0; pass < 2; ++pass) {
        u32x4 v[8];
#pragma unroll
        for (int i = 0; i < 8; ++i) { const int id = tid + NTHR * i; const int row = id >> 4, ch = id & 15; const int bn = (row < 128) ? n - 1 : n; const int lr = row & 127;
            const int pos = ((bn * 128 + lr) << dl) + r;
            const bf16_t* src = (pass == 0 ? KB : VB) + (size_t)(b * S + pos) * 1536 + head * 128 + ch * 8;
            v[i] = (bn >= 0) ? *(const u32x4*)src : (u32x4){0u, 0u, 0u, 0u}; }
#pragma unroll
        for (int i = 0; i < 8; ++i) { const int id = tid + NTHR * i; const int row = id >> 4, ch = id & 15;
            if (pass == 0) *(LAS u32x4*)(Ks + row * AT_KP + ch * 16) = v[i]; else *(LAS u32x4*)(Vs + row * AT_VP + ch * 16) = v[i]; }
    }
    const int posq = (((n * 128 + 16 * w + jl)) << dl) + r;
    const size_t tq = (size_t)b * S + posq;
    bf16x8 qf[4];
#pragma unroll
    for (int ks = 0; ks < 4; ++ks) qf[ks] = *(const bf16x8*)(QB + tq * 1536 + head * 128 + ks * 32 + 8 * g4);
    __syncthreads();
    f32x4 sT[10];
#pragma unroll
    for (int u = 0; u < 9; ++u) { f32x4 a = {0.f, 0.f, 0.f, 0.f};
#pragma unroll
        for (int ks = 0; ks < 4; ++ks) { const bf16x8 kf = *(const LAS bf16x8*)(Ks + (16 * (w + u) + jl) * AT_KP + (ks * 32 + 8 * g4) * 2); a = __builtin_amdgcn_mfma_f32_16x16x32_bf16(kf, qf[ks], a, 0, 0, 0); }
        sT[u] = a; }
    sT[9] = (f32x4){0.f, 0.f, 0.f, 0.f};
    float mx = -INFINITY;
#pragma unroll
    for (int u = 0; u < 9; ++u)
#pragma unroll
        for (int rg = 0; rg < 4; ++rg) { const int kin = 4 * g4 + rg; bool valid;
            if (u == 0) valid = (n > 0) && (kin >= jl); else if (u == 8) valid = (kin <= jl); else valid = (w + u >= 8) || (n > 0);
            const float s = valid ? sT[u][rg] : -INFINITY; sT[u][rg] = s; mx = fmaxf(mx, s); }
    mx = fmaxf(mx, __shfl_xor(mx, 16)); mx = fmaxf(mx, __shfl_xor(mx, 32));
    float den = 0.f;
#pragma unroll
    for (int u = 0; u < 9; ++u)
#pragma unroll
        for (int rg = 0; rg < 4; ++rg) { const float p = fast_exp2(sT[u][rg] - mx); sT[u][rg] = p; den += p; }
    den += __shfl_xor(den, 16); den += __shfl_xor(den, 32);
    f32x4 oT[8];
#pragma unroll
    for (int et = 0; et < 8; ++et) oT[et] = (f32x4){0.f, 0.f, 0.f, 0.f};
    const unsigned vbase = (unsigned)(uintptr_t)(Vs) + (unsigned)((4 * g4 + (jl >> 2)) * AT_VP + (jl & 3) * 8);
#pragma unroll
    for (int c = 0; c < 5; ++c) {
        const int kt0 = w + 2 * c, kt1 = (c == 4) ? kt0 : kt0 + 1;
        union { bf16x8 v; unsigned u[4]; } pf;
        pf.u[0] = cvt_pk_bf16(sT[2 * c][0], sT[2 * c][1]); pf.u[1] = cvt_pk_bf16(sT[2 * c][2], sT[2 * c][3]);
        pf.u[2] = cvt_pk_bf16(sT[2 * c + 1][0], sT[2 * c + 1][1]); pf.u[3] = cvt_pk_bf16(sT[2 * c + 1][2], sT[2 * c + 1][3]);
        s16x4 t0[8], t1[8];
        const unsigned vb0 = vbase + kt0 * 16 * AT_VP, vb1 = vbase + kt1 * 16 * AT_VP;
#pragma unroll
        for (int et = 0; et < 8; ++et) { t0[et] = tr_read_o(vb0, et * 32); t1[et] = tr_read_o(vb1, et * 32); }
        LGKM_WAIT0();
#pragma unroll
        for (int et = 0; et < 8; ++et) oT[et] = __builtin_amdgcn_mfma_f32_16x16x32_bf16(PK8(t0[et], t1[et]), pf.v, oT[et], 0, 0, 0);
    }
    const float inv = 1.f / den;
#pragma unroll
    for (int et = 0; et < 8; ++et) { u32x2 o; o.x = cvt_pk_bf16(oT[et][0] * inv, oT[et][1] * inv); o.y = cvt_pk_bf16(oT[et][2] * inv, oT[et][3] * inv);
        *(u32x2*)(OA + tq * 1536 + head * 128 + 16 * et + 4 * g4) = o; }
    if (g4 == 0) LSE[tq * 12 + head] = (mx + log2f(den)) * LN2;
}

constexpr int ML_P = 544;
__device__ __forceinline__ void mlstm_dc_unit(const Frame& F, int unit) {
    const bf16_t* KM = WSP(bf16_t, WS_KM); const bf16_t* VM = WSP(bf16_t, WS_VMB); const float* gpre = WSP(float, WS_GPRE);
    const float* bcum = WSP(float, WS_BCUM); const float* mcum = WSP(float, WS_MCUM); float* DC = WSP(float, WS_DC) + (size_t)unit * 65536; float* DN = WSP(float, WS_DN) + (size_t)unit * 256;
    const int bh = unit >> 4, c = unit & 15, b = bh >> 2, h = bh & 3; const size_t t0 = (size_t)b * S + c * 128;
    const int tid = FTID, lane = FLANE, w = FWAVE, jl = lane & 15, g4 = lane >> 4;
    LAS unsigned char* Ks = F.lds; LAS unsigned char* Vs = F.lds + 128 * ML_P; LAS float* wt = (LAS float*)(F.lds + 2 * 128 * ML_P);
    __syncthreads();
    if (tid < 128) { const float Be = bcum[bh * S + c * 128 + 127], me = mcum[bh * S + c * 128 + 127];
        wt[tid] = expf(Be - bcum[bh * S + c * 128 + tid] + gpre[(t0 + tid) * 8 + h] - me); }
    __syncthreads();
    {
        u32x4 v[8];
#pragma unroll
        for (int i = 0; i < 8; ++i) { const int id = tid + NTHR * i; const int row = id >> 5, ch = id & 31; v[i] = *(const u32x4*)(KM + (t0 + row) * 1024 + h * 256 + ch * 8); }
#pragma unroll
        for (int i = 0; i < 8; ++i) { const int id = tid + NTHR * i; const int row = id >> 5, ch = id & 31; *(LAS u32x4*)(Ks + row * ML_P + ch * 16) = v[i]; }
#pragma unroll
        for (int i = 0; i < 8; ++i) { const int id = tid + NTHR * i; const int row = id >> 5, ch = id & 31; v[i] = *(const u32x4*)(VM + (t0 + row) * 1024 + h * 256 + ch * 8); }
#pragma unroll
        for (int i = 0; i < 8; ++i) { const int id = tid + NTHR * i; const int row = id >> 5, ch = id & 31; const float ws_ = wt[row]; u32x4 o;
            o.x = cvt_pk_bf16(bf_lo(v[i].x) * ws_, bf_hi(v[i].x) * ws_); o.y = cvt_pk_bf16(bf_lo(v[i].y) * ws_, bf_hi(v[i].y) * ws_);
            o.z = cvt_pk_bf16(bf_lo(v[i].z) * ws_, bf_hi(v[i].z) * ws_); o.w = cvt_pk_bf16(bf_lo(v[i].w) * ws_, bf_hi(v[i].w) * ws_);
            *(LAS u32x4*)(Vs + row * ML_P + ch * 16) = o; }
    }
    __syncthreads();
    if (tid < 256) { float a = 0.f; for (int s = 0; s < 128; ++s) a += wt[s] * bf2f(*(const LAS bf16_t*)(Ks + s * ML_P + tid * 2)); DN[tid] = a; }
    const int vr = w >> 1, kr = w & 1;
    f32x4 acc[4][8];
#pragma unroll
    for (int i = 0; i < 4; ++i)
#pragma unroll
        for (int j = 0; j < 8; ++j) acc[i][j] = (f32x4){0.f, 0.f, 0.f, 0.f};
    const unsigned rowoff = (unsigned)((4 * g4 + (jl >> 2)) * ML_P + (jl & 3) * 8);
    const unsigned kb = (unsigned)(uintptr_t)Ks + rowoff + kr * 256, vb = (unsigned)(uintptr_t)Vs + rowoff + vr * 128;
#pragma unroll 1
    for (int ks = 0; ks < 4; ++ks) {
        s16x4 a0[4], a1[4], b0[8], b1[8];
#pragma unroll
        for (int i = 0; i < 4; ++i) { a0[i] = tr_read_o(vb + ks * 32 * ML_P, i * 32); a1[i] = tr_read_o(vb + ks * 32 * ML_P, 16 * ML_P + i * 32); }
#pragma unroll
        for (int j = 0; j < 8; ++j) { b0[j] = tr_read_o(kb + ks * 32 * ML_P, j * 32); b1[j] = tr_read_o(kb + ks * 32 * ML_P, 16 * ML_P + j * 32); }
        LGKM_WAIT0();
#pragma unroll
        for (int i = 0; i < 4; ++i)
#pragma unroll
            for (int j = 0; j < 8; ++j) acc[i][j] = __builtin_amdgcn_mfma_f32_16x16x32_bf16(PK8(a0[i], a1[i]), PK8(b0[j], b1[j]), acc[i][j], 0, 0, 0);
    }
#pragma unroll
    for (int i = 0; i < 4; ++i)
#pragma unroll
        for (int j = 0; j < 8; ++j)
#pragma unroll
            for (int rg = 0; rg < 4; ++rg) DC[(size_t)(16 * (4 * vr + i) + 4 * g4 + rg) * 256 + 16 * (8 * kr + j) + jl] = acc[i][j][rg];
}

__device__ __forceinline__ float chunk_decay(const float* bcum, const float* mcum, int bh, int c) {
    const float Be = bcum[bh * S + c * 128 + 127], me = mcum[bh * S + c * 128 + 127];
    const float Bp = (c > 0) ? bcum[bh * S + c * 128 - 1] : 0.f, mp = (c > 0) ? mcum[bh * S + c * 128 - 1] : 0.f;
    return expf(Be - Bp + mp - me);
}
__device__ __forceinline__ void p5_scan_mix(const Frame& F) {
    const float* bcum = WSP(float, WS_BCUM); const float* mcum = WSP(float, WS_MCUM);
    const float* DC = WSP(float, WS_DC); bf16_t* CST = WSP(bf16_t, WS_CST); const float* DN = WSP(float, WS_DN); float* NST = WSP(float, WS_NST);
    const int gt = F.bx * NTHR + FTID, NG = F.G * NTHR;
    for (int item = gt; item < 16 * 8192; item += NG) {
        const int bh = item >> 13, e8 = item & 8191;
        f32x4 c0 = {0.f, 0.f, 0.f, 0.f}, c1 = {0.f, 0.f, 0.f, 0.f};
#pragma unroll 5
        for (int c = 0; c < 15; ++c) { const float dec = chunk_decay(bcum, mcum, bh, c);
            const float* p = DC + (size_t)(bh * 16 + c) * 65536 + e8 * 8; const f32x4 d0 = *(const f32x4*)p, d1 = *(const f32x4*)(p + 4);
            c0 = c0 * dec + d0; c1 = c1 * dec + d1;
            u32x4 o; o.x = cvt_pk_bf16(c0[0], c0[1]); o.y = cvt_pk_bf16(c0[2], c0[3]); o.z = cvt_pk_bf16(c1[0], c1[1]); o.w = cvt_pk_bf16(c1[2], c1[3]);
            *(u32x4*)(CST + (size_t)(bh * 16 + c + 1) * 65536 + e8 * 8) = o; }
    }
    for (int item = gt; item < 16 * 256; item += NG) { const int bh = item >> 8, k = item & 255; float n = 0.f;
        for (int c = 0; c < 15; ++c) { n = n * chunk_decay(bcum, mcum, bh, c) + DN[(size_t)(bh * 16 + c) * 256 + k]; NST[(size_t)(bh * 16 + c + 1) * 256 + k] = n; } }
    const bf16_t* OA = WSP(bf16_t, WS_OATT); const float* LSE = WSP(float, WS_LSE); bf16_t* YA = WSP(bf16_t, WS_YA);
    for (int item = gt; item < T * 64; item += NG) { const int t = item >> 6, h = (item >> 4) & 3, e8 = item & 15;
        const float l0 = LSE[(size_t)t * 12 + h], l1 = LSE[(size_t)t * 12 + 4 + h], l2 = LSE[(size_t)t * 12 + 8 + h];
        const float ml = fmaxf(l0, fmaxf(l1, l2)); float w0 = expf(l0 - ml), w1 = expf(l1 - ml), w2 = expf(l2 - ml); const float ws_ = 1.f / (w0 + w1 + w2); w0 *= ws_; w1 *= ws_; w2 *= ws_;
        const u32x4 a = *(const u32x4*)(OA + (size_t)t * 1536 + h * 128 + e8 * 8), bq = *(const u32x4*)(OA + (size_t)t * 1536 + (4 + h) * 128 + e8 * 8), cq = *(const u32x4*)(OA + (size_t)t * 1536 + (8 + h) * 128 + e8 * 8);
        u32x4 o;
        o.x = cvt_pk_bf16(w0 * bf_lo(a.x) + w1 * bf_lo(bq.x) + w2 * bf_lo(cq.x), w0 * bf_hi(a.x) + w1 * bf_hi(bq.x) + w2 * bf_hi(cq.x));
        o.y = cvt_pk_bf16(w0 * bf_lo(a.y) + w1 * bf_lo(bq.y) + w2 * bf_lo(cq.y), w0 * bf_hi(a.y) + w1 * bf_hi(bq.y) + w2 * bf_hi(cq.y));
        o.z = cvt_pk_bf16(w0 * bf_lo(a.z) + w1 * bf_lo(bq.z) + w2 * bf_lo(cq.z), w0 * bf_hi(a.z) + w1 * bf_hi(bq.z) + w2 * bf_hi(cq.z));
        o.w = cvt_pk_bf16(w0 * bf_lo(a.w) + w1 * bf_lo(bq.w) + w2 * bf_lo(cq.w), w0 * bf_hi(a.w) + w1 * bf_hi(bq.w) + w2 * bf_hi(cq.w));
        *(u32x4*)(YA + (size_t)t * 512 + h * 128 + e8 * 8) = o; }
}

constexpr int MO_KP = 528, MO_VOFF = 128 * MO_KP, MO_TAB = MO_VOFF + 128 * ML_P;
__device__ __forceinline__ void mlstm_out_unit(const Frame& F, int unit) {
    const bf16_t* QM = WSP(bf16_t, WS_QM); const bf16_t* KM = WSP(bf16_t, WS_KM); const bf16_t* VM = WSP(bf16_t, WS_VMB); const bf16_t* OG = WSP(bf16_t, WS_OGB);
    const bf16_t* CST = WSP(bf16_t, WS_CST) + (size_t)unit * 65536; const float* NST = WSP(float, WS_NST) + (size_t)unit * 256; bf16_t* YM = WSP(bf16_t, WS_YM);
    const float* gpre = WSP(float, WS_GPRE); const float* bcum = WSP(float, WS_BCUM); const float* mcum = WSP(float, WS_MCUM);
    const int bh = unit >> 4, c = unit & 15, b = bh >> 2, h = bh & 3; const size_t t0 = (size_t)b * S + c * 128;
    const int tid = FTID, lane = FLANE, w = FWAVE, jl = lane & 15, g4 = lane >> 4;
    LAS unsigned char* RA = F.lds; LAS unsigned char* RB = F.lds + MO_VOFF; LAS float* cs = (LAS float*)(F.lds + MO_TAB); LAS float* ntab = cs + 128;
    __syncthreads();
    {
        u32x4 v[8];
#pragma unroll
        for (int i = 0; i < 8; ++i) { const int id = tid + NTHR * i; const int row = id >> 5, ch = id & 31; v[i] = *(const u32x4*)(KM + (t0 + row) * 1024 + h * 256 + ch * 8); }
#pragma unroll
        for (int i = 0; i < 8; ++i) { const int id = tid + NTHR * i; const int row = id >> 5, ch = id & 31; *(LAS u32x4*)(RA + row * MO_KP + ch * 16) = v[i]; }
#pragma unroll
        for (int i = 0; i < 8; ++i) { const int id = tid + NTHR * i; const int row = id >> 5, ch = id & 31; v[i] = *(const u32x4*)(VM + (t0 + row) * 1024 + h * 256 + ch * 8); }
#pragma unroll
        for (int i = 0; i < 8; ++i) { const int id = tid + NTHR * i; const int row = id >> 5, ch = id & 31; *(LAS u32x4*)(RB + row * ML_P + ch * 16) = v[i]; }
        if (tid < 128) cs[tid] = (gpre[(t0 + tid) * 8 + h] - bcum[bh * S + c * 128 + tid]) * LOG2E;
        if (tid >= 128 && tid < 384) ntab[tid - 128] = (c > 0) ? NST[tid - 128] : 0.f;
    }
    const int tl = 16 * w + jl; const size_t t = t0 + tl;
    const float Bt = bcum[bh * S + c * 128 + tl], mt = mcum[bh * S + c * 128 + tl];
    const float Bp = (c > 0) ? bcum[bh * S + c * 128 - 1] : 0.f, mp = (c > 0) ? mcum[bh * S + c * 128 - 1] : 0.f;
    const float at = (Bt - mt) * LOG2E; const float inter = fast_exp2((Bt - Bp + mp - mt) * LOG2E);
    union QF { bf16x8 v; unsigned u[4]; }; QF qf[8];
#pragma unroll
    for (int ks = 0; ks < 8; ++ks) qf[ks].v = *(const bf16x8*)(QM + t * 1024 + h * 256 + ks * 32 + 8 * g4);
    __syncthreads();
    f32x4 sT[8];
#pragma unroll
    for (int st = 0; st < 8; ++st) { f32x4 a = {0.f, 0.f, 0.f, 0.f};
        if (st <= w) {
#pragma unroll
            for (int ks = 0; ks < 8; ++ks) { const bf16x8 kf = *(const LAS bf16x8*)(RA + (16 * st + jl) * MO_KP + (ks * 32 + 8 * g4) * 2); a = __builtin_amdgcn_mfma_f32_16x16x32_bf16(kf, qf[ks].v, a, 0, 0, 0); } }
        sT[st] = a; __builtin_amdgcn_sched_barrier(0); }
    float dsum = 0.f;
#pragma unroll
    for (int st = 0; st < 8; ++st) { const f32x4 cv = *(const LAS f32x4*)(cs + 16 * st + 4 * g4);
#pragma unroll
        for (int rg = 0; rg < 4; ++rg) { const bool valid = (st < w) || (st == w && (4 * g4 + rg) <= jl); const float f = valid ? fast_exp2(fminf(at + cv[rg], 0.f)) : 0.f; const float sv = sT[st][rg] * f; sT[st][rg] = sv; dsum += sv; } }
    dsum += __shfl_xor(dsum, 16); dsum += __shfl_xor(dsum, 32);
    float nq = 0.f;
#pragma unroll
    for (int ks = 0; ks < 8; ++ks) { const f32x4 n0 = *(const LAS f32x4*)(ntab + ks * 32 + 8 * g4), n1 = *(const LAS f32x4*)(ntab + ks * 32 + 8 * g4 + 4);
        nq += bf_lo(qf[ks].u[0]) * n0[0] + bf_hi(qf[ks].u[0]) * n0[1] + bf_lo(qf[ks].u[1]) * n0[2] + bf_hi(qf[ks].u[1]) * n0[3]
            + bf_lo(qf[ks].u[2]) * n1[0] + bf_hi(qf[ks].u[2]) * n1[1] + bf_lo(qf[ks].u[3]) * n1[2] + bf_hi(qf[ks].u[3]) * n1[3]; }
    nq += __shfl_xor(nq, 16); nq += __shfl_xor(nq, 32);
    const float den = dsum + inter * nq;
    f32x4 acc[16];
#pragma unroll
    for (int vt = 0; vt < 16; ++vt) acc[vt] = (f32x4){0.f, 0.f, 0.f, 0.f};
    const unsigned vbase = (unsigned)(uintptr_t)RB + (unsigned)((4 * g4 + (jl >> 2)) * ML_P + (jl & 3) * 8);
#pragma unroll
    for (int c4 = 0; c4 < 4; ++c4) {
        if (2 * c4 <= w) {
            union { bf16x8 v; unsigned u[4]; } pf;
            pf.u[0] = cvt_pk_bf16(sT[2 * c4][0], sT[2 * c4][1]); pf.u[1] = cvt_pk_bf16(sT[2 * c4][2], sT[2 * c4][3]);
            pf.u[2] = cvt_pk_bf16(sT[2 * c4 + 1][0], sT[2 * c4 + 1][1]); pf.u[3] = cvt_pk_bf16(sT[2 * c4 + 1][2], sT[2 * c4 + 1][3]);
#pragma unroll
            for (int hb = 0; hb < 2; ++hb) {
                s16x4 a0[8], a1[8];
#pragma unroll
                for (int i = 0; i < 8; ++i) { a0[i] = tr_read_o(vbase, c4 * 32 * ML_P + (hb * 8 + i) * 32); a1[i] = tr_read_o(vbase, (c4 * 32 + 16) * ML_P + (hb * 8 + i) * 32); }
                LGKM_WAIT0();
#pragma unroll
                for (int i = 0; i < 8; ++i) acc[hb * 8 + i] = __builtin_amdgcn_mfma_f32_16x16x32_bf16(PK8(a0[i], a1[i]), pf.v, acc[hb * 8 + i], 0, 0, 0);
            }
        }
    }
    if (c > 0) {
#pragma unroll
        for (int ks = 0; ks < 8; ++ks)
#pragma unroll
            for (int j = 0; j < 4; ++j) qf[ks].u[j] = cvt_pk_bf16(bf_lo(qf[ks].u[j]) * inter, bf_hi(qf[ks].u[j]) * inter);
#pragma unroll
        for (int half = 0; half < 2; ++half) {
            __syncthreads();
            u32x4 v[8];
#pragma unroll
            for (int i = 0; i < 8; ++i) { const int id = tid + NTHR * i; const int row = id >> 5, ch = id & 31; v[i] = *(const u32x4*)(CST + (size_t)(half * 128 + row) * 256 + ch * 8); }
#pragma unroll
            for (int i = 0; i < 8; ++i) { const int id = tid + NTHR * i; const int row = id >> 5, ch = id & 31; *(LAS u32x4*)(RA + row * MO_KP + ch * 16) = v[i]; }
            __syncthreads();
#pragma unroll
            for (int vt = 0; vt < 8; ++vt)
#pragma unroll
                for (int ks = 0; ks < 8; ++ks) { const bf16x8 cf = *(const LAS bf16x8*)(RA + (16 * vt + jl) * MO_KP + (ks * 32 + 8 * g4) * 2);
                    acc[half * 8 + vt] = __builtin_amdgcn_mfma_f32_16x16x32_bf16(cf, qf[ks].v, acc[half * 8 + vt], 0, 0, 0); if (ks == 7) __builtin_amdgcn_sched_barrier(0); }
        }
    }
    const float rden = 1.f / fmaxf(fabsf(den), fast_exp2(-mt * LOG2E));
    float sm = 0.f;
#pragma unroll
    for (int vt = 0; vt < 16; ++vt) { const u32x2 og = *(const u32x2*)(OG + t * 1024 + h * 256 + 16 * vt + 4 * g4);
        acc[vt][0] *= rden * bf_lo(og.x); acc[vt][1] *= rden * bf_hi(og.x); acc[vt][2] *= rden * bf_lo(og.y); acc[vt][3] *= rden * bf_hi(og.y);
        sm += (acc[vt][0] + acc[vt][1]) + (acc[vt][2] + acc[vt][3]); }
    sm += __shfl_xor(sm, 16); sm += __shfl_xor(sm, 32);
    const float mu = sm * (1.f / 256.f); float sq = 0.f;
#pragma unroll
    for (int vt = 0; vt < 16; ++vt) { acc[vt] = acc[vt] - mu; sq += (acc[vt][0] * acc[vt][0] + acc[vt][1] * acc[vt][1]) + (acc[vt][2] * acc[vt][2] + acc[vt][3] * acc[vt][3]); }
    sq += __shfl_xor(sq, 16); sq += __shfl_xor(sq, 32);
    const float rstd = rsqrtf(sq * (1.f / 256.f) + LN_EPS);
#pragma unroll
    for (int vt = 0; vt < 16; ++vt) { const f32x4 gg = *(const f32x4*)(F.m_norm_g + h * 256 + 16 * vt + 4 * g4); const f32x4 o = acc[vt] * rstd * gg;
        u32x2 ow; ow.x = cvt_pk_bf16(o[0], o[1]); ow.y = cvt_pk_bf16(o[2], o[3]); *(u32x2*)(YM + t * 1024 + h * 256 + 16 * vt + 4 * g4) = ow; }
}

struct EpiMerge {
    static constexpr bool PERM = true;
    bf16_t* MG; const bf16_t* GB; int step;
    __device__ __forceinline__ void operator()(const f32x4 (&acc)[2][2][4][2], const pg8::Unit& u, int wr, int wc, int fr, int fq) const {
        const int row0 = u.pm * 256 + wr * 64 + fr, col0 = u.pn * 256 + wc * 32 + 8 * fq;
#pragma unroll
        for (int ai = 0; ai < 2; ++ai)
#pragma unroll
            for (int m = 0; m < 4; ++m) { const size_t r = row0 + ai * 128 + m * 16;
#pragma unroll
                for (int bj = 0; bj < 2; ++bj) { const int col = col0 + bj * 128; const f32x4 v0 = acc[ai][bj][m][0], v1 = acc[ai][bj][m][1];
                    const u32x4 gq = *(const u32x4*)(GB + r * 4096 + step * 2048 + col);
                    float o[8] = {v0[0] * bf_lo(gq.x), v0[1] * bf_hi(gq.x), v0[2] * bf_lo(gq.y), v0[3] * bf_hi(gq.y), v1[0] * bf_lo(gq.z), v1[1] * bf_hi(gq.z), v1[2] * bf_lo(gq.w), v1[3] * bf_hi(gq.w)};
                    if (step) { const u32x4 pq = *(const u32x4*)(MG + r * 2048 + col);
                        o[0] += bf_lo(pq.x); o[1] += bf_hi(pq.x); o[2] += bf_lo(pq.y); o[3] += bf_hi(pq.y); o[4] += bf_lo(pq.z); o[5] += bf_hi(pq.z); o[6] += bf_lo(pq.w); o[7] += bf_hi(pq.w); }
                    u32x4 wv; wv.x = cvt_pk_bf16(o[0], o[1]); wv.y = cvt_pk_bf16(o[2], o[3]); wv.z = cvt_pk_bf16(o[4], o[5]); wv.w = cvt_pk_bf16(o[6], o[7]);
                    *(u32x4*)(MG + r * 2048 + col) = wv; } }
    }
};
struct EpiWout {
    static constexpr bool PERM = false;
    const float* x; const float* mod; float* PRE;
    __device__ __forceinline__ void operator()(const f32x4 (&acc)[2][2][4][2], const pg8::Unit& u, int wr, int wc, int fr, int fq) const {
        const int row0 = u.pm * 256 + wr * 64 + fr, col0 = u.pn * 256 + wc * 32 + 4 * fq;
        const float* gate = mod + (size_t)((u.pm * 256) / S) * 6 * D + 2 * D;
        f32x4 gv[2][2];
#pragma unroll
        for (int bj = 0; bj < 2; ++bj)
#pragma unroll
            for (int n = 0; n < 2; ++n) gv[bj][n] = *(const f32x4*)(gate + col0 + bj * 128 + n * 16);
#pragma unroll
        for (int ai = 0; ai < 2; ++ai)
#pragma unroll
            for (int m = 0; m < 4; ++m) { const size_t off = (size_t)(row0 + ai * 128 + m * 16) * D + col0;
#pragma unroll
                for (int bj = 0; bj < 2; ++bj)
#pragma unroll
                    for (int n = 0; n < 2; ++n) { const f32x4 xv = *(const f32x4*)(x + off + bj * 128 + n * 16); *(f32x4*)(PRE + off + bj * 128 + n * 16) = xv * ALPHA + gv[bj][n] * acc[ai][bj][m][n]; } }
    }
};

constexpr int R_UP = 4112, R_LO = 16 * R_UP, R_PART = 2 * 16 * R_UP, R_LOG = R_PART + 8 * 16 * 48 * 4;
template <bool DRY> __device__ __forceinline__ void p9_ln_router(const Frame& F) {
    const float* PRE = WSP(float, WS_PRE); const float* mod = WSP(float, WS_MOD); bf16_t* U2 = WSP(bf16_t, WS_U); const bf16_t* WRT = WSP(bf16_t, WS_WRT);
    int* cnt = (int*)(F.ws + WS_CTL) + CW_CNT; int* idx = WSP(int, WS_IDX); float* wl = WSP(float, WS_WL); int* tok = WSP(int, WS_TOK);
    const int lane = FLANE, w = FWAVE, tid = FTID, jl = lane & 15, g4 = lane >> 4;
    LAS unsigned char* Uhi = F.lds; LAS unsigned char* Ulo = F.lds + R_LO; LAS float* part = (LAS float*)(F.lds + R_PART); LAS float* lg = (LAS float*)(F.lds + R_LOG);
    for (int rgp = F.bx; rgp < T / 16; rgp += F.G) {
        __syncthreads();
#pragma unroll 1
        for (int rr = 0; rr < 2; ++rr) {
            const int lr = 2 * w + rr; const int t = rgp * 16 + lr; const int b = t / S;
            f32x4 v[8]; float s = 0.f;
#pragma unroll
            for (int i = 0; i < 8; ++i) { v[i] = *(const f32x4*)(PRE + (size_t)t * D + 4 * (lane + 64 * i)); s += (v[i][0] + v[i][1]) + (v[i][2] + v[i][3]); }
            float mu = wave_sum(s) * (1.f / D); float q = 0.f;
#pragma unroll
            for (int i = 0; i < 8; ++i) { v[i] = v[i] - mu; q += (v[i][0] * v[i][0] + v[i][1] * v[i][1]) + (v[i][2] * v[i][2] + v[i][3] * v[i][3]); }
            float rstd = rsqrtf(wave_sum(q) * (1.f / D) + LN_EPS);
            s = 0.f;
#pragma unroll
            for (int i = 0; i < 8; ++i) { const int d = 4 * (lane + 64 * i); const f32x4 gg = *(const f32x4*)(F.ln1_g + d), bb = *(const f32x4*)(F.ln1_b + d);
                v[i] = v[i] * rstd * gg + bb; *(f32x4*)(F.out + (size_t)t * D + d) = v[i]; s += (v[i][0] + v[i][1]) + (v[i][2] + v[i][3]); }
            mu = wave_sum(s) * (1.f / D); q = 0.f;
#pragma unroll
            for (int i = 0; i < 8; ++i) { v[i] = v[i] - mu; q += (v[i][0] * v[i][0] + v[i][1] * v[i][1]) + (v[i][2] * v[i][2] + v[i][3] * v[i][3]); }
            rstd = rsqrtf(wave_sum(q) * (1.f / D) + LN_EPS);
            const float* sc = mod + (size_t)b * 6 * D + 4 * D; const float* sf = mod + (size_t)b * 6 * D + 3 * D;
#pragma unroll
            for (int i = 0; i < 8; ++i) { const int d = 4 * (lane + 64 * i); const f32x4 a = *(const f32x4*)(sc + d), bb = *(const f32x4*)(sf + d);
                v[i] = v[i] * rstd * (a + 1.f) + bb;
                u32x2 hi; hi.x = cvt_pk_bf16(v[i][0], v[i][1]); hi.y = cvt_pk_bf16(v[i][2], v[i][3]);
                *(u32x2*)(U2 + (size_t)t * D + d) = hi;
                u32x2 lo; lo.x = cvt_pk_bf16(v[i][0] - bf_lo(hi.x), v[i][1] - bf_hi(hi.x)); lo.y = cvt_pk_bf16(v[i][2] - bf_lo(hi.y), v[i][3] - bf_hi(hi.y));
                *(LAS u32x2*)(Uhi + lr * R_UP + d * 2) = hi; *(LAS u32x2*)(Ulo + lr * R_UP + d * 2) = lo; }
        }
        __syncthreads();
        {
            f32x4 a3[3] = {{0.f, 0.f, 0.f, 0.f}, {0.f, 0.f, 0.f, 0.f}, {0.f, 0.f, 0.f, 0.f}};
#pragma unroll 2
            for (int ks = 0; ks < 8; ++ks) { const int k0 = 256 * w + 32 * ks + 8 * g4;
                const bf16x8 ah = *(const LAS bf16x8*)(Uhi + jl * R_UP + k0 * 2), al = *(const LAS bf16x8*)(Ulo + jl * R_UP + k0 * 2);
#pragma unroll
                for (int nt = 0; nt < 3; ++nt) { const bf16x8 bh = *(const bf16x8*)(WRT + (size_t)(16 * nt + jl) * D + k0), bl = *(const bf16x8*)(WRT + (size_t)48 * D + (size_t)(16 * nt + jl) * D + k0);
                    a3[nt] = __builtin_amdgcn_mfma_f32_16x16x32_bf16(ah, bh, a3[nt], 0, 0, 0); a3[nt] = __builtin_amdgcn_mfma_f32_16x16x32_bf16(ah, bl, a3[nt], 0, 0, 0); a3[nt] = __builtin_amdgcn_mfma_f32_16x16x32_bf16(al, bh, a3[nt], 0, 0, 0); } }
#pragma unroll
            for (int nt = 0; nt < 3; ++nt)
#pragma unroll
                for (int rg = 0; rg < 4; ++rg) part[(w * 16 + 4 * g4 + rg) * 48 + 16 * nt + jl] = a3[nt][rg];
        }
        __syncthreads();
        for (int i = tid; i < 16 * 48; i += NTHR) { float s = 0.f;
#pragma unroll
            for (int ww = 0; ww < 8; ++ww) s += part[ww * 768 + i];
            lg[i] = s; }
        __syncthreads();
        if (tid < 16) { const int t = rgp * 16 + tid; const LAS float* l = lg + tid * 48;
            int gt = 0; float lgt = l[0] + F.b_rg[0];
            for (int j = 1; j < 4; ++j) { const float x = l[j] + F.b_rg[j]; if (x > lgt) { lgt = x; gt = j; } }
            float se = 0.f; for (int j = 0; j < 4; ++j) se += expf(l[j] + F.b_rg[j] - lgt);
            const float gw = 1.f / se;
            int a = 0; float la = l[4 + gt * 8] + F.b_re[gt * 8];
            for (int j = 1; j < 8; ++j) { const float x = l[4 + gt * 8 + j] + F.b_re[gt * 8 + j]; if (x > la) { la = x; a = j; } }
            int bb = -1; float lb = -INFINITY;
            for (int j = 0; j < 8; ++j) { const float x = l[4 + gt * 8 + j] + F.b_re[gt * 8 + j]; if (j != a && x > lb) { lb = x; bb = j; } }
            const float wa = 1.f / (1.f + expf(lb - la)), wb = 1.f - wa;
            const int ea = gt * 8 + a, eb = gt * 8 + bb;
            if (!DRY) {
            const int pa = atomicAdd(&cnt[ea], 1); idx[ea * T + pa] = t; wl[ea * T + pa] = gw * wa;
            const int pb = atomicAdd(&cnt[eb], 1); idx[eb * T + pb] = t; wl[eb * T + pb] = gw * wb;
            *(int4*)(tok + (size_t)t * 4) = make_int4(ea, pa, eb, pb); } }
    }
}

struct MoeSched {
    const int* idx; const LAS int* tb; const LAS int* cn; int G, c;
    __device__ bool next(int i, pg8::Unit& u) const {
        const int total = tb[32] * 8; const long L = (long)i * G + c; if (L >= total) return false;
        const int l = (int)L; int e = 0;
        for (int k = 1; k < 32; ++k) if (l >= tb[k] * 8) e = k;
        const int nt = tb[e + 1] - tb[e], r = l - tb[e] * 8; const int j = r / nt, it = r - j * nt;
        u.e = __builtin_amdgcn_readfirstlane(e); u.it = __builtin_amdgcn_readfirstlane(it); u.pm = __builtin_amdgcn_readfirstlane(tb[e] + it); u.pn = __builtin_amdgcn_readfirstlane(e * 8 + j); u.cnt = __builtin_amdgcn_readfirstlane(cn[e]); return true;
    }
    __device__ __forceinline__ int arow(const pg8::Unit& u, int r) const { int p = u.it * 256 + r; p = p < u.cnt ? p : u.cnt - 1; return idx[u.e * T + p]; }
};
__device__ __forceinline__ void moe_tables(const Frame& F, LAS int* tb, LAS int* cn) {
    const int* cnt = (const int*)(F.ws + WS_CTL) + CW_CNT;
    __syncthreads();
    if (FTID == 0) { int acc = 0; for (int e = 0; e < 32; ++e) { const int c = cnt[e]; cn[e] = c; tb[e] = acc; acc += (c + 255) >> 8; } tb[32] = acc; }
    __syncthreads();
}
struct EpiMoe1 {
    static constexpr bool PERM = true;
    bf16_t* H;
    __device__ __forceinline__ void operator()(const f32x4 (&acc)[2][2][4][2], const pg8::Unit& u, int wr, int wc, int fr, int fq) const {
        const int row0 = u.pm * 256 + wr * 64 + fr, col0 = (u.pn & 7) * 128 + wc * 32 + 8 * fq;
#pragma unroll
        for (int ai = 0; ai < 2; ++ai)
#pragma unroll
            for (int m = 0; m < 4; ++m) { const size_t r = row0 + ai * 128 + m * 16; float o[8];
#pragma unroll
                for (int n = 0; n < 2; ++n)
#pragma unroll
                    for (int j = 0; j < 4; ++j) o[4 * n + j] = silu_fast(acc[ai][0][m][n][j]) * acc[ai][1][m][n][j];
                u32x4 wv; wv.x = cvt_pk_bf16(o[0], o[1]); wv.y = cvt_pk_bf16(o[2], o[3]); wv.z = cvt_pk_bf16(o[4], o[5]); wv.w = cvt_pk_bf16(o[6], o[7]);
                *(u32x4*)(H + r * FF + col0) = wv; }
    }
};
struct EpiMoe2 {
    static constexpr bool PERM = true;
    bf16_t* Y2; const float* wl;
    __device__ __forceinline__ void operator()(const f32x4 (&acc)[2][2][4][2], const pg8::Unit& u, int wr, int wc, int fr, int fq) const {
        const int lrow0 = wr * 64 + fr, col0 = (u.pn & 7) * 256 + wc * 32 + 8 * fq;
#pragma unroll
        for (int ai = 0; ai < 2; ++ai)
#pragma unroll
            for (int m = 0; m < 4; ++m) { const int lr = lrow0 + ai * 128 + m * 16; const int p = u.it * 256 + lr; const float cw = (p < u.cnt) ? wl[u.e * T + p] : 0.f; const size_t r = (size_t)u.pm * 256 + lr;
#pragma unroll
                for (int bj = 0; bj < 2; ++bj) { const f32x4 v0 = acc[ai][bj][m][0] * cw, v1 = acc[ai][bj][m][1] * cw;
                    u32x4 wv; wv.x = cvt_pk_bf16(v0[0], v0[1]); wv.y = cvt_pk_bf16(v0[2], v0[3]); wv.z = cvt_pk_bf16(v1[0], v1[1]); wv.w = cvt_pk_bf16(v1[2], v1[3]);
                    *(u32x4*)(Y2 + r * D + col0 + bj * 128) = wv; } }
    }
};

template <bool DRY> __device__ __forceinline__ void p12_final(const Frame& F, const LAS int* tb) {
    float* dst = DRY ? WSP(float, WS_PRE) : F.out;
    const float* mod = WSP(float, WS_MOD); const bf16_t* Y2 = WSP(bf16_t, WS_Y2); const int* tok = WSP(int, WS_TOK);
    const int gw = F.bx * NWAVES + FWAVE, NGW = F.G * NWAVES, lane = FLANE;
    for (int t = gw; t < T; t += NGW) {
        const int b = t / S; const int4 ti = *(const int4*)(tok + (size_t)t * 4);
        const size_t r0 = (size_t)tb[ti.x] * 256 + ti.y, r1 = (size_t)tb[ti.z] * 256 + ti.w;
        const float* gate = mod + (size_t)b * 6 * D + 5 * D;
        f32x4 v[8]; float s = 0.f;
#pragma unroll
        for (int i = 0; i < 8; ++i) { const int d = 4 * (lane + 64 * i); const f32x4 xv = *(const f32x4*)(F.out + (size_t)t * D + d), gv = *(const f32x4*)(gate + d);
            const u32x2 ya = *(const u32x2*)(Y2 + r0 * D + d), yb = *(const u32x2*)(Y2 + r1 * D + d);
            f32x4 f; f[0] = bf_lo(ya.x) + bf_lo(yb.x); f[1] = bf_hi(ya.x) + bf_hi(yb.x); f[2] = bf_lo(ya.y) + bf_lo(yb.y); f[3] = bf_hi(ya.y) + bf_hi(yb.y);
            v[i] = xv * ALPHA + gv * f; s += (v[i][0] + v[i][1]) + (v[i][2] + v[i][3]); }
        const float mu = wave_sum(s) * (1.f / D); float q = 0.f;
#pragma unroll
        for (int i = 0; i < 8; ++i) { v[i] = v[i] - mu; q += (v[i][0] * v[i][0] + v[i][1] * v[i][1]) + (v[i][2] * v[i][2] + v[i][3] * v[i][3]); }
        const float rstd = rsqrtf(wave_sum(q) * (1.f / D) + LN_EPS);
#pragma unroll
        for (int i = 0; i < 8; ++i) { const int d = 4 * (lane + 64 * i); const f32x4 gg = *(const f32x4*)(F.ln2_g + d), bb = *(const f32x4*)(F.ln2_b + d);
            *(f32x4*)(dst + (size_t)t * D + d) = v[i] * rstd * gg + bb; }
    }
}

#if MK_DEBUG
__device__ __forceinline__ void dbg_acc(float* slot, double num, double den) { atomicAdd(slot, (float)num); atomicAdd(slot + 1, (float)den); }
__global__ void k_chk_u(Params p, float* res) {
    __shared__ float sh[8]; __shared__ float ush[D];
    const int t = (blockIdx.x * 37) % T, b = t / S; const float* x = p.in[0] + (size_t)t * D; const float* mod = (const float*)(p.ws + WS_MOD);
    float s = 0; for (int i = threadIdx.x; i < D; i += 256) s += x[i]; s = wave_sum(s); if ((threadIdx.x & 63) == 0) sh[threadIdx.x >> 6] = s; __syncthreads();
    const float mu = (sh[0] + sh[1] + sh[2] + sh[3]) / D; __syncthreads();
    float q = 0; for (int i = threadIdx.x; i < D; i += 256) { const float d = x[i] - mu; q += d * d; } q = wave_sum(q); if ((threadIdx.x & 63) == 0) sh[threadIdx.x >> 6] = q; __syncthreads();
    const float rstd = rsqrtf((sh[0] + sh[1] + sh[2] + sh[3]) / D + LN_EPS);
    const bf16_t* U = (const bf16_t*)(p.ws + WS_U); double num = 0, den = 0;
    for (int i = threadIdx.x; i < D; i += 256) {
        float sc = p.in[3][1 * D + i], sf = p.in[3][0 * D + i];
        if (i < 64) { for (int k = 0; k < D; ++k) { const float cv = p.in[1][b * D + k]; const float sl = cv / (1.f + expf(-cv)); sc += sl * p.in[2][(size_t)k * 6 * D + D + i]; sf += sl * p.in[2][(size_t)k * 6 * D + i]; } }
        else { sc = mod[(size_t)b * 6 * D + D + i]; sf = mod[(size_t)b * 6 * D + i]; }
        const float ref = (x[i] - mu) * rstd * (1.f + sc) + sf; ush[i] = ref; const float got = bf2f(U[(size_t)t * D + i]); num += (double)(got - ref) * (got - ref); den += (double)ref * ref; }
    __syncthreads();
    if (threadIdx.x < 8) { const int j = threadIdx.x; float a = 0; for (int k = 0; k < D; ++k) a += ush[k] * p.in[4][(size_t)k * NIN + OFF_IF + j]; a += p.in[5][j];
        if (j >= 4) a = fminf(a, 0.f) - log1pf(expf(-fabsf(a))); const float got = ((const float*)(p.ws + WS_GPRE))[(size_t)t * 8 + j]; num += (double)(got - a) * (got - a) * 1000.0; den += (double)a * a * 1000.0; }
    dbg_acc(res, num, den);
}
__global__ void k_chk_p2(Params p, float* res) {
    const int gid = blockIdx.x * blockDim.x + threadIdx.x;
    const int t = (gid * 131 + 7) % T; const int col = (gid * 977 + 13) % (NIN - 8 + 4096);
    const bf16_t* U = (const bf16_t*)(p.ws + WS_U) + (size_t)t * D;
    const int pos = t % S; float ref, got; unsigned char* ws = p.ws;
    auto dot = [&](const float* w, int ld, int c) { float a = 0; for (int k = 0; k < D; ++k) a += bf2f(U[k]) * w[(size_t)k * ld + c]; return a; };
    if (col < 3072) { const int hd = col / 128, lc = col % 128, i = lc % 64; const int c1 = hd * 128 + i, c2 = c1 + 64; const float x1 = dot(p.in[4], NIN, c1), x2 = dot(p.in[4], NIN, c2);
        const float inv = powf(10000.f, -(float)(2 * i) / 128.f), ang = (float)pos * inv, cs = cosf(ang), sn = sinf(ang);
        ref = (lc < 64) ? (x1 * cs - x2 * sn) : (x2 * cs + x1 * sn); const int pc = hd * 128 + 2 * i + (lc >= 64);
        if (col < 1536) { ref *= QSCALE; got = bf2f(((const bf16_t*)(ws + WS_QB))[(size_t)t * 1536 + pc]); } else got = bf2f(((const bf16_t*)(ws + WS_KB))[(size_t)t * 1536 + pc - 1536]); }
    else if (col < 4608) { ref = dot(p.in[4], NIN, col); got = bf2f(((const bf16_t*)(ws + WS_VB))[(size_t)t * 1536 + col - 3072]); }
    else if (col < 6656) { ref = dot(p.in[4], NIN, col); got = bf2f(((const bf16_t*)(ws + WS_QKP))[(size_t)t * 2048 + col - 4608]); }
    else if (col < 7680) { ref = dot(p.in[4], NIN, col); got = bf2f(((const bf16_t*)(ws + WS_VMB))[(size_t)t * 1024 + col - 6656]); }
    else if (col < 8704) { ref = dot(p.in[4], NIN, col); ref = 1.f / (1.f + expf(-ref)); got = bf2f(((const bf16_t*)(ws + WS_OGB))[(size_t)t * 1024 + col - 7680]); }
    else { const int c = col - 8704; ref = dot(p.in[11], 4096, c) + p.in[12][c]; ref = 1.f / (1.f + expf(-ref)); got = bf2f(((const bf16_t*)(ws + WS_GB))[(size_t)t * 4096 + c]); }
    double num = (double)(got - ref) * (got - ref), den = (double)ref * ref;
    for (int o = 32; o >= 1; o >>= 1) { num += __shfl_xor(num, o); den += __shfl_xor(den, o); }
    if ((threadIdx.x & 63) == 0) dbg_acc(res, num, den);
}

__global__ void __launch_bounds__(256) k_chk_attn(Params p, float* res) {
    const int t = (blockIdx.x * 1543 + 11) % T, h = threadIdx.x >> 6, lane = threadIdx.x & 63; const int b = t / S, pos = t % S;
    const bf16_t* QB = (const bf16_t*)(p.ws + WS_QB); const bf16_t* KB = (const bf16_t*)(p.ws + WS_KB); const bf16_t* VB = (const bf16_t*)(p.ws + WS_VB); const bf16_t* YA = (const bf16_t*)(p.ws + WS_YA);
    float og[3][2], lse[3];
    for (int g = 0; g < 3; ++g) { const int d = (g == 0) ? 1 : (g == 1 ? 4 : 16); const int head = 4 * g + h;
        const bf16_t* qp = QB + (size_t)t * 1536 + head * 128; const float q0 = bf2f(qp[lane]), q1 = bf2f(qp[lane + 64]);
        float mx = -INFINITY, den = 0, o0 = 0, o1 = 0;
        for (int j = 0; j <= 128; ++j) { const int tk = pos - j * d; if (tk < 0) break;
            const bf16_t* kp = KB + (size_t)(b * S + tk) * 1536 + head * 128; const bf16_t* vp = VB + (size_t)(b * S + tk) * 1536 + head * 128;
            const float dot = wave_sum(q0 * bf2f(kp[lane]) + q1 * bf2f(kp[lane + 64]));
            const float nm = fmaxf(mx, dot); const float sc = exp2f(mx - nm), pe = exp2f(dot - nm);
            den = den * sc + pe; o0 = o0 * sc + pe * bf2f(vp[lane]); o1 = o1 * sc + pe * bf2f(vp[lane + 64]); mx = nm; }
        og[g][0] = o0 / den; og[g][1] = o1 / den; lse[g] = (mx + log2f(den)) * LN2; }
    const float ml = fmaxf(lse[0], fmaxf(lse[1], lse[2])); const float w0 = expf(lse[0] - ml), w1 = expf(lse[1] - ml), w2 = expf(lse[2] - ml); const float ws_ = 1.f / (w0 + w1 + w2);
    const float r0 = (w0 * og[0][0] + w1 * og[1][0] + w2 * og[2][0]) * ws_, r1 = (w0 * og[0][1] + w1 * og[1][1] + w2 * og[2][1]) * ws_;
    const float g0 = bf2f(YA[(size_t)t * 512 + h * 128 + lane]), g1 = bf2f(YA[(size_t)t * 512 + h * 128 + lane + 64]);
    double num = (double)(g0 - r0) * (g0 - r0) + (double)(g1 - r1) * (g1 - r1), den2 = (double)r0 * r0 + (double)r1 * r1;
    for (int o = 32; o >= 1; o >>= 1) { num += __shfl_xor(num, o); den2 += __shfl_xor(den2, o); }
    if (lane == 0) dbg_acc(res, num, den2);
}
__global__ void __launch_bounds__(1024) k_chk_mlstm(Params p, float* hb) {
    const int b = blockIdx.x / 4, h = blockIdx.x % 4; const int tid = threadIdx.x, v = tid >> 2, kq = tid & 3;
    const bf16_t* QKP = (const bf16_t*)(p.ws + WS_QKP); const bf16_t* VM = (const bf16_t*)(p.ws + WS_VMB);
    const float* gpre = (const float*)(p.ws + WS_GPRE); const float* conv_w = p.in[6]; const float* conv_b = p.in[7];
    __shared__ float qs[256], ks[256], vs[256], ns[256], nq[256];
    float C[64];
#pragma unroll
    for (int i = 0; i < 64; ++i) C[i] = 0.f;
    if (tid < 256) ns[tid] = 0.f;
    float m = 0.f;
    for (int pos = 0; pos < S; ++pos) { const int t = b * S + pos;
        __syncthreads();
        if (tid < 256) { float yq = conv_b[h * 256 + tid], yk = conv_b[1024 + h * 256 + tid];
            for (int j = 0; j < 4; ++j) { const int pp = pos + j - 3; if (pp >= 0) { yq += conv_w[j * 2048 + h * 256 + tid] * bf2f(QKP[(size_t)(t + j - 3) * 2048 + h * 256 + tid]); yk += conv_w[j * 2048 + 1024 + h * 256 + tid] * bf2f(QKP[(size_t)(t + j - 3) * 2048 + 1024 + h * 256 + tid]); } }
            qs[tid] = yq / (1.f + expf(-yq)); ks[tid] = yk / (1.f + expf(-yk)) * 0.0625f; vs[tid] = bf2f(VM[(size_t)t * 1024 + h * 256 + tid]); }
        const float ip = gpre[(size_t)t * 8 + h], lf = gpre[(size_t)t * 8 + 4 + h];
        const float mn = fmaxf(lf + m, ip); const float iw = expf(ip - mn), fw = expf(lf + m - mn); m = mn;
        __syncthreads();
        if (tid < 256) { const float nn = fw * ns[tid] + iw * ks[tid]; ns[tid] = nn; nq[tid] = nn * qs[tid]; }
        __syncthreads();
        const float vv = vs[v] * iw; float nu = 0.f, de = 0.f;
#pragma unroll
        for (int i = 0; i < 64; ++i) { const int k = 4 * i + kq; const float cc = fw * C[i] + vv * ks[k]; C[i] = cc; nu += cc * qs[k]; de += nq[k]; }
        nu += __shfl_xor(nu, 1); nu += __shfl_xor(nu, 2); de += __shfl_xor(de, 1); de += __shfl_xor(de, 2);
        if (kq == 0) hb[(size_t)t * 1024 + h * 256 + v] = nu / fmaxf(fabsf(de), expf(-mn));
    }
}
__global__ void __launch_bounds__(256) k_chk_mnorm(Params p, const float* hb, float* res) {
    __shared__ float red[8];
    const int t = blockIdx.x / 4, h = blockIdx.x % 4, tid = threadIdx.x;
    const bf16_t* OG = (const bf16_t*)(p.ws + WS_OGB); const bf16_t* YM = (const bf16_t*)(p.ws + WS_YM); const float* mg = p.in[8];
    const float val = bf2f(OG[(size_t)t * 1024 + h * 256 + tid]) * hb[(size_t)t * 1024 + h * 256 + tid];
    float s = wave_sum(val); if ((tid & 63) == 0) red[tid >> 6] = s; __syncthreads();
    const float mu = (red[0] + red[1] + red[2] + red[3]) * (1.f / 256.f); const float d = val - mu;
    s = wave_sum(d * d); if ((tid & 63) == 0) red[4 + (tid >> 6)] = s; __syncthreads();
    const float rstd = rsqrtf((red[4] + red[5] + red[6] + red[7]) * (1.f / 256.f) + LN_EPS); const float ref = d * rstd * mg[h * 256 + tid];
    const float got = bf2f(YM[(size_t)t * 1024 + h * 256 + tid]);
    double num = (double)(got - ref) * (got - ref), den = (double)ref * ref;
    for (int o = 32; o >= 1; o >>= 1) { num += __shfl_xor(num, o); den += __shfl_xor(den, o); }
    if ((tid & 63) == 0) dbg_acc(res, num, den);
}
__global__ void k_chk_fin(const float* res, int nchk, float* out, int n) {
    const int i = blockIdx.x * blockDim.x + threadIdx.x; if (i >= n) return;
    float code = 0.f;
    for (int k = 0; k < nchk; ++k) { const float rv = res[2 * k] / fmaxf(res[2 * k + 1], 1e-30f); int s;
        if (!(rv == rv) || !(res[2 * k + 1] > 0.f)) s = 9; else { s = (int)floorf(log10f(fmaxf(rv, 1e-12f)) + 6.f); s = s < 0 ? 0 : (s > 8 ? 8 : s); }
        if (s >= 3 && code == 0.f) code = ((k + 1) * 10 + s) * 100.f; }
    out[i] = (i == 0) ? code : 0.f;
}
#endif

__global__ void __launch_bounds__(NTHR, 2) mk_fwd(Params args) {
    extern __shared__ __attribute__((aligned(16))) unsigned char lds_raw[];
    Frame F;
    F.lds = (LAS unsigned char*)lds_raw; F.G = gridDim.x; F.bx = blockIdx.x; F.ws = args.ws;
    F.x = args.in[0]; F.c = args.in[1]; F.w_ada = args.in[2]; F.b_ada = args.in[3]; F.w_in = args.in[4]; F.b_mgate = args.in[5]; F.conv_w = args.in[6]; F.conv_b = args.in[7];
    F.m_norm_g = args.in[8]; F.w_proj_a = args.in[9]; F.w_proj_m = args.in[10]; F.w_gate = args.in[11]; F.b_gate = args.in[12]; F.w_out = args.in[13]; F.ln1_g = args.in[14]; F.ln1_b = args.in[15];
    F.w_rg = args.in[16]; F.b_rg = args.in[17]; F.w_re = args.in[18]; F.b_re = args.in[19]; F.w_eg = args.in[20]; F.w_eu = args.in[21]; F.w_ed = args.in[22]; F.ln2_g = args.in[23]; F.ln2_b = args.in[24];
    F.out = args.out;
    volatile LAS unsigned* misc = (volatile LAS unsigned*)(F.lds + LDS_MISC);
    if (FTID < 64) misc[FTID] = 0u;
    __syncthreads();
    const int lo = args.ph_lo, hi = args.ph_hi;
    XcdBarrier bar; bar.bar = (unsigned*)(F.ws + WS_CTL) + CW_BAR; bar.x = 0; bar.st = nullptr;
    if (hi - lo > 1) bar = xcd_barrier_post((unsigned*)(F.ws + WS_CTL) + CW_BAR, misc + 8);
#define IN(k) (lo <= (k) && (k) < hi)
#define BOTH(k) (IN(k) && IN((k) + 1))
#define SEAM(k) do { if (BOTH(k)) xcd_barrier(bar); } while (0)

#define DUPRUN(k, BODY) do { BODY; if (MK_DUP & (1 << (k))) { xcd_barrier(bar); BODY; } } while (0)
#define PH0 { p0_prologue(F); }
#define PH1 { p1_lnmod(F); }
#define PH2 { const int GG = (F.G == 256) ? 229 : F.G; unsigned* done2 = (unsigned*)(F.ws + WS_CTL) + CW_DONE2; \
        if (F.bx < GG) { pg8::StaticOrder So; So.init(T, NBIG, GG, F.bx); \
            EpiP2 E{WSP(bf16_t, WS_QB), WSP(bf16_t, WS_KB), WSP(bf16_t, WS_VB), WSP(bf16_t, WS_QKP), WSP(bf16_t, WS_VMB), WSP(bf16_t, WS_OGB), WSP(bf16_t, WS_GB), WSP(float, WS_ROPE), F.b_gate}; \
            pg8::gemm_phase<EpiP2, pg8::StaticOrder, false>(F.lds, WSP(bf16_t, WS_U), WSP(bf16_t, WS_WBIG), D, So, E); \
            if (FTID == 0) __hip_atomic_fetch_add(done2, 1u, __ATOMIC_RELAXED, __HIP_MEMORY_SCOPE_AGENT); \
            if (GG == F.G && F.bx >= F.G - 16 && FWAVE == 0) scan_bh(F, F.bx - (F.G - 16)); } \
        else { if (F.bx >= F.G - 16 && FWAVE == 0) scan_bh(F, F.bx - (F.G - 16)); \
            cvt_stream<1>(F, N_IT_BG, done2, (unsigned)GG); } }
#define PH3 { p3_conv(F); for (int u = F.bx; u < 768; u += F.G) attn_unit(F, u); }
#define PH4 { for (int u = F.bx; u < 256; u += F.G) mlstm_dc_unit(F, u); }
#define PH5 { p5_scan_mix(F); }
#define PH6 { for (int u = F.bx; u < 256; u += F.G) mlstm_out_unit(F, u); }
#define PH7 { pg8::StaticOrder So; So.init(T, D, F.G, F.bx); \
        EpiMerge E0{WSP(bf16_t, WS_MG), WSP(bf16_t, WS_GB), 0}, E1{WSP(bf16_t, WS_MG), WSP(bf16_t, WS_GB), 1}; \
        pg8::gemm_phase<EpiMerge, pg8::StaticOrder, false>(F.lds, WSP(bf16_t, WS_YA), WSP(bf16_t, WS_WPA), 512, So, E0); \
        pg8::gemm_phase<EpiMerge, pg8::StaticOrder, false>(F.lds, WSP(bf16_t, WS_YM), WSP(bf16_t, WS_WPM), 1024, So, E1); }
#define PH8 { pg8::StaticOrder So; So.init(T, D, F.G, F.bx); EpiWout E{F.x, WSP(float, WS_MOD), WSP(float, WS_PRE)}; \
        pg8::gemm_phase<EpiWout, pg8::StaticOrder, false>(F.lds, WSP(bf16_t, WS_MG), WSP(bf16_t, WS_WO), D, So, E); }
#define PH10 { moe_tables(F, tb, cn); unsigned* done10 = (unsigned*)(F.ws + WS_CTL) + CW_DONE10; \
        const int U1 = tb[32] * 8; const int rounds = (U1 + F.G - 1) / F.G; const int GG1 = __builtin_amdgcn_readfirstlane(rounds > 0 ? (U1 + rounds - 1) / rounds : 0); \
        if (F.bx < GG1) { MoeSched Sm{WSP(int, WS_IDX), tb, cn, GG1, F.bx}; EpiMoe1 E{WSP(bf16_t, WS_H)}; \
            pg8::gemm_phase<EpiMoe1, MoeSched, true>(F.lds, WSP(bf16_t, WS_U), WSP(bf16_t, WS_W1T), D, Sm, E); \
            if (FTID == 0) __hip_atomic_fetch_add(done10, 1u, __ATOMIC_RELAXED, __HIP_MEMORY_SCOPE_AGENT); } \
        else cvt_stream<1>(F, N_IT_BG, done10, (unsigned)GG1); \
        cvt_stream<1>(F, N_IT_BG, nullptr, 0u); }
#define PH11 { moe_tables(F, tb, cn); MoeSched Sm{WSP(int, WS_IDX), tb, cn, F.G, vcu}; EpiMoe2 E{WSP(bf16_t, WS_Y2), WSP(float, WS_WL)}; \
        pg8::gemm_phase<EpiMoe2, MoeSched, false>(F.lds, WSP(bf16_t, WS_H), WSP(bf16_t, WS_W2T), FF, Sm, E); }
    LAS int* tb = (LAS int*)(F.lds + LDS_MISC) + 64; LAS int* cn = tb + 40;
    const int vcu = (F.G % 8 == 0) ? (F.bx % 8) * (F.G / 8) + F.bx / 8 : F.bx;
    if (IN(0)) { DUPRUN(0, PH0); SEAM(0); }
    if (IN(1)) { DUPRUN(1, PH1); SEAM(1); }
    if (IN(2)) { PH2; SEAM(2); }
    if (IN(3)) { DUPRUN(3, PH3); SEAM(3); }
    if (IN(4)) { DUPRUN(4, PH4); SEAM(4); }
    if (IN(5)) { DUPRUN(5, PH5); SEAM(5); }
    if (IN(6)) { DUPRUN(6, PH6); SEAM(6); }
    if (IN(7)) { DUPRUN(7, PH7); SEAM(7); }
    if (IN(8)) { DUPRUN(8, PH8); SEAM(8); }
    if (IN(9)) { if (MK_DUP & (1 << 9)) { p9_ln_router<true>(F); xcd_barrier(bar); } p9_ln_router<false>(F); cvt_stream<1>(F, N_IT_W1, nullptr, 0u); SEAM(9); }
    if (IN(10)) { PH10; SEAM(10); }
    if (IN(11)) { DUPRUN(11, PH11); SEAM(11); }
    if (IN(12)) { moe_tables(F, tb, cn); if (MK_DUP & (1 << 12)) { p12_final<true>(F, tb); xcd_barrier(bar); } p12_final<false>(F, tb); }
#undef IN
#undef BOTH
#undef SEAM
}

extern "C" void kernel_launch(void* const* d_in, const int* in_sizes, int n_in, void* d_out, int out_size, void* d_ws, size_t ws_size, hipStream_t stream) {
    static int grid = 0;
    if (grid == 0) {
        size_t need = WS_END;
#if MK_DEBUG
        need += (1 << 20) + (size_t)T * 1024 * 4;
#endif
        if (n_in != 25 || out_size != T * D || ws_size < need) { fprintf(stderr, "kernel_launch: unexpected shapes / workspace (%zu < %zu)\n", ws_size, need); grid = -1; return; }
        int dev = 0, cus = 0, per_cu = 0;
        if (hipGetDevice(&dev) != hipSuccess || hipDeviceGetAttribute(&cus, hipDeviceAttributeMultiprocessorCount, dev) != hipSuccess) { grid = -1; return; }
        if (hipFuncSetAttribute((const void*)mk_fwd, hipFuncAttributeMaxDynamicSharedMemorySize, LDS_BYTES) != hipSuccess) { fprintf(stderr, "kernel_launch: hipFuncSetAttribute failed\n"); grid = -1; return; }
        if (hipOccupancyMaxActiveBlocksPerMultiprocessor(&per_cu, (const void*)mk_fwd, NTHR, LDS_BYTES) != hipSuccess || per_cu < 1) { fprintf(stderr, "kernel_launch: occupancy query says %d\n", per_cu); (void)hipGetLastError(); grid = -1; return; }
        grid = cus;
    }
    if (grid < 0) return;
    (void)hipMemsetAsync((char*)d_ws + WS_CTL, 0, CTL_ZERO_BYTES, stream);
    Params a{};
    for (int i = 0; i < 25; ++i) a.in[i] = (const float*)d_in[i];
    a.out = (float*)d_out; a.ws = (unsigned char*)d_ws;
#if MK_DEBUG
    constexpr int NPH = 7;
#else
    constexpr int NPH = 13;
#endif
#if MK_PER_PHASE
    for (int p = 0; p < NPH; ++p) { a.ph_lo = p; a.ph_hi = p + 1; hipLaunchKernelGGL(mk_fwd, dim3(grid), dim3(NTHR), LDS_BYTES, stream, a); }
#else
    a.ph_lo = 0; a.ph_hi = NPH; hipLaunchKernelGGL(mk_fwd, dim3(grid), dim3(NTHR), LDS_BYTES, stream, a);
#endif
#if MK_DEBUG
    float* res = (float*)((char*)d_ws + WS_DBG0);
    (void)hipMemsetAsync(res, 0, 256, stream);
    k_chk_u<<<64, 256, 0, stream>>>(a, res);
    k_chk_p2<<<32, 64, 0, stream>>>(a, res + 2);
    k_chk_attn<<<256, 256, 0, stream>>>(a, res + 4);
    float* hb = (float*)((char*)d_ws + WS_DBG0 + (1 << 20));
    k_chk_mlstm<<<16, 1024, 0, stream>>>(a, hb);
    k_chk_mnorm<<<T * 4, 256, 0, stream>>>(a, hb, res + 6);
    k_chk_fin<<<(T * D + 255) / 256, 256, 0, stream>>>(res, 4, (float*)d_out, T * D);
#endif
}
```

```cpp
#include <hip/hip_runtime.h>
#include <stdint.h>
#include <math.h>
#include <stdio.h>

#ifndef MK_DEBUG
#define MK_DEBUG 0
#endif
#ifndef MK_DUP
#define MK_DUP 0
#endif
#ifndef MK_GG2
#define MK_GG2 200
#endif
#ifndef MK_PER_PHASE
#define MK_PER_PHASE 0
#endif

#define LAS __attribute__((address_space(3)))
typedef unsigned short bf16_t;
typedef short bf16x8 __attribute__((ext_vector_type(8)));
typedef short s16x4 __attribute__((ext_vector_type(4)));
typedef float f32x4 __attribute__((ext_vector_type(4)));
typedef float f32x2 __attribute__((ext_vector_type(2)));
typedef unsigned u32x4 __attribute__((ext_vector_type(4)));
typedef unsigned u32x2 __attribute__((ext_vector_type(2)));

constexpr int D = 2048, NB = 4, S = 2048, T = NB * S, NIN = 8712;
constexpr int OFF_QA = 0, OFF_KA = 1536, OFF_VA = 3072, OFF_QKM = 4608, OFF_VM = 6656, OFF_OM = 7680, OFF_IF = 8704;
constexpr int FF = 1024, NEXP = 32, NBIG = 12800;
constexpr float ALPHA = 1.189207115002721f, LN_EPS = 1e-5f;
constexpr float LOG2E = 1.4426950408889634f, LN2 = 0.6931471805599453f;
constexpr float QSCALE = 0.08838834764831845f * 1.4426950408889634f;
constexpr int NTHR = 512, NWAVES = 8;
constexpr int SORT_ROWS = 24576;

constexpr size_t al256(size_t x) { return (x + 255) & ~(size_t)255; }
constexpr size_t WS_CTL = 0, CTL_ZERO_BYTES = 65536;
constexpr int CW_BAR = 0;
constexpr int CW_CNT = 4096;
constexpr int CW_DBG = 4224;
constexpr size_t WS_MOD = 65536;
constexpr size_t WS_ROPE = WS_MOD + al256((size_t)NB * 6 * D * 4);
constexpr size_t WS_WIF = WS_ROPE + (size_t)S * 64 * 2 * 4;
constexpr size_t WS_GPRE = WS_WIF + (size_t)8 * D * 4;
constexpr size_t WS_BCUM = WS_GPRE + (size_t)T * 8 * 4;
constexpr size_t WS_MCUM = WS_BCUM + (size_t)16 * S * 4;
constexpr size_t WS_WRT = WS_MCUM + (size_t)16 * S * 4;
constexpr size_t WS_LSE = WS_WRT + (size_t)2 * 48 * D * 2;
constexpr size_t WS_IDX = WS_LSE + (size_t)T * 12 * 4;
constexpr size_t WS_WL = WS_IDX + (size_t)NEXP * T * 4;
constexpr size_t WS_TOK = WS_WL + (size_t)NEXP * T * 4;
constexpr size_t WS_DN = WS_TOK + (size_t)T * 16;
constexpr size_t WS_NST = WS_DN + (size_t)256 * 256 * 4;
constexpr size_t WS_WBIG = al256(WS_NST + (size_t)256 * 256 * 4);
constexpr size_t WS_WPA = WS_WBIG + (size_t)NBIG * D * 2;
constexpr size_t WS_WPM = WS_WPA + (size_t)D * 512 * 2;
constexpr size_t WS_WO = WS_WPM + (size_t)D * 1024 * 2;
constexpr size_t WS_W1T = WS_WO + (size_t)D * D * 2;
constexpr size_t WS_W2T = WS_W1T + (size_t)NEXP * 2048 * D * 2;
constexpr size_t WS_U = WS_W2T + (size_t)NEXP * D * FF * 2;
constexpr size_t WS_QB = WS_U + (size_t)T * D * 2;
constexpr size_t WS_KB = WS_QB + (size_t)T * 1536 * 2;
constexpr size_t WS_VB = WS_KB + (size_t)T * 1536 * 2;
constexpr size_t WS_QKP = WS_VB + (size_t)T * 1536 * 2;
constexpr size_t WS_VMB = WS_QKP + (size_t)T * 2048 * 2;
constexpr size_t WS_OGB = WS_VMB + (size_t)T * 1024 * 2;
constexpr size_t WS_GB = WS_OGB + (size_t)T * 1024 * 2;
constexpr size_t WS_QM = WS_GB + (size_t)T * 4096 * 2;
constexpr size_t WS_KM = WS_QM + (size_t)T * 1024 * 2;
constexpr size_t WS_OATT = WS_KM + (size_t)T * 1024 * 2;
constexpr size_t WS_YA = WS_OATT + (size_t)T * 1536 * 2;
constexpr size_t WS_YM = WS_YA + (size_t)T * 512 * 2;
constexpr size_t WS_DC = WS_YM + (size_t)T * 1024 * 2;
constexpr size_t WS_CST = WS_DC + (size_t)256 * 65536 * 4;
constexpr size_t WS_MG = WS_CST + (size_t)256 * 65536 * 2;
constexpr size_t WS_PRE = WS_MG + (size_t)T * D * 2;
constexpr size_t WS_END = WS_PRE + (size_t)T * D * 4;
constexpr size_t WS_H = WS_QB;
constexpr size_t WS_Y2 = WS_H + (size_t)SORT_ROWS * FF * 2;
static_assert(WS_Y2 + (size_t)SORT_ROWS * D * 2 <= WS_QM, "overlay");
constexpr size_t WS_DBG0 = WS_END;

constexpr int LDS_MISC = 162816;
constexpr int LDS_BYTES = LDS_MISC + 1024;

__device__ __forceinline__ unsigned cvt_pk_bf16(float lo, float hi) { unsigned r; asm volatile("v_cvt_pk_bf16_f32 %0, %1, %2" : "=v"(r) : "v"(lo), "v"(hi)); return r; }
__device__ __forceinline__ float bf_lo(unsigned w) { return __uint_as_float(w << 16); }
__device__ __forceinline__ float bf_hi(unsigned w) { return __uint_as_float(w & 0xffff0000u); }
__device__ __forceinline__ float bf2f(bf16_t b) { return __uint_as_float(((unsigned)b) << 16); }
__device__ __forceinline__ bf16_t f2bf(float f) { return (bf16_t)(cvt_pk_bf16(f, 0.f) & 0xffffu); }
__device__ __forceinline__ float fast_exp2(float x) { return __builtin_amdgcn_exp2f(x); }
__device__ __forceinline__ float fast_rcp(float x) { return __builtin_amdgcn_rcpf(x); }
__device__ __forceinline__ float sigmoid_fast(float x) { return fast_rcp(1.f + fast_exp2(-x * LOG2E)); }
__device__ __forceinline__ float silu_fast(float x) { return x * sigmoid_fast(x); }
__device__ __forceinline__ float wave_sum(float v) {
#pragma unroll
    for (int o = 32; o >= 1; o >>= 1) v += __shfl_xor(v, o);
    return v; }
__device__ __forceinline__ float wave_max(float v) {
#pragma unroll
    for (int o = 32; o >= 1; o >>= 1) v = fmaxf(v, __shfl_xor(v, o));
    return v; }
__device__ __forceinline__ s16x4 tr_read(unsigned addr) { s16x4 r; asm volatile("ds_read_b64_tr_b16 %0, %1" : "=&v"(r) : "v"(addr) : "memory"); return r; }
__device__ __forceinline__ s16x4 tr_read_o(unsigned base, const int off) { s16x4 r; asm volatile("ds_read_b64_tr_b16 %0, %1 offset:%2" : "=&v"(r) : "v"(base), "n"(off) : "memory"); return r; }
#define LGKM_WAIT0() do { asm volatile("s_waitcnt lgkmcnt(0)" ::: "memory"); __builtin_amdgcn_sched_barrier(0); } while (0)
#define PK8(L, H) ((bf16x8){L[0], L[1], L[2], L[3], H[0], H[1], H[2], H[3]})

#define XB_TMO      128
#define XB_XCNT(j)  (256  + 64 * (j))
#define XB_XSUB(j)  (1280 + 64 * (j))
#define XB_XGEN(j)  (2304 + 64 * (j))
#define XB_TOP      3328
#define XB_TOPGEN   3392
#define XCD_BAR_WORDS 3456
#define XB_SPIN_CAP (1u << 18)
__device__ __forceinline__ unsigned xb_ld(unsigned* p)              { return __hip_atomic_load(p, __ATOMIC_RELAXED, __HIP_MEMORY_SCOPE_AGENT); }
__device__ __forceinline__ unsigned xb_add(unsigned* p, unsigned v) { return __hip_atomic_fetch_add(p, v, __ATOMIC_RELAXED, __HIP_MEMORY_SCOPE_AGENT); }
__device__ __forceinline__ unsigned xb_xcc_id() { return (unsigned)__builtin_amdgcn_s_getreg((3 << 11) | 20) & 0xFu; }
#define XB_SPIN(cond, bar) do { unsigned _sp = 0; while (cond) { __builtin_amdgcn_s_sleep(1); \
    if ((++_sp & 255u) == 0u) { if (xb_ld(&(bar)[XB_TMO])) break; if (_sp > XB_SPIN_CAP) { atomicAdd(&(bar)[XB_TMO], 1u); break; } } } } while (0)
struct XcdBarrier { unsigned* bar; unsigned x; volatile LAS unsigned* st; };
__device__ __forceinline__ XcdBarrier xcd_barrier_post(unsigned* bar, volatile LAS unsigned* st) {
    XcdBarrier b; b.bar = bar; b.x = xb_xcc_id(); b.st = st;
    if (threadIdx.x == 0) (void)xb_add(&bar[XB_XCNT(b.x)], 1u);
    return b;
}
__device__ __forceinline__ void xcd_barrier_complete(unsigned* bar, unsigned x, unsigned& nloc, unsigned& nx) {
    const unsigned G = gridDim.x * gridDim.y * gridDim.z;
    unsigned sum, cnt, mine, sp = 0u;
    for (;;) {
        sum = 0u; cnt = 0u; mine = 0u;
#pragma unroll
        for (unsigned j = 0; j < 16; ++j) { const unsigned c = xb_ld(&bar[XB_XCNT(j)]); sum += c; cnt += (c > 0u) ? 1u : 0u; mine = (j == x) ? c : mine; }
        if (sum == G) break;
        __builtin_amdgcn_s_sleep(1);
        if ((++sp & 255u) == 0u) { if (xb_ld(&bar[XB_TMO])) break; if (sp > XB_SPIN_CAP) { atomicAdd(&bar[XB_TMO], 1u); break; } }
    }
    nloc = mine > 0u ? mine : 1u; nx = cnt > 0u ? cnt : 1u;
}
__device__ __forceinline__ void xcd_barrier(const XcdBarrier& b) {
    asm volatile("s_waitcnt vmcnt(0)" ::: "memory");
    __syncthreads();
    if (threadIdx.x == 0) {
        unsigned* bar = b.bar;
        __builtin_amdgcn_s_waitcnt(0);
        unsigned nloc = b.st[0], nx = b.st[1];
        if (nloc == 0u) { xcd_barrier_complete(bar, b.x, nloc, nx); b.st[0] = nloc; b.st[1] = nx; }
        const unsigned old = xb_add(&bar[XB_XSUB(b.x)], 1u);
        const unsigned gen = old / nloc;
        if (old + 1u == (gen + 1u) * nloc) {
            __builtin_amdgcn_fence(__ATOMIC_RELEASE, "agent");
            asm volatile("s_waitcnt vmcnt(0)" ::: "memory");
            const unsigned og = xb_add(&bar[XB_TOP], 1u);
            const unsigned tg = og / nx;
            if (og + 1u == (tg + 1u) * nx) xb_add(&bar[XB_TOPGEN], 1u);
            else XB_SPIN(xb_ld(&bar[XB_TOPGEN]) == tg, bar);
            __builtin_amdgcn_fence(__ATOMIC_ACQUIRE, "agent");
            xb_add(&bar[XB_XGEN(b.x)], 1u);
            asm volatile("s_waitcnt vmcnt(0)" ::: "memory");
        } else {
            XB_SPIN(xb_ld(&bar[XB_XGEN(b.x)]) == gen, bar);
            __builtin_amdgcn_fence(__ATOMIC_ACQUIRE, "agent");
            asm volatile("s_waitcnt vmcnt(0)" ::: "memory");
        }
    }
    __syncthreads();
}

namespace pg8 {
constexpr int BM = 256, BK = 64, HALF = 128, HTB = HALF * BK * 2, STAGE_BYTES = 8 * HTB, NXCD = 8, WGM = 8;
__host__ __device__ __forceinline__ int lds_byte(int r, int c) { const int st = (r >> 4) * 2 + (c >> 5), rr = r & 15, cc = c & 31, ob = rr * 64 + cc * 2; return st * 1024 + (ob ^ (((ob >> 9) & 1) << 5)); }
__host__ __device__ __forceinline__ void stage_rc(int b, int& R, int& C) { const int st = b / 1024, sb = b % 1024, swz = sb ^ (((sb >> 9) & 1) << 5); R = (st >> 1) * 16 + swz / 64; C = (st & 1) * 32 + (swz % 64) / 2; }
__host__ __device__ __forceinline__ int perm32(int rho) { const int n = rho >> 4, i = rho & 15; return 8 * (i >> 2) + 4 * n + (i & 3); }

struct Unit { int pm, pn, e, it, cnt; };

struct StaticOrder {
    int nM, nN, nwg, G, c;
    __device__ void init(int M, int N, int G_, int c_) { nM = M / BM; nN = N / BM; nwg = nM * nN; G = G_; c = c_; }
    __device__ bool next(int i, Unit& u) const {
        const long L = (long)i * G + c; if (L >= nwg) return false;
        int wgid = (int)L; { const int q = nwg / NXCD, r = nwg % NXCD, xcd = wgid % NXCD, off = wgid / NXCD; wgid = (xcd < r ? xcd * (q + 1) : r * (q + 1) + (xcd - r) * q) + off; }
        const int nig = WGM * nN, gid = wgid / nig, fm = gid * WGM, gsz = (nM - fm) < WGM ? (nM - fm) : WGM;
        u.pm = fm + ((wgid % nig) % gsz); u.pn = (wgid % nig) / gsz; u.e = 0; u.it = 0; u.cnt = 0; return true;
    }
    __device__ __forceinline__ int arow(const Unit&, int r) const { return r; }
};

template <class Epi, class Sched, bool GATHER>
__device__ __forceinline__ void gemm_phase(LAS unsigned char* lds, const bf16_t* Ap, const bf16_t* Btp, const int K, const Sched& S, const Epi& E) {
    const int tid = threadIdx.x, wid = __builtin_amdgcn_readfirstlane(tid >> 6), lane = tid & 63, wr = wid >> 2, wc = wid & 3, fr = lane & 15, fq = lane >> 4;
    const int nt = K / BK;
    unsigned voffA[2], voffB[2]; int RA[2], CA[2];
#pragma unroll
    for (int i = 0; i < 2; ++i) { int R, C; stage_rc(tid * 16 + i * 8192, R, C); const int Rb = Epi::PERM ? ((R & ~31) + perm32(R & 31)) : R;
        RA[i] = R; CA[i] = C; voffA[i] = (unsigned)(R * K + C) * 2u; voffB[i] = (unsigned)(Rb * K + C) * 2u; }
    const size_t kstep = (size_t)(BK * 2);
    const size_t hstep = (size_t)HALF * K * 2;
    const size_t tstep = 2 * hstep;
    const unsigned ldsw = (unsigned)wid * 1024u;
    const int aoff = lds_byte(wr * 64 + fr, fq * 8), boff = lds_byte(wc * 32 + fr, fq * 8);
    unsigned vC[2][2], vN[2][2], v2[2][2];
#define PG8_SA(b, h) (((b) * 2 + (h)) * HTB)
#define PG8_SB(b, h) ((4 + (b) * 2 + (h)) * HTB)
#define PG8_STAGE(bufoff, gbase, voff) do { _Pragma("unroll") for (int _i = 0; _i < 2; ++_i) \
        __builtin_amdgcn_global_load_lds((const unsigned*)((const char*)(gbase) + (voff)[_i]), (LAS unsigned*)(lds + (bufoff) + ldsw + _i * 8192), 16, 0, 0); } while (0)
#define PG8_STAGE_A(bufoff, gbase, h, vsel) do { if constexpr (GATHER) { PG8_STAGE(bufoff, gbase, (vsel)[h]); } else { PG8_STAGE(bufoff, (gbase) + (h) * hstep, voffA); } } while (0)
#define PG8_GVOFF(u, v) do { _Pragma("unroll") for (int _h = 0; _h < 2; ++_h) _Pragma("unroll") for (int _i = 0; _i < 2; ++_i) \
        (v)[_h][_i] = (unsigned)(S.arow(u, _h * HALF + RA[_i]) * K + CA[_i]) * 2u; } while (0)
#define PG8_LDA(dst, b, h) do { _Pragma("unroll") for (int m = 0; m < 4; ++m) _Pragma("unroll") for (int k = 0; k < 2; ++k) dst[m][k] = *(const LAS bf16x8*)(lds + PG8_SA(b, h) + aoff + m * 2048 + k * 1024); } while (0)
#define PG8_LDB(dst, b, h) do { _Pragma("unroll") for (int n = 0; n < 2; ++n) _Pragma("unroll") for (int k = 0; k < 2; ++k) dst[n][k] = *(const LAS bf16x8*)(lds + PG8_SB(b, h) + boff + n * 2048 + k * 1024); } while (0)
#define PG8_MMA(ai, bj, At, Bt) do { __builtin_amdgcn_s_setprio(1); _Pragma("unroll") for (int m = 0; m < 4; ++m) _Pragma("unroll") for (int n = 0; n < 2; ++n) _Pragma("unroll") for (int k = 0; k < 2; ++k) \
        acc[ai][bj][m][n] = __builtin_amdgcn_mfma_f32_16x16x32_bf16(Bt[n][k], At[m][k], acc[ai][bj][m][n], 0, 0, 0); __builtin_amdgcn_s_setprio(0); } while (0)
#define PG8_WAIT_V(n) asm volatile("s_waitcnt vmcnt(" #n ")" ::: "memory")
#define PG8_WAIT_L(n) asm volatile("s_waitcnt lgkmcnt(" #n ")" ::: "memory")
#define PG8_BAR __builtin_amdgcn_s_barrier()
#define PG8_SCHED __builtin_amdgcn_sched_barrier(0)
    Unit cur, nxt; int ui = 0;
    if (!S.next(0, cur)) return;
    f32x4 acc[2][2][4][2];
#pragma unroll
    for (int a = 0; a < 2; ++a)
#pragma unroll
        for (int b = 0; b < 2; ++b)
#pragma unroll
            for (int m = 0; m < 4; ++m)
#pragma unroll
                for (int n = 0; n < 2; ++n) acc[a][b][m][n] = (f32x4){0.f, 0.f, 0.f, 0.f};
    bf16x8 At[4][2], B0[2][2], B1[2][2];
    const char* cA = GATHER ? (const char*)Ap : (const char*)Ap + (size_t)cur.pm * tstep; const char* cB = (const char*)Btp + (size_t)cur.pn * tstep;
    if constexpr (GATHER) { PG8_GVOFF(cur, vC); }
    PG8_STAGE(PG8_SB(0, 0), cB, voffB); PG8_STAGE(PG8_SB(0, 1), cB + hstep, voffB); PG8_STAGE_A(PG8_SA(0, 0), cA, 0, vC); PG8_STAGE_A(PG8_SA(0, 1), cA, 1, vC);
    if (wr == 1) PG8_BAR;
    PG8_WAIT_V(2); PG8_BAR;
    PG8_STAGE(PG8_SB(1, 0), cB + kstep, voffB); PG8_STAGE_A(PG8_SA(1, 0), cA + kstep, 0, vC); PG8_STAGE(PG8_SB(1, 1), cB + hstep + kstep, voffB);
    PG8_WAIT_V(6); PG8_BAR;
    for (;;) {
        const bool has_next = S.next(ui + 1, nxt);
        const char* nA = GATHER ? (const char*)Ap : (has_next ? (const char*)Ap + (size_t)nxt.pm * tstep : cA);
        const char* nB = has_next ? (const char*)Btp + (size_t)nxt.pn * tstep : cB;
        if constexpr (GATHER) { if (has_next) { PG8_GVOFF(nxt, vN); } else {
#pragma unroll
            for (int h = 0; h < 2; ++h) { vN[h][0] = vC[h][0]; vN[h][1] = vC[h][1]; } } }
        for (int t = 0; t < nt; t += 2) {
            const bool last = (t == nt - 2);
            const char* a1 = cA + (size_t)(t + 1) * kstep;
            const char* a2 = last ? nA : cA + (size_t)(t + 2) * kstep; const char* b2 = last ? nB : cB + (size_t)(t + 2) * kstep;
            const char* a3 = a2 + kstep; const char* b3 = b2 + kstep;
            if constexpr (GATHER) {
#pragma unroll
                for (int h = 0; h < 2; ++h) { v2[h][0] = last ? vN[h][0] : vC[h][0]; v2[h][1] = last ? vN[h][1] : vC[h][1]; } }
            PG8_LDB(B0, 0, 0); PG8_LDB(B1, 0, 1); PG8_SCHED; PG8_LDA(At, 0, 0); PG8_STAGE_A(PG8_SA(1, 1), a1, 1, vC);
            PG8_WAIT_V(8); PG8_WAIT_L(0); PG8_BAR; PG8_MMA(0, 0, At, B0); PG8_MMA(0, 1, At, B1); PG8_BAR; PG8_SCHED;
            PG8_LDA(At, 0, 1); PG8_STAGE(PG8_SB(0, 0), b2, voffB); PG8_STAGE(PG8_SB(0, 1), b2 + hstep, voffB); PG8_STAGE_A(PG8_SA(0, 0), a2, 0, v2);
            PG8_WAIT_V(8); PG8_WAIT_L(0); PG8_BAR; PG8_MMA(1, 0, At, B0); PG8_MMA(1, 1, At, B1); PG8_BAR; PG8_SCHED;
            PG8_LDB(B0, 1, 0); PG8_LDB(B1, 1, 1); PG8_SCHED; PG8_LDA(At, 1, 0); PG8_STAGE_A(PG8_SA(0, 1), a2, 1, v2);
            PG8_WAIT_V(8); PG8_WAIT_L(0); PG8_BAR; PG8_MMA(0, 0, At, B0); PG8_MMA(0, 1, At, B1); PG8_BAR; PG8_SCHED;
            PG8_LDA(At, 1, 1); PG8_STAGE(PG8_SB(1, 0), b3, voffB); PG8_STAGE(PG8_SB(1, 1), b3 + hstep, voffB); PG8_STAGE_A(PG8_SA(1, 0), a3, 0, v2);
            PG8_WAIT_V(8); PG8_WAIT_L(0); PG8_BAR; PG8_MMA(1, 0, At, B0); PG8_MMA(1, 1, At, B1); PG8_BAR; PG8_SCHED;
        }
        if (wr == 0) PG8_BAR;
        E(acc, cur, wr, wc, fr, fq);
        if (!has_next) break;
#pragma unroll
        for (int a = 0; a < 2; ++a)
#pragma unroll
            for (int b = 0; b < 2; ++b)
#pragma unroll
                for (int m = 0; m < 4; ++m)
#pragma unroll
                    for (int n = 0; n < 2; ++n) acc[a][b][m][n] = (f32x4){0.f, 0.f, 0.f, 0.f};
        cur = nxt; cA = nA; cB = nB; ++ui;
        if constexpr (GATHER) {
#pragma unroll
            for (int h = 0; h < 2; ++h) { vC[h][0] = vN[h][0]; vC[h][1] = vN[h][1]; } }
        if (wr == 1) PG8_BAR;
    }
    PG8_WAIT_V(0);
    PG8_BAR;
#undef PG8_SA
#undef PG8_SB
#undef PG8_STAGE
#undef PG8_STAGE_A
#undef PG8_GVOFF
#undef PG8_LDA
#undef PG8_LDB
#undef PG8_MMA
#undef PG8_WAIT_V
#undef PG8_WAIT_L
#undef PG8_BAR
#undef PG8_SCHED
}
}

struct Params { const float* in[25]; float* out; unsigned char* ws; int ph_lo, ph_hi; };
struct Frame {
    LAS unsigned char* lds; int G, bx;
    unsigned char* ws;
    const float *x, *c, *w_ada, *b_ada, *w_in, *b_mgate, *conv_w, *conv_b, *m_norm_g, *w_proj_a, *w_proj_m, *w_gate, *b_gate, *w_out, *ln1_g, *ln1_b, *w_rg, *b_rg, *w_re, *b_re, *w_eg, *w_eu, *w_ed, *ln2_g, *ln2_b;
    float* out;
};
__device__ __forceinline__ int otid() { int t = threadIdx.x; asm volatile("" : "+v"(t)); return t; }
#define FTID otid()
#define FLANE (otid() & 63)
#define FWAVE __builtin_amdgcn_readfirstlane(otid() >> 6)
#define WSP(T_, off) ((T_*)(F.ws + (off)))

#ifndef CVT_SWAP
#define CVT_SWAP 1
#endif
constexpr int N_IT_W1 = 2048, N_IT_BG = 3072, N_IT_P0 = 512;
constexpr int CVT_P = 544, CVT_BUF = 64 * CVT_P, CVT_RP = 144, CVT_IMG = 2 * CVT_BUF;
constexpr int CW_QHEAD = 4160, CW_QHEAD2 = 4352, CW_DONE2 = 4224, CW_DONE10 = 4288;
struct CvtItem { const float* src; bf16_t* dst; int ld, Kdst, kind, arg, n0, valid; };
__device__ __forceinline__ int cvt_row(int kind, int arg, int n) {
    if (kind == 1) { if (n < 3072) { const int hd = n >> 7, lc = n & 127; return hd * 128 + 2 * (lc & 63) + (lc >> 6); } return n; }
    if (kind == 2) return 256 * (n >> 7) + 128 * arg + (n & 127);
    return n + arg;
}
__device__ __forceinline__ CvtItem cvt_decode_bg(const Frame& F, int item) {
    CvtItem c; c.valid = (item < N_IT_BG);
    if (item < N_IT_W1) { const int e = item >> 6, r = item & 63, mat = r >> 5, nt = (r >> 3) & 3, kq = r & 7;
        c.src = (mat ? F.w_eu : F.w_eg) + (size_t)e * D * FF + (size_t)(kq * 256) * FF + nt * 256; c.ld = FF; c.dst = WSP(bf16_t, WS_W1T) + (size_t)e * 2048 * D + kq * 256; c.Kdst = D; c.kind = 2; c.arg = mat; c.n0 = nt * 256; }
    else { const int i2 = (item < N_IT_BG ? item : N_IT_BG - 1) - N_IT_W1; const int e = i2 >> 5, r = i2 & 31, nt = r >> 2, kq = r & 3;
        c.src = F.w_ed + (size_t)e * FF * D + (size_t)(kq * 256) * D + nt * 256; c.ld = D; c.dst = WSP(bf16_t, WS_W2T) + (size_t)e * D * FF + kq * 256; c.Kdst = FF; c.kind = 0; c.arg = 0; c.n0 = nt * 256; }
    return c;
}
__device__ __forceinline__ CvtItem cvt_decode_p0(const Frame& F, int item) {
    CvtItem c; c.valid = (item < N_IT_P0); c.kind = 0; c.arg = 0;
    if (item < 272) { const int nt = item >> 3, kq = item & 7; c.src = F.w_in + (size_t)(kq * 256) * NIN + nt * 256; c.ld = NIN; c.dst = WSP(bf16_t, WS_WBIG) + kq * 256; c.Kdst = D; c.kind = 1; c.n0 = nt * 256; }
    else if (item < 400) { const int i = item - 272; const int nt = i >> 3, kq = i & 7; c.src = F.w_gate + (size_t)(kq * 256) * 4096 + nt * 256; c.ld = 4096; c.dst = WSP(bf16_t, WS_WBIG) + kq * 256; c.Kdst = D; c.arg = 8704; c.n0 = nt * 256; }
    else if (item < 416) { const int i = item - 400; const int nt = i >> 1, kq = i & 1; c.src = F.w_proj_a + (size_t)(kq * 256) * D + nt * 256; c.ld = D; c.dst = WSP(bf16_t, WS_WPA) + kq * 256; c.Kdst = 512; c.n0 = nt * 256; }
    else if (item < 448) { const int i = item - 416; const int nt = i >> 2, kq = i & 3; c.src = F.w_proj_m + (size_t)(kq * 256) * D + nt * 256; c.ld = D; c.dst = WSP(bf16_t, WS_WPM) + kq * 256; c.Kdst = 1024; c.n0 = nt * 256; }
    else { const int i = (item < N_IT_P0 ? item : N_IT_P0 - 1) - 448; const int nt = i >> 3, kq = i & 7; c.src = F.w_out + (size_t)(kq * 256) * D + nt * 256; c.ld = D; c.dst = WSP(bf16_t, WS_WO) + kq * 256; c.Kdst = D; c.n0 = nt * 256; }
    return c;
}
#define CVT_LOAD(R, it, j) do { _Pragma("unroll") for (int _p = 0; _p < 8; ++_p) (R)[_p] = *(const f32x4*)((it).src + (size_t)(64 * (j) + kr + 8 * _p) * (it).ld + n4); } while (0)
template <int MODE>
__device__ __forceinline__ void cvt_stream(const Frame& F, int limit) {
    const int tid = FTID; const int lane = tid & 63, w = __builtin_amdgcn_readfirstlane(tid >> 6), li = lane & 15, g = lane >> 4;
    const int kr = tid >> 6, n4 = 4 * (tid & 63);
    unsigned* qh = (unsigned*)(F.ws + WS_CTL) + (limit <= N_IT_W1 ? CW_QHEAD : CW_QHEAD2); const int ibase = (limit <= N_IT_W1) ? 0 : N_IT_W1;
    volatile LAS int* mb = (volatile LAS int*)(F.lds + LDS_MISC) + 16;
    LAS unsigned char* lbuf = F.lds; LAS unsigned char* wimg = F.lds + CVT_IMG + w * (32 * CVT_RP);
    __syncthreads();
    int i0, i1;
    if (MODE == 0) { i0 = F.bx; i1 = F.bx + F.G; }
    else { if (tid == 0) { const unsigned a0 = atomicAdd(qh, 2u); mb[0] = (int)a0; mb[2] = 0; } __syncthreads(); i0 = ibase + mb[0]; i1 = i0 + 1; if (i0 >= limit) i0 = 0x7fffffff; if (i1 >= limit) i1 = 0x7fffffff; }
    CvtItem cur = (MODE == 0) ? cvt_decode_p0(F, i0) : cvt_decode_bg(F, i0), nxt = (MODE == 0) ? cvt_decode_p0(F, i1) : cvt_decode_bg(F, i1);
    int inext = i1;
    f32x4 R0[8], R1[8], R2[8], R3[8];
    if (cur.valid) { CVT_LOAD(R0, cur, 0); CVT_LOAD(R1, cur, 1); CVT_LOAD(R2, cur, 2); CVT_LOAD(R3, cur, 3); }
    const unsigned rdbase = (unsigned)(uintptr_t)lbuf + (unsigned)((4 * g + (li >> 2)) * CVT_P + (32 * w + 4 * (li & 3)) * 2);
    while (cur.valid) {
        unsigned cl = 0u;
        if (MODE == 1 && tid == 0) cl = atomicAdd(qh, 1u);
        size_t rofs[4];
#pragma unroll
        for (int i4 = 0; i4 < 4; ++i4) rofs[i4] = (size_t)cvt_row(cur.kind, cur.arg, cur.n0 + 32 * w + 8 * i4 + (lane >> 3)) * cur.Kdst;
#define CVT_PROC(R, j) do { LAS unsigned char* bw = lbuf + ((j) & 1) * CVT_BUF; \
            _Pragma("unroll") for (int _p = 0; _p < 8; ++_p) { u32x2 wv; wv.x = cvt_pk_bf16((R)[_p][0], (R)[_p][1]); wv.y = cvt_pk_bf16((R)[_p][2], (R)[_p][3]); *(LAS u32x2*)(bw + (kr + 8 * _p) * CVT_P + 2 * n4) = wv; } \
            asm volatile("s_waitcnt lgkmcnt(0)\n\ts_barrier" ::: "memory"); \
            if (nxt.valid) CVT_LOAD(R, nxt, j); \
            s16x4 tA[4], tB[4]; const unsigned rb = rdbase + ((j) & 1) * CVT_BUF; \
            _Pragma("unroll") for (int kb = 0; kb < 4; ++kb) { tA[kb] = tr_read_o(rb, kb * 16 * CVT_P); tB[kb] = tr_read_o(rb, kb * 16 * CVT_P + 32); } \
            LGKM_WAIT0(); \
            _Pragma("unroll") for (int kb = 0; kb < 4; ++kb) { union { s16x4 v; unsigned u[2]; } a, b; a.v = tA[kb]; b.v = tB[kb]; \
                auto r0 = __builtin_amdgcn_permlane16_swap(a.u[0], b.u[0], false, false); auto r1 = __builtin_amdgcn_permlane16_swap(a.u[1], b.u[1], false, false); \
                u32x4 o; o.x = r0[0]; o.y = r1[0]; o.z = r0[1]; o.w = r1[1]; \
                *(LAS u32x4*)(wimg + (16 * (g & 1) + li) * CVT_RP + (16 * kb + 8 * (g >> 1)) * 2) = o; } \
            asm volatile("s_waitcnt lgkmcnt(0)" ::: "memory"); \
            _Pragma("unroll") for (int i4 = 0; i4 < 4; ++i4) { const u32x4 o = *(const LAS u32x4*)(wimg + (8 * i4 + (lane >> 3)) * CVT_RP + (lane & 7) * 16); \
                *(u32x4*)(cur.dst + rofs[i4] + 64 * (j) + 8 * (lane & 7)) = o; } } while (0)
        CVT_PROC(R0, 0); CVT_PROC(R1, 1); CVT_PROC(R2, 2); CVT_PROC(R3, 3);
        int i2;
        if (MODE == 0) { i2 = inext + F.G; }
        else { if (tid == 0) mb[0] = (int)cl; asm volatile("s_waitcnt lgkmcnt(0)\n\ts_barrier" ::: "memory"); i2 = ibase + mb[0]; if (i2 >= limit || i2 < 0) i2 = 0x7fffffff; asm volatile("s_waitcnt lgkmcnt(0)\n\ts_barrier" ::: "memory"); }
        cur = nxt; inext = i2; nxt = (MODE == 0) ? cvt_decode_p0(F, i2) : cvt_decode_bg(F, i2);
    }
    __syncthreads();
#undef CVT_PROC
}

__device__ __forceinline__ void p0_prologue(const Frame& F) {
    const int G = F.G, bx = F.bx;
    cvt_stream<0>(F, N_IT_P0);
    __syncthreads();
    {
        LAS float* sc = (LAS float*)F.lds;
        LAS float* red = (LAS float*)(F.lds + 32768);
        float* mod = WSP(float, WS_MOD);
        for (int i = FTID; i < NB * D; i += NTHR) { const float cv = F.c[i]; sc[i] = cv / (1.f + expf(-cv)); }
        __syncthreads();
        for (int cb = bx; cb < 6 * D / 48; cb += G) {
            const int cg = FTID % 12, kl = FTID / 12;
            float a[4][4] = {};
            if (kl < 42) {
                for (int k0 = kl; k0 < D; k0 += 42 * 7) { f32x4 w[7];
#pragma unroll
                    for (int u = 0; u < 7; ++u) { const int k = k0 + 42 * u; w[u] = (k < D) ? *(const f32x4*)(F.w_ada + (size_t)k * (6 * D) + cb * 48 + cg * 4) : (f32x4){0.f, 0.f, 0.f, 0.f}; }
#pragma unroll
                    for (int u = 0; u < 7; ++u) { const int k = (k0 + 42 * u < D) ? k0 + 42 * u : 0;
#pragma unroll
                        for (int b = 0; b < 4; ++b) { const float s = sc[b * D + k];
#pragma unroll
                            for (int j = 0; j < 4; ++j) a[b][j] += s * w[u][j]; } } }
#pragma unroll
                for (int b = 0; b < 4; ++b)
#pragma unroll
                    for (int j = 0; j < 4; ++j) red[(kl * 12 + cg) * 16 + b * 4 + j] = a[b][j];
            }
            __syncthreads();
            if (FTID < 192) { const int cgi = FTID / 16, bj = FTID % 16; float s = 0.f; for (int q = 0; q < 42; ++q) s += red[(q * 12 + cgi) * 16 + bj];
                const int b = bj / 4, j = bj % 4; const int col = cb * 48 + cgi * 4 + j; mod[(size_t)b * 6 * D + col] = s + F.b_ada[col]; }
            __syncthreads();
        }
    }
    {
        float* rope = WSP(float, WS_ROPE);
        for (int i = bx * NTHR + FTID; i < S * 64; i += G * NTHR) { const int pos = i >> 6, fi = i & 63;
            const float inv = powf(10000.f, -(float)(2 * fi) / 128.f); const float ang = (float)pos * inv; rope[2 * i] = cosf(ang); rope[2 * i + 1] = sinf(ang); }
        float* wif = WSP(float, WS_WIF);
        for (int i = bx * NTHR + FTID; i < 8 * D; i += G * NTHR) { const int j = i / D, k = i % D; wif[i] = F.w_in[(size_t)k * NIN + OFF_IF + j]; }
        bf16_t* wrt = WSP(bf16_t, WS_WRT);
        for (int i = bx * NTHR + FTID; i < 48 * D; i += G * NTHR) { const int j = i / D, k = i % D;
            const float w = (j < 4) ? F.w_rg[k * 4 + j] : (j < 36 ? F.w_re[k * 32 + (j - 4)] : 0.f);
            const bf16_t hi = f2bf(w); const bf16_t lo = f2bf(w - bf2f(hi)); wrt[i] = hi; wrt[48 * D + i] = lo; }
    }
}

__device__ __forceinline__ void p1_lnmod(const Frame& F) {
    const float* mod = WSP(float, WS_MOD); const float* wif = WSP(float, WS_WIF); bf16_t* U = WSP(bf16_t, WS_U); float* gpre = WSP(float, WS_GPRE);
    const int tid = FTID; const int lane = tid & 63; const int gw = F.bx * NWAVES + __builtin_amdgcn_readfirstlane(tid >> 6), NGW = F.G * NWAVES;
    LAS float* wl = (LAS float*)F.lds;
    __syncthreads();
#pragma unroll
    for (int i = 0; i < 8; ++i) *(LAS f32x4*)(wl + 4 * (tid + NTHR * i)) = *(const f32x4*)(wif + 4 * (tid + NTHR * i));
    __syncthreads();
    f32x4 v[8], nx[8];
    if (gw < T) {
#pragma unroll
        for (int i = 0; i < 8; ++i) nx[i] = *(const f32x4*)(F.x + (size_t)gw * D + 4 * (lane + 64 * i)); }
    for (int t = gw; t < T; t += NGW) {
        const int b = t / S; float s = 0.f;
#pragma unroll
        for (int i = 0; i < 8; ++i) { v[i] = nx[i]; s += (v[i][0] + v[i][1]) + (v[i][2] + v[i][3]); }
        if (t + NGW < T) {
#pragma unroll
            for (int i = 0; i < 8; ++i) nx[i] = *(const f32x4*)(F.x + (size_t)(t + NGW) * D + 4 * (lane + 64 * i)); }
        const float mu = wave_sum(s) * (1.f / D);
        float q = 0.f;
#pragma unroll
        for (int i = 0; i < 8; ++i) { v[i] = v[i] - mu; q += (v[i][0] * v[i][0] + v[i][1] * v[i][1]) + (v[i][2] * v[i][2] + v[i][3] * v[i][3]); }
        const float rstd = rsqrtf(wave_sum(q) * (1.f / D) + LN_EPS);
        const float* sc = mod + (size_t)b * 6 * D + 1 * D; const float* sf = mod + (size_t)b * 6 * D;
#pragma unroll
        for (int i = 0; i < 8; ++i) { const int d = 4 * (lane + 64 * i); const f32x4 a = *(const f32x4*)(sc + d), bb = *(const f32x4*)(sf + d);
            v[i] = v[i] * rstd * (a + 1.f) + bb;
            u32x2 w; w.x = cvt_pk_bf16(v[i][0], v[i][1]); w.y = cvt_pk_bf16(v[i][2], v[i][3]); *(u32x2*)(U + (size_t)t * D + d) = w; }
        float g[8];
#pragma unroll
        for (int j = 0; j < 8; ++j) { float a = 0.f;
#pragma unroll
            for (int i = 0; i < 8; ++i) { const f32x4 w = *(const LAS f32x4*)(wl + j * D + 4 * (lane + 64 * i)); a += (v[i][0] * w[0] + v[i][1] * w[1]) + (v[i][2] * w[2] + v[i][3] * w[3]); }
            g[j] = wave_sum(a); }
        if (lane < 8) { float val = 0.f;
#pragma unroll
            for (int j = 0; j < 8; ++j) val = (lane == j) ? g[j] : val;
            val += F.b_mgate[lane];
            if (lane >= 4) val = fminf(val, 0.f) - log1pf(expf(-fabsf(val)));
            gpre[(size_t)t * 8 + lane] = val; }
    }
}

struct EpiP2 {
    static constexpr bool PERM = true;
    bf16_t *Q, *Kb, *V, *QKP, *VM, *OG, *GB; const float* rope; const float* b_gate;
    __device__ __forceinline__ void operator()(const f32x4 (&acc)[2][2][4][2], const pg8::Unit& u, int wr, int wc, int fr, int fq) const {
        const int pn = u.pn; int kind, coff, ldc; bf16_t* base;
        if (pn < 6) { kind = 0; base = Q; ldc = 1536; coff = pn * 256; }
        else if (pn < 12) { kind = 1; base = Kb; ldc = 1536; coff = (pn - 6) * 256; }
        else if (pn < 18) { kind = 2; base = V; ldc = 1536; coff = (pn - 12) * 256; }
        else if (pn < 26) { kind = 2; base = QKP; ldc = 2048; coff = (pn - 18) * 256; }
        else if (pn < 30) { kind = 2; base = VM; ldc = 1024; coff = (pn - 26) * 256; }
        else if (pn < 34) { kind = 3; base = OG; ldc = 1024; coff = (pn - 30) * 256; }
        else { kind = 4; base = GB; ldc = 4096; coff = (pn - 34) * 256; }
        const int row0 = u.pm * 256 + wr * 64 + fr, colL = wc * 32 + 8 * fq;
#pragma unroll
        for (int ai = 0; ai < 2; ++ai)
#pragma unroll
            for (int m = 0; m < 4; ++m) { const int r = row0 + ai * 128 + m * 16; const int pos = r & (S - 1);
#pragma unroll
                for (int bj = 0; bj < 2; ++bj) { f32x4 v0 = acc[ai][bj][m][0], v1 = acc[ai][bj][m][1]; const int col = coff + bj * 128 + colL;
                    if (kind <= 1) {
                        const float* rp = rope + ((size_t)pos * 64 + (16 * wc + 4 * fq)) * 2;
                        const f32x4 c0 = *(const f32x4*)rp, c1 = *(const f32x4*)(rp + 4);
                        const float sc = (kind == 0) ? QSCALE : 1.f;
                        f32x4 o0, o1;
                        o0[0] = (v0[0] * c0[0] - v0[1] * c0[1]) * sc; o0[1] = (v0[1] * c0[0] + v0[0] * c0[1]) * sc;
                        o0[2] = (v0[2] * c0[2] - v0[3] * c0[3]) * sc; o0[3] = (v0[3] * c0[2] + v0[2] * c0[3]) * sc;
                        o1[0] = (v1[0] * c1[0] - v1[1] * c1[1]) * sc; o1[1] = (v1[1] * c1[0] + v1[0] * c1[1]) * sc;
                        o1[2] = (v1[2] * c1[2] - v1[3] * c1[3]) * sc; o1[3] = (v1[3] * c1[2] + v1[2] * c1[3]) * sc;
                        v0 = o0; v1 = o1;
                    } else if (kind >= 3) {
                        if (kind == 4) { v0 = v0 + *(const f32x4*)(b_gate + col); v1 = v1 + *(const f32x4*)(b_gate + col + 4); }
#pragma unroll
                        for (int j = 0; j < 4; ++j) { v0[j] = sigmoid_fast(v0[j]); v1[j] = sigmoid_fast(v1[j]); }
                    }
                    u32x4 w; w.x = cvt_pk_bf16(v0[0], v0[1]); w.y = cvt_pk_bf16(v0[2], v0[3]); w.z = cvt_pk_bf16(v1[0], v1[1]); w.w = cvt_pk_bf16(v1[2], v1[3]);
                    *(u32x4*)(base + (size_t)r * ldc + col) = w; } }
    }
};

__device__ __forceinline__ void scan_bh(const Frame& F, int bh) {
    const float* gpre = WSP(float, WS_GPRE); float* bc = WSP(float, WS_BCUM) + (size_t)bh * S; float* mc = WSP(float, WS_MCUM) + (size_t)bh * S;
    const int b = bh >> 2, h = bh & 3, lane = FLANE;
    float lf[32], iv[32];
#pragma unroll
    for (int j = 0; j < 32; ++j) { const size_t t = (size_t)b * S + lane * 32 + j; iv[j] = gpre[t * 8 + h]; lf[j] = gpre[t * 8 + 4 + h]; }
    float run = 0.f;
#pragma unroll
    for (int j = 0; j < 32; ++j) { run += lf[j]; lf[j] = run; }
    float tot = run, incl = run;
#pragma unroll
    for (int o = 1; o < 64; o <<= 1) { const float n = __shfl_up(incl, o); if (lane >= o) incl += n; }
    const float excl = incl - tot;
    float mx = -INFINITY;
#pragma unroll
    for (int j = 0; j < 32; ++j) { lf[j] += excl; mx = fmaxf(mx, iv[j] - lf[j]); iv[j] = mx; }
    float mincl = mx;
#pragma unroll
    for (int o = 1; o < 64; o <<= 1) { const float n = __shfl_up(mincl, o); if (lane >= o) mincl = fmaxf(mincl, n); }
    float mexcl = __shfl_up(mincl, 1); if (lane == 0) mexcl = -INFINITY;
#pragma unroll
    for (int j = 0; j < 32; ++j) { const float cm = fmaxf(0.f, fmaxf(mexcl, iv[j])); bc[lane * 32 + j] = lf[j]; mc[lane * 32 + j] = lf[j] + cm; }
}

__device__ __forceinline__ void p3_conv(const Frame& F) {
    const bf16_t* QKP = WSP(bf16_t, WS_QKP); bf16_t* QM = WSP(bf16_t, WS_QM); bf16_t* KM = WSP(bf16_t, WS_KM);
    for (int item = F.bx * NTHR + FTID; item < 256 * 512; item += F.G * NTHR) {
        const int cc = item & 255, rs = item >> 8; const int c0 = cc * 8, t0 = rs * 16;
        float w[4][8], bias[8];
#pragma unroll
        for (int j = 0; j < 4; ++j) { const f32x4 a = *(const f32x4*)(F.conv_w + j * 2048 + c0), b = *(const f32x4*)(F.conv_w + j * 2048 + c0 + 4);
#pragma unroll
            for (int e = 0; e < 4; ++e) { w[j][e] = a[e]; w[j][4 + e] = b[e]; } }
        { const f32x4 a = *(const f32x4*)(F.conv_b + c0), b = *(const f32x4*)(F.conv_b + c0 + 4);
#pragma unroll
            for (int e = 0; e < 4; ++e) { bias[e] = a[e]; bias[4 + e] = b[e]; } }
        float x1[8], x2[8], x3[8];
        const int pos0 = t0 & (S - 1);
        auto ldrow = [&](int t, float (&dst)[8]) { const u32x4 v = *(const u32x4*)(QKP + (size_t)t * 2048 + c0);
            dst[0] = bf_lo(v.x); dst[1] = bf_hi(v.x); dst[2] = bf_lo(v.y); dst[3] = bf_hi(v.y); dst[4] = bf_lo(v.z); dst[5] = bf_hi(v.z); dst[6] = bf_lo(v.w); dst[7] = bf_hi(v.w); };
        if (pos0 >= 3) { ldrow(t0 - 1, x1); ldrow(t0 - 2, x2); ldrow(t0 - 3, x3); }
        else {
#pragma unroll
            for (int e = 0; e < 8; ++e) { x1[e] = 0.f; x2[e] = 0.f; x3[e] = 0.f; } }
        const bool isk = c0 >= 1024; bf16_t* dst = isk ? (KM + (c0 - 1024)) : (QM + c0); const float osc = isk ? 0.0625f : 1.f;
#pragma unroll 4
        for (int r = 0; r < 16; ++r) { float x0[8]; ldrow(t0 + r, x0); float y[8];
#pragma unroll
            for (int e = 0; e < 8; ++e) { y[e] = bias[e] + w[3][e] * x0[e] + w[2][e] * x1[e] + w[1][e] * x2[e] + w[0][e] * x3[e]; y[e] = silu_fast(y[e]) * osc; x3[e] = x2[e]; x2[e] = x1[e]; x1[e] = x0[e]; }
            u32x4 o; o.x = cvt_pk_bf16(y[0], y[1]); o.y = cvt_pk_bf16(y[2], y[3]); o.z = cvt_pk_bf16(y[4], y[5]); o.w = cvt_pk_bf16(y[6], y[7]);
            *(u32x4*)(dst + (size_t)(t0 + r) * 1024) = o; }
    }
}

constexpr int AT_KP = 272, AT_VP = 288, AT_VOFF = 256 * AT_KP;
__device__ __forceinline__ void attn_unit(const Frame& F, int unit) {
    const bf16_t* QB = WSP(bf16_t, WS_QB); const bf16_t* KB = WSP(bf16_t, WS_KB); const bf16_t* VB = WSP(bf16_t, WS_VB); bf16_t* OA = WSP(bf16_t, WS_OATT); float* LSE = WSP(float, WS_LSE);
    const int b = unit / 192, rem = unit % 192, head = rem >> 4, blk = rem & 15;
    const int g = head >> 2; const int dl = (g == 0) ? 0 : (g == 1 ? 2 : 4); const int d = 1 << dl; const int nbr = 16 >> dl;
    const int r = blk / nbr, n = blk % nbr;
    const int tid = FTID, lane = FLANE, w = FWAVE, jl = lane & 15, g4 = lane >> 4;
    LAS unsigned char* Ks = F.lds; LAS unsigned char* Vs = F.lds + AT_VOFF;
    __syncthreads();
#pragma unroll
    for (int pass = 0; pass < 2; ++pass) {
        u32x4 v[8];
#pragma unroll
        for (int i = 0; i < 8; ++i) { const int id = tid + NTHR * i; const int row = id >> 4, ch = id & 15; const int bn = (row < 128) ? n - 1 : n; const int lr = row & 127;
            const int pos = ((bn * 128 + lr) << dl) + r;
            const bf16_t* src = (pass == 0 ? KB : VB) + (size_t)(b * S + pos) * 1536 + head * 128 + ch * 8;
            v[i] = (bn >= 0) ? *(const u32x4*)src : (u32x4){0u, 0u, 0u, 0u}; }
#pragma unroll
        for (int i = 0; i < 8; ++i) { const int id = tid + NTHR * i; const int row = id >> 4, ch = id & 15;
            if (pass == 0) *(LAS u32x4*)(Ks + row * AT_KP + ch * 16) = v[i]; else *(LAS u32x4*)(Vs + row * AT_VP + ch * 16) = v[i]; }
    }
    const int posq = (((n * 128 + 16 * w + jl)) << dl) + r;
    const size_t tq = (size_t)b * S + posq;
    bf16x8 qf[4];
#pragma unroll
    for (int ks = 0; ks < 4; ++ks) qf[ks] = *(const bf16x8*)(QB + tq * 1536 + head * 128 + ks * 32 + 8 * g4);
    __syncthreads();
    f32x4 sT[10];
#pragma unroll
    for (int u = 0; u < 9; ++u) { f32x4 a = {0.f, 0.f, 0.f, 0.f};
#pragma unroll
        for (int ks = 0; ks < 4; ++ks) { const bf16x8 kf = *(const LAS bf16x8*)(Ks + (16 * (w + u) + jl) * AT_KP + (ks * 32 + 8 * g4) * 2); a = __builtin_amdgcn_mfma_f32_16x16x32_bf16(kf, qf[ks], a, 0, 0, 0); }
        sT[u] = a; }
    sT[9] = (f32x4){0.f, 0.f, 0.f, 0.f};
    float mx = -INFINITY;
#pragma unroll
    for (int u = 0; u < 9; ++u)
#pragma unroll
        for (int rg = 0; rg < 4; ++rg) { const int kin = 4 * g4 + rg; bool valid;
            if (u == 0) valid = (n > 0) && (kin >= jl); else if (u == 8) valid = (kin <= jl); else valid = (w + u >= 8) || (n > 0);
            const float s = valid ? sT[u][rg] : -INFINITY; sT[u][rg] = s; mx = fmaxf(mx, s); }
    mx = fmaxf(mx, __shfl_xor(mx, 16)); mx = fmaxf(mx, __shfl_xor(mx, 32));
    float den = 0.f;
#pragma unroll
    for (int u = 0; u < 9; ++u)
#pragma unroll
        for (int rg = 0; rg < 4; ++rg) { const float p = fast_exp2(sT[u][rg] - mx); sT[u][rg] = p; den += p; }
    den += __shfl_xor(den, 16); den += __shfl_xor(den, 32);
    f32x4 oT[8];
#pragma unroll
    for (int et = 0; et < 8; ++et) oT[et] = (f32x4){0.f, 0.f, 0.f, 0.f};
    const unsigned vbase = (unsigned)(uintptr_t)(Vs) + (unsigned)((4 * g4 + (jl >> 2)) * AT_VP + (jl & 3) * 8);
#pragma unroll
    for (int c = 0; c < 5; ++c) {
        const int kt0 = w + 2 * c, kt1 = (c == 4) ? kt0 : kt0 + 1;
        union { bf16x8 v; unsigned u[4]; } pf;
        pf.u[0] = cvt_pk_bf16(sT[2 * c][0], sT[2 * c][1]); pf.u[1] = cvt_pk_bf16(sT[2 * c][2], sT[2 * c][3]);
        pf.u[2] = cvt_pk_bf16(sT[2 * c + 1][0], sT[2 * c + 1][1]); pf.u[3] = cvt_pk_bf16(sT[2 * c + 1][2], sT[2 * c + 1][3]);
        s16x4 t0[8], t1[8];
        const unsigned vb0 = vbase + kt0 * 16 * AT_VP, vb1 = vbase + kt1 * 16 * AT_VP;
#pragma unroll
        for (int et = 0; et < 8; ++et) { t0[et] = tr_read_o(vb0, et * 32); t1[et] = tr_read_o(vb1, et * 32); }
        LGKM_WAIT0();
#pragma unroll
        for (int et = 0; et < 8; ++et) oT[et] = __builtin_amdgcn_mfma_f32_16x16x32_bf16(PK8(t0[et], t1[et]), pf.v, oT[et], 0, 0, 0);
    }
    const float inv = 1.f / den;
#pragma unroll
    for (int et = 0; et < 8; ++et) { u32x2 o; o.x = cvt_pk_bf16(oT[et][0] * inv, oT[et][1] * inv); o.y = cvt_pk_bf16(oT[et][2] * inv, oT[et][3] * inv);
        *(u32x2*)(OA + tq * 1536 + head * 128 + 16 * et + 4 * g4) = o; }
    if (g4 == 0) LSE[tq * 12 + head] = (mx + log2f(den)) * LN2;
}

constexpr int ML_P = 544;
__device__ __forceinline__ void mlstm_dc_unit(const Frame& F, int unit) {
    const bf16_t* KM = WSP(bf16_t, WS_KM); const bf16_t* VM = WSP(bf16_t, WS_VMB); const float* gpre = WSP(float, WS_GPRE);
    const float* bcum = WSP(float, WS_BCUM); const float* mcum = WSP(float, WS_MCUM); float* DC = WSP(float, WS_DC) + (size_t)unit * 65536; float* DN = WSP(float, WS_DN) + (size_t)unit * 256;
    const int bh = unit >> 4, c = unit & 15, b = bh >> 2, h = bh & 3; const size_t t0 = (size_t)b * S + c * 128;
    const int tid = FTID, lane = FLANE, w = FWAVE, jl = lane & 15, g4 = lane >> 4;
    LAS unsigned char* Ks = F.lds; LAS unsigned char* Vs = F.lds + 128 * ML_P; LAS float* wt = (LAS float*)(F.lds + 2 * 128 * ML_P);
    __syncthreads();
    if (tid < 128) { const float Be = bcum[bh * S + c * 128 + 127], me = mcum[bh * S + c * 128 + 127];
        wt[tid] = expf(Be - bcum[bh * S + c * 128 + tid] + gpre[(t0 + tid) * 8 + h] - me); }
    __syncthreads();
    {
        u32x4 v[8];
#pragma unroll
        for (int i = 0; i < 8; ++i) { const int id = tid + NTHR * i; const int row = id >> 5, ch = id & 31; v[i] = *(const u32x4*)(KM + (t0 + row) * 1024 + h * 256 + ch * 8); }
#pragma unroll
        for (int i = 0; i < 8; ++i) { const int id = tid + NTHR * i; const int row = id >> 5, ch = id & 31; *(LAS u32x4*)(Ks + row * ML_P + ch * 16) = v[i]; }
#pragma unroll
        for (int i = 0; i < 8; ++i) { const int id = tid + NTHR * i; const int row = id >> 5, ch = id & 31; v[i] = *(const u32x4*)(VM + (t0 + row) * 1024 + h * 256 + ch * 8); }
#pragma unroll
        for (int i = 0; i < 8; ++i) { const int id = tid + NTHR * i; const int row = id >> 5, ch = id & 31; const float ws_ = wt[row]; u32x4 o;
            o.x = cvt_pk_bf16(bf_lo(v[i].x) * ws_, bf_hi(v[i].x) * ws_); o.y = cvt_pk_bf16(bf_lo(v[i].y) * ws_, bf_hi(v[i].y) * ws_);
            o.z = cvt_pk_bf16(bf_lo(v[i].z) * ws_, bf_hi(v[i].z) * ws_); o.w = cvt_pk_bf16(bf_lo(v[i].w) * ws_, bf_hi(v[i].w) * ws_);
            *(LAS u32x4*)(Vs + row * ML_P + ch * 16) = o; }
    }
    __syncthreads();
    if (tid < 256) { float a = 0.f; for (int s = 0; s < 128; ++s) a += wt[s] * bf2f(*(const LAS bf16_t*)(Ks + s * ML_P + tid * 2)); DN[tid] = a; }
    const int vr = w >> 1, kr = w & 1;
    f32x4 acc[4][8];
#pragma unroll
    for (int i = 0; i < 4; ++i)
#pragma unroll
        for (int j = 0; j < 8; ++j) acc[i][j] = (f32x4){0.f, 0.f, 0.f, 0.f};
    const unsigned rowoff = (unsigned)((4 * g4 + (jl >> 2)) * ML_P + (jl & 3) * 8);
    const unsigned kb = (unsigned)(uintptr_t)Ks + rowoff + kr * 256, vb = (unsigned)(uintptr_t)Vs + rowoff + vr * 128;
#pragma unroll 1
    for (int ks = 0; ks < 4; ++ks) {
        s16x4 a0[4], a1[4], b0[8], b1[8];
#pragma unroll
        for (int i = 0; i < 4; ++i) { a0[i] = tr_read_o(vb + ks * 32 * ML_P, i * 32); a1[i] = tr_read_o(vb + ks * 32 * ML_P, 16 * ML_P + i * 32); }
#pragma unroll
        for (int j = 0; j < 8; ++j) { b0[j] = tr_read_o(kb + ks * 32 * ML_P, j * 32); b1[j] = tr_read_o(kb + ks * 32 * ML_P, 16 * ML_P + j * 32); }
        LGKM_WAIT0();
#pragma unroll
        for (int i = 0; i < 4; ++i)
#pragma unroll
            for (int j = 0; j < 8; ++j) acc[i][j] = __builtin_amdgcn_mfma_f32_16x16x32_bf16(PK8(a0[i], a1[i]), PK8(b0[j], b1[j]), acc[i][j], 0, 0, 0);
    }
#pragma unroll
    for (int i = 0; i < 4; ++i)
#pragma unroll
        for (int j = 0; j < 8; ++j)
#pragma unroll
            for (int rg = 0; rg < 4; ++rg) DC[(size_t)(16 * (4 * vr + i) + 4 * g4 + rg) * 256 + 16 * (8 * kr + j) + jl] = acc[i][j][rg];
}

__device__ __forceinline__ float chunk_decay(const float* bcum, const float* mcum, int bh, int c) {
    const float Be = bcum[bh * S + c * 128 + 127], me = mcum[bh * S + c * 128 + 127];
    const float Bp = (c > 0) ? bcum[bh * S + c * 128 - 1] : 0.f, mp = (c > 0) ? mcum[bh * S + c * 128 - 1] : 0.f;
    return expf(Be - Bp + mp - me);
}
__device__ __forceinline__ void p5_scan_mix(const Frame& F) {
    const float* bcum = WSP(float, WS_BCUM); const float* mcum = WSP(float, WS_MCUM);
    const float* DC = WSP(float, WS_DC); bf16_t* CST = WSP(bf16_t, WS_CST); const float* DN = WSP(float, WS_DN); float* NST = WSP(float, WS_NST);
    const int gt = F.bx * NTHR + FTID, NG = F.G * NTHR;
    for (int item = gt; item < 16 * 8192; item += NG) {
        const int bh = item >> 13, e8 = item & 8191;
        f32x4 c0 = {0.f, 0.f, 0.f, 0.f}, c1 = {0.f, 0.f, 0.f, 0.f};
#pragma unroll 5
        for (int c = 0; c < 15; ++c) { const float dec = chunk_decay(bcum, mcum, bh, c);
            const float* p = DC + (size_t)(bh * 16 + c) * 65536 + e8 * 8; const f32x4 d0 = *(const f32x4*)p, d1 = *(const f32x4*)(p + 4);
            c0 = c0 * dec + d0; c1 = c1 * dec + d1;
            u32x4 o; o.x = cvt_pk_bf16(c0[0], c0[1]); o.y = cvt_pk_bf16(c0[2], c0[3]); o.z = cvt_pk_bf16(c1[0], c1[1]); o.w = cvt_pk_bf16(c1[2], c1[3]);
            *(u32x4*)(CST + (size_t)(bh * 16 + c + 1) * 65536 + e8 * 8) = o; }
    }
    for (int item = gt; item < 16 * 256; item += NG) { const int bh = item >> 8, k = item & 255; float n = 0.f;
        for (int c = 0; c < 15; ++c) { n = n * chunk_decay(bcum, mcum, bh, c) + DN[(size_t)(bh * 16 + c) * 256 + k]; NST[(size_t)(bh * 16 + c + 1) * 256 + k] = n; } }
    const bf16_t* OA = WSP(bf16_t, WS_OATT); const float* LSE = WSP(float, WS_LSE); bf16_t* YA = WSP(bf16_t, WS_YA);
    for (int item = gt; item < T * 64; item += NG) { const int t = item >> 6, h = (item >> 4) & 3, e8 = item & 15;
        const float l0 = LSE[(size_t)t * 12 + h], l1 = LSE[(size_t)t * 12 + 4 + h], l2 = LSE[(size_t)t * 12 + 8 + h];
        const float ml = fmaxf(l0, fmaxf(l1, l2)); float w0 = expf(l0 - ml), w1 = expf(l1 - ml), w2 = expf(l2 - ml); const float ws_ = 1.f / (w0 + w1 + w2); w0 *= ws_; w1 *= ws_; w2 *= ws_;
        const u32x4 a = *(const u32x4*)(OA + (size_t)t * 1536 + h * 128 + e8 * 8), bq = *(const u32x4*)(OA + (size_t)t * 1536 + (4 + h) * 128 + e8 * 8), cq = *(const u32x4*)(OA + (size_t)t * 1536 + (8 + h) * 128 + e8 * 8);
        u32x4 o;
        o.x = cvt_pk_bf16(w0 * bf_lo(a.x) + w1 * bf_lo(bq.x) + w2 * bf_lo(cq.x), w0 * bf_hi(a.x) + w1 * bf_hi(bq.x) + w2 * bf_hi(cq.x));
        o.y = cvt_pk_bf16(w0 * bf_lo(a.y) + w1 * bf_lo(bq.y) + w2 * bf_lo(cq.y), w0 * bf_hi(a.y) + w1 * bf_hi(bq.y) + w2 * bf_hi(cq.y));
        o.z = cvt_pk_bf16(w0 * bf_lo(a.z) + w1 * bf_lo(bq.z) + w2 * bf_lo(cq.z), w0 * bf_hi(a.z) + w1 * bf_hi(bq.z) + w2 * bf_hi(cq.z));
        o.w = cvt_pk_bf16(w0 * bf_lo(a.w) + w1 * bf_lo(bq.w) + w2 * bf_lo(cq.w), w0 * bf_hi(a.w) + w1 * bf_hi(bq.w) + w2 * bf_hi(cq.w));
        *(u32x4*)(YA + (size_t)t * 512 + h * 128 + e8 * 8) = o; }
}

constexpr int MO_KP = 528, MO_VOFF = 128 * MO_KP, MO_TAB = MO_VOFF + 128 * ML_P;
__device__ __forceinline__ void mlstm_out_unit(const Frame& F, int unit) {
    const bf16_t* QM = WSP(bf16_t, WS_QM); const bf16_t* KM = WSP(bf16_t, WS_KM); const bf16_t* VM = WSP(bf16_t, WS_VMB); const bf16_t* OG = WSP(bf16_t, WS_OGB);
    const bf16_t* CST = WSP(bf16_t, WS_CST) + (size_t)unit * 65536; const float* NST = WSP(float, WS_NST) + (size_t)unit * 256; bf16_t* YM = WSP(bf16_t, WS_YM);
    const float* gpre = WSP(float, WS_GPRE); const float* bcum = WSP(float, WS_BCUM); const float* mcum = WSP(float, WS_MCUM);
    const int bh = unit >> 4, c = unit & 15, b = bh >> 2, h = bh & 3; const size_t t0 = (size_t)b * S + c * 128;
    const int tid = FTID, lane = FLANE, w = FWAVE, jl = lane & 15, g4 = lane >> 4;
    LAS unsigned char* RA = F.lds; LAS unsigned char* RB = F.lds + MO_VOFF; LAS float* cs = (LAS float*)(F.lds + MO_TAB); LAS float* ntab = cs + 128;
    __syncthreads();
    {
        u32x4 v[8];
#pragma unroll
        for (int i = 0; i < 8; ++i) { const int id = tid + NTHR * i; const int row = id >> 5, ch = id & 31; v[i] = *(const u32x4*)(KM + (t0 + row) * 1024 + h * 256 + ch * 8); }
#pragma unroll
        for (int i = 0; i < 8; ++i) { const int id = tid + NTHR * i; const int row = id >> 5, ch = id & 31; *(LAS u32x4*)(RA + row * MO_KP + ch * 16) = v[i]; }
#pragma unroll
        for (int i = 0; i < 8; ++i) { const int id = tid + NTHR * i; const int row = id >> 5, ch = id & 31; v[i] = *(const u32x4*)(VM + (t0 + row) * 1024 + h * 256 + ch * 8); }
#pragma unroll
        for (int i = 0; i < 8; ++i) { const int id = tid + NTHR * i; const int row = id >> 5, ch = id & 31; *(LAS u32x4*)(RB + row * ML_P + ch * 16) = v[i]; }
        if (tid < 128) cs[tid] = (gpre[(t0 + tid) * 8 + h] - bcum[bh * S + c * 128 + tid]) * LOG2E;
        if (tid >= 128 && tid < 384) ntab[tid - 128] = (c > 0) ? NST[tid - 128] : 0.f;
    }
    const int tl = 16 * w + jl; const size_t t = t0 + tl;
    const float Bt = bcum[bh * S + c * 128 + tl], mt = mcum[bh * S + c * 128 + tl];
    const float Bp = (c > 0) ? bcum[bh * S + c * 128 - 1] : 0.f, mp = (c > 0) ? mcum[bh * S + c * 128 - 1] : 0.f;
    const float at = (Bt - mt) * LOG2E; const float inter = fast_exp2((Bt - Bp + mp - mt) * LOG2E);
    union QF { bf16x8 v; unsigned u[4]; }; QF qf[8];
#pragma unroll
    for (int ks = 0; ks < 8; ++ks) qf[ks].v = *(const bf16x8*)(QM + t * 1024 + h * 256 + ks * 32 + 8 * g4);
    __syncthreads();
    f32x4 sT[8];
#pragma unroll
    for (int st = 0; st < 8; ++st) { f32x4 a = {0.f, 0.f, 0.f, 0.f};
        if (st <= w) {
#pragma unroll
            for (int ks = 0; ks < 8; ++ks) { const bf16x8 kf = *(const LAS bf16x8*)(RA + (16 * st + jl) * MO_KP + (ks * 32 + 8 * g4) * 2); a = __builtin_amdgcn_mfma_f32_16x16x32_bf16(kf, qf[ks].v, a, 0, 0, 0); } }
        sT[st] = a; __builtin_amdgcn_sched_barrier(0); }
    float dsum = 0.f;
#pragma unroll
    for (int st = 0; st < 8; ++st) { const f32x4 cv = *(const LAS f32x4*)(cs + 16 * st + 4 * g4);
#pragma unroll
        for (int rg = 0; rg < 4; ++rg) { const bool valid = (st < w) || (st == w && (4 * g4 + rg) <= jl); const float f = valid ? fast_exp2(fminf(at + cv[rg], 0.f)) : 0.f; const float sv = sT[st][rg] * f; sT[st][rg] = sv; dsum += sv; } }
    dsum += __shfl_xor(dsum, 16); dsum += __shfl_xor(dsum, 32);
    float nq = 0.f;
#pragma unroll
    for (int ks = 0; ks < 8; ++ks) { const f32x4 n0 = *(const LAS f32x4*)(ntab + ks * 32 + 8 * g4), n1 = *(const LAS f32x4*)(ntab + ks * 32 + 8 * g4 + 4);
        nq += bf_lo(qf[ks].u[0]) * n0[0] + bf_hi(qf[ks].u[0]) * n0[1] + bf_lo(qf[ks].u[1]) * n0[2] + bf_hi(qf[ks].u[1]) * n0[3]
            + bf_lo(qf[ks].u[2]) * n1[0] + bf_hi(qf[ks].u[2]) * n1[1] + bf_lo(qf[ks].u[3]) * n1[2] + bf_hi(qf[ks].u[3]) * n1[3]; }
    nq += __shfl_xor(nq, 16); nq += __shfl_xor(nq, 32);
    const float den = dsum + inter * nq;
    f32x4 acc[16];
#pragma unroll
    for (int vt = 0; vt < 16; ++vt) acc[vt] = (f32x4){0.f, 0.f, 0.f, 0.f};
    const unsigned vbase = (unsigned)(uintptr_t)RB + (unsigned)((4 * g4 + (jl >> 2)) * ML_P + (jl & 3) * 8);
#pragma unroll
    for (int c4 = 0; c4 < 4; ++c4) {
        if (2 * c4 <= w) {
            union { bf16x8 v; unsigned u[4]; } pf;
            pf.u[0] = cvt_pk_bf16(sT[2 * c4][0], sT[2 * c4][1]); pf.u[1] = cvt_pk_bf16(sT[2 * c4][2], sT[2 * c4][3]);
            pf.u[2] = cvt_pk_bf16(sT[2 * c4 + 1][0], sT[2 * c4 + 1][1]); pf.u[3] = cvt_pk_bf16(sT[2 * c4 + 1][2], sT[2 * c4 + 1][3]);
#pragma unroll
            for (int hb = 0; hb < 2; ++hb) {
                s16x4 a0[8], a1[8];
#pragma unroll
                for (int i = 0; i < 8; ++i) { a0[i] = tr_read_o(vbase, c4 * 32 * ML_P + (hb * 8 + i) * 32); a1[i] = tr_read_o(vbase, (c4 * 32 + 16) * ML_P + (hb * 8 + i) * 32); }
                LGKM_WAIT0();
#pragma unroll
                for (int i = 0; i < 8; ++i) acc[hb * 8 + i] = __builtin_amdgcn_mfma_f32_16x16x32_bf16(PK8(a0[i], a1[i]), pf.v, acc[hb * 8 + i], 0, 0, 0);
            }
        }
    }
    if (c > 0) {
#pragma unroll
        for (int ks = 0; ks < 8; ++ks)
#pragma unroll
            for (int j = 0; j < 4; ++j) qf[ks].u[j] = cvt_pk_bf16(bf_lo(qf[ks].u[j]) * inter, bf_hi(qf[ks].u[j]) * inter);
#pragma unroll
        for (int half = 0; half < 2; ++half) {
            __syncthreads();
            u32x4 v[8];
#pragma unroll
            for (int i = 0; i < 8; ++i) { const int id = tid + NTHR * i; const int row = id >> 5, ch = id & 31; v[i] = *(const u32x4*)(CST + (size_t)(half * 128 + row) * 256 + ch * 8); }
#pragma unroll
            for (int i = 0; i < 8; ++i) { const int id = tid + NTHR * i; const int row = id >> 5, ch = id & 31; *(LAS u32x4*)(RA + row * MO_KP + ch * 16) = v[i]; }
            __syncthreads();
#pragma unroll
            for (int vt = 0; vt < 8; ++vt)
#pragma unroll
                for (int ks = 0; ks < 8; ++ks) { const bf16x8 cf = *(const LAS bf16x8*)(RA + (16 * vt + jl) * MO_KP + (ks * 32 + 8 * g4) * 2);
                    acc[half * 8 + vt] = __builtin_amdgcn_mfma_f32_16x16x32_bf16(cf, qf[ks].v, acc[half * 8 + vt], 0, 0, 0); if (ks == 7) __builtin_amdgcn_sched_barrier(0); }
        }
    }
    const float rden = 1.f / fmaxf(fabsf(den), fast_exp2(-mt * LOG2E));
    float sm = 0.f;
#pragma unroll
    for (int vt = 0; vt < 16; ++vt) { const u32x2 og = *(const u32x2*)(OG + t * 1024 + h * 256 + 16 * vt + 4 * g4);
        acc[vt][0] *= rden * bf_lo(og.x); acc[vt][1] *= rden * bf_hi(og.x); acc[vt][2] *= rden * bf_lo(og.y); acc[vt][3] *= rden * bf_hi(og.y);
        sm += (acc[vt][0] + acc[vt][1]) + (acc[vt][2] + acc[vt][3]); }
    sm += __shfl_xor(sm, 16); sm += __shfl_xor(sm, 32);
    const float mu = sm * (1.f / 256.f); float sq = 0.f;
#pragma unroll
    for (int vt = 0; vt < 16; ++vt) { acc[vt] = acc[vt] - mu; sq += (acc[vt][0] * acc[vt][0] + acc[vt][1] * acc[vt][1]) + (acc[vt][2] * acc[vt][2] + acc[vt][3] * acc[vt][3]); }
    sq += __shfl_xor(sq, 16); sq += __shfl_xor(sq, 32);
    const float rstd = rsqrtf(sq * (1.f / 256.f) + LN_EPS);
#pragma unroll
    for (int vt = 0; vt < 16; ++vt) { const f32x4 gg = *(const f32x4*)(F.m_norm_g + h * 256 + 16 * vt + 4 * g4); const f32x4 o = acc[vt] * rstd * gg;
        u32x2 ow; ow.x = cvt_pk_bf16(o[0], o[1]); ow.y = cvt_pk_bf16(o[2], o[3]); *(u32x2*)(YM + t * 1024 + h * 256 + 16 * vt + 4 * g4) = ow; }
}

struct EpiMerge {
    static constexpr bool PERM = true;
    bf16_t* MG; const bf16_t* GB; int step;
    __device__ __forceinline__ void operator()(const f32x4 (&acc)[2][2][4][2], const pg8::Unit& u, int wr, int wc, int fr, int fq) const {
        const int row0 = u.pm * 256 + wr * 64 + fr, col0 = u.pn * 256 + wc * 32 + 8 * fq;
#pragma unroll
        for (int ai = 0; ai < 2; ++ai)
#pragma unroll
            for (int m = 0; m < 4; ++m) { const size_t r = row0 + ai * 128 + m * 16;
#pragma unroll
                for (int bj = 0; bj < 2; ++bj) { const int col = col0 + bj * 128; const f32x4 v0 = acc[ai][bj][m][0], v1 = acc[ai][bj][m][1];
                    const u32x4 gq = *(const u32x4*)(GB + r * 4096 + step * 2048 + col);
                    float o[8] = {v0[0] * bf_lo(gq.x), v0[1] * bf_hi(gq.x), v0[2] * bf_lo(gq.y), v0[3] * bf_hi(gq.y), v1[0] * bf_lo(gq.z), v1[1] * bf_hi(gq.z), v1[2] * bf_lo(gq.w), v1[3] * bf_hi(gq.w)};
                    if (step) { const u32x4 pq = *(const u32x4*)(MG + r * 2048 + col);
                        o[0] += bf_lo(pq.x); o[1] += bf_hi(pq.x); o[2] += bf_lo(pq.y); o[3] += bf_hi(pq.y); o[4] += bf_lo(pq.z); o[5] += bf_hi(pq.z); o[6] += bf_lo(pq.w); o[7] += bf_hi(pq.w); }
                    u32x4 wv; wv.x = cvt_pk_bf16(o[0], o[1]); wv.y = cvt_pk_bf16(o[2], o[3]); wv.z = cvt_pk_bf16(o[4], o[5]); wv.w = cvt_pk_bf16(o[6], o[7]);
                    *(u32x4*)(MG + r * 2048 + col) = wv; } }
    }
};
struct EpiWout {
    static constexpr bool PERM = false;
    const float* x; const float* mod; float* PRE;
    __device__ __forceinline__ void operator()(const f32x4 (&acc)[2][2][4][2], const pg8::Unit& u, int wr, int wc, int fr, int fq) const {
        const int row0 = u.pm * 256 + wr * 64 + fr, col0 = u.pn * 256 + wc * 32 + 4 * fq;
        const float* gate = mod + (size_t)((u.pm * 256) / S) * 6 * D + 2 * D;
        f32x4 gv[2][2];
#pragma unroll
        for (int bj = 0; bj < 2; ++bj)
#pragma unroll
            for (int n = 0; n < 2; ++n) gv[bj][n] = *(const f32x4*)(gate + col0 + bj * 128 + n * 16);
#pragma unroll
        for (int ai = 0; ai < 2; ++ai)
#pragma unroll
            for (int m = 0; m < 4; ++m) { const size_t off = (size_t)(row0 + ai * 128 + m * 16) * D + col0;
#pragma unroll
                for (int bj = 0; bj < 2; ++bj)
#pragma unroll
                    for (int n = 0; n < 2; ++n) { const f32x4 xv = *(const f32x4*)(x + off + bj * 128 + n * 16); *(f32x4*)(PRE + off + bj * 128 + n * 16) = xv * ALPHA + gv[bj][n] * acc[ai][bj][m][n]; } }
    }
};

constexpr int R_UP = 4112, R_LO = 16 * R_UP, R_PART = 2 * 16 * R_UP, R_LOG = R_PART + 8 * 16 * 48 * 4;
template <bool DRY> __device__ __forceinline__ void p9_ln_router(const Frame& F) {
    const float* PRE = WSP(float, WS_PRE); const float* mod = WSP(float, WS_MOD); bf16_t* U2 = WSP(bf16_t, WS_U); const bf16_t* WRT = WSP(bf16_t, WS_WRT);
    int* cnt = (int*)(F.ws + WS_CTL) + CW_CNT; int* idx = WSP(int, WS_IDX); float* wl = WSP(float, WS_WL); int* tok = WSP(int, WS_TOK);
    const int lane = FLANE, w = FWAVE, tid = FTID, jl = lane & 15, g4 = lane >> 4;
    LAS unsigned char* Uhi = F.lds; LAS unsigned char* Ulo = F.lds + R_LO; LAS float* part = (LAS float*)(F.lds + R_PART); LAS float* lg = (LAS float*)(F.lds + R_LOG);
    for (int rgp = F.bx; rgp < T / 16; rgp += F.G) {
        __syncthreads();
#pragma unroll 1
        for (int rr = 0; rr < 2; ++rr) {
            const int lr = 2 * w + rr; const int t = rgp * 16 + lr; const int b = t / S;
            f32x4 v[8]; float s = 0.f;
#pragma unroll
            for (int i = 0; i < 8; ++i) { v[i] = *(const f32x4*)(PRE + (size_t)t * D + 4 * (lane + 64 * i)); s += (v[i][0] + v[i][1]) + (v[i][2] + v[i][3]); }
            float mu = wave_sum(s) * (1.f / D); float q = 0.f;
#pragma unroll
            for (int i = 0; i < 8; ++i) { v[i] = v[i] - mu; q += (v[i][0] * v[i][0] + v[i][1] * v[i][1]) + (v[i][2] * v[i][2] + v[i][3] * v[i][3]); }
            float rstd = rsqrtf(wave_sum(q) * (1.f / D) + LN_EPS);
            s = 0.f;
#pragma unroll
            for (int i = 0; i < 8; ++i) { const int d = 4 * (lane + 64 * i); const f32x4 gg = *(const f32x4*)(F.ln1_g + d), bb = *(const f32x4*)(F.ln1_b + d);
                v[i] = v[i] * rstd * gg + bb; *(f32x4*)(F.out + (size_t)t * D + d) = v[i]; s += (v[i][0] + v[i][1]) + (v[i][2] + v[i][3]); }
            mu = wave_sum(s) * (1.f / D); q = 0.f;
#pragma unroll
            for (int i = 0; i < 8; ++i) { v[i] = v[i] - mu; q += (v[i][0] * v[i][0] + v[i][1] * v[i][1]) + (v[i][2] * v[i][2] + v[i][3] * v[i][3]); }
            rstd = rsqrtf(wave_sum(q) * (1.f / D) + LN_EPS);
            const float* sc = mod + (size_t)b * 6 * D + 4 * D; const float* sf = mod + (size_t)b * 6 * D + 3 * D;
#pragma unroll
            for (int i = 0; i < 8; ++i) { const int d = 4 * (lane + 64 * i); const f32x4 a = *(const f32x4*)(sc + d), bb = *(const f32x4*)(sf + d);
                v[i] = v[i] * rstd * (a + 1.f) + bb;
                u32x2 hi; hi.x = cvt_pk_bf16(v[i][0], v[i][1]); hi.y = cvt_pk_bf16(v[i][2], v[i][3]);
                *(u32x2*)(U2 + (size_t)t * D + d) = hi;
                u32x2 lo; lo.x = cvt_pk_bf16(v[i][0] - bf_lo(hi.x), v[i][1] - bf_hi(hi.x)); lo.y = cvt_pk_bf16(v[i][2] - bf_lo(hi.y), v[i][3] - bf_hi(hi.y));
                *(LAS u32x2*)(Uhi + lr * R_UP + d * 2) = hi; *(LAS u32x2*)(Ulo + lr * R_UP + d * 2) = lo; }
        }
        __syncthreads();
        {
            f32x4 a3[3] = {{0.f, 0.f, 0.f, 0.f}, {0.f, 0.f, 0.f, 0.f}, {0.f, 0.f, 0.f, 0.f}};
#pragma unroll 2
            for (int ks = 0; ks < 8; ++ks) { const int k0 = 256 * w + 32 * ks + 8 * g4;
                const bf16x8 ah = *(const LAS bf16x8*)(Uhi + jl * R_UP + k0 * 2), al = *(const LAS bf16x8*)(Ulo + jl * R_UP + k0 * 2);
#pragma unroll
                for (int nt = 0; nt < 3; ++nt) { const bf16x8 bh = *(const bf16x8*)(WRT + (size_t)(16 * nt + jl) * D + k0), bl = *(const bf16x8*)(WRT + (size_t)48 * D + (size_t)(16 * nt + jl) * D + k0);
                    a3[nt] = __builtin_amdgcn_mfma_f32_16x16x32_bf16(ah, bh, a3[nt], 0, 0, 0); a3[nt] = __builtin_amdgcn_mfma_f32_16x16x32_bf16(ah, bl, a3[nt], 0, 0, 0); a3[nt] = __builtin_amdgcn_mfma_f32_16x16x32_bf16(al, bh, a3[nt], 0, 0, 0); } }
#pragma unroll
            for (int nt = 0; nt < 3; ++nt)
#pragma unroll
                for (int rg = 0; rg < 4; ++rg) part[(w * 16 + 4 * g4 + rg) * 48 + 16 * nt + jl] = a3[nt][rg];
        }
        __syncthreads();
        for (int i = tid; i < 16 * 48; i += NTHR) { float s = 0.f;
#pragma unroll
            for (int ww = 0; ww < 8; ++ww) s += part[ww * 768 + i];
            lg[i] = s; }
        __syncthreads();
        if (tid < 16) { const int t = rgp * 16 + tid; const LAS float* l = lg + tid * 48;
            int gt = 0; float lgt = l[0] + F.b_rg[0];
            for (int j = 1; j < 4; ++j) { const float x = l[j] + F.b_rg[j]; if (x > lgt) { lgt = x; gt = j; } }
            float se = 0.f; for (int j = 0; j < 4; ++j) se += expf(l[j] + F.b_rg[j] - lgt);
            const float gw = 1.f / se;
            int a = 0; float la = l[4 + gt * 8] + F.b_re[gt * 8];
            for (int j = 1; j < 8; ++j) { const float x = l[4 + gt * 8 + j] + F.b_re[gt * 8 + j]; if (x > la) { la = x; a = j; } }
            int bb = -1; float lb = -INFINITY;
            for (int j = 0; j < 8; ++j) { const float x = l[4 + gt * 8 + j] + F.b_re[gt * 8 + j]; if (j != a && x > lb) { lb = x; bb = j; } }
            const float wa = 1.f / (1.f + expf(lb - la)), wb = 1.f - wa;
            const int ea = gt * 8 + a, eb = gt * 8 + bb;
            if (!DRY) {
            const int pa = atomicAdd(&cnt[ea], 1); idx[ea * T + pa] = t; wl[ea * T + pa] = gw * wa;
            const int pb = atomicAdd(&cnt[eb], 1); idx[eb * T + pb] = t; wl[eb * T + pb] = gw * wb;
            *(int4*)(tok + (size_t)t * 4) = make_int4(ea, pa, eb, pb); } }
    }
}

struct MoeSched {
    const int* idx; const LAS int* tb; const LAS int* cn; int G, c;
    __device__ bool next(int i, pg8::Unit& u) const {
        const int total = tb[32] * 8; const long L = (long)i * G + c; if (L >= total) return false;
        const int l = (int)L; int e = 0;
        for (int k = 1; k < 32; ++k) if (l >= tb[k] * 8) e = k;
        const int nt = tb[e + 1] - tb[e], r = l - tb[e] * 8; const int j = r / nt, it = r - j * nt;
        u.e = __builtin_amdgcn_readfirstlane(e); u.it = __builtin_amdgcn_readfirstlane(it); u.pm = __builtin_amdgcn_readfirstlane(tb[e] + it); u.pn = __builtin_amdgcn_readfirstlane(e * 8 + j); u.cnt = __builtin_amdgcn_readfirstlane(cn[e]); return true;
    }
    __device__ __forceinline__ int arow(const pg8::Unit& u, int r) const { int p = u.it * 256 + r; p = p < u.cnt ? p : u.cnt - 1; return idx[u.e * T + p]; }
};
__device__ __forceinline__ void moe_tables(const Frame& F, LAS int* tb, LAS int* cn) {
    const int* cnt = (const int*)(F.ws + WS_CTL) + CW_CNT;
    __syncthreads();
    if (FTID == 0) { int acc = 0; for (int e = 0; e < 32; ++e) { const int c = cnt[e]; cn[e] = c; tb[e] = acc; acc += (c + 255) >> 8; } tb[32] = acc; }
    __syncthreads();
}
struct EpiMoe1 {
    static constexpr bool PERM = true;
    bf16_t* H;
    __device__ __forceinline__ void operator()(const f32x4 (&acc)[2][2][4][2], const pg8::Unit& u, int wr, int wc, int fr, int fq) const {
        const int row0 = u.pm * 256 + wr * 64 + fr, col0 = (u.pn & 7) * 128 + wc * 32 + 8 * fq;
#pragma unroll
        for (int ai = 0; ai < 2; ++ai)
#pragma unroll
            for (int m = 0; m < 4; ++m) { const size_t r = row0 + ai * 128 + m * 16; float o[8];
#pragma unroll
                for (int n = 0; n < 2; ++n)
#pragma unroll
                    for (int j = 0; j < 4; ++j) o[4 * n + j] = silu_fast(acc[ai][0][m][n][j]) * acc[ai][1][m][n][j];
                u32x4 wv; wv.x = cvt_pk_bf16(o[0], o[1]); wv.y = cvt_pk_bf16(o[2], o[3]); wv.z = cvt_pk_bf16(o[4], o[5]); wv.w = cvt_pk_bf16(o[6], o[7]);
                *(u32x4*)(H + r * FF + col0) = wv; }
    }
};
struct EpiMoe2 {
    static constexpr bool PERM = true;
    bf16_t* Y2; const float* wl;
    __device__ __forceinline__ void operator()(const f32x4 (&acc)[2][2][4][2], const pg8::Unit& u, int wr, int wc, int fr, int fq) const {
        const int lrow0 = wr * 64 + fr, col0 = (u.pn & 7) * 256 + wc * 32 + 8 * fq;
#pragma unroll
        for (int ai = 0; ai < 2; ++ai)
#pragma unroll
            for (int m = 0; m < 4; ++m) { const int lr = lrow0 + ai * 128 + m * 16; const int p = u.it * 256 + lr; const float cw = (p < u.cnt) ? wl[u.e * T + p] : 0.f; const size_t r = (size_t)u.pm * 256 + lr;
#pragma unroll
                for (int bj = 0; bj < 2; ++bj) { const f32x4 v0 = acc[ai][bj][m][0] * cw, v1 = acc[ai][bj][m][1] * cw;
                    u32x4 wv; wv.x = cvt_pk_bf16(v0[0], v0[1]); wv.y = cvt_pk_bf16(v0[2], v0[3]); wv.z = cvt_pk_bf16(v1[0], v1[1]); wv.w = cvt_pk_bf16(v1[2], v1[3]);
                    *(u32x4*)(Y2 + r * D + col0 + bj * 128) = wv; } }
    }
};

template <bool DRY> __device__ __forceinline__ void p12_final(const Frame& F, const LAS int* tb) {
    float* dst = DRY ? WSP(float, WS_PRE) : F.out;
    const float* mod = WSP(float, WS_MOD); const bf16_t* Y2 = WSP(bf16_t, WS_Y2); const int* tok = WSP(int, WS_TOK);
    const int gw = F.bx * NWAVES + FWAVE, NGW = F.G * NWAVES, lane = FLANE;
    for (int t = gw; t < T; t += NGW) {
        const int b = t / S; const int4 ti = *(const int4*)(tok + (size_t)t * 4);
        const size_t r0 = (size_t)tb[ti.x] * 256 + ti.y, r1 = (size_t)tb[ti.z] * 256 + ti.w;
        const float* gate = mod + (size_t)b * 6 * D + 5 * D;
        f32x4 v[8]; float s = 0.f;
#pragma unroll
        for (int i = 0; i < 8; ++i) { const int d = 4 * (lane + 64 * i); const f32x4 xv = *(const f32x4*)(F.out + (size_t)t * D + d), gv = *(const f32x4*)(gate + d);
            const u32x2 ya = *(const u32x2*)(Y2 + r0 * D + d), yb = *(const u32x2*)(Y2 + r1 * D + d);
            f32x4 f; f[0] = bf_lo(ya.x) + bf_lo(yb.x); f[1] = bf_hi(ya.x) + bf_hi(yb.x); f[2] = bf_lo(ya.y) + bf_lo(yb.y); f[3] = bf_hi(ya.y) + bf_hi(yb.y);
            v[i] = xv * ALPHA + gv * f; s += (v[i][0] + v[i][1]) + (v[i][2] + v[i][3]); }
        const float mu = wave_sum(s) * (1.f / D); float q = 0.f;
#pragma unroll
        for (int i = 0; i < 8; ++i) { v[i] = v[i] - mu; q += (v[i][0] * v[i][0] + v[i][1] * v[i][1]) + (v[i][2] * v[i][2] + v[i][3] * v[i][3]); }
        const float rstd = rsqrtf(wave_sum(q) * (1.f / D) + LN_EPS);
#pragma unroll
        for (int i = 0; i < 8; ++i) { const int d = 4 * (lane + 64 * i); const f32x4 gg = *(const f32x4*)(F.ln2_g + d), bb = *(const f32x4*)(F.ln2_b + d);
            *(f32x4*)(dst + (size_t)t * D + d) = v[i] * rstd * gg + bb; }
    }
}

#if MK_DEBUG
__device__ __forceinline__ void dbg_acc(float* slot, double num, double den) { atomicAdd(slot, (float)num); atomicAdd(slot + 1, (float)den); }
__global__ void k_chk_u(Params p, float* res) {
    __shared__ float sh[8]; __shared__ float ush[D];
    const int t = (blockIdx.x * 37) % T, b = t / S; const float* x = p.in[0] + (size_t)t * D; const float* mod = (const float*)(p.ws + WS_MOD);
    float s = 0; for (int i = threadIdx.x; i < D; i += 256) s += x[i]; s = wave_sum(s); if ((threadIdx.x & 63) == 0) sh[threadIdx.x >> 6] = s; __syncthreads();
    const float mu = (sh[0] + sh[1] + sh[2] + sh[3]) / D; __syncthreads();
    float q = 0; for (int i = threadIdx.x; i < D; i += 256) { const float d = x[i] - mu; q += d * d; } q = wave_sum(q); if ((threadIdx.x & 63) == 0) sh[threadIdx.x >> 6] = q; __syncthreads();
    const float rstd = rsqrtf((sh[0] + sh[1] + sh[2] + sh[3]) / D + LN_EPS);
    const bf16_t* U = (const bf16_t*)(p.ws + WS_U); double num = 0, den = 0;
    for (int i = threadIdx.x; i < D; i += 256) {
        float sc = p.in[3][1 * D + i], sf = p.in[3][0 * D + i];
        if (i < 64) { for (int k = 0; k < D; ++k) { const float cv = p.in[1][b * D + k]; const float sl = cv / (1.f + expf(-cv)); sc += sl * p.in[2][(size_t)k * 6 * D + D + i]; sf += sl * p.in[2][(size_t)k * 6 * D + i]; } }
        else { sc = mod[(size_t)b * 6 * D + D + i]; sf = mod[(size_t)b * 6 * D + i]; }
        const float ref = (x[i] - mu) * rstd * (1.f + sc) + sf; ush[i] = ref; const float got = bf2f(U[(size_t)t * D + i]); num += (double)(got - ref) * (got - ref); den += (double)ref * ref; }
    __syncthreads();
    if (threadIdx.x < 8) { const int j = threadIdx.x; float a = 0; for (int k = 0; k < D; ++k) a += ush[k] * p.in[4][(size_t)k * NIN + OFF_IF + j]; a += p.in[5][j];
        if (j >= 4) a = fminf(a, 0.f) - log1pf(expf(-fabsf(a))); const float got = ((const float*)(p.ws + WS_GPRE))[(size_t)t * 8 + j]; num += (double)(got - a) * (got - a) * 1000.0; den += (double)a * a * 1000.0; }
    dbg_acc(res, num, den);
}
__global__ void k_chk_p2(Params p, float* res) {
    const int gid = blockIdx.x * blockDim.x + threadIdx.x;
    const int t = (gid * 131 + 7) % T; const int col = (gid * 977 + 13) % (NIN - 8 + 4096);
    const bf16_t* U = (const bf16_t*)(p.ws + WS_U) + (size_t)t * D;
    const int pos = t % S; float ref, got; unsigned char* ws = p.ws;
    auto dot = [&](const float* w, int ld, int c) { float a = 0; for (int k = 0; k < D; ++k) a += bf2f(U[k]) * w[(size_t)k * ld + c]; return a; };
    if (col < 3072) { const int hd = col / 128, lc = col % 128, i = lc % 64; const int c1 = hd * 128 + i, c2 = c1 + 64; const float x1 = dot(p.in[4], NIN, c1), x2 = dot(p.in[4], NIN, c2);
        const float inv = powf(10000.f, -(float)(2 * i) / 128.f), ang = (float)pos * inv, cs = cosf(ang), sn = sinf(ang);
        ref = (lc < 64) ? (x1 * cs - x2 * sn) : (x2 * cs + x1 * sn); const int pc = hd * 128 + 2 * i + (lc >= 64);
        if (col < 1536) { ref *= QSCALE; got = bf2f(((const bf16_t*)(ws + WS_QB))[(size_t)t * 1536 + pc]); } else got = bf2f(((const bf16_t*)(ws + WS_KB))[(size_t)t * 1536 + pc - 1536]); }
    else if (col < 4608) { ref = dot(p.in[4], NIN, col); got = bf2f(((const bf16_t*)(ws + WS_VB))[(size_t)t * 1536 + col - 3072]); }
    else if (col < 6656) { ref = dot(p.in[4], NIN, col); got = bf2f(((const bf16_t*)(ws + WS_QKP))[(size_t)t * 2048 + col - 4608]); }
    else if (col < 7680) { ref = dot(p.in[4], NIN, col); got = bf2f(((const bf16_t*)(ws + WS_VMB))[(size_t)t * 1024 + col - 6656]); }
    else if (col < 8704) { ref = dot(p.in[4], NIN, col); ref = 1.f / (1.f + expf(-ref)); got = bf2f(((const bf16_t*)(ws + WS_OGB))[(size_t)t * 1024 + col - 7680]); }
    else { const int c = col - 8704; ref = dot(p.in[11], 4096, c) + p.in[12][c]; ref = 1.f / (1.f + expf(-ref)); got = bf2f(((const bf16_t*)(ws + WS_GB))[(size_t)t * 4096 + c]); }
    double num = (double)(got - ref) * (got - ref), den = (double)ref * ref;
    for (int o = 32; o >= 1; o >>= 1) { num += __shfl_xor(num, o); den += __shfl_xor(den, o); }
    if ((threadIdx.x & 63) == 0) dbg_acc(res, num, den);
}

__global__ void __launch_bounds__(256) k_chk_attn(Params p, float* res) {
    const int t = (blockIdx.x * 1543 + 11) % T, h = threadIdx.x >> 6, lane = threadIdx.x & 63; const int b = t / S, pos = t % S;
    const bf16_t* QB = (const bf16_t*)(p.ws + WS_QB); const bf16_t* KB = (const bf16_t*)(p.ws + WS_KB); const bf16_t* VB = (const bf16_t*)(p.ws + WS_VB); const bf16_t* YA = (const bf16_t*)(p.ws + WS_YA);
    float og[3][2], lse[3];
    for (int g = 0; g < 3; ++g) { const int d = (g == 0) ? 1 : (g == 1 ? 4 : 16); const int head = 4 * g + h;
        const bf16_t* qp = QB + (size_t)t * 1536 + head * 128; const float q0 = bf2f(qp[lane]), q1 = bf2f(qp[lane + 64]);
        float mx = -INFINITY, den = 0, o0 = 0, o1 = 0;
        for (int j = 0; j <= 128; ++j) { const int tk = pos - j * d; if (tk < 0) break;
            const bf16_t* kp = KB + (size_t)(b * S + tk) * 1536 + head * 128; const bf16_t* vp = VB + (size_t)(b * S + tk) * 1536 + head * 128;
            const float dot = wave_sum(q0 * bf2f(kp[lane]) + q1 * bf2f(kp[lane + 64]));
            const float nm = fmaxf(mx, dot); const float sc = exp2f(mx - nm), pe = exp2f(dot - nm);
            den = den * sc + pe; o0 = o0 * sc + pe * bf2f(vp[lane]); o1 = o1 * sc + pe * bf2f(vp[lane + 64]); mx = nm; }
        og[g][0] = o0 / den; og[g][1] = o1 / den; lse[g] = (mx + log2f(den)) * LN2; }
    const float ml = fmaxf(lse[0], fmaxf(lse[1], lse[2])); const float w0 = expf(lse[0] - ml), w1 = expf(lse[1] - ml), w2 = expf(lse[2] - ml); const float ws_ = 1.f / (w0 + w1 + w2);
    const float r0 = (w0 * og[0][0] + w1 * og[1][0] + w2 * og[2][0]) * ws_, r1 = (w0 * og[0][1] + w1 * og[1][1] + w2 * og[2][1]) * ws_;
    const float g0 = bf2f(YA[(size_t)t * 512 + h * 128 + lane]), g1 = bf2f(YA[(size_t)t * 512 + h * 128 + lane + 64]);
    double num = (double)(g0 - r0) * (g0 - r0) + (double)(g1 - r1) * (g1 - r1), den2 = (double)r0 * r0 + (double)r1 * r1;
    for (int o = 32; o >= 1; o >>= 1) { num += __shfl_xor(num, o); den2 += __shfl_xor(den2, o); }
    if (lane == 0) dbg_acc(res, num, den2);
}
__global__ void __launch_bounds__(1024) k_chk_mlstm(Params p, float* hb) {
    const int b = blockIdx.x / 4, h = blockIdx.x % 4; const int tid = threadIdx.x, v = tid >> 2, kq = tid & 3;
    const bf16_t* QKP = (const bf16_t*)(p.ws + WS_QKP); const bf16_t* VM = (const bf16_t*)(p.ws + WS_VMB);
    const float* gpre = (const float*)(p.ws + WS_GPRE); const float* conv_w = p.in[6]; const float* conv_b = p.in[7];
    __shared__ float qs[256], ks[256], vs[256], ns[256], nq[256];
    float C[64];
#pragma unroll
    for (int i = 0; i < 64; ++i) C[i] = 0.f;
    if (tid < 256) ns[tid] = 0.f;
    float m = 0.f;
    for (int pos = 0; pos < S; ++pos) { const int t = b * S + pos;
        __syncthreads();
        if (tid < 256) { float yq = conv_b[h * 256 + tid], yk = conv_b[1024 + h * 256 + tid];
            for (int j = 0; j < 4; ++j) { const int pp = pos + j - 3; if (pp >= 0) { yq += conv_w[j * 2048 + h * 256 + tid] * bf2f(QKP[(size_t)(t + j - 3) * 2048 + h * 256 + tid]); yk += conv_w[j * 2048 + 1024 + h * 256 + tid] * bf2f(QKP[(size_t)(t + j - 3) * 2048 + 1024 + h * 256 + tid]); } }
            qs[tid] = yq / (1.f + expf(-yq)); ks[tid] = yk / (1.f + expf(-yk)) * 0.0625f; vs[tid] = bf2f(VM[(size_t)t * 1024 + h * 256 + tid]); }
        const float ip = gpre[(size_t)t * 8 + h], lf = gpre[(size_t)t * 8 + 4 + h];
        const float mn = fmaxf(lf + m, ip); const float iw = expf(ip - mn), fw = expf(lf + m - mn); m = mn;
        __syncthreads();
        if (tid < 256) { const float nn = fw * ns[tid] + iw * ks[tid]; ns[tid] = nn; nq[tid] = nn * qs[tid]; }
        __syncthreads();
        const float vv = vs[v] * iw; float nu = 0.f, de = 0.f;
#pragma unroll
        for (int i = 0; i < 64; ++i) { const int k = 4 * i + kq; const float cc = fw * C[i] + vv * ks[k]; C[i] = cc; nu += cc * qs[k]; de += nq[k]; }
        nu += __shfl_xor(nu, 1); nu += __shfl_xor(nu, 2); de += __shfl_xor(de, 1); de += __shfl_xor(de, 2);
        if (kq == 0) hb[(size_t)t * 1024 + h * 256 + v] = nu / fmaxf(fabsf(de), expf(-mn));
    }
}
__global__ void __launch_bounds__(256) k_chk_mnorm(Params p, const float* hb, float* res) {
    __shared__ float red[8];
    const int t = blockIdx.x / 4, h = blockIdx.x % 4, tid = threadIdx.x;
    const bf16_t* OG = (const bf16_t*)(p.ws + WS_OGB); const bf16_t* YM = (const bf16_t*)(p.ws + WS_YM); const float* mg = p.in[8];
    const float val = bf2f(OG[(size_t)t * 1024 + h * 256 + tid]) * hb[(size_t)t * 1024 + h * 256 + tid];
    float s = wave_sum(val); if ((tid & 63) == 0) red[tid >> 6] = s; __syncthreads();
    const float mu = (red[0] + red[1] + red[2] + red[3]) * (1.f / 256.f); const float d = val - mu;
    s = wave_sum(d * d); if ((tid & 63) == 0) red[4 + (tid >> 6)] = s; __syncthreads();
    const float rstd = rsqrtf((red[4] + red[5] + red[6] + red[7]) * (1.f / 256.f) + LN_EPS); const float ref = d * rstd * mg[h * 256 + tid];
    const float got = bf2f(YM[(size_t)t * 1024 + h * 256 + tid]);
    double num = (double)(got - ref) * (got - ref), den = (double)ref * ref;
    for (int o = 32; o >= 1; o >>= 1) { num += __shfl_xor(num, o); den += __shfl_xor(den, o); }
    if ((tid & 63) == 0) dbg_acc(res, num, den);
}
__global__ void k_chk_fin(const float* res, int nchk, float* out, int n) {
    const int i = blockIdx.x * blockDim.x + threadIdx.x; if (i >= n) return;
    float code = 0.f;
    for (int k = 0; k < nchk; ++k) { const float rv = res[2 * k] / fmaxf(res[2 * k + 1], 1e-30f); int s;
        if (!(rv == rv) || !(res[2 * k + 1] > 0.f)) s = 9; else { s = (int)floorf(log10f(fmaxf(rv, 1e-12f)) + 6.f); s = s < 0 ? 0 : (s > 8 ? 8 : s); }
        if (s >= 3 && code == 0.f) code = ((k + 1) * 10 + s) * 100.f; }
    out[i] = (i == 0) ? code : 0.f;
}
#endif

__global__ void __launch_bounds__(NTHR, 2) mk_fwd(Params args) {
    extern __shared__ __attribute__((aligned(16))) unsigned char lds_raw[];
    Frame F;
    F.lds = (LAS unsigned char*)lds_raw; F.G = gridDim.x; F.bx = blockIdx.x; F.ws = args.ws;
    F.x = args.in[0]; F.c = args.in[1]; F.w_ada = args.in[2]; F.b_ada = args.in[3]; F.w_in = args.in[4]; F.b_mgate = args.in[5]; F.conv_w = args.in[6]; F.conv_b = args.in[7];
    F.m_norm_g = args.in[8]; F.w_proj_a = args.in[9]; F.w_proj_m = args.in[10]; F.w_gate = args.in[11]; F.b_gate = args.in[12]; F.w_out = args.in[13]; F.ln1_g = args.in[14]; F.ln1_b = args.in[15];
    F.w_rg = args.in[16]; F.b_rg = args.in[17]; F.w_re = args.in[18]; F.b_re = args.in[19]; F.w_eg = args.in[20]; F.w_eu = args.in[21]; F.w_ed = args.in[22]; F.ln2_g = args.in[23]; F.ln2_b = args.in[24];
    F.out = args.out;
    volatile LAS unsigned* misc = (volatile LAS unsigned*)(F.lds + LDS_MISC);
    if (FTID < 64) misc[FTID] = 0u;
    __syncthreads();
    const int lo = args.ph_lo, hi = args.ph_hi;
    XcdBarrier bar; bar.bar = (unsigned*)(F.ws + WS_CTL) + CW_BAR; bar.x = 0; bar.st = nullptr;
    if (hi - lo > 1) bar = xcd_barrier_post((unsigned*)(F.ws + WS_CTL) + CW_BAR, misc + 8);
#define IN(k) (lo <= (k) && (k) < hi)
#define BOTH(k) (IN(k) && IN((k) + 1))
#define SEAM(k) do { if (BOTH(k)) xcd_barrier(bar); } while (0)

#define DUPRUN(k, BODY) do { BODY; if (MK_DUP & (1 << (k))) { xcd_barrier(bar); BODY; } } while (0)
#define PH0 { p0_prologue(F); }
#define PH1 { p1_lnmod(F); }
#define PH2 { const int GG = (F.G == 256) ? MK_GG2 : F.G; \
        if (F.bx < GG) { pg8::StaticOrder So; So.init(T, NBIG, GG, F.bx); \
            EpiP2 E{WSP(bf16_t, WS_QB), WSP(bf16_t, WS_KB), WSP(bf16_t, WS_VB), WSP(bf16_t, WS_QKP), WSP(bf16_t, WS_VMB), WSP(bf16_t, WS_OGB), WSP(bf16_t, WS_GB), WSP(float, WS_ROPE), F.b_gate}; \
            pg8::gemm_phase<EpiP2, pg8::StaticOrder, false>(F.lds, WSP(bf16_t, WS_U), WSP(bf16_t, WS_WBIG), D, So, E); } \
        if (F.bx >= F.G - 16 && FWAVE == 0) scan_bh(F, F.bx - (F.G - 16)); \
        cvt_stream<1>(F, N_IT_W1); cvt_stream<1>(F, N_IT_BG); }
#define PH3 { p3_conv(F); for (int u = F.bx; u < 768; u += F.G) attn_unit(F, u); }
#define PH4 { for (int u = F.bx; u < 256; u += F.G) mlstm_dc_unit(F, u); }
#define PH5 { p5_scan_mix(F); }
#define PH6 { for (int u = F.bx; u < 256; u += F.G) mlstm_out_unit(F, u); }
#define PH7 { pg8::StaticOrder So; So.init(T, D, F.G, F.bx); \
        EpiMerge E0{WSP(bf16_t, WS_MG), WSP(bf16_t, WS_GB), 0}, E1{WSP(bf16_t, WS_MG), WSP(bf16_t, WS_GB), 1}; \
        pg8::gemm_phase<EpiMerge, pg8::StaticOrder, false>(F.lds, WSP(bf16_t, WS_YA), WSP(bf16_t, WS_WPA), 512, So, E0); \
        pg8::gemm_phase<EpiMerge, pg8::StaticOrder, false>(F.lds, WSP(bf16_t, WS_YM), WSP(bf16_t, WS_WPM), 1024, So, E1); }
#define PH8 { pg8::StaticOrder So; So.init(T, D, F.G, F.bx); EpiWout E{F.x, WSP(float, WS_MOD), WSP(float, WS_PRE)}; \
        pg8::gemm_phase<EpiWout, pg8::StaticOrder, false>(F.lds, WSP(bf16_t, WS_MG), WSP(bf16_t, WS_WO), D, So, E); }
#define PH10 { moe_tables(F, tb, cn); MoeSched Sm{WSP(int, WS_IDX), tb, cn, F.G, vcu}; EpiMoe1 E{WSP(bf16_t, WS_H)}; \
        pg8::gemm_phase<EpiMoe1, MoeSched, true>(F.lds, WSP(bf16_t, WS_U), WSP(bf16_t, WS_W1T), D, Sm, E); }
#define PH11 { moe_tables(F, tb, cn); MoeSched Sm{WSP(int, WS_IDX), tb, cn, F.G, vcu}; EpiMoe2 E{WSP(bf16_t, WS_Y2), WSP(float, WS_WL)}; \
        pg8::gemm_phase<EpiMoe2, MoeSched, false>(F.lds, WSP(bf16_t, WS_H), WSP(bf16_t, WS_W2T), FF, Sm, E); }
    LAS int* tb = (LAS int*)(F.lds + LDS_MISC) + 64; LAS int* cn = tb + 40;
    const int vcu = (F.G % 8 == 0) ? (F.bx % 8) * (F.G / 8) + F.bx / 8 : F.bx;
    if (IN(0)) { DUPRUN(0, PH0); SEAM(0); }
    if (IN(1)) { DUPRUN(1, PH1); SEAM(1); }
    if (IN(2)) { PH2; SEAM(2); }
    if (IN(3)) { DUPRUN(3, PH3); SEAM(3); }
    if (IN(4)) { DUPRUN(4, PH4); SEAM(4); }
    if (IN(5)) { DUPRUN(5, PH5); SEAM(5); }
    if (IN(6)) { DUPRUN(6, PH6); SEAM(6); }
    if (IN(7)) { DUPRUN(7, PH7); SEAM(7); }
    if (IN(8)) { DUPRUN(8, PH8); SEAM(8); }
    if (IN(9)) { if (MK_DUP & (1 << 9)) { p9_ln_router<true>(F); xcd_barrier(bar); } p9_ln_router<false>(F); SEAM(9); }
    if (IN(10)) { DUPRUN(10, PH10); SEAM(10); }
    if (IN(11)) { DUPRUN(11, PH11); SEAM(11); }
    if (IN(12)) { moe_tables(F, tb, cn); if (MK_DUP & (1 << 12)) { p12_final<true>(F, tb); xcd_barrier(bar); } p12_final<false>(F, tb); }
#undef IN
#undef BOTH
#undef SEAM
}

extern "C" void kernel_launch(void* const* d_in, const int* in_sizes, int n_in, void* d_out, int out_size, void* d_ws, size_t ws_size, hipStream_t stream) {
    static int grid = 0;
    if (grid == 0) {
        size_t need = WS_END;
#if MK_DEBUG
        need += (1 << 20) + (size_t)T * 1024 * 4;
#endif
        if (n_in != 25 || out_size != T * D || ws_size < need) { fprintf(stderr, "kernel_launch: unexpected shapes / workspace (%zu < %zu)\n", ws_size, need); grid = -1; return; }
        int dev = 0, cus = 0, per_cu = 0;
        if (hipGetDevice(&dev) != hipSuccess || hipDeviceGetAttribute(&cus, hipDeviceAttributeMultiprocessorCount, dev) != hipSuccess) { grid = -1; return; }
        if (hipFuncSetAttribute((const void*)mk_fwd, hipFuncAttributeMaxDynamicSharedMemorySize, LDS_BYTES) != hipSuccess) { fprintf(stderr, "kernel_launch: hipFuncSetAttribute failed\n"); grid = -1; return; }
        if (hipOccupancyMaxActiveBlocksPerMultiprocessor(&per_cu, (const void*)mk_fwd, NTHR, LDS_BYTES) != hipSuccess || per_cu < 1) { fprintf(stderr, "kernel_launch: occupancy query says %d\n", per_cu); (void)hipGetLastError(); grid = -1; return; }
        grid = cus;
    }
    if (grid < 0) return;
    (void)hipMemsetAsync((char*)d_ws + WS_CTL, 0, CTL_ZERO_BYTES, stream);
    Params a{};
    for (int i = 0; i < 25; ++i) a.in[i] = (const float*)d_in[i];
    a.out = (float*)d_out; a.ws = (unsigned char*)d_ws;
#if MK_DEBUG
    constexpr int NPH = 7;
#else
    constexpr int NPH = 13;
#endif
#if MK_PER_PHASE
    for (int p = 0; p < NPH; ++p) { a.ph_lo = p; a.ph_hi = p + 1; hipLaunchKernelGGL(mk_fwd, dim3(grid), dim3(NTHR), LDS_BYTES, stream, a); }
#else
    a.ph_lo = 0; a.ph_hi = NPH; hipLaunchKernelGGL(mk_fwd, dim3(grid), dim3(NTHR), LDS_BYTES, stream, a);
#endif
#if MK_DEBUG
    float* res = (float*)((char*)d_ws + WS_DBG0);
    (void)hipMemsetAsync(res, 0, 256, stream);
    k_chk_u<<<64, 256, 0, stream>>>(a, res);
    k_chk_p2<<<32, 64, 0, stream>>>(a, res + 2);
    k_chk_attn<<<256, 256, 0, stream>>>(a, res + 4);
    float* hb = (float*)((char*)d_ws + WS_DBG0 + (1 << 20));
    k_chk_mlstm<<<16, 1024, 0, stream>>>(a, hb);
    k_chk_mnorm<<<T * 4, 256, 0, stream>>>(a, hb, res + 6);
    k_chk_fin<<<(T * D + 255) / 256, 256, 0, stream>>>(res, 4, (float*)d_out, T * D);
#endif
}
```

```cpp
#include <hip/hip_runtime.h>
#include <stdint.h>
#include <math.h>
#include <stdio.h>

#ifndef MK_DEBUG
#define MK_DEBUG 0
#endif
#ifndef MK_DUP
#define MK_DUP 0
#endif
#ifndef MK_GG2
#define MK_GG2 200
#endif
#ifndef MK_STAGGER
#define MK_STAGGER 0
#endif
#ifndef MK_PER_PHASE
#define MK_PER_PHASE 0
#endif

#define LAS __attribute__((address_space(3)))
typedef unsigned short bf16_t;
typedef short bf16x8 __attribute__((ext_vector_type(8)));
typedef short s16x4 __attribute__((ext_vector_type(4)));
typedef float f32x4 __attribute__((ext_vector_type(4)));
typedef float f32x2 __attribute__((ext_vector_type(2)));
typedef unsigned u32x4 __attribute__((ext_vector_type(4)));
typedef unsigned u32x2 __attribute__((ext_vector_type(2)));

constexpr int D = 2048, NB = 4, S = 2048, T = NB * S, NIN = 8712;
constexpr int OFF_QA = 0, OFF_KA = 1536, OFF_VA = 3072, OFF_QKM = 4608, OFF_VM = 6656, OFF_OM = 7680, OFF_IF = 8704;
constexpr int FF = 1024, NEXP = 32, NBIG = 12800;
constexpr float ALPHA = 1.189207115002721f, LN_EPS = 1e-5f;
constexpr float LOG2E = 1.4426950408889634f, LN2 = 0.6931471805599453f;
constexpr float QSCALE = 0.08838834764831845f * 1.4426950408889634f;
constexpr int NTHR = 512, NWAVES = 8;
constexpr int SORT_ROWS = 24576;

constexpr size_t al256(size_t x) { return (x + 255) & ~(size_t)255; }
constexpr size_t WS_CTL = 0, CTL_ZERO_BYTES = 65536;
constexpr int CW_BAR = 0;
constexpr int CW_CNT = 4096;
constexpr int CW_DBG = 4224;
constexpr size_t WS_MOD = 65536;
constexpr size_t WS_ROPE = WS_MOD + al256((size_t)NB * 6 * D * 4);
constexpr size_t WS_WIF = WS_ROPE + (size_t)S * 64 * 2 * 4;
constexpr size_t WS_GPRE = WS_WIF + (size_t)8 * D * 4;
constexpr size_t WS_BCUM = WS_GPRE + (size_t)T * 8 * 4;
constexpr size_t WS_MCUM = WS_BCUM + (size_t)16 * S * 4;
constexpr size_t WS_WRT = WS_MCUM + (size_t)16 * S * 4;
constexpr size_t WS_LSE = WS_WRT + (size_t)2 * 48 * D * 2;
constexpr size_t WS_IDX = WS_LSE + (size_t)T * 12 * 4;
constexpr size_t WS_WL = WS_IDX + (size_t)NEXP * T * 4;
constexpr size_t WS_TOK = WS_WL + (size_t)NEXP * T * 4;
constexpr size_t WS_DN = WS_TOK + (size_t)T * 16;
constexpr size_t WS_NST = WS_DN + (size_t)256 * 256 * 4;
constexpr size_t WS_WBIG = al256(WS_NST + (size_t)256 * 256 * 4);
constexpr size_t WS_WPA = WS_WBIG + (size_t)NBIG * D * 2;
constexpr size_t WS_WPM = WS_WPA + (size_t)D * 512 * 2;
constexpr size_t WS_WO = WS_WPM + (size_t)D * 1024 * 2;
constexpr size_t WS_W1T = WS_WO + (size_t)D * D * 2;
constexpr size_t WS_W2T = WS_W1T + (size_t)NEXP * 2048 * D * 2;
constexpr size_t WS_U = WS_W2T + (size_t)NEXP * D * FF * 2;
constexpr size_t WS_QB = WS_U + (size_t)T * D * 2;
constexpr size_t WS_KB = WS_QB + (size_t)T * 1536 * 2;
constexpr size_t WS_VB = WS_KB + (size_t)T * 1536 * 2;
constexpr size_t WS_QKP = WS_VB + (size_t)T * 1536 * 2;
constexpr size_t WS_VMB = WS_QKP + (size_t)T * 2048 * 2;
constexpr size_t WS_OGB = WS_VMB + (size_t)T * 1024 * 2;
constexpr size_t WS_GB = WS_OGB + (size_t)T * 1024 * 2;
constexpr size_t WS_QM = WS_GB + (size_t)T * 4096 * 2;
constexpr size_t WS_KM = WS_QM + (size_t)T * 1024 * 2;
constexpr size_t WS_OATT = WS_KM + (size_t)T * 1024 * 2;
constexpr size_t WS_YA = WS_OATT + (size_t)T * 1536 * 2;
constexpr size_t WS_YM = WS_YA + (size_t)T * 512 * 2;
constexpr size_t WS_DC = WS_YM + (size_t)T * 1024 * 2;
constexpr size_t WS_CST = WS_DC + (size_t)256 * 65536 * 4;
constexpr size_t WS_MG = WS_CST + (size_t)256 * 65536 * 2;
constexpr size_t WS_PRE = WS_MG + (size_t)T * D * 2;
constexpr size_t WS_END = WS_PRE + (size_t)T * D * 4;
constexpr size_t WS_H = WS_QB;
constexpr size_t WS_Y2 = WS_H + (size_t)SORT_ROWS * FF * 2;
static_assert(WS_Y2 + (size_t)SORT_ROWS * D * 2 <= WS_QM, "overlay");
constexpr size_t WS_DBG0 = WS_END;

constexpr int LDS_MISC = 162816;
constexpr int LDS_BYTES = LDS_MISC + 1024;

__device__ __forceinline__ unsigned cvt_pk_bf16(float lo, float hi) { unsigned r; asm volatile("v_cvt_pk_bf16_f32 %0, %1, %2" : "=v"(r) : "v"(lo), "v"(hi)); return r; }
__device__ __forceinline__ float bf_lo(unsigned w) { return __uint_as_float(w << 16); }
__device__ __forceinline__ float bf_hi(unsigned w) { return __uint_as_float(w & 0xffff0000u); }
__device__ __forceinline__ float bf2f(bf16_t b) { return __uint_as_float(((unsigned)b) << 16); }
__device__ __forceinline__ bf16_t f2bf(float f) { return (bf16_t)(cvt_pk_bf16(f, 0.f) & 0xffffu); }
__device__ __forceinline__ float fast_exp2(float x) { return __builtin_amdgcn_exp2f(x); }
__device__ __forceinline__ float fast_rcp(float x) { return __builtin_amdgcn_rcpf(x); }
__device__ __forceinline__ float sigmoid_fast(float x) { return fast_rcp(1.f + fast_exp2(-x * LOG2E)); }
__device__ __forceinline__ float silu_fast(float x) { return x * sigmoid_fast(x); }
__device__ __forceinline__ float wave_sum(float v) {
#pragma unroll
    for (int o = 32; o >= 1; o >>= 1) v += __shfl_xor(v, o);
    return v; }
__device__ __forceinline__ float wave_max(float v) {
#pragma unroll
    for (int o = 32; o >= 1; o >>= 1) v = fmaxf(v, __shfl_xor(v, o));
    return v; }
__device__ __forceinline__ s16x4 tr_read(unsigned addr) { s16x4 r; asm volatile("ds_read_b64_tr_b16 %0, %1" : "=&v"(r) : "v"(addr) : "memory"); return r; }
__device__ __forceinline__ s16x4 tr_read_o(unsigned base, const int off) { s16x4 r; asm volatile("ds_read_b64_tr_b16 %0, %1 offset:%2" : "=&v"(r) : "v"(base), "n"(off) : "memory"); return r; }
#define LGKM_WAIT0() do { asm volatile("s_waitcnt lgkmcnt(0)" ::: "memory"); __builtin_amdgcn_sched_barrier(0); } while (0)
#define PK8(L, H) ((bf16x8){L[0], L[1], L[2], L[3], H[0], H[1], H[2], H[3]})

#define XB_TMO      128
#define XB_XCNT(j)  (256  + 64 * (j))
#define XB_XSUB(j)  (1280 + 64 * (j))
#define XB_XGEN(j)  (2304 + 64 * (j))
#define XB_TOP      3328
#define XB_TOPGEN   3392
#define XCD_BAR_WORDS 3456
#define XB_SPIN_CAP (1u << 18)
__device__ __forceinline__ unsigned xb_ld(unsigned* p)              { return __hip_atomic_load(p, __ATOMIC_RELAXED, __HIP_MEMORY_SCOPE_AGENT); }
__device__ __forceinline__ unsigned xb_add(unsigned* p, unsigned v) { return __hip_atomic_fetch_add(p, v, __ATOMIC_RELAXED, __HIP_MEMORY_SCOPE_AGENT); }
__device__ __forceinline__ unsigned xb_xcc_id() { return (unsigned)__builtin_amdgcn_s_getreg((3 << 11) | 20) & 0xFu; }
#define XB_SPIN(cond, bar) do { unsigned _sp = 0; while (cond) { __builtin_amdgcn_s_sleep(1); \
    if ((++_sp & 255u) == 0u) { if (xb_ld(&(bar)[XB_TMO])) break; if (_sp > XB_SPIN_CAP) { atomicAdd(&(bar)[XB_TMO], 1u); break; } } } } while (0)
struct XcdBarrier { unsigned* bar; unsigned x; volatile LAS unsigned* st; };
__device__ __forceinline__ XcdBarrier xcd_barrier_post(unsigned* bar, volatile LAS unsigned* st) {
    XcdBarrier b; b.bar = bar; b.x = xb_xcc_id(); b.st = st;
    if (threadIdx.x == 0) (void)xb_add(&bar[XB_XCNT(b.x)], 1u);
    return b;
}
__device__ __forceinline__ void xcd_barrier_complete(unsigned* bar, unsigned x, unsigned& nloc, unsigned& nx) {
    const unsigned G = gridDim.x * gridDim.y * gridDim.z;
    unsigned sum, cnt, mine, sp = 0u;
    for (;;) {
        sum = 0u; cnt = 0u; mine = 0u;
#pragma unroll
        for (unsigned j = 0; j < 16; ++j) { const unsigned c = xb_ld(&bar[XB_XCNT(j)]); sum += c; cnt += (c > 0u) ? 1u : 0u; mine = (j == x) ? c : mine; }
        if (sum == G) break;
        __builtin_amdgcn_s_sleep(1);
        if ((++sp & 255u) == 0u) { if (xb_ld(&bar[XB_TMO])) break; if (sp > XB_SPIN_CAP) { atomicAdd(&bar[XB_TMO], 1u); break; } }
    }
    nloc = mine > 0u ? mine : 1u; nx = cnt > 0u ? cnt : 1u;
}
__device__ __forceinline__ void xcd_barrier(const XcdBarrier& b) {
    asm volatile("s_waitcnt vmcnt(0)" ::: "memory");
    __syncthreads();
    if (threadIdx.x == 0) {
        unsigned* bar = b.bar;
        __builtin_amdgcn_s_waitcnt(0);
        unsigned nloc = b.st[0], nx = b.st[1];
        if (nloc == 0u) { xcd_barrier_complete(bar, b.x, nloc, nx); b.st[0] = nloc; b.st[1] = nx; }
        const unsigned old = xb_add(&bar[XB_XSUB(b.x)], 1u);
        const unsigned gen = old / nloc;
        if (old + 1u == (gen + 1u) * nloc) {
            __builtin_amdgcn_fence(__ATOMIC_RELEASE, "agent");
            asm volatile("s_waitcnt vmcnt(0)" ::: "memory");
            const unsigned og = xb_add(&bar[XB_TOP], 1u);
            const unsigned tg = og / nx;
            if (og + 1u == (tg + 1u) * nx) xb_add(&bar[XB_TOPGEN], 1u);
            else XB_SPIN(xb_ld(&bar[XB_TOPGEN]) == tg, bar);
            __builtin_amdgcn_fence(__ATOMIC_ACQUIRE, "agent");
            xb_add(&bar[XB_XGEN(b.x)], 1u);
            asm volatile("s_waitcnt vmcnt(0)" ::: "memory");
        } else {
            XB_SPIN(xb_ld(&bar[XB_XGEN(b.x)]) == gen, bar);
            __builtin_amdgcn_fence(__ATOMIC_ACQUIRE, "agent");
            asm volatile("s_waitcnt vmcnt(0)" ::: "memory");
        }
    }
    __syncthreads();
}

namespace pg8 {
constexpr int BM = 256, BK = 64, HALF = 128, HTB = HALF * BK * 2, STAGE_BYTES = 8 * HTB, NXCD = 8, WGM = 8;
__host__ __device__ __forceinline__ int lds_byte(int r, int c) { const int st = (r >> 4) * 2 + (c >> 5), rr = r & 15, cc = c & 31, ob = rr * 64 + cc * 2; return st * 1024 + (ob ^ (((ob >> 9) & 1) << 5)); }
__host__ __device__ __forceinline__ void stage_rc(int b, int& R, int& C) { const int st = b / 1024, sb = b % 1024, swz = sb ^ (((sb >> 9) & 1) << 5); R = (st >> 1) * 16 + swz / 64; C = (st & 1) * 32 + (swz % 64) / 2; }
__host__ __device__ __forceinline__ int perm32(int rho) { const int n = rho >> 4, i = rho & 15; return 8 * (i >> 2) + 4 * n + (i & 3); }

struct Unit { int pm, pn, e, it, cnt; };

struct StaticOrder {
    int nM, nN, nwg, G, c;
    __device__ void init(int M, int N, int G_, int c_) { nM = M / BM; nN = N / BM; nwg = nM * nN; G = G_; c = c_; }
    __device__ bool next(int i, Unit& u) const {
        const long L = (long)i * G + c; if (L >= nwg) return false;
        int wgid = (int)L; { const int q = nwg / NXCD, r = nwg % NXCD, xcd = wgid % NXCD, off = wgid / NXCD; wgid = (xcd < r ? xcd * (q + 1) : r * (q + 1) + (xcd - r) * q) + off; }
        const int nig = WGM * nN, gid = wgid / nig, fm = gid * WGM, gsz = (nM - fm) < WGM ? (nM - fm) : WGM;
        u.pm = fm + ((wgid % nig) % gsz); u.pn = (wgid % nig) / gsz; u.e = 0; u.it = 0; u.cnt = 0; return true;
    }
    __device__ __forceinline__ int arow(const Unit&, int r) const { return r; }
};

template <class Epi, class Sched, bool GATHER>
__device__ __forceinline__ void gemm_phase(LAS unsigned char* lds, const bf16_t* Ap, const bf16_t* Btp, const int K, const Sched& S, const Epi& E) {
    const int tid = threadIdx.x, wid = __builtin_amdgcn_readfirstlane(tid >> 6), lane = tid & 63, wr = wid >> 2, wc = wid & 3, fr = lane & 15, fq = lane >> 4;
    const int nt = K / BK;
    unsigned voffA[2], voffB[2]; int RA[2], CA[2];
#pragma unroll
    for (int i = 0; i < 2; ++i) { int R, C; stage_rc(tid * 16 + i * 8192, R, C); const int Rb = Epi::PERM ? ((R & ~31) + perm32(R & 31)) : R;
        RA[i] = R; CA[i] = C; voffA[i] = (unsigned)(R * K + C) * 2u; voffB[i] = (unsigned)(Rb * K + C) * 2u; }
    const size_t kstep = (size_t)(BK * 2);
    const size_t hstep = (size_t)HALF * K * 2;
    const size_t tstep = 2 * hstep;
    const unsigned ldsw = (unsigned)wid * 1024u;
    const int aoff = lds_byte(wr * 64 + fr, fq * 8), boff = lds_byte(wc * 32 + fr, fq * 8);
    unsigned vC[2][2], vN[2][2], v2[2][2];
#define PG8_SA(b, h) (((b) * 2 + (h)) * HTB)
#define PG8_SB(b, h) ((4 + (b) * 2 + (h)) * HTB)
#define PG8_STAGE(bufoff, gbase, voff) do { _Pragma("unroll") for (int _i = 0; _i < 2; ++_i) \
        __builtin_amdgcn_global_load_lds((const unsigned*)((const char*)(gbase) + (voff)[_i]), (LAS unsigned*)(lds + (bufoff) + ldsw + _i * 8192), 16, 0, 0); } while (0)
#define PG8_STAGE_A(bufoff, gbase, h, vsel) do { if constexpr (GATHER) { PG8_STAGE(bufoff, gbase, (vsel)[h]); } else { PG8_STAGE(bufoff, (gbase) + (h) * hstep, voffA); } } while (0)
#define PG8_GVOFF(u, v) do { _Pragma("unroll") for (int _h = 0; _h < 2; ++_h) _Pragma("unroll") for (int _i = 0; _i < 2; ++_i) \
        (v)[_h][_i] = (unsigned)(S.arow(u, _h * HALF + RA[_i]) * K + CA[_i]) * 2u; } while (0)
#define PG8_LDA(dst, b, h) do { _Pragma("unroll") for (int m = 0; m < 4; ++m) _Pragma("unroll") for (int k = 0; k < 2; ++k) dst[m][k] = *(const LAS bf16x8*)(lds + PG8_SA(b, h) + aoff + m * 2048 + k * 1024); } while (0)
#define PG8_LDB(dst, b, h) do { _Pragma("unroll") for (int n = 0; n < 2; ++n) _Pragma("unroll") for (int k = 0; k < 2; ++k) dst[n][k] = *(const LAS bf16x8*)(lds + PG8_SB(b, h) + boff + n * 2048 + k * 1024); } while (0)
#define PG8_MMA(ai, bj, At, Bt) do { __builtin_amdgcn_s_setprio(1); _Pragma("unroll") for (int m = 0; m < 4; ++m) _Pragma("unroll") for (int n = 0; n < 2; ++n) _Pragma("unroll") for (int k = 0; k < 2; ++k) \
        acc[ai][bj][m][n] = __builtin_amdgcn_mfma_f32_16x16x32_bf16(Bt[n][k], At[m][k], acc[ai][bj][m][n], 0, 0, 0); __builtin_amdgcn_s_setprio(0); } while (0)
#define PG8_WAIT_V(n) asm volatile("s_waitcnt vmcnt(" #n ")" ::: "memory")
#define PG8_WAIT_L(n) asm volatile("s_waitcnt lgkmcnt(" #n ")" ::: "memory")
#define PG8_BAR __builtin_amdgcn_s_barrier()
#define PG8_SCHED __builtin_amdgcn_sched_barrier(0)
    Unit cur, nxt; int ui = 0;
    if (!S.next(0, cur)) return;
    f32x4 acc[2][2][4][2];
#pragma unroll
    for (int a = 0; a < 2; ++a)
#pragma unroll
        for (int b = 0; b < 2; ++b)
#pragma unroll
            for (int m = 0; m < 4; ++m)
#pragma unroll
                for (int n = 0; n < 2; ++n) acc[a][b][m][n] = (f32x4){0.f, 0.f, 0.f, 0.f};
    bf16x8 At[4][2], B0[2][2], B1[2][2];
    const char* cA = GATHER ? (const char*)Ap : (const char*)Ap + (size_t)cur.pm * tstep; const char* cB = (const char*)Btp + (size_t)cur.pn * tstep;
    if constexpr (GATHER) { PG8_GVOFF(cur, vC); }
    PG8_STAGE(PG8_SB(0, 0), cB, voffB); PG8_STAGE(PG8_SB(0, 1), cB + hstep, voffB); PG8_STAGE_A(PG8_SA(0, 0), cA, 0, vC); PG8_STAGE_A(PG8_SA(0, 1), cA, 1, vC);
    if (wr == 1) PG8_BAR;
    PG8_WAIT_V(2); PG8_BAR;
    PG8_STAGE(PG8_SB(1, 0), cB + kstep, voffB); PG8_STAGE_A(PG8_SA(1, 0), cA + kstep, 0, vC); PG8_STAGE(PG8_SB(1, 1), cB + hstep + kstep, voffB);
    PG8_WAIT_V(6); PG8_BAR;
    for (;;) {
        const bool has_next = S.next(ui + 1, nxt);
        const char* nA = GATHER ? (const char*)Ap : (has_next ? (const char*)Ap + (size_t)nxt.pm * tstep : cA);
        const char* nB = has_next ? (const char*)Btp + (size_t)nxt.pn * tstep : cB;
        if constexpr (GATHER) { if (has_next) { PG8_GVOFF(nxt, vN); } else {
#pragma unroll
            for (int h = 0; h < 2; ++h) { vN[h][0] = vC[h][0]; vN[h][1] = vC[h][1]; } } }
        for (int t = 0; t < nt; t += 2) {
            const bool last = (t == nt - 2);
            const char* a1 = cA + (size_t)(t + 1) * kstep;
            const char* a2 = last ? nA : cA + (size_t)(t + 2) * kstep; const char* b2 = last ? nB : cB + (size_t)(t + 2) * kstep;
            const char* a3 = a2 + kstep; const char* b3 = b2 + kstep;
            if constexpr (GATHER) {
#pragma unroll
                for (int h = 0; h < 2; ++h) { v2[h][0] = last ? vN[h][0] : vC[h][0]; v2[h][1] = last ? vN[h][1] : vC[h][1]; } }
            PG8_LDB(B0, 0, 0); PG8_LDB(B1, 0, 1); PG8_SCHED; PG8_LDA(At, 0, 0); PG8_STAGE_A(PG8_SA(1, 1), a1, 1, vC);
            PG8_WAIT_V(8); PG8_WAIT_L(0); PG8_BAR; PG8_MMA(0, 0, At, B0); PG8_MMA(0, 1, At, B1); PG8_BAR; PG8_SCHED;
            PG8_LDA(At, 0, 1); PG8_STAGE(PG8_SB(0, 0), b2, voffB); PG8_STAGE(PG8_SB(0, 1), b2 + hstep, voffB); PG8_STAGE_A(PG8_SA(0, 0), a2, 0, v2);
            PG8_WAIT_V(8); PG8_WAIT_L(0); PG8_BAR; PG8_MMA(1, 0, At, B0); PG8_MMA(1, 1, At, B1); PG8_BAR; PG8_SCHED;
            PG8_LDB(B0, 1, 0); PG8_LDB(B1, 1, 1); PG8_SCHED; PG8_LDA(At, 1, 0); PG8_STAGE_A(PG8_SA(0, 1), a2, 1, v2);
            PG8_WAIT_V(8); PG8_WAIT_L(0); PG8_BAR; PG8_MMA(0, 0, At, B0); PG8_MMA(0, 1, At, B1); PG8_BAR; PG8_SCHED;
            PG8_LDA(At, 1, 1); PG8_STAGE(PG8_SB(1, 0), b3, voffB); PG8_STAGE(PG8_SB(1, 1), b3 + hstep, voffB); PG8_STAGE_A(PG8_SA(1, 0), a3, 0, v2);
            PG8_WAIT_V(8); PG8_WAIT_L(0); PG8_BAR; PG8_MMA(1, 0, At, B0); PG8_MMA(1, 1, At, B1); PG8_BAR; PG8_SCHED;
        }
        if (wr == 0) PG8_BAR;
        E(acc, cur, wr, wc, fr, fq);
        if (!has_next) break;
#pragma unroll
        for (int a = 0; a < 2; ++a)
#pragma unroll
            for (int b = 0; b < 2; ++b)
#pragma unroll
                for (int m = 0; m < 4; ++m)
#pragma unroll
                    for (int n = 0; n < 2; ++n) acc[a][b][m][n] = (f32x4){0.f, 0.f, 0.f, 0.f};
        cur = nxt; cA = nA; cB = nB; ++ui;
        if constexpr (GATHER) {
#pragma unroll
            for (int h = 0; h < 2; ++h) { vC[h][0] = vN[h][0]; vC[h][1] = vN[h][1]; } }
        if (wr == 1) PG8_BAR;
    }
    PG8_WAIT_V(0);
    PG8_BAR;
#undef PG8_SA
#undef PG8_SB
#undef PG8_STAGE
#undef PG8_STAGE_A
#undef PG8_GVOFF
#undef PG8_LDA
#undef PG8_LDB
#undef PG8_MMA
#undef PG8_WAIT_V
#undef PG8_WAIT_L
#undef PG8_BAR
#undef PG8_SCHED
}
}

struct Params { const float* in[25]; float* out; unsigned char* ws; int ph_lo, ph_hi; };
struct Frame {
    LAS unsigned char* lds; int G, bx;
    unsigned char* ws;
    const float *x, *c, *w_ada, *b_ada, *w_in, *b_mgate, *conv_w, *conv_b, *m_norm_g, *w_proj_a, *w_proj_m, *w_gate, *b_gate, *w_out, *ln1_g, *ln1_b, *w_rg, *b_rg, *w_re, *b_re, *w_eg, *w_eu, *w_ed, *ln2_g, *ln2_b;
    float* out;
};
__device__ __forceinline__ int otid() { int t = threadIdx.x; asm volatile("" : "+v"(t)); return t; }
#define FTID otid()
#define FLANE (otid() & 63)
#define FWAVE __builtin_amdgcn_readfirstlane(otid() >> 6)
#define WSP(T_, off) ((T_*)(F.ws + (off)))

#ifndef CVT_SWAP
#define CVT_SWAP 1
#endif
constexpr int N_IT_P0 = 400, N_IT_PX = 112, N_IT_W1 = N_IT_PX + 2048, N_IT_BG = N_IT_W1 + 1024;
constexpr int CVT_P = 544, CVT_BUF = 64 * CVT_P, CVT_RP = 144, CVT_IMG = 2 * CVT_BUF;
constexpr int CW_QHEAD = 4160, CW_QHEAD2 = 4352, CW_DONE2 = 4224, CW_DONE10 = 4288;
struct CvtItem { const float* src; bf16_t* dst; int ld, Kdst, kind, arg, n0, valid; };
__device__ __forceinline__ int cvt_row(int kind, int arg, int n) {
    if (kind == 1) { if (n < 3072) { const int hd = n >> 7, lc = n & 127; return hd * 128 + 2 * (lc & 63) + (lc >> 6); } return n; }
    if (kind == 2) return 256 * (n >> 7) + 128 * arg + (n & 127);
    return n + arg;
}
__device__ __forceinline__ CvtItem cvt_decode_p0(const Frame& F, int item, int lim) {
    CvtItem c; c.valid = (item < lim); c.kind = 0; c.arg = 0;
    if (item < 272) { const int nt = item >> 3, kq = item & 7; c.src = F.w_in + (size_t)(kq * 256) * NIN + nt * 256; c.ld = NIN; c.dst = WSP(bf16_t, WS_WBIG) + kq * 256; c.Kdst = D; c.kind = 1; c.n0 = nt * 256; }
    else if (item < 400) { const int i = item - 272; const int nt = i >> 3, kq = i & 7; c.src = F.w_gate + (size_t)(kq * 256) * 4096 + nt * 256; c.ld = 4096; c.dst = WSP(bf16_t, WS_WBIG) + kq * 256; c.Kdst = D; c.arg = 8704; c.n0 = nt * 256; }
    else if (item < 416) { const int i = item - 400; const int nt = i >> 1, kq = i & 1; c.src = F.w_proj_a + (size_t)(kq * 256) * D + nt * 256; c.ld = D; c.dst = WSP(bf16_t, WS_WPA) + kq * 256; c.Kdst = 512; c.n0 = nt * 256; }
    else if (item < 448) { const int i = item - 416; const int nt = i >> 2, kq = i & 3; c.src = F.w_proj_m + (size_t)(kq * 256) * D + nt * 256; c.ld = D; c.dst = WSP(bf16_t, WS_WPM) + kq * 256; c.Kdst = 1024; c.n0 = nt * 256; }
    else { const int i = (item < 512 ? item : 511) - 448; const int nt = i >> 3, kq = i & 7; c.src = F.w_out + (size_t)(kq * 256) * D + nt * 256; c.ld = D; c.dst = WSP(bf16_t, WS_WO) + kq * 256; c.Kdst = D; c.n0 = nt * 256; }
    return c;
}
__device__ __forceinline__ CvtItem cvt_decode_bg(const Frame& F, int item) {
    if (item < N_IT_PX) return cvt_decode_p0(F, 400 + item, 512);
    CvtItem c; c.valid = (item < N_IT_BG);
    if (item < N_IT_W1) { const int iw = item - N_IT_PX; const int e = iw >> 6, r = iw & 63, mat = r >> 5, kq = (r >> 2) & 7, nt = r & 3;
        c.src = (mat ? F.w_eu : F.w_eg) + (size_t)e * D * FF + (size_t)(kq * 256) * FF + nt * 256; c.ld = FF; c.dst = WSP(bf16_t, WS_W1T) + (size_t)e * 2048 * D + kq * 256; c.Kdst = D; c.kind = 2; c.arg = mat; c.n0 = nt * 256; }
    else { const int i2 = (item < N_IT_BG ? item : N_IT_BG - 1) - N_IT_W1; const int e = i2 >> 5, r = i2 & 31, kq = r >> 3, nt = r & 7;
        c.src = F.w_ed + (size_t)e * FF * D + (size_t)(kq * 256) * D + nt * 256; c.ld = D; c.dst = WSP(bf16_t, WS_W2T) + (size_t)e * D * FF + kq * 256; c.Kdst = FF; c.kind = 0; c.arg = 0; c.n0 = nt * 256; }
    return c;
}
#define CVT_LOAD(R, it, j) do { _Pragma("unroll") for (int _p = 0; _p < 8; ++_p) (R)[_p] = *(const f32x4*)((it).src + (size_t)(64 * (j) + kr + 8 * _p) * (it).ld + n4); } while (0)
template <int MODE>
__device__ __forceinline__ void cvt_stream(const Frame& F, int limit) {
    const int tid = FTID; const int lane = tid & 63, w = __builtin_amdgcn_readfirstlane(tid >> 6), li = lane & 15, g = lane >> 4;
    const int kr = tid >> 6, n4 = 4 * (tid & 63);
    unsigned* qh = (unsigned*)(F.ws + WS_CTL) + (limit <= N_IT_W1 ? CW_QHEAD : CW_QHEAD2); const int ibase = (limit <= N_IT_W1) ? 0 : N_IT_W1;
    volatile LAS int* mb = (volatile LAS int*)(F.lds + LDS_MISC) + 16;
    LAS unsigned char* lbuf = F.lds; LAS unsigned char* wimg = F.lds + CVT_IMG + w * (32 * CVT_RP);
    __syncthreads();
    int i0, i1;
    if (MODE == 0) { i0 = F.bx; i1 = F.bx + F.G; }
    else { if (tid == 0) { const unsigned a0 = atomicAdd(qh, 2u); mb[0] = (int)a0; mb[2] = 0; } __syncthreads(); i0 = ibase + mb[0]; i1 = i0 + 1; if (i0 >= limit) i0 = 0x7fffffff; if (i1 >= limit) i1 = 0x7fffffff; }
    CvtItem cur = (MODE == 0) ? cvt_decode_p0(F, i0, N_IT_P0) : cvt_decode_bg(F, i0), nxt = (MODE == 0) ? cvt_decode_p0(F, i1, N_IT_P0) : cvt_decode_bg(F, i1);
    int inext = i1;
    f32x4 R0[8], R1[8], R2[8], R3[8];
    if (cur.valid) { CVT_LOAD(R0, cur, 0); CVT_LOAD(R1, cur, 1); CVT_LOAD(R2, cur, 2); CVT_LOAD(R3, cur, 3); }
    const unsigned rdbase = (unsigned)(uintptr_t)lbuf + (unsigned)((4 * g + (li >> 2)) * CVT_P + (32 * w + 4 * (li & 3)) * 2);
    while (cur.valid) {
        unsigned cl = 0u;
        if (MODE == 1 && tid == 0) cl = atomicAdd(qh, 1u);
        size_t rofs[4];
#pragma unroll
        for (int i4 = 0; i4 < 4; ++i4) rofs[i4] = (size_t)cvt_row(cur.kind, cur.arg, cur.n0 + 32 * w + 8 * i4 + (lane >> 3)) * cur.Kdst;
#define CVT_PROC(R, j) do { LAS unsigned char* bw = lbuf + ((j) & 1) * CVT_BUF; \
            _Pragma("unroll") for (int _p = 0; _p < 8; ++_p) { u32x2 wv; wv.x = cvt_pk_bf16((R)[_p][0], (R)[_p][1]); wv.y = cvt_pk_bf16((R)[_p][2], (R)[_p][3]); *(LAS u32x2*)(bw + (kr + 8 * _p) * CVT_P + 2 * n4) = wv; } \
            asm volatile("s_waitcnt lgkmcnt(0)\n\ts_barrier" ::: "memory"); \
            if (nxt.valid) CVT_LOAD(R, nxt, j); \
            s16x4 tA[4], tB[4]; const unsigned rb = rdbase + ((j) & 1) * CVT_BUF; \
            _Pragma("unroll") for (int kb = 0; kb < 4; ++kb) { tA[kb] = tr_read_o(rb, kb * 16 * CVT_P); tB[kb] = tr_read_o(rb, kb * 16 * CVT_P + 32); } \
            LGKM_WAIT0(); \
            _Pragma("unroll") for (int kb = 0; kb < 4; ++kb) { union { s16x4 v; unsigned u[2]; } a, b; a.v = tA[kb]; b.v = tB[kb]; \
                auto r0 = __builtin_amdgcn_permlane16_swap(a.u[0], b.u[0], false, false); auto r1 = __builtin_amdgcn_permlane16_swap(a.u[1], b.u[1], false, false); \
                u32x4 o; o.x = r0[0]; o.y = r1[0]; o.z = r0[1]; o.w = r1[1]; \
                *(LAS u32x4*)(wimg + (16 * (g & 1) + li) * CVT_RP + (16 * kb + 8 * (g >> 1)) * 2) = o; } \
            asm volatile("s_waitcnt lgkmcnt(0)" ::: "memory"); \
            _Pragma("unroll") for (int i4 = 0; i4 < 4; ++i4) { const u32x4 o = *(const LAS u32x4*)(wimg + (8 * i4 + (lane >> 3)) * CVT_RP + (lane & 7) * 16); \
                *(u32x4*)(cur.dst + rofs[i4] + 64 * (j) + 8 * (lane & 7)) = o; } } while (0)
        CVT_PROC(R0, 0); CVT_PROC(R1, 1); CVT_PROC(R2, 2); CVT_PROC(R3, 3);
        int i2;
        if (MODE == 0) { i2 = inext + F.G; }
        else { if (tid == 0) mb[0] = (int)cl; asm volatile("s_waitcnt lgkmcnt(0)\n\ts_barrier" ::: "memory"); i2 = ibase + mb[0]; if (i2 >= limit || i2 < 0) i2 = 0x7fffffff; asm volatile("s_waitcnt lgkmcnt(0)\n\ts_barrier" ::: "memory"); }
        cur = nxt; inext = i2; nxt = (MODE == 0) ? cvt_decode_p0(F, i2, N_IT_P0) : cvt_decode_bg(F, i2);
    }
    __syncthreads();
#undef CVT_PROC
}

__device__ __forceinline__ void p0_prologue(const Frame& F) {
    const int G = F.G, bx = F.bx;
    cvt_stream<0>(F, N_IT_P0);
    __syncthreads();
    {
        LAS float* sc = (LAS float*)F.lds;
        LAS float* red = (LAS float*)(F.lds + 32768);
        float* mod = WSP(float, WS_MOD);
        for (int i = FTID; i < NB * D; i += NTHR) { const float cv = F.c[i]; sc[i] = cv / (1.f + expf(-cv)); }
        __syncthreads();
        for (int cb = bx; cb < 6 * D / 48; cb += G) {
            const int cg = FTID % 12, kl = FTID / 12;
            float a[4][4] = {};
            if (kl < 42) {
                for (int k0 = kl; k0 < D; k0 += 42 * 7) { f32x4 w[7];
#pragma unroll
                    for (int u = 0; u < 7; ++u) { const int k = k0 + 42 * u; w[u] = (k < D) ? *(const f32x4*)(F.w_ada + (size_t)k * (6 * D) + cb * 48 + cg * 4) : (f32x4){0.f, 0.f, 0.f, 0.f}; }
#pragma unroll
                    for (int u = 0; u < 7; ++u) { const int k = (k0 + 42 * u < D) ? k0 + 42 * u : 0;
#pragma unroll
                        for (int b = 0; b < 4; ++b) { const float s = sc[b * D + k];
#pragma unroll
                            for (int j = 0; j < 4; ++j) a[b][j] += s * w[u][j]; } } }
#pragma unroll
                for (int b = 0; b < 4; ++b)
#pragma unroll
                    for (int j = 0; j < 4; ++j) red[(kl * 12 + cg) * 16 + b * 4 + j] = a[b][j];
            }
            __syncthreads();
            if (FTID < 192) { const int cgi = FTID / 16, bj = FTID % 16; float s = 0.f; for (int q = 0; q < 42; ++q) s += red[(q * 12 + cgi) * 16 + bj];
                const int b = bj / 4, j = bj % 4; const int col = cb * 48 + cgi * 4 + j; mod[(size_t)b * 6 * D + col] = s + F.b_ada[col]; }
            __syncthreads();
        }
    }
    {
        float* rope = WSP(float, WS_ROPE);
        for (int i = bx * NTHR + FTID; i < S * 64; i += G * NTHR) { const int pos = i >> 6, fi = i & 63;
            const float inv = powf(10000.f, -(float)(2 * fi) / 128.f); const float ang = (float)pos * inv; rope[2 * i] = cosf(ang); rope[2 * i + 1] = sinf(ang); }
        float* wif = WSP(float, WS_WIF);
        for (int i = bx * NTHR + FTID; i < 8 * D; i += G * NTHR) { const int j = i / D, k = i % D; wif[i] = F.w_in[(size_t)k * NIN + OFF_IF + j]; }
        bf16_t* wrt = WSP(bf16_t, WS_WRT);
        for (int i = bx * NTHR + FTID; i < 48 * D; i += G * NTHR) { const int j = i / D, k = i % D;
            const float w = (j < 4) ? F.w_rg[k * 4 + j] : (j < 36 ? F.w_re[k * 32 + (j - 4)] : 0.f);
            const bf16_t hi = f2bf(w); const bf16_t lo = f2bf(w - bf2f(hi)); wrt[i] = hi; wrt[48 * D + i] = lo; }
    }
}

__device__ __forceinline__ void p1_lnmod(const Frame& F) {
    const float* mod = WSP(float, WS_MOD); const float* wif = WSP(float, WS_WIF); bf16_t* U = WSP(bf16_t, WS_U); float* gpre = WSP(float, WS_GPRE);
    const int tid = FTID; const int lane = tid & 63; const int gw = F.bx * NWAVES + __builtin_amdgcn_readfirstlane(tid >> 6), NGW = F.G * NWAVES;
    LAS float* wl = (LAS float*)F.lds;
    __syncthreads();
#pragma unroll
    for (int i = 0; i < 8; ++i) *(LAS f32x4*)(wl + 4 * (tid + NTHR * i)) = *(const f32x4*)(wif + 4 * (tid + NTHR * i));
    __syncthreads();
    f32x4 v[8], nx[8];
    if (gw < T) {
#pragma unroll
        for (int i = 0; i < 8; ++i) nx[i] = *(const f32x4*)(F.x + (size_t)gw * D + 4 * (lane + 64 * i)); }
    for (int t = gw; t < T; t += NGW) {
        const int b = t / S; float s = 0.f;
#pragma unroll
        for (int i = 0; i < 8; ++i) { v[i] = nx[i]; s += (v[i][0] + v[i][1]) + (v[i][2] + v[i][3]); }
        if (t + NGW < T) {
#pragma unroll
            for (int i = 0; i < 8; ++i) nx[i] = *(const f32x4*)(F.x + (size_t)(t + NGW) * D + 4 * (lane + 64 * i)); }
        const float mu = wave_sum(s) * (1.f / D);
        float q = 0.f;
#pragma unroll
        for (int i = 0; i < 8; ++i) { v[i] = v[i] - mu; q += (v[i][0] * v[i][0] + v[i][1] * v[i][1]) + (v[i][2] * v[i][2] + v[i][3] * v[i][3]); }
        const float rstd = rsqrtf(wave_sum(q) * (1.f / D) + LN_EPS);
        const float* sc = mod + (size_t)b * 6 * D + 1 * D; const float* sf = mod + (size_t)b * 6 * D;
#pragma unroll
        for (int i = 0; i < 8; ++i) { const int d = 4 * (lane + 64 * i); const f32x4 a = *(const f32x4*)(sc + d), bb = *(const f32x4*)(sf + d);
            v[i] = v[i] * rstd * (a + 1.f) + bb;
            u32x2 w; w.x = cvt_pk_bf16(v[i][0], v[i][1]); w.y = cvt_pk_bf16(v[i][2], v[i][3]); *(u32x2*)(U + (size_t)t * D + d) = w; }
        float g[8];
#pragma unroll
        for (int j = 0; j < 8; ++j) { float a = 0.f;
#pragma unroll
            for (int i = 0; i < 8; ++i) { const f32x4 w = *(const LAS f32x4*)(wl + j * D + 4 * (lane + 64 * i)); a += (v[i][0] * w[0] + v[i][1] * w[1]) + (v[i][2] * w[2] + v[i][3] * w[3]); }
            g[j] = wave_sum(a); }
        if (lane < 8) { float val = 0.f;
#pragma unroll
            for (int j = 0; j < 8; ++j) val = (lane == j) ? g[j] : val;
            val += F.b_mgate[lane];
            if (lane >= 4) val = fminf(val, 0.f) - log1pf(expf(-fabsf(val)));
            gpre[(size_t)t * 8 + lane] = val; }
    }
}

struct EpiP2 {
    static constexpr bool PERM = true;
    bf16_t *Q, *Kb, *V, *QKP, *VM, *OG, *GB; const float* rope; const float* b_gate;
    __device__ __forceinline__ void operator()(const f32x4 (&acc)[2][2][4][2], const pg8::Unit& u, int wr, int wc, int fr, int fq) const {
        const int pn = u.pn; int kind, coff, ldc; bf16_t* base;
        if (pn < 6) { kind = 0; base = Q; ldc = 1536; coff = pn * 256; }
        else if (pn < 12) { kind = 1; base = Kb; ldc = 1536; coff = (pn - 6) * 256; }
        else if (pn < 18) { kind = 2; base = V; ldc = 1536; coff = (pn - 12) * 256; }
        else if (pn < 26) { kind = 2; base = QKP; ldc = 2048; coff = (pn - 18) * 256; }
        else if (pn < 30) { kind = 2; base = VM; ldc = 1024; coff = (pn - 26) * 256; }
        else if (pn < 34) { kind = 3; base = OG; ldc = 1024; coff = (pn - 30) * 256; }
        else { kind = 4; base = GB; ldc = 4096; coff = (pn - 34) * 256; }
        const int row0 = u.pm * 256 + wr * 64 + fr, colL = wc * 32 + 8 * fq;
#pragma unroll
        for (int ai = 0; ai < 2; ++ai)
#pragma unroll
            for (int m = 0; m < 4; ++m) { const int r = row0 + ai * 128 + m * 16; const int pos = r & (S - 1);
#pragma unroll
                for (int bj = 0; bj < 2; ++bj) { f32x4 v0 = acc[ai][bj][m][0], v1 = acc[ai][bj][m][1]; const int col = coff + bj * 128 + colL;
                    if (kind <= 1) {
                        const float* rp = rope + ((size_t)pos * 64 + (16 * wc + 4 * fq)) * 2;
                        const f32x4 c0 = *(const f32x4*)rp, c1 = *(const f32x4*)(rp + 4);
                        const float sc = (kind == 0) ? QSCALE : 1.f;
                        f32x4 o0, o1;
                        o0[0] = (v0[0] * c0[0] - v0[1] * c0[1]) * sc; o0[1] = (v0[1] * c0[0] + v0[0] * c0[1]) * sc;
                        o0[2] = (v0[2] * c0[2] - v0[3] * c0[3]) * sc; o0[3] = (v0[3] * c0[2] + v0[2] * c0[3]) * sc;
                        o1[0] = (v1[0] * c1[0] - v1[1] * c1[1]) * sc; o1[1] = (v1[1] * c1[0] + v1[0] * c1[1]) * sc;
                        o1[2] = (v1[2] * c1[2] - v1[3] * c1[3]) * sc; o1[3] = (v1[3] * c1[2] + v1[2] * c1[3]) * sc;
                        v0 = o0; v1 = o1;
                    } else if (kind >= 3) {
                        if (kind == 4) { v0 = v0 + *(const f32x4*)(b_gate + col); v1 = v1 + *(const f32x4*)(b_gate + col + 4); }
#pragma unroll
                        for (int j = 0; j < 4; ++j) { v0[j] = sigmoid_fast(v0[j]); v1[j] = sigmoid_fast(v1[j]); }
                    }
                    u32x4 w; w.x = cvt_pk_bf16(v0[0], v0[1]); w.y = cvt_pk_bf16(v0[2], v0[3]); w.z = cvt_pk_bf16(v1[0], v1[1]); w.w = cvt_pk_bf16(v1[2], v1[3]);
                    *(u32x4*)(base + (size_t)r * ldc + col) = w; } }
    }
};

__device__ __forceinline__ void scan_bh(const Frame& F, int bh) {
    const float* gpre = WSP(float, WS_GPRE); float* bc = WSP(float, WS_BCUM) + (size_t)bh * S; float* mc = WSP(float, WS_MCUM) + (size_t)bh * S;
    const int b = bh >> 2, h = bh & 3, lane = FLANE;
    float lf[32], iv[32];
#pragma unroll
    for (int j = 0; j < 32; ++j) { const size_t t = (size_t)b * S + lane * 32 + j; iv[j] = gpre[t * 8 + h]; lf[j] = gpre[t * 8 + 4 + h]; }
    float run = 0.f;
#pragma unroll
    for (int j = 0; j < 32; ++j) { run += lf[j]; lf[j] = run; }
    float tot = run, incl = run;
#pragma unroll
    for (int o = 1; o < 64; o <<= 1) { const float n = __shfl_up(incl, o); if (lane >= o) incl += n; }
    const float excl = incl - tot;
    float mx = -INFINITY;
#pragma unroll
    for (int j = 0; j < 32; ++j) { lf[j] += excl; mx = fmaxf(mx, iv[j] - lf[j]); iv[j] = mx; }
    float mincl = mx;
#pragma unroll
    for (int o = 1; o < 64; o <<= 1) { const float n = __shfl_up(mincl, o); if (lane >= o) mincl = fmaxf(mincl, n); }
    float mexcl = __shfl_up(mincl, 1); if (lane == 0) mexcl = -INFINITY;
#pragma unroll
    for (int j = 0; j < 32; ++j) { const float cm = fmaxf(0.f, fmaxf(mexcl, iv[j])); bc[lane * 32 + j] = lf[j]; mc[lane * 32 + j] = lf[j] + cm; }
}

__device__ __forceinline__ void p3_conv(const Frame& F) {
    const bf16_t* QKP = WSP(bf16_t, WS_QKP); bf16_t* QM = WSP(bf16_t, WS_QM); bf16_t* KM = WSP(bf16_t, WS_KM);
    for (int item = F.bx * NTHR + FTID; item < 256 * 512; item += F.G * NTHR) {
        const int cc = item & 255, rs = item >> 8; const int c0 = cc * 8, t0 = rs * 16;
        float w[4][8], bias[8];
#pragma unroll
        for (int j = 0; j < 4; ++j) { const f32x4 a = *(const f32x4*)(F.conv_w + j * 2048 + c0), b = *(const f32x4*)(F.conv_w + j * 2048 + c0 + 4);
#pragma unroll
            for (int e = 0; e < 4; ++e) { w[j][e] = a[e]; w[j][4 + e] = b[e]; } }
        { const f32x4 a = *(const f32x4*)(F.conv_b + c0), b = *(const f32x4*)(F.conv_b + c0 + 4);
#pragma unroll
            for (int e = 0; e < 4; ++e) { bias[e] = a[e]; bias[4 + e] = b[e]; } }
        float x1[8], x2[8], x3[8];
        const int pos0 = t0 & (S - 1);
        auto ldrow = [&](int t, float (&dst)[8]) { const u32x4 v = *(const u32x4*)(QKP + (size_t)t * 2048 + c0);
            dst[0] = bf_lo(v.x); dst[1] = bf_hi(v.x); dst[2] = bf_lo(v.y); dst[3] = bf_hi(v.y); dst[4] = bf_lo(v.z); dst[5] = bf_hi(v.z); dst[6] = bf_lo(v.w); dst[7] = bf_hi(v.w); };
        if (pos0 >= 3) { ldrow(t0 - 1, x1); ldrow(t0 - 2, x2); ldrow(t0 - 3, x3); }
        else {
#pragma unroll
            for (int e = 0; e < 8; ++e) { x1[e] = 0.f; x2[e] = 0.f; x3[e] = 0.f; } }
        const bool isk = c0 >= 1024; bf16_t* dst = isk ? (KM + (c0 - 1024)) : (QM + c0); const float osc = isk ? 0.0625f : 1.f;
#pragma unroll 4
        for (int r = 0; r < 16; ++r) { float x0[8]; ldrow(t0 + r, x0); float y[8];
#pragma unroll
            for (int e = 0; e < 8; ++e) { y[e] = bias[e] + w[3][e] * x0[e] + w[2][e] * x1[e] + w[1][e] * x2[e] + w[0][e] * x3[e]; y[e] = silu_fast(y[e]) * osc; x3[e] = x2[e]; x2[e] = x1[e]; x1[e] = x0[e]; }
            u32x4 o; o.x = cvt_pk_bf16(y[0], y[1]); o.y = cvt_pk_bf16(y[2], y[3]); o.z = cvt_pk_bf16(y[4], y[5]); o.w = cvt_pk_bf16(y[6], y[7]);
            *(u32x4*)(dst + (size_t)(t0 + r) * 1024) = o; }
    }
}

constexpr int AT_KP = 272, AT_VP = 288, AT_VOFF = 256 * AT_KP;
struct AttnDec { int b, head, dl, r, n; };
__device__ __forceinline__ AttnDec attn_decode(int unit) {
    AttnDec a; a.b = unit / 192; const int rem = unit % 192; a.head = rem >> 4; const int blk = rem & 15;
    const int g = a.head >> 2; a.dl = (g == 0) ? 0 : (g == 1 ? 2 : 4); const int nbr = 16 >> a.dl; a.r = blk / nbr; a.n = blk % nbr; return a;
}
#define ATTN_PREFETCH(A, kv, vv) do { _Pragma("unroll") for (int i = 0; i < 8; ++i) { const int id = tid + NTHR * i; const int row = id >> 4, ch = id & 15; const int bn = (row < 128) ? (A).n - 1 : (A).n; const int lr = row & 127; \
        const int pos = ((bn * 128 + lr) << (A).dl) + (A).r; const size_t so = (size_t)((A).b * S + pos) * 1536 + (A).head * 128 + ch * 8; \
        (kv)[i] = (bn >= 0) ? *(const u32x4*)(KB + so) : (u32x4){0u, 0u, 0u, 0u}; (vv)[i] = (bn >= 0) ? *(const u32x4*)(VB + so) : (u32x4){0u, 0u, 0u, 0u}; } } while (0)
__device__ __forceinline__ void attn_phase(const Frame& F) {
    const bf16_t* QB = WSP(bf16_t, WS_QB); const bf16_t* KB = WSP(bf16_t, WS_KB); const bf16_t* VB = WSP(bf16_t, WS_VB); bf16_t* OA = WSP(bf16_t, WS_OATT); float* LSE = WSP(float, WS_LSE);
    const int tid = FTID; const int lane = tid & 63, w = __builtin_amdgcn_readfirstlane(tid >> 6), jl = lane & 15, g4 = lane >> 4;
    LAS unsigned char* Ks = F.lds; LAS unsigned char* Vs = F.lds + AT_VOFF;
    int unit = F.bx; if (unit >= 768) return;
    u32x4 kv[8], vv[8];
    { const AttnDec A0 = attn_decode(unit); ATTN_PREFETCH(A0, kv, vv); }
  for (; unit < 768; unit += F.G) {
    const AttnDec A = attn_decode(unit); const int b = A.b, head = A.head, dl = A.dl, r = A.r, n = A.n;
    __syncthreads();
#pragma unroll
    for (int i = 0; i < 8; ++i) { const int id = tid + NTHR * i; const int row = id >> 4, ch = id & 15;
        *(LAS u32x4*)(Ks + row * AT_KP + ch * 16) = kv[i]; *(LAS u32x4*)(Vs + row * AT_VP + ch * 16) = vv[i]; }
    const int posq = (((n * 128 + 16 * w + jl)) << dl) + r;
    const size_t tq = (size_t)b * S + posq;
    bf16x8 qf[4];
#pragma unroll
    for (int ks = 0; ks < 4; ++ks) qf[ks] = *(const bf16x8*)(QB + tq * 1536 + head * 128 + ks * 32 + 8 * g4);
    __syncthreads();
    if (unit + F.G < 768) { const AttnDec A1 = attn_decode(unit + F.G); ATTN_PREFETCH(A1, kv, vv); }
    f32x4 sT[10];
#pragma unroll
    for (int u = 0; u < 9; ++u) { f32x4 a = {0.f, 0.f, 0.f, 0.f};
#pragma unroll
        for (int ks = 0; ks < 4; ++ks) { const bf16x8 kf = *(const LAS bf16x8*)(Ks + (16 * (w + u) + jl) * AT_KP + (ks * 32 + 8 * g4) * 2); a = __builtin_amdgcn_mfma_f32_16x16x32_bf16(kf, qf[ks], a, 0, 0, 0); }
        sT[u] = a; }
    sT[9] = (f32x4){0.f, 0.f, 0.f, 0.f};
    float mx = -INFINITY;
#pragma unroll
    for (int u = 0; u < 9; ++u)
#pragma unroll
        for (int rg = 0; rg < 4; ++rg) { const int kin = 4 * g4 + rg; bool valid;
            if (u == 0) valid = (n > 0) && (kin >= jl); else if (u == 8) valid = (kin <= jl); else valid = (w + u >= 8) || (n > 0);
            const float s = valid ? sT[u][rg] : -INFINITY; sT[u][rg] = s; mx = fmaxf(mx, s); }
    mx = fmaxf(mx, __shfl_xor(mx, 16)); mx = fmaxf(mx, __shfl_xor(mx, 32));
    float den = 0.f;
#pragma unroll
    for (int u = 0; u < 9; ++u)
#pragma unroll
        for (int rg = 0; rg < 4; ++rg) { const float p = fast_exp2(sT[u][rg] - mx); sT[u][rg] = p; den += p; }
    den += __shfl_xor(den, 16); den += __shfl_xor(den, 32);
    f32x4 oT[8];
#pragma unroll
    for (int et = 0; et < 8; ++et) oT[et] = (f32x4){0.f, 0.f, 0.f, 0.f};
    const unsigned vbase = (unsigned)(uintptr_t)(Vs) + (unsigned)((4 * g4 + (jl >> 2)) * AT_VP + (jl & 3) * 8);
#pragma unroll
    for (int c = 0; c < 5; ++c) {
        const int kt0 = w + 2 * c, kt1 = (c == 4) ? kt0 : kt0 + 1;
        union { bf16x8 v; unsigned u[4]; } pf;
        pf.u[0] = cvt_pk_bf16(sT[2 * c][0], sT[2 * c][1]); pf.u[1] = cvt_pk_bf16(sT[2 * c][2], sT[2 * c][3]);
        pf.u[2] = cvt_pk_bf16(sT[2 * c + 1][0], sT[2 * c + 1][1]); pf.u[3] = cvt_pk_bf16(sT[2 * c + 1][2], sT[2 * c + 1][3]);
        s16x4 t0[8], t1[8];
        const unsigned vb0 = vbase + kt0 * 16 * AT_VP, vb1 = vbase + kt1 * 16 * AT_VP;
#pragma unroll
        for (int et = 0; et < 8; ++et) { t0[et] = tr_read_o(vb0, et * 32); t1[et] = tr_read_o(vb1, et * 32); }
        LGKM_WAIT0();
#pragma unroll
        for (int et = 0; et < 8; ++et) oT[et] = __builtin_amdgcn_mfma_f32_16x16x32_bf16(PK8(t0[et], t1[et]), pf.v, oT[et], 0, 0, 0);
    }
    const float inv = 1.f / den;
#pragma unroll
    for (int et = 0; et < 8; ++et) { u32x2 o; o.x = cvt_pk_bf16(oT[et][0] * inv, oT[et][1] * inv); o.y = cvt_pk_bf16(oT[et][2] * inv, oT[et][3] * inv);
        *(u32x2*)(OA + tq * 1536 + head * 128 + 16 * et + 4 * g4) = o; }
    if (g4 == 0) LSE[tq * 12 + head] = (mx + log2f(den)) * LN2;
  }
}

constexpr int ML_P = 544;
__device__ __forceinline__ void mlstm_dc_unit(const Frame& F, int unit) {
    const bf16_t* KM = WSP(bf16_t, WS_KM); const bf16_t* VM = WSP(bf16_t, WS_VMB); const float* gpre = WSP(float, WS_GPRE);
    const float* bcum = WSP(float, WS_BCUM); const float* mcum = WSP(float, WS_MCUM); bf16_t* DC = WSP(bf16_t, WS_DC) + (size_t)unit * 65536; float* DN = WSP(float, WS_DN) + (size_t)unit * 256;
    const int bh = unit >> 4, c = unit & 15, b = bh >> 2, h = bh & 3; const size_t t0 = (size_t)b * S + c * 128;
    const int tid = FTID, lane = FLANE, w = FWAVE, jl = lane & 15, g4 = lane >> 4;
    LAS unsigned char* Ks = F.lds; LAS unsigned char* Vs = F.lds + 128 * ML_P; LAS float* wt = (LAS float*)(F.lds + 2 * 128 * ML_P);
    __syncthreads();
    if (tid < 128) { const float Be = bcum[bh * S + c * 128 + 127], me = mcum[bh * S + c * 128 + 127];
        wt[tid] = expf(Be - bcum[bh * S + c * 128 + tid] + gpre[(t0 + tid) * 8 + h] - me); }
    __syncthreads();
    {
        u32x4 v[8];
#pragma unroll
        for (int i = 0; i < 8; ++i) { const int id = tid + NTHR * i; const int row = id >> 5, ch = id & 31; v[i] = *(const u32x4*)(KM + (t0 + row) * 1024 + h * 256 + ch * 8); }
#pragma unroll
        for (int i = 0; i < 8; ++i) { const int id = tid + NTHR * i; const int row = id >> 5, ch = id & 31; *(LAS u32x4*)(Ks + row * ML_P + ch * 16) = v[i]; }
#pragma unroll
        for (int i = 0; i < 8; ++i) { const int id = tid + NTHR * i; const int row = id >> 5, ch = id & 31; v[i] = *(const u32x4*)(VM + (t0 + row) * 1024 + h * 256 + ch * 8); }
#pragma unroll
        for (int i = 0; i < 8; ++i) { const int id = tid + NTHR * i; const int row = id >> 5, ch = id & 31; const float ws_ = wt[row]; u32x4 o;
            o.x = cvt_pk_bf16(bf_lo(v[i].x) * ws_, bf_hi(v[i].x) * ws_); o.y = cvt_pk_bf16(bf_lo(v[i].y) * ws_, bf_hi(v[i].y) * ws_);
            o.z = cvt_pk_bf16(bf_lo(v[i].z) * ws_, bf_hi(v[i].z) * ws_); o.w = cvt_pk_bf16(bf_lo(v[i].w) * ws_, bf_hi(v[i].w) * ws_);
            *(LAS u32x4*)(Vs + row * ML_P + ch * 16) = o; }
    }
    __syncthreads();
    if (tid < 256) { float a = 0.f; for (int s = 0; s < 128; ++s) a += wt[s] * bf2f(*(const LAS bf16_t*)(Ks + s * ML_P + tid * 2)); DN[tid] = a; }
    const int vr = w >> 1, kr = w & 1;
    f32x4 acc[4][8];
#pragma unroll
    for (int i = 0; i < 4; ++i)
#pragma unroll
        for (int j = 0; j < 8; ++j) acc[i][j] = (f32x4){0.f, 0.f, 0.f, 0.f};
    const unsigned rowoff = (unsigned)((4 * g4 + (jl >> 2)) * ML_P + (jl & 3) * 8);
    const unsigned kb = (unsigned)(uintptr_t)Ks + rowoff + kr * 256, vb = (unsigned)(uintptr_t)Vs + rowoff + vr * 128;
#pragma unroll 1
    for (int ks = 0; ks < 4; ++ks) {
        s16x4 a0[4], a1[4], b0[8], b1[8];
#pragma unroll
        for (int i = 0; i < 4; ++i) { a0[i] = tr_read_o(vb + ks * 32 * ML_P, i * 32); a1[i] = tr_read_o(vb + ks * 32 * ML_P, 16 * ML_P + i * 32); }
#pragma unroll
        for (int j = 0; j < 8; ++j) { b0[j] = tr_read_o(kb + ks * 32 * ML_P, j * 32); b1[j] = tr_read_o(kb + ks * 32 * ML_P, 16 * ML_P + j * 32); }
        LGKM_WAIT0();
#pragma unroll
        for (int i = 0; i < 4; ++i)
#pragma unroll
            for (int j = 0; j < 8; ++j) acc[i][j] = __builtin_amdgcn_mfma_f32_16x16x32_bf16(PK8(b0[j], b1[j]), PK8(a0[i], a1[i]), acc[i][j], 0, 0, 0);
    }
#pragma unroll
    for (int i = 0; i < 4; ++i)
#pragma unroll
        for (int j = 0; j < 8; ++j) { u32x2 o; o.x = cvt_pk_bf16(acc[i][j][0], acc[i][j][1]); o.y = cvt_pk_bf16(acc[i][j][2], acc[i][j][3]);
            *(u32x2*)(DC + (size_t)(16 * (4 * vr + i) + jl) * 256 + 16 * (8 * kr + j) + 4 * g4) = o; }
}

__device__ __forceinline__ float chunk_decay(const float* bcum, const float* mcum, int bh, int c) {
    const float Be = bcum[bh * S + c * 128 + 127], me = mcum[bh * S + c * 128 + 127];
    const float Bp = (c > 0) ? bcum[bh * S + c * 128 - 1] : 0.f, mp = (c > 0) ? mcum[bh * S + c * 128 - 1] : 0.f;
    return expf(Be - Bp + mp - me);
}
__device__ __forceinline__ void p5_scan_mix(const Frame& F) {
    const float* bcum = WSP(float, WS_BCUM); const float* mcum = WSP(float, WS_MCUM);
    const bf16_t* DC = WSP(bf16_t, WS_DC); bf16_t* CST = WSP(bf16_t, WS_CST); const float* DN = WSP(float, WS_DN); float* NST = WSP(float, WS_NST);
    const int gt = F.bx * NTHR + FTID, NG = F.G * NTHR;
    for (int item = gt; item < 16 * 8192; item += NG) {
        const int bh = item >> 13, e8 = item & 8191;
        f32x4 c0 = {0.f, 0.f, 0.f, 0.f}, c1 = {0.f, 0.f, 0.f, 0.f};
#pragma unroll 5
        for (int c = 0; c < 15; ++c) { const float dec = chunk_decay(bcum, mcum, bh, c);
            const u32x4 dq = *(const u32x4*)(DC + (size_t)(bh * 16 + c) * 65536 + e8 * 8); const f32x4 d0 = {bf_lo(dq.x), bf_hi(dq.x), bf_lo(dq.y), bf_hi(dq.y)}, d1 = {bf_lo(dq.z), bf_hi(dq.z), bf_lo(dq.w), bf_hi(dq.w)};
            c0 = c0 * dec + d0; c1 = c1 * dec + d1;
            u32x4 o; o.x = cvt_pk_bf16(c0[0], c0[1]); o.y = cvt_pk_bf16(c0[2], c0[3]); o.z = cvt_pk_bf16(c1[0], c1[1]); o.w = cvt_pk_bf16(c1[2], c1[3]);
            *(u32x4*)(CST + (size_t)(bh * 16 + c + 1) * 65536 + e8 * 8) = o; }
    }
    for (int item = gt; item < 16 * 256; item += NG) { const int bh = item >> 8, k = item & 255; float n = 0.f;
        for (int c = 0; c < 15; ++c) { n = n * chunk_decay(bcum, mcum, bh, c) + DN[(size_t)(bh * 16 + c) * 256 + k]; NST[(size_t)(bh * 16 + c + 1) * 256 + k] = n; } }
    const bf16_t* OA = WSP(bf16_t, WS_OATT); const float* LSE = WSP(float, WS_LSE); bf16_t* YA = WSP(bf16_t, WS_YA);
    for (int item = gt; item < T * 64; item += NG) { const int t = item >> 6, h = (item >> 4) & 3, e8 = item & 15;
        const float l0 = LSE[(size_t)t * 12 + h], l1 = LSE[(size_t)t * 12 + 4 + h], l2 = LSE[(size_t)t * 12 + 8 + h];
        const float ml = fmaxf(l0, fmaxf(l1, l2)); float w0 = expf(l0 - ml), w1 = expf(l1 - ml), w2 = expf(l2 - ml); const float ws_ = 1.f / (w0 + w1 + w2); w0 *= ws_; w1 *= ws_; w2 *= ws_;
        const u32x4 a = *(const u32x4*)(OA + (size_t)t * 1536 + h * 128 + e8 * 8), bq = *(const u32x4*)(OA + (size_t)t * 1536 + (4 + h) * 128 + e8 * 8), cq = *(const u32x4*)(OA + (size_t)t * 1536 + (8 + h) * 128 + e8 * 8);
        u32x4 o;
        o.x = cvt_pk_bf16(w0 * bf_lo(a.x) + w1 * bf_lo(bq.x) + w2 * bf_lo(cq.x), w0 * bf_hi(a.x) + w1 * bf_hi(bq.x) + w2 * bf_hi(cq.x));
        o.y = cvt_pk_bf16(w0 * bf_lo(a.y) + w1 * bf_lo(bq.y) + w2 * bf_lo(cq.y), w0 * bf_hi(a.y) + w1 * bf_hi(bq.y) + w2 * bf_hi(cq.y));
        o.z = cvt_pk_bf16(w0 * bf_lo(a.z) + w1 * bf_lo(bq.z) + w2 * bf_lo(cq.z), w0 * bf_hi(a.z) + w1 * bf_hi(bq.z) + w2 * bf_hi(cq.z));
        o.w = cvt_pk_bf16(w0 * bf_lo(a.w) + w1 * bf_lo(bq.w) + w2 * bf_lo(cq.w), w0 * bf_hi(a.w) + w1 * bf_hi(bq.w) + w2 * bf_hi(cq.w));
        *(u32x4*)(YA + (size_t)t * 512 + h * 128 + e8 * 8) = o; }
}

constexpr int MO_KP = 528, MO_VOFF = 128 * MO_KP, MO_TAB = MO_VOFF + 128 * ML_P;
__device__ __forceinline__ void mlstm_out_unit(const Frame& F, int unit) {
    const bf16_t* QM = WSP(bf16_t, WS_QM); const bf16_t* KM = WSP(bf16_t, WS_KM); const bf16_t* VM = WSP(bf16_t, WS_VMB); const bf16_t* OG = WSP(bf16_t, WS_OGB);
    const bf16_t* CST = WSP(bf16_t, WS_CST) + (size_t)unit * 65536; const float* NST = WSP(float, WS_NST) + (size_t)unit * 256; bf16_t* YM = WSP(bf16_t, WS_YM);
    const float* gpre = WSP(float, WS_GPRE); const float* bcum = WSP(float, WS_BCUM); const float* mcum = WSP(float, WS_MCUM);
    const int bh = unit >> 4, c = unit & 15, b = bh >> 2, h = bh & 3; const size_t t0 = (size_t)b * S + c * 128;
    const int tid = FTID, lane = FLANE, w = FWAVE, jl = lane & 15, g4 = lane >> 4;
    LAS unsigned char* RA = F.lds; LAS unsigned char* RB = F.lds + MO_VOFF; LAS float* cs = (LAS float*)(F.lds + MO_TAB); LAS float* ntab = cs + 128;
    __syncthreads();
    {
        u32x4 v[8];
#pragma unroll
        for (int i = 0; i < 8; ++i) { const int id = tid + NTHR * i; const int row = id >> 5, ch = id & 31; v[i] = *(const u32x4*)(KM + (t0 + row) * 1024 + h * 256 + ch * 8); }
#pragma unroll
        for (int i = 0; i < 8; ++i) { const int id = tid + NTHR * i; const int row = id >> 5, ch = id & 31; *(LAS u32x4*)(RA + row * MO_KP + ch * 16) = v[i]; }
#pragma unroll
        for (int i = 0; i < 8; ++i) { const int id = tid + NTHR * i; const int row = id >> 5, ch = id & 31; v[i] = *(const u32x4*)(VM + (t0 + row) * 1024 + h * 256 + ch * 8); }
#pragma unroll
        for (int i = 0; i < 8; ++i) { const int id = tid + NTHR * i; const int row = id >> 5, ch = id & 31; *(LAS u32x4*)(RB + row * ML_P + ch * 16) = v[i]; }
        if (tid < 128) cs[tid] = (gpre[(t0 + tid) * 8 + h] - bcum[bh * S + c * 128 + tid]) * LOG2E;
        if (tid >= 128 && tid < 384) ntab[tid - 128] = (c > 0) ? NST[tid - 128] : 0.f;
    }
    const int tl = 16 * w + jl; const size_t t = t0 + tl;
    const float Bt = bcum[bh * S + c * 128 + tl], mt = mcum[bh * S + c * 128 + tl];
    const float Bp = (c > 0) ? bcum[bh * S + c * 128 - 1] : 0.f, mp = (c > 0) ? mcum[bh * S + c * 128 - 1] : 0.f;
    const float at = (Bt - mt) * LOG2E; const float inter = fast_exp2((Bt - Bp + mp - mt) * LOG2E);
    union QF { bf16x8 v; unsigned u[4]; }; QF qf[8];
#pragma unroll
    for (int ks = 0; ks < 8; ++ks) qf[ks].v = *(const bf16x8*)(QM + t * 1024 + h * 256 + ks * 32 + 8 * g4);
    __syncthreads();
    f32x4 sT[8];
#pragma unroll
    for (int st = 0; st < 8; ++st) { f32x4 a = {0.f, 0.f, 0.f, 0.f};
        if (st <= w) {
#pragma unroll
            for (int ks = 0; ks < 8; ++ks) { const bf16x8 kf = *(const LAS bf16x8*)(RA + (16 * st + jl) * MO_KP + (ks * 32 + 8 * g4) * 2); a = __builtin_amdgcn_mfma_f32_16x16x32_bf16(kf, qf[ks].v, a, 0, 0, 0); } }
        sT[st] = a; __builtin_amdgcn_sched_barrier(0); }
    float dsum = 0.f;
#pragma unroll
    for (int st = 0; st < 8; ++st) { const f32x4 cv = *(const LAS f32x4*)(cs + 16 * st + 4 * g4);
#pragma unroll
        for (int rg = 0; rg < 4; ++rg) { const bool valid = (st < w) || (st == w && (4 * g4 + rg) <= jl); const float f = valid ? fast_exp2(fminf(at + cv[rg], 0.f)) : 0.f; const float sv = sT[st][rg] * f; sT[st][rg] = sv; dsum += sv; } }
    dsum += __shfl_xor(dsum, 16); dsum += __shfl_xor(dsum, 32);
    float nq = 0.f;
#pragma unroll
    for (int ks = 0; ks < 8; ++ks) { const f32x4 n0 = *(const LAS f32x4*)(ntab + ks * 32 + 8 * g4), n1 = *(const LAS f32x4*)(ntab + ks * 32 + 8 * g4 + 4);
        nq += bf_lo(qf[ks].u[0]) * n0[0] + bf_hi(qf[ks].u[0]) * n0[1] + bf_lo(qf[ks].u[1]) * n0[2] + bf_hi(qf[ks].u[1]) * n0[3]
            + bf_lo(qf[ks].u[2]) * n1[0] + bf_hi(qf[ks].u[2]) * n1[1] + bf_lo(qf[ks].u[3]) * n1[2] + bf_hi(qf[ks].u[3]) * n1[3]; }
    nq += __shfl_xor(nq, 16); nq += __shfl_xor(nq, 32);
    const float den = dsum + inter * nq;
    f32x4 acc[16];
#pragma unroll
    for (int vt = 0; vt < 16; ++vt) acc[vt] = (f32x4){0.f, 0.f, 0.f, 0.f};
    const unsigned vbase = (unsigned)(uintptr_t)RB + (unsigned)((4 * g4 + (jl >> 2)) * ML_P + (jl & 3) * 8);
#pragma unroll
    for (int c4 = 0; c4 < 4; ++c4) {
        if (2 * c4 <= w) {
            union { bf16x8 v; unsigned u[4]; } pf;
            pf.u[0] = cvt_pk_bf16(sT[2 * c4][0], sT[2 * c4][1]); pf.u[1] = cvt_pk_bf16(sT[2 * c4][2], sT[2 * c4][3]);
            pf.u[2] = cvt_pk_bf16(sT[2 * c4 + 1][0], sT[2 * c4 + 1][1]); pf.u[3] = cvt_pk_bf16(sT[2 * c4 + 1][2], sT[2 * c4 + 1][3]);
#pragma unroll
            for (int hb = 0; hb < 2; ++hb) {
                s16x4 a0[8], a1[8];
#pragma unroll
                for (int i = 0; i < 8; ++i) { a0[i] = tr_read_o(vbase, c4 * 32 * ML_P + (hb * 8 + i) * 32); a1[i] = tr_read_o(vbase, (c4 * 32 + 16) * ML_P + (hb * 8 + i) * 32); }
                LGKM_WAIT0();
#pragma unroll
                for (int i = 0; i < 8; ++i) acc[hb * 8 + i] = __builtin_amdgcn_mfma_f32_16x16x32_bf16(PK8(a0[i], a1[i]), pf.v, acc[hb * 8 + i], 0, 0, 0);
            }
        }
    }
    if (c > 0) {
#pragma unroll
        for (int ks = 0; ks < 8; ++ks)
#pragma unroll
            for (int j = 0; j < 4; ++j) qf[ks].u[j] = cvt_pk_bf16(bf_lo(qf[ks].u[j]) * inter, bf_hi(qf[ks].u[j]) * inter);
#pragma unroll
        for (int half = 0; half < 2; ++half) {
            __syncthreads();
            u32x4 v[8];
#pragma unroll
            for (int i = 0; i < 8; ++i) { const int id = tid + NTHR * i; const int row = id >> 5, ch = id & 31; v[i] = *(const u32x4*)(CST + (size_t)(half * 128 + row) * 256 + ch * 8); }
#pragma unroll
            for (int i = 0; i < 8; ++i) { const int id = tid + NTHR * i; const int row = id >> 5, ch = id & 31; *(LAS u32x4*)(RA + row * MO_KP + ch * 16) = v[i]; }
            __syncthreads();
#pragma unroll
            for (int vt = 0; vt < 8; ++vt)
#pragma unroll
                for (int ks = 0; ks < 8; ++ks) { const bf16x8 cf = *(const LAS bf16x8*)(RA + (16 * vt + jl) * MO_KP + (ks * 32 + 8 * g4) * 2);
                    acc[half * 8 + vt] = __builtin_amdgcn_mfma_f32_16x16x32_bf16(cf, qf[ks].v, acc[half * 8 + vt], 0, 0, 0); if (ks == 7) __builtin_amdgcn_sched_barrier(0); }
        }
    }
    const float rden = 1.f / fmaxf(fabsf(den), fast_exp2(-mt * LOG2E));
    float sm = 0.f;
#pragma unroll
    for (int vt = 0; vt < 16; ++vt) { const u32x2 og = *(const u32x2*)(OG + t * 1024 + h * 256 + 16 * vt + 4 * g4);
        acc[vt][0] *= rden * bf_lo(og.x); acc[vt][1] *= rden * bf_hi(og.x); acc[vt][2] *= rden * bf_lo(og.y); acc[vt][3] *= rden * bf_hi(og.y);
        sm += (acc[vt][0] + acc[vt][1]) + (acc[vt][2] + acc[vt][3]); }
    sm += __shfl_xor(sm, 16); sm += __shfl_xor(sm, 32);
    const float mu = sm * (1.f / 256.f); float sq = 0.f;
#pragma unroll
    for (int vt = 0; vt < 16; ++vt) { acc[vt] = acc[vt] - mu; sq += (acc[vt][0] * acc[vt][0] + acc[vt][1] * acc[vt][1]) + (acc[vt][2] * acc[vt][2] + acc[vt][3] * acc[vt][3]); }
    sq += __shfl_xor(sq, 16); sq += __shfl_xor(sq, 32);
    const float rstd = rsqrtf(sq * (1.f / 256.f) + LN_EPS);
#pragma unroll
    for (int vt = 0; vt < 16; ++vt) { const f32x4 gg = *(const f32x4*)(F.m_norm_g + h * 256 + 16 * vt + 4 * g4); const f32x4 o = acc[vt] * rstd * gg;
        u32x2 ow; ow.x = cvt_pk_bf16(o[0], o[1]); ow.y = cvt_pk_bf16(o[2], o[3]); *(u32x2*)(YM + t * 1024 + h * 256 + 16 * vt + 4 * g4) = ow; }
}

struct EpiMerge {
    static constexpr bool PERM = true;
    bf16_t* MG; const bf16_t* GB; int step;
    __device__ __forceinline__ void operator()(const f32x4 (&acc)[2][2][4][2], const pg8::Unit& u, int wr, int wc, int fr, int fq) const {
        const int row0 = u.pm * 256 + wr * 64 + fr, col0 = u.pn * 256 + wc * 32 + 8 * fq;
#pragma unroll
        for (int ai = 0; ai < 2; ++ai)
#pragma unroll
            for (int m = 0; m < 4; ++m) { const size_t r = row0 + ai * 128 + m * 16;
#pragma unroll
                for (int bj = 0; bj < 2; ++bj) { const int col = col0 + bj * 128; const f32x4 v0 = acc[ai][bj][m][0], v1 = acc[ai][bj][m][1];
                    const u32x4 gq = *(const u32x4*)(GB + r * 4096 + step * 2048 + col);
                    float o[8] = {v0[0] * bf_lo(gq.x), v0[1] * bf_hi(gq.x), v0[2] * bf_lo(gq.y), v0[3] * bf_hi(gq.y), v1[0] * bf_lo(gq.z), v1[1] * bf_hi(gq.z), v1[2] * bf_lo(gq.w), v1[3] * bf_hi(gq.w)};
                    if (step) { const u32x4 pq = *(const u32x4*)(MG + r * 2048 + col);
                        o[0] += bf_lo(pq.x); o[1] += bf_hi(pq.x); o[2] += bf_lo(pq.y); o[3] += bf_hi(pq.y); o[4] += bf_lo(pq.z); o[5] += bf_hi(pq.z); o[6] += bf_lo(pq.w); o[7] += bf_hi(pq.w); }
                    u32x4 wv; wv.x = cvt_pk_bf16(o[0], o[1]); wv.y = cvt_pk_bf16(o[2], o[3]); wv.z = cvt_pk_bf16(o[4], o[5]); wv.w = cvt_pk_bf16(o[6], o[7]);
                    *(u32x4*)(MG + r * 2048 + col) = wv; } }
    }
};
struct EpiWout {
    static constexpr bool PERM = true;
    const float* mod; bf16_t* PREb;
    __device__ __forceinline__ void operator()(const f32x4 (&acc)[2][2][4][2], const pg8::Unit& u, int wr, int wc, int fr, int fq) const {
        const int row0 = u.pm * 256 + wr * 64 + fr, col0 = u.pn * 256 + wc * 32 + 8 * fq;
        const float* gate = mod + (size_t)((u.pm * 256) / S) * 6 * D + 2 * D;
        f32x4 gv[2][2];
#pragma unroll
        for (int bj = 0; bj < 2; ++bj)
#pragma unroll
            for (int n = 0; n < 2; ++n) gv[bj][n] = *(const f32x4*)(gate + col0 + bj * 128 + n * 4);
#pragma unroll
        for (int ai = 0; ai < 2; ++ai)
#pragma unroll
            for (int m = 0; m < 4; ++m) { const size_t off = (size_t)(row0 + ai * 128 + m * 16) * D + col0;
#pragma unroll
                for (int bj = 0; bj < 2; ++bj) { const f32x4 v0 = gv[bj][0] * acc[ai][bj][m][0], v1 = gv[bj][1] * acc[ai][bj][m][1];
                    u32x4 wv; wv.x = cvt_pk_bf16(v0[0], v0[1]); wv.y = cvt_pk_bf16(v0[2], v0[3]); wv.z = cvt_pk_bf16(v1[0], v1[1]); wv.w = cvt_pk_bf16(v1[2], v1[3]);
                    *(u32x4*)(PREb + off + bj * 128) = wv; } }
    }
};
struct EpiNull { static constexpr bool PERM = false; float* sink;
    __device__ __forceinline__ void operator()(const f32x4 (&acc)[2][2][4][2], const pg8::Unit& u, int wr, int wc, int fr, int fq) const {
        float s = 0.f;
#pragma unroll
        for (int ai = 0; ai < 2; ++ai)
#pragma unroll
            for (int bj = 0; bj < 2; ++bj)
#pragma unroll
                for (int m = 0; m < 4; ++m)
#pragma unroll
                    for (int n = 0; n < 2; ++n) s += acc[ai][bj][m][n][0] + acc[ai][bj][m][n][1] + acc[ai][bj][m][n][2] + acc[ai][bj][m][n][3];
        if (s == 123.456f) sink[0] = s; } };
constexpr int R_UP = 4112, R_LO = 16 * R_UP, R_PART = 2 * 16 * R_UP, R_LOG = R_PART + 8 * 16 * 48 * 4;
template <bool DRY> __device__ __forceinline__ void p9_ln_router(const Frame& F) {
    const bf16_t* PREb = WSP(bf16_t, WS_PRE); bf16_t* X1b = WSP(bf16_t, WS_PRE + (size_t)T * D * 2); const float* mod = WSP(float, WS_MOD); bf16_t* U2 = WSP(bf16_t, WS_U); const bf16_t* WRT = WSP(bf16_t, WS_WRT);
    int* cnt = (int*)(F.ws + WS_CTL) + CW_CNT; int* idx = WSP(int, WS_IDX); float* wl = WSP(float, WS_WL); int* tok = WSP(int, WS_TOK);
    const int lane = FLANE, w = FWAVE, tid = FTID, jl = lane & 15, g4 = lane >> 4;
    LAS unsigned char* Uhi = F.lds; LAS unsigned char* Ulo = F.lds + R_LO; LAS float* part = (LAS float*)(F.lds + R_PART); LAS float* lg = (LAS float*)(F.lds + R_LOG);
    for (int rgp = F.bx; rgp < T / 16; rgp += F.G) {
        __syncthreads();
#pragma unroll 1
        for (int rr = 0; rr < 2; ++rr) {
            const int lr = 2 * w + rr; const int t = rgp * 16 + lr; const int b = t / S;
            f32x4 v[8]; float s = 0.f;
#pragma unroll
            for (int i = 0; i < 8; ++i) { const int d = 4 * (lane + 64 * i); const f32x4 xv = *(const f32x4*)(F.x + (size_t)t * D + d); const u32x2 pq = *(const u32x2*)(PREb + (size_t)t * D + d);
                v[i] = xv * ALPHA; v[i][0] += bf_lo(pq.x); v[i][1] += bf_hi(pq.x); v[i][2] += bf_lo(pq.y); v[i][3] += bf_hi(pq.y); s += (v[i][0] + v[i][1]) + (v[i][2] + v[i][3]); }
            float mu = wave_sum(s) * (1.f / D); float q = 0.f;
#pragma unroll
            for (int i = 0; i < 8; ++i) { v[i] = v[i] - mu; q += (v[i][0] * v[i][0] + v[i][1] * v[i][1]) + (v[i][2] * v[i][2] + v[i][3] * v[i][3]); }
            float rstd = rsqrtf(wave_sum(q) * (1.f / D) + LN_EPS);
            s = 0.f;
#pragma unroll
            for (int i = 0; i < 8; ++i) { const int d = 4 * (lane + 64 * i); const f32x4 gg = *(const f32x4*)(F.ln1_g + d), bb = *(const f32x4*)(F.ln1_b + d);
                v[i] = v[i] * rstd * gg + bb; { u32x2 xb; xb.x = cvt_pk_bf16(v[i][0], v[i][1]); xb.y = cvt_pk_bf16(v[i][2], v[i][3]); *(u32x2*)(X1b + (size_t)t * D + d) = xb; } s += (v[i][0] + v[i][1]) + (v[i][2] + v[i][3]); }
            mu = wave_sum(s) * (1.f / D); q = 0.f;
#pragma unroll
            for (int i = 0; i < 8; ++i) { v[i] = v[i] - mu; q += (v[i][0] * v[i][0] + v[i][1] * v[i][1]) + (v[i][2] * v[i][2] + v[i][3] * v[i][3]); }
            rstd = rsqrtf(wave_sum(q) * (1.f / D) + LN_EPS);
            const float* sc = mod + (size_t)b * 6 * D + 4 * D; const float* sf = mod + (size_t)b * 6 * D + 3 * D;
#pragma unroll
            for (int i = 0; i < 8; ++i) { const int d = 4 * (lane + 64 * i); const f32x4 a = *(const f32x4*)(sc + d), bb = *(const f32x4*)(sf + d);
                v[i] = v[i] * rstd * (a + 1.f) + bb;
                u32x2 hi; hi.x = cvt_pk_bf16(v[i][0], v[i][1]); hi.y = cvt_pk_bf16(v[i][2], v[i][3]);
                *(u32x2*)(U2 + (size_t)t * D + d) = hi;
                u32x2 lo; lo.x = cvt_pk_bf16(v[i][0] - bf_lo(hi.x), v[i][1] - bf_hi(hi.x)); lo.y = cvt_pk_bf16(v[i][2] - bf_lo(hi.y), v[i][3] - bf_hi(hi.y));
                *(LAS u32x2*)(Uhi + lr * R_UP + d * 2) = hi; *(LAS u32x2*)(Ulo + lr * R_UP + d * 2) = lo; }
        }
        __syncthreads();
        {
            f32x4 a3[3] = {{0.f, 0.f, 0.f, 0.f}, {0.f, 0.f, 0.f, 0.f}, {0.f, 0.f, 0.f, 0.f}};
#pragma unroll 2
            for (int ks = 0; ks < 8; ++ks) { const int k0 = 256 * w + 32 * ks + 8 * g4;
                const bf16x8 ah = *(const LAS bf16x8*)(Uhi + jl * R_UP + k0 * 2), al = *(const LAS bf16x8*)(Ulo + jl * R_UP + k0 * 2);
#pragma unroll
                for (int nt = 0; nt < 3; ++nt) { const bf16x8 bh = *(const bf16x8*)(WRT + (size_t)(16 * nt + jl) * D + k0), bl = *(const bf16x8*)(WRT + (size_t)48 * D + (size_t)(16 * nt + jl) * D + k0);
                    a3[nt] = __builtin_amdgcn_mfma_f32_16x16x32_bf16(ah, bh, a3[nt], 0, 0, 0); a3[nt] = __builtin_amdgcn_mfma_f32_16x16x32_bf16(ah, bl, a3[nt], 0, 0, 0); a3[nt] = __builtin_amdgcn_mfma_f32_16x16x32_bf16(al, bh, a3[nt], 0, 0, 0); } }
#pragma unroll
            for (int nt = 0; nt < 3; ++nt)
#pragma unroll
                for (int rg = 0; rg < 4; ++rg) part[(w * 16 + 4 * g4 + rg) * 48 + 16 * nt + jl] = a3[nt][rg];
        }
        __syncthreads();
        for (int i = tid; i < 16 * 48; i += NTHR) { float s = 0.f;
#pragma unroll
            for (int ww = 0; ww < 8; ++ww) s += part[ww * 768 + i];
            lg[i] = s; }
        __syncthreads();
        if (tid < 16) { const int t = rgp * 16 + tid; const LAS float* l = lg + tid * 48;
            int gt = 0; float lgt = l[0] + F.b_rg[0];
            for (int j = 1; j < 4; ++j) { const float x = l[j] + F.b_rg[j]; if (x > lgt) { lgt = x; gt = j; } }
            float se = 0.f; for (int j = 0; j < 4; ++j) se += expf(l[j] + F.b_rg[j] - lgt);
            const float gw = 1.f / se;
            int a = 0; float la = l[4 + gt * 8] + F.b_re[gt * 8];
            for (int j = 1; j < 8; ++j) { const float x = l[4 + gt * 8 + j] + F.b_re[gt * 8 + j]; if (x > la) { la = x; a = j; } }
            int bb = -1; float lb = -INFINITY;
            for (int j = 0; j < 8; ++j) { const float x = l[4 + gt * 8 + j] + F.b_re[gt * 8 + j]; if (j != a && x > lb) { lb = x; bb = j; } }
            const float wa = 1.f / (1.f + expf(lb - la)), wb = 1.f - wa;
            const int ea = gt * 8 + a, eb = gt * 8 + bb;
            if (!DRY) {
            const int pa = atomicAdd(&cnt[ea], 1); idx[ea * T + pa] = t; wl[ea * T + pa] = gw * wa;
            const int pb = atomicAdd(&cnt[eb], 1); idx[eb * T + pb] = t; wl[eb * T + pb] = gw * wb;
            *(int4*)(tok + (size_t)t * 4) = make_int4(ea, pa, eb, pb); } }
    }
}

struct MoeSched {
    const int* idx; const LAS int* tb; const LAS int* cn; int G, c;
    __device__ bool next(int i, pg8::Unit& u) const {
        const int total = tb[32] * 8; const long L = (long)i * G + c; if (L >= total) return false;
        const int l = (int)L; int e = 0;
        for (int k = 1; k < 32; ++k) if (l >= tb[k] * 8) e = k;
        const int nt = tb[e + 1] - tb[e], r = l - tb[e] * 8; const int j = r / nt, it = r - j * nt;
        u.e = __builtin_amdgcn_readfirstlane(e); u.it = __builtin_amdgcn_readfirstlane(it); u.pm = __builtin_amdgcn_readfirstlane(tb[e] + it); u.pn = __builtin_amdgcn_readfirstlane(e * 8 + j); u.cnt = __builtin_amdgcn_readfirstlane(cn[e]); return true;
    }
    __device__ __forceinline__ int arow(const pg8::Unit& u, int r) const { int p = u.it * 256 + r; p = p < u.cnt ? p : u.cnt - 1; return idx[u.e * T + p]; }
};
__device__ __forceinline__ void moe_tables(const Frame& F, LAS int* tb, LAS int* cn) {
    const int* cnt = (const int*)(F.ws + WS_CTL) + CW_CNT;
    __syncthreads();
    if (FTID == 0) { int acc = 0; for (int e = 0; e < 32; ++e) { const int c = cnt[e]; cn[e] = c; tb[e] = acc; acc += (c + 255) >> 8; } tb[32] = acc; }
    __syncthreads();
}
struct EpiMoe1 {
    static constexpr bool PERM = true;
    bf16_t* H;
    __device__ __forceinline__ void operator()(const f32x4 (&acc)[2][2][4][2], const pg8::Unit& u, int wr, int wc, int fr, int fq) const {
        const int row0 = u.pm * 256 + wr * 64 + fr, col0 = (u.pn & 7) * 128 + wc * 32 + 8 * fq;
#pragma unroll
        for (int ai = 0; ai < 2; ++ai)
#pragma unroll
            for (int m = 0; m < 4; ++m) { const size_t r = row0 + ai * 128 + m * 16; float o[8];
#pragma unroll
                for (int n = 0; n < 2; ++n)
#pragma unroll
                    for (int j = 0; j < 4; ++j) o[4 * n + j] = silu_fast(acc[ai][0][m][n][j]) * acc[ai][1][m][n][j];
                u32x4 wv; wv.x = cvt_pk_bf16(o[0], o[1]); wv.y = cvt_pk_bf16(o[2], o[3]); wv.z = cvt_pk_bf16(o[4], o[5]); wv.w = cvt_pk_bf16(o[6], o[7]);
                *(u32x4*)(H + r * FF + col0) = wv; }
    }
};
struct EpiMoe2 {
    static constexpr bool PERM = true;
    bf16_t* Y2; const float* wl;
    __device__ __forceinline__ void operator()(const f32x4 (&acc)[2][2][4][2], const pg8::Unit& u, int wr, int wc, int fr, int fq) const {
        const int lrow0 = wr * 64 + fr, col0 = (u.pn & 7) * 256 + wc * 32 + 8 * fq;
#pragma unroll
        for (int ai = 0; ai < 2; ++ai)
#pragma unroll
            for (int m = 0; m < 4; ++m) { const int lr = lrow0 + ai * 128 + m * 16; const int p = u.it * 256 + lr; const float cw = (p < u.cnt) ? wl[u.e * T + p] : 0.f; const size_t r = (size_t)u.pm * 256 + lr;
#pragma unroll
                for (int bj = 0; bj < 2; ++bj) { const f32x4 v0 = acc[ai][bj][m][0] * cw, v1 = acc[ai][bj][m][1] * cw;
                    u32x4 wv; wv.x = cvt_pk_bf16(v0[0], v0[1]); wv.y = cvt_pk_bf16(v0[2], v0[3]); wv.z = cvt_pk_bf16(v1[0], v1[1]); wv.w = cvt_pk_bf16(v1[2], v1[3]);
                    *(u32x4*)(Y2 + r * D + col0 + bj * 128) = wv; } }
    }
};

template <bool DRY> __device__ __forceinline__ void p12_final(const Frame& F, const LAS int* tb) {
    float* dst = DRY ? WSP(float, WS_DC) : F.out; const bf16_t* X1b = WSP(bf16_t, WS_PRE + (size_t)T * D * 2);
    const float* mod = WSP(float, WS_MOD); const bf16_t* Y2 = WSP(bf16_t, WS_Y2); const int* tok = WSP(int, WS_TOK);
    const int gw = F.bx * NWAVES + FWAVE, NGW = F.G * NWAVES, lane = FLANE;
    for (int t = gw; t < T; t += NGW) {
        const int b = t / S; const int4 ti = *(const int4*)(tok + (size_t)t * 4);
        const size_t r0 = (size_t)tb[ti.x] * 256 + ti.y, r1 = (size_t)tb[ti.z] * 256 + ti.w;
        const float* gate = mod + (size_t)b * 6 * D + 5 * D;
        f32x4 v[8]; float s = 0.f;
#pragma unroll
        for (int i = 0; i < 8; ++i) { const int d = 4 * (lane + 64 * i); const u32x2 xq = *(const u32x2*)(X1b + (size_t)t * D + d); f32x4 xv; xv[0] = bf_lo(xq.x); xv[1] = bf_hi(xq.x); xv[2] = bf_lo(xq.y); xv[3] = bf_hi(xq.y); const f32x4 gv = *(const f32x4*)(gate + d);
            const u32x2 ya = *(const u32x2*)(Y2 + r0 * D + d), yb = *(const u32x2*)(Y2 + r1 * D + d);
            f32x4 f; f[0] = bf_lo(ya.x) + bf_lo(yb.x); f[1] = bf_hi(ya.x) + bf_hi(yb.x); f[2] = bf_lo(ya.y) + bf_lo(yb.y); f[3] = bf_hi(ya.y) + bf_hi(yb.y);
            v[i] = xv * ALPHA + gv * f; s += (v[i][0] + v[i][1]) + (v[i][2] + v[i][3]); }
        const float mu = wave_sum(s) * (1.f / D); float q = 0.f;
#pragma unroll
        for (int i = 0; i < 8; ++i) { v[i] = v[i] - mu; q += (v[i][0] * v[i][0] + v[i][1] * v[i][1]) + (v[i][2] * v[i][2] + v[i][3] * v[i][3]); }
        const float rstd = rsqrtf(wave_sum(q) * (1.f / D) + LN_EPS);
#pragma unroll
        for (int i = 0; i < 8; ++i) { const int d = 4 * (lane + 64 * i); const f32x4 gg = *(const f32x4*)(F.ln2_g + d), bb = *(const f32x4*)(F.ln2_b + d);
            *(f32x4*)(dst + (size_t)t * D + d) = v[i] * rstd * gg + bb; }
    }
}

#if MK_DEBUG
__device__ __forceinline__ void dbg_acc(float* slot, double num, double den) { atomicAdd(slot, (float)num); atomicAdd(slot + 1, (float)den); }
__global__ void k_chk_u(Params p, float* res) {
    __shared__ float sh[8]; __shared__ float ush[D];
    const int t = (blockIdx.x * 37) % T, b = t / S; const float* x = p.in[0] + (size_t)t * D; const float* mod = (const float*)(p.ws + WS_MOD);
    float s = 0; for (int i = threadIdx.x; i < D; i += 256) s += x[i]; s = wave_sum(s); if ((threadIdx.x & 63) == 0) sh[threadIdx.x >> 6] = s; __syncthreads();
    const float mu = (sh[0] + sh[1] + sh[2] + sh[3]) / D; __syncthreads();
    float q = 0; for (int i = threadIdx.x; i < D; i += 256) { const float d = x[i] - mu; q += d * d; } q = wave_sum(q); if ((threadIdx.x & 63) == 0) sh[threadIdx.x >> 6] = q; __syncthreads();
    const float rstd = rsqrtf((sh[0] + sh[1] + sh[2] + sh[3]) / D + LN_EPS);
    const bf16_t* U = (const bf16_t*)(p.ws + WS_U); double num = 0, den = 0;
    for (int i = threadIdx.x; i < D; i += 256) {
        float sc = p.in[3][1 * D + i], sf = p.in[3][0 * D + i];
        if (i < 64) { for (int k = 0; k < D; ++k) { const float cv = p.in[1][b * D + k]; const float sl = cv / (1.f + expf(-cv)); sc += sl * p.in[2][(size_t)k * 6 * D + D + i]; sf += sl * p.in[2][(size_t)k * 6 * D + i]; } }
        else { sc = mod[(size_t)b * 6 * D + D + i]; sf = mod[(size_t)b * 6 * D + i]; }
        const float ref = (x[i] - mu) * rstd * (1.f + sc) + sf; ush[i] = ref; const float got = bf2f(U[(size_t)t * D + i]); num += (double)(got - ref) * (got - ref); den += (double)ref * ref; }
    __syncthreads();
    if (threadIdx.x < 8) { const int j = threadIdx.x; float a = 0; for (int k = 0; k < D; ++k) a += ush[k] * p.in[4][(size_t)k * NIN + OFF_IF + j]; a += p.in[5][j];
        if (j >= 4) a = fminf(a, 0.f) - log1pf(expf(-fabsf(a))); const float got = ((const float*)(p.ws + WS_GPRE))[(size_t)t * 8 + j]; num += (double)(got - a) * (got - a) * 1000.0; den += (double)a * a * 1000.0; }
    dbg_acc(res, num, den);
}
__global__ void k_chk_p2(Params p, float* res) {
    const int gid = blockIdx.x * blockDim.x + threadIdx.x;
    const int t = (gid * 131 + 7) % T; const int col = (gid * 977 + 13) % (NIN - 8 + 4096);
    const bf16_t* U = (const bf16_t*)(p.ws + WS_U) + (size_t)t * D;
    const int pos = t % S; float ref, got; unsigned char* ws = p.ws;
    auto dot = [&](const float* w, int ld, int c) { float a = 0; for (int k = 0; k < D; ++k) a += bf2f(U[k]) * w[(size_t)k * ld + c]; return a; };
    if (col < 3072) { const int hd = col / 128, lc = col % 128, i = lc % 64; const int c1 = hd * 128 + i, c2 = c1 + 64; const float x1 = dot(p.in[4], NIN, c1), x2 = dot(p.in[4], NIN, c2);
        const float inv = powf(10000.f, -(float)(2 * i) / 128.f), ang = (float)pos * inv, cs = cosf(ang), sn = sinf(ang);
        ref = (lc < 64) ? (x1 * cs - x2 * sn) : (x2 * cs + x1 * sn); const int pc = hd * 128 + 2 * i + (lc >= 64);
        if (col < 1536) { ref *= QSCALE; got = bf2f(((const bf16_t*)(ws + WS_QB))[(size_t)t * 1536 + pc]); } else got = bf2f(((const bf16_t*)(ws + WS_KB))[(size_t)t * 1536 + pc - 1536]); }
    else if (col < 4608) { ref = dot(p.in[4], NIN, col); got = bf2f(((const bf16_t*)(ws + WS_VB))[(size_t)t * 1536 + col - 3072]); }
    else if (col < 6656) { ref = dot(p.in[4], NIN, col); got = bf2f(((const bf16_t*)(ws + WS_QKP))[(size_t)t * 2048 + col - 4608]); }
    else if (col < 7680) { ref = dot(p.in[4], NIN, col); got = bf2f(((const bf16_t*)(ws + WS_VMB))[(size_t)t * 1024 + col - 6656]); }
    else if (col < 8704) { ref = dot(p.in[4], NIN, col); ref = 1.f / (1.f + expf(-ref)); got = bf2f(((const bf16_t*)(ws + WS_OGB))[(size_t)t * 1024 + col - 7680]); }
    else { const int c = col - 8704; ref = dot(p.in[11], 4096, c) + p.in[12][c]; ref = 1.f / (1.f + expf(-ref)); got = bf2f(((const bf16_t*)(ws + WS_GB))[(size_t)t * 4096 + c]); }
    double num = (double)(got - ref) * (got - ref), den = (double)ref * ref;
    for (int o = 32; o >= 1; o >>= 1) { num += __shfl_xor(num, o); den += __shfl_xor(den, o); }
    if ((threadIdx.x & 63) == 0) dbg_acc(res, num, den);
}

__global__ void __launch_bounds__(256) k_chk_attn(Params p, float* res) {
    const int t = (blockIdx.x * 1543 + 11) % T, h = threadIdx.x >> 6, lane = threadIdx.x & 63; const int b = t / S, pos = t % S;
    const bf16_t* QB = (const bf16_t*)(p.ws + WS_QB); const bf16_t* KB = (const bf16_t*)(p.ws + WS_KB); const bf16_t* VB = (const bf16_t*)(p.ws + WS_VB); const bf16_t* YA = (const bf16_t*)(p.ws + WS_YA);
    float og[3][2], lse[3];
    for (int g = 0; g < 3; ++g) { const int d = (g == 0) ? 1 : (g == 1 ? 4 : 16); const int head = 4 * g + h;
        const bf16_t* qp = QB + (size_t)t * 1536 + head * 128; const float q0 = bf2f(qp[lane]), q1 = bf2f(qp[lane + 64]);
        float mx = -INFINITY, den = 0, o0 = 0, o1 = 0;
        for (int j = 0; j <= 128; ++j) { const int tk = pos - j * d; if (tk < 0) break;
            const bf16_t* kp = KB + (size_t)(b * S + tk) * 1536 + head * 128; const bf16_t* vp = VB + (size_t)(b * S + tk) * 1536 + head * 128;
            const float dot = wave_sum(q0 * bf2f(kp[lane]) + q1 * bf2f(kp[lane + 64]));
            const float nm = fmaxf(mx, dot); const float sc = exp2f(mx - nm), pe = exp2f(dot - nm);
            den = den * sc + pe; o0 = o0 * sc + pe * bf2f(vp[lane]); o1 = o1 * sc + pe * bf2f(vp[lane + 64]); mx = nm; }
        og[g][0] = o0 / den; og[g][1] = o1 / den; lse[g] = (mx + log2f(den)) * LN2; }
    const float ml = fmaxf(lse[0], fmaxf(lse[1], lse[2])); const float w0 = expf(lse[0] - ml), w1 = expf(lse[1] - ml), w2 = expf(lse[2] - ml); const float ws_ = 1.f / (w0 + w1 + w2);
    const float r0 = (w0 * og[0][0] + w1 * og[1][0] + w2 * og[2][0]) * ws_, r1 = (w0 * og[0][1] + w1 * og[1][1] + w2 * og[2][1]) * ws_;
    const float g0 = bf2f(YA[(size_t)t * 512 + h * 128 + lane]), g1 = bf2f(YA[(size_t)t * 512 + h * 128 + lane + 64]);
    double num = (double)(g0 - r0) * (g0 - r0) + (double)(g1 - r1) * (g1 - r1), den2 = (double)r0 * r0 + (double)r1 * r1;
    for (int o = 32; o >= 1; o >>= 1) { num += __shfl_xor(num, o); den2 += __shfl_xor(den2, o); }
    if (lane == 0) dbg_acc(res, num, den2);
}
__global__ void __launch_bounds__(1024) k_chk_mlstm(Params p, float* hb) {
    const int b = blockIdx.x / 4, h = blockIdx.x % 4; const int tid = threadIdx.x, v = tid >> 2, kq = tid & 3;
    const bf16_t* QKP = (const bf16_t*)(p.ws + WS_QKP); const bf16_t* VM = (const bf16_t*)(p.ws + WS_VMB);
    const float* gpre = (const float*)(p.ws + WS_GPRE); const float* conv_w = p.in[6]; const float* conv_b = p.in[7];
    __shared__ float qs[256], ks[256], vs[256], ns[256], nq[256];
    float C[64];
#pragma unroll
    for (int i = 0; i < 64; ++i) C[i] = 0.f;
    if (tid < 256) ns[tid] = 0.f;
    float m = 0.f;
    for (int pos = 0; pos < S; ++pos) { const int t = b * S + pos;
        __syncthreads();
        if (tid < 256) { float yq = conv_b[h * 256 + tid], yk = conv_b[1024 + h * 256 + tid];
            for (int j = 0; j < 4; ++j) { const int pp = pos + j - 3; if (pp >= 0) { yq += conv_w[j * 2048 + h * 256 + tid] * bf2f(QKP[(size_t)(t + j - 3) * 2048 + h * 256 + tid]); yk += conv_w[j * 2048 + 1024 + h * 256 + tid] * bf2f(QKP[(size_t)(t + j - 3) * 2048 + 1024 + h * 256 + tid]); } }
            qs[tid] = yq / (1.f + expf(-yq)); ks[tid] = yk / (1.f + expf(-yk)) * 0.0625f; vs[tid] = bf2f(VM[(size_t)t * 1024 + h * 256 + tid]); }
        const float ip = gpre[(size_t)t * 8 + h], lf = gpre[(size_t)t * 8 + 4 + h];
        const float mn = fmaxf(lf + m, ip); const float iw = expf(ip - mn), fw = expf(lf + m - mn); m = mn;
        __syncthreads();
        if (tid < 256) { const float nn = fw * ns[tid] + iw * ks[tid]; ns[tid] = nn; nq[tid] = nn * qs[tid]; }
        __syncthreads();
        const float vv = vs[v] * iw; float nu = 0.f, de = 0.f;
#pragma unroll
        for (int i = 0; i < 64; ++i) { const int k = 4 * i + kq; const float cc = fw * C[i] + vv * ks[k]; C[i] = cc; nu += cc * qs[k]; de += nq[k]; }
        nu += __shfl_xor(nu, 1); nu += __shfl_xor(nu, 2); de += __shfl_xor(de, 1); de += __shfl_xor(de, 2);
        if (kq == 0) hb[(size_t)t * 1024 + h * 256 + v] = nu / fmaxf(fabsf(de), expf(-mn));
    }
}
__global__ void __launch_bounds__(256) k_chk_mnorm(Params p, const float* hb, float* res) {
    __shared__ float red[8];
    const int t = blockIdx.x / 4, h = blockIdx.x % 4, tid = threadIdx.x;
    const bf16_t* OG = (const bf16_t*)(p.ws + WS_OGB); const bf16_t* YM = (const bf16_t*)(p.ws + WS_YM); const float* mg = p.in[8];
    const float val = bf2f(OG[(size_t)t * 1024 + h * 256 + tid]) * hb[(size_t)t * 1024 + h * 256 + tid];
    float s = wave_sum(val); if ((tid & 63) == 0) red[tid >> 6] = s; __syncthreads();
    const float mu = (red[0] + red[1] + red[2] + red[3]) * (1.f / 256.f); const float d = val - mu;
    s = wave_sum(d * d); if ((tid & 63) == 0) red[4 + (tid >> 6)] = s; __syncthreads();
    const float rstd = rsqrtf((red[4] + red[5] + red[6] + red[7]) * (1.f / 256.f) + LN_EPS); const float ref = d * rstd * mg[h * 256 + tid];
    const float got = bf2f(YM[(size_t)t * 1024 + h * 256 + tid]);
    double num = (double)(got - ref) * (got - ref), den = (double)ref * ref;
    for (int o = 32; o >= 1; o >>= 1) { num += __shfl_xor(num, o); den += __shfl_xor(den, o); }
    if ((tid & 63) == 0) dbg_acc(res, num, den);
}
__global__ void k_chk_fin(const float* res, int nchk, float* out, int n) {
    const int i = blockIdx.x * blockDim.x + threadIdx.x; if (i >= n) return;
    float code = 0.f;
    for (int k = 0; k < nchk; ++k) { const float rv = res[2 * k] / fmaxf(res[2 * k + 1], 1e-30f); int s;
        if (!(rv == rv) || !(res[2 * k + 1] > 0.f)) s = 9; else { s = (int)floorf(log10f(fmaxf(rv, 1e-12f)) + 6.f); s = s < 0 ? 0 : (s > 8 ? 8 : s); }
        if (s >= 3 && code == 0.f) code = ((k + 1) * 10 + s) * 100.f; }
    out[i] = (i == 0) ? code : 0.f;
}
#endif

__global__ void __launch_bounds__(NTHR, 2) mk_fwd(Params args) {
    extern __shared__ __attribute__((aligned(16))) unsigned char lds_raw[];
    Frame F;
    F.lds = (LAS unsigned char*)lds_raw; F.G = gridDim.x; F.bx = blockIdx.x; F.ws = args.ws;
    F.x = args.in[0]; F.c = args.in[1]; F.w_ada = args.in[2]; F.b_ada = args.in[3]; F.w_in = args.in[4]; F.b_mgate = args.in[5]; F.conv_w = args.in[6]; F.conv_b = args.in[7];
    F.m_norm_g = args.in[8]; F.w_proj_a = args.in[9]; F.w_proj_m = args.in[10]; F.w_gate = args.in[11]; F.b_gate = args.in[12]; F.w_out = args.in[13]; F.ln1_g = args.in[14]; F.ln1_b = args.in[15];
    F.w_rg = args.in[16]; F.b_rg = args.in[17]; F.w_re = args.in[18]; F.b_re = args.in[19]; F.w_eg = args.in[20]; F.w_eu = args.in[21]; F.w_ed = args.in[22]; F.ln2_g = args.in[23]; F.ln2_b = args.in[24];
    F.out = args.out;
    volatile LAS unsigned* misc = (volatile LAS unsigned*)(F.lds + LDS_MISC);
    if (FTID < 64) misc[FTID] = 0u;
    __syncthreads();
    const int lo = args.ph_lo, hi = args.ph_hi;
    XcdBarrier bar; bar.bar = (unsigned*)(F.ws + WS_CTL) + CW_BAR; bar.x = 0; bar.st = nullptr;
    if (hi - lo > 1) bar = xcd_barrier_post((unsigned*)(F.ws + WS_CTL) + CW_BAR, misc + 8);
#define IN(k) (lo <= (k) && (k) < hi)
#define BOTH(k) (IN(k) && IN((k) + 1))
#define SEAM(k) do { if (BOTH(k)) xcd_barrier(bar); } while (0)

#define DUPRUN(k, BODY) do { BODY; if (MK_DUP & (1 << (k))) { xcd_barrier(bar); BODY; } } while (0)
#define PH0 { p0_prologue(F); }
#define PH1 { p1_lnmod(F); }
#define PH2 { const int GG = (F.G == 256) ? MK_GG2 : F.G; \
        if (F.bx < GG) { pg8::StaticOrder So; So.init(T, NBIG, GG, F.bx); \
            if (MK_STAGGER > 0) { const unsigned long long t0 = __builtin_amdgcn_s_memrealtime(); const unsigned long long dl = (unsigned long long)((F.bx >> 3) & 7) * MK_STAGGER; while (__builtin_amdgcn_s_memrealtime() - t0 < dl) __builtin_amdgcn_s_sleep(8); } \
            EpiP2 E{WSP(bf16_t, WS_QB), WSP(bf16_t, WS_KB), WSP(bf16_t, WS_VB), WSP(bf16_t, WS_QKP), WSP(bf16_t, WS_VMB), WSP(bf16_t, WS_OGB), WSP(bf16_t, WS_GB), WSP(float, WS_ROPE), F.b_gate}; \
            pg8::gemm_phase<EpiP2, pg8::StaticOrder, false>(F.lds, WSP(bf16_t, WS_U), WSP(bf16_t, WS_WBIG), D, So, E); } \
        if (F.bx >= F.G - 16 && FWAVE == 0) scan_bh(F, F.bx - (F.G - 16)); \
        cvt_stream<1>(F, N_IT_W1); cvt_stream<1>(F, N_IT_BG); }
#define PH3 { p3_conv(F); attn_phase(F); }
#define PH4 { for (int u = F.bx; u < 256; u += F.G) mlstm_dc_unit(F, u); }
#define PH5 { p5_scan_mix(F); }
#define PH6 { for (int u = F.bx; u < 256; u += F.G) mlstm_out_unit(F, u); }
#define PH7 { pg8::StaticOrder So; So.init(T, D, F.G, F.bx); \
        EpiMerge E0{WSP(bf16_t, WS_MG), WSP(bf16_t, WS_GB), 0}, E1{WSP(bf16_t, WS_MG), WSP(bf16_t, WS_GB), 1}; \
        pg8::gemm_phase<EpiMerge, pg8::StaticOrder, false>(F.lds, WSP(bf16_t, WS_YA), WSP(bf16_t, WS_WPA), 512, So, E0); \
        pg8::gemm_phase<EpiMerge, pg8::StaticOrder, false>(F.lds, WSP(bf16_t, WS_YM), WSP(bf16_t, WS_WPM), 1024, So, E1); }
#define PH8 { pg8::StaticOrder So; So.init(T, D, F.G, F.bx); EpiWout E{WSP(float, WS_MOD), WSP(bf16_t, WS_PRE)}; \
        pg8::gemm_phase<EpiWout, pg8::StaticOrder, false>(F.lds, WSP(bf16_t, WS_MG), WSP(bf16_t, WS_WO), D, So, E); }
#define PH10 { moe_tables(F, tb, cn); MoeSched Sm{WSP(int, WS_IDX), tb, cn, F.G, vcu}; EpiMoe1 E{WSP(bf16_t, WS_H)}; \
        pg8::gemm_phase<EpiMoe1, MoeSched, true>(F.lds, WSP(bf16_t, WS_U), WSP(bf16_t, WS_W1T), D, Sm, E); }
#define PH11 { moe_tables(F, tb, cn); MoeSched Sm{WSP(int, WS_IDX), tb, cn, F.G, vcu}; EpiMoe2 E{WSP(bf16_t, WS_Y2), WSP(float, WS_WL)}; \
        pg8::gemm_phase<EpiMoe2, MoeSched, false>(F.lds, WSP(bf16_t, WS_H), WSP(bf16_t, WS_W2T), FF, Sm, E); }
    LAS int* tb = (LAS int*)(F.lds + LDS_MISC) + 64; LAS int* cn = tb + 40;
    const int vcu = (F.G % 8 == 0) ? (F.bx % 8) * (F.G / 8) + F.bx / 8 : F.bx;
    if (IN(0)) { DUPRUN(0, PH0); SEAM(0); }
    if (IN(1)) { DUPRUN(1, PH1); SEAM(1); }
    if (IN(2)) { PH2;
        if (MK_DUP & (1 << 21)) { xcd_barrier(bar); const int GG = MK_GG2; if (F.bx < GG) { pg8::StaticOrder So; So.init(T, NBIG, GG, F.bx); EpiNull E{WSP(float, WS_DC)}; pg8::gemm_phase<EpiNull, pg8::StaticOrder, false>(F.lds, WSP(bf16_t, WS_U), WSP(bf16_t, WS_WBIG), D, So, E); } }
        SEAM(2); }
    if (IN(3)) { DUPRUN(3, PH3); SEAM(3); }
    if (IN(4)) { DUPRUN(4, PH4); SEAM(4); }
    if (IN(5)) { DUPRUN(5, PH5); SEAM(5); }
    if (IN(6)) { DUPRUN(6, PH6); SEAM(6); }
    if (IN(7)) { DUPRUN(7, PH7); SEAM(7); }
    if (IN(8)) { DUPRUN(8, PH8);
        if (MK_DUP & (1 << 20)) { xcd_barrier(bar); pg8::StaticOrder So; So.init(T, D, F.G, F.bx); EpiNull E{WSP(float, WS_DC)}; pg8::gemm_phase<EpiNull, pg8::StaticOrder, false>(F.lds, WSP(bf16_t, WS_MG), WSP(bf16_t, WS_WO), D, So, E); }
        SEAM(8); }
    if (IN(9)) { if (MK_DUP & (1 << 9)) { p9_ln_router<true>(F); xcd_barrier(bar); } p9_ln_router<false>(F); SEAM(9); }
    if (IN(10)) { DUPRUN(10, PH10); SEAM(10); }
    if (IN(11)) { DUPRUN(11, PH11); SEAM(11); }
    if (IN(12)) { moe_tables(F, tb, cn); if (MK_DUP & (1 << 12)) { p12_final<true>(F, tb); xcd_barrier(bar); } p12_final<false>(F, tb); }
#undef IN
#undef BOTH
#undef SEAM
}

extern "C" void kernel_launch(void* const* d_in, const int* in_sizes, int n_in, void* d_out, int out_size, void* d_ws, size_t ws_size, hipStream_t stream) {
    static int grid = 0;
    if (grid == 0) {
        size_t need = WS_END;
#if MK_DEBUG
        need += (1 << 20) + (size_t)T * 1024 * 4;
#endif
        if (n_in != 25 || out_size != T * D || ws_size < need) { fprintf(stderr, "kernel_launch: unexpected shapes / workspace (%zu < %zu)\n", ws_size, need); grid = -1; return; }
        int dev = 0, cus = 0, per_cu = 0;
        if (hipGetDevice(&dev) != hipSuccess || hipDeviceGetAttribute(&cus, hipDeviceAttributeMultiprocessorCount, dev) != hipSuccess) { grid = -1; return; }
        if (hipFuncSetAttribute((const void*)mk_fwd, hipFuncAttributeMaxDynamicSharedMemorySize, LDS_BYTES) != hipSuccess) { fprintf(stderr, "kernel_launch: hipFuncSetAttribute failed\n"); grid = -1; return; }
        if (hipOccupancyMaxActiveBlocksPerMultiprocessor(&per_cu, (const void*)mk_fwd, NTHR, LDS_BYTES) != hipSuccess || per_cu < 1) { fprintf(stderr, "kernel_launch: occupancy query says %d\n", per_cu); (void)hipGetLastError(); grid = -1; return; }
        grid = cus;
    }
    if (grid < 0) return;
    (void)hipMemsetAsync((char*)d_ws + WS_CTL, 0, CTL_ZERO_BYTES, stream);
    Params a{};
    for (int i = 0; i < 25; ++i) a.in[i] = (const float*)d_in[i];
    a.out = (float*)d_out; a.ws = (unsigned char*)d_ws;
#if MK_DEBUG
    constexpr int NPH = 7;
#else
    constexpr int NPH = 13;
#endif
#if MK_PER_PHASE
    for (int p = 0; p < NPH; ++p) { a.ph_lo = p; a.ph_hi = p + 1; hipLaunchKernelGGL(mk_fwd, dim3(grid), dim3(NTHR), LDS_BYTES, stream, a); }
#else
    a.ph_lo = 0; a.ph_hi = NPH; hipLaunchKernelGGL(mk_fwd, dim3(grid), dim3(NTHR), LDS_BYTES, stream, a);
#endif
#if MK_DEBUG
    float* res = (float*)((char*)d_ws + WS_DBG0);
    (void)hipMemsetAsync(res, 0, 256, stream);
    k_chk_u<<<64, 256, 0, stream>>>(a, res);
    k_chk_p2<<<32, 64, 0, stream>>>(a, res + 2);
    k_chk_attn<<<256, 256, 0, stream>>>(a, res + 4);
    float* hb = (float*)((char*)d_ws + WS_DBG0 + (1 << 20));
    k_chk_mlstm<<<16, 1024, 0, stream>>>(a, hb);
    k_chk_mnorm<<<T * 4, 256, 0, stream>>>(a, hb, res + 6);
    k_chk_fin<<<(T * D + 255) / 256, 256, 0, stream>>>(res, 4, (float*)d_out, T * D);
#endif
}
```

```cpp
#include <hip/hip_runtime.h>
#include <stdint.h>
#include <math.h>
#include <stdio.h>

#ifndef MK_DEBUG
#define MK_DEBUG 0
#endif
#ifndef MK_DUP
#define MK_DUP 0
#endif
#ifndef MK_GG2
#define MK_GG2 200
#endif
#ifndef MK_STAGGER
#define MK_STAGGER 0
#endif
#ifndef MK_PER_PHASE
#define MK_PER_PHASE 0
#endif

#define LAS __attribute__((address_space(3)))
typedef unsigned short bf16_t;
typedef short bf16x8 __attribute__((ext_vector_type(8)));
typedef short s16x4 __attribute__((ext_vector_type(4)));
typedef float f32x4 __attribute__((ext_vector_type(4)));
typedef float f32x2 __attribute__((ext_vector_type(2)));
typedef unsigned u32x4 __attribute__((ext_vector_type(4)));
typedef unsigned u32x2 __attribute__((ext_vector_type(2)));

constexpr int D = 2048, NB = 4, S = 2048, T = NB * S, NIN = 8712;
constexpr int OFF_QA = 0, OFF_KA = 1536, OFF_VA = 3072, OFF_QKM = 4608, OFF_VM = 6656, OFF_OM = 7680, OFF_IF = 8704;
constexpr int FF = 1024, NEXP = 32, NBIG = 12800;
constexpr float ALPHA = 1.189207115002721f, LN_EPS = 1e-5f;
constexpr float LOG2E = 1.4426950408889634f, LN2 = 0.6931471805599453f;
constexpr float QSCALE = 0.08838834764831845f * 1.4426950408889634f;
constexpr int NTHR = 512, NWAVES = 8;
constexpr int SORT_ROWS = 24576;

constexpr size_t al256(size_t x) { return (x + 255) & ~(size_t)255; }
constexpr size_t WS_CTL = 0, CTL_ZERO_BYTES = 65536;
constexpr int CW_BAR = 0;
constexpr int CW_CNT = 4096;
constexpr int CW_DBG = 4224;
constexpr size_t WS_MOD = 65536;
constexpr size_t WS_ROPE = WS_MOD + al256((size_t)NB * 6 * D * 4);
constexpr size_t WS_WIF = WS_ROPE + (size_t)S * 64 * 2 * 4;
constexpr size_t WS_GPRE = WS_WIF + (size_t)8 * D * 4;
constexpr size_t WS_BCUM = WS_GPRE + (size_t)T * 8 * 4;
constexpr size_t WS_MCUM = WS_BCUM + (size_t)16 * S * 4;
constexpr size_t WS_WRT = WS_MCUM + (size_t)16 * S * 4;
constexpr size_t WS_LSE = WS_WRT + (size_t)2 * 48 * D * 2;
constexpr size_t WS_IDX = WS_LSE + (size_t)T * 12 * 4;
constexpr size_t WS_WL = WS_IDX + (size_t)NEXP * T * 4;
constexpr size_t WS_TOK = WS_WL + (size_t)NEXP * T * 4;
constexpr size_t WS_DN = WS_TOK + (size_t)T * 16;
constexpr size_t WS_NST = WS_DN + (size_t)256 * 256 * 4;
constexpr size_t WS_WBIG = al256(WS_NST + (size_t)256 * 256 * 4);
constexpr size_t WS_WPA = WS_WBIG + (size_t)NBIG * D * 2;
constexpr size_t WS_WPM = WS_WPA + (size_t)D * 512 * 2;
constexpr size_t WS_WO = WS_WPM + (size_t)D * 1024 * 2;
constexpr size_t WS_W1T = WS_WO + (size_t)D * D * 2;
constexpr size_t WS_W2T = WS_W1T + (size_t)NEXP * 2048 * D * 2;
constexpr size_t WS_U = WS_W2T + (size_t)NEXP * D * FF * 2;
constexpr size_t WS_QB = WS_U + (size_t)T * D * 2;
constexpr size_t WS_KB = WS_QB + (size_t)T * 1536 * 2;
constexpr size_t WS_VB = WS_KB + (size_t)T * 1536 * 2;
constexpr size_t WS_QKP = WS_VB + (size_t)T * 1536 * 2;
constexpr size_t WS_VMB = WS_QKP + (size_t)T * 2048 * 2;
constexpr size_t WS_OGB = WS_VMB + (size_t)T * 1024 * 2;
constexpr size_t WS_GB = WS_OGB + (size_t)T * 1024 * 2;
constexpr size_t WS_QM = WS_GB + (size_t)T * 4096 * 2;
constexpr size_t WS_KM = WS_QM + (size_t)T * 1024 * 2;
constexpr size_t WS_OATT = WS_KM + (size_t)T * 1024 * 2;
constexpr size_t WS_YA = WS_OATT + (size_t)T * 1536 * 2;
constexpr size_t WS_YM = WS_YA + (size_t)T * 512 * 2;
constexpr size_t WS_DC = WS_YM + (size_t)T * 1024 * 2;
constexpr size_t WS_CST = WS_DC + (size_t)256 * 65536 * 4;
constexpr size_t WS_MG = WS_CST + (size_t)256 * 65536 * 2;
constexpr size_t WS_PRE = WS_MG + (size_t)T * D * 2;
constexpr size_t WS_END = WS_PRE + (size_t)T * D * 4;
constexpr size_t WS_H = WS_QB;
constexpr size_t WS_Y2 = WS_H + (size_t)SORT_ROWS * FF * 2;
static_assert(WS_Y2 + (size_t)SORT_ROWS * D * 2 <= WS_QM, "overlay");
constexpr size_t WS_DBG0 = WS_END;

constexpr int LDS_MISC = 162816;
constexpr int LDS_BYTES = LDS_MISC + 1024;

__device__ __forceinline__ unsigned cvt_pk_bf16(float lo, float hi) { unsigned r; asm volatile("v_cvt_pk_bf16_f32 %0, %1, %2" : "=v"(r) : "v"(lo), "v"(hi)); return r; }
__device__ __forceinline__ float bf_lo(unsigned w) { return __uint_as_float(w << 16); }
__device__ __forceinline__ float bf_hi(unsigned w) { return __uint_as_float(w & 0xffff0000u); }
__device__ __forceinline__ float bf2f(bf16_t b) { return __uint_as_float(((unsigned)b) << 16); }
__device__ __forceinline__ bf16_t f2bf(float f) { return (bf16_t)(cvt_pk_bf16(f, 0.f) & 0xffffu); }
__device__ __forceinline__ float fast_exp2(float x) { return __builtin_amdgcn_exp2f(x); }
__device__ __forceinline__ float fast_rcp(float x) { return __builtin_amdgcn_rcpf(x); }
__device__ __forceinline__ float sigmoid_fast(float x) { return fast_rcp(1.f + fast_exp2(-x * LOG2E)); }
__device__ __forceinline__ float silu_fast(float x) { return x * sigmoid_fast(x); }
__device__ __forceinline__ float wave_sum(float v) {
#pragma unroll
    for (int o = 32; o >= 1; o >>= 1) v += __shfl_xor(v, o);
    return v; }
__device__ __forceinline__ float wave_max(float v) {
#pragma unroll
    for (int o = 32; o >= 1; o >>= 1) v = fmaxf(v, __shfl_xor(v, o));
    return v; }
__device__ __forceinline__ s16x4 tr_read(unsigned addr) { s16x4 r; asm volatile("ds_read_b64_tr_b16 %0, %1" : "=&v"(r) : "v"(addr) : "memory"); return r; }
__device__ __forceinline__ s16x4 tr_read_o(unsigned base, const int off) { s16x4 r; asm volatile("ds_read_b64_tr_b16 %0, %1 offset:%2" : "=&v"(r) : "v"(base), "n"(off) : "memory"); return r; }
#define LGKM_WAIT0() do { asm volatile("s_waitcnt lgkmcnt(0)" ::: "memory"); __builtin_amdgcn_sched_barrier(0); } while (0)
#define PK8(L, H) ((bf16x8){L[0], L[1], L[2], L[3], H[0], H[1], H[2], H[3]})

#define XB_TMO      128
#define XB_XCNT(j)  (256  + 64 * (j))
#define XB_XSUB(j)  (1280 + 64 * (j))
#define XB_XGEN(j)  (2304 + 64 * (j))
#define XB_TOP      3328
#define XB_TOPGEN   3392
#define XCD_BAR_WORDS 3456
#define XB_SPIN_CAP (1u << 18)
__device__ __forceinline__ unsigned xb_ld(unsigned* p)              { return __hip_atomic_load(p, __ATOMIC_RELAXED, __HIP_MEMORY_SCOPE_AGENT); }
__device__ __forceinline__ unsigned xb_add(unsigned* p, unsigned v) { return __hip_atomic_fetch_add(p, v, __ATOMIC_RELAXED, __HIP_MEMORY_SCOPE_AGENT); }
__device__ __forceinline__ unsigned xb_xcc_id() { return (unsigned)__builtin_amdgcn_s_getreg((3 << 11) | 20) & 0xFu; }
#define XB_SPIN(cond, bar) do { unsigned _sp = 0; while (cond) { __builtin_amdgcn_s_sleep(1); \
    if ((++_sp & 255u) == 0u) { if (xb_ld(&(bar)[XB_TMO])) break; if (_sp > XB_SPIN_CAP) { atomicAdd(&(bar)[XB_TMO], 1u); break; } } } } while (0)
struct XcdBarrier { unsigned* bar; unsigned x; volatile LAS unsigned* st; };
__device__ __forceinline__ XcdBarrier xcd_barrier_post(unsigned* bar, volatile LAS unsigned* st) {
    XcdBarrier b; b.bar = bar; b.x = xb_xcc_id(); b.st = st;
    if (threadIdx.x == 0) (void)xb_add(&bar[XB_XCNT(b.x)], 1u);
    return b;
}
__device__ __forceinline__ void xcd_barrier_complete(unsigned* bar, unsigned x, unsigned& nloc, unsigned& nx) {
    const unsigned G = gridDim.x * gridDim.y * gridDim.z;
    unsigned sum, cnt, mine, sp = 0u;
    for (;;) {
        sum = 0u; cnt = 0u; mine = 0u;
#pragma unroll
        for (unsigned j = 0; j < 16; ++j) { const unsigned c = xb_ld(&bar[XB_XCNT(j)]); sum += c; cnt += (c > 0u) ? 1u : 0u; mine = (j == x) ? c : mine; }
        if (sum == G) break;
        __builtin_amdgcn_s_sleep(1);
        if ((++sp & 255u) == 0u) { if (xb_ld(&bar[XB_TMO])) break; if (sp > XB_SPIN_CAP) { atomicAdd(&bar[XB_TMO], 1u); break; } }
    }
    nloc = mine > 0u ? mine : 1u; nx = cnt > 0u ? cnt : 1u;
}
__device__ __forceinline__ void xcd_barrier(const XcdBarrier& b) {
    asm volatile("s_waitcnt vmcnt(0)" ::: "memory");
    __syncthreads();
    if (threadIdx.x == 0) {
        unsigned* bar = b.bar;
        __builtin_amdgcn_s_waitcnt(0);
        unsigned nloc = b.st[0], nx = b.st[1];
        if (nloc == 0u) { xcd_barrier_complete(bar, b.x, nloc, nx); b.st[0] = nloc; b.st[1] = nx; }
        const unsigned old = xb_add(&bar[XB_XSUB(b.x)], 1u);
        const unsigned gen = old / nloc;
        if (old + 1u == (gen + 1u) * nloc) {
            __builtin_amdgcn_fence(__ATOMIC_RELEASE, "agent");
            asm volatile("s_waitcnt vmcnt(0)" ::: "memory");
            const unsigned og = xb_add(&bar[XB_TOP], 1u);
            const unsigned tg = og / nx;
            if (og + 1u == (tg + 1u) * nx) xb_add(&bar[XB_TOPGEN], 1u);
            else XB_SPIN(xb_ld(&bar[XB_TOPGEN]) == tg, bar);
            __builtin_amdgcn_fence(__ATOMIC_ACQUIRE, "agent");
            xb_add(&bar[XB_XGEN(b.x)], 1u);
            asm volatile("s_waitcnt vmcnt(0)" ::: "memory");
        } else {
            XB_SPIN(xb_ld(&bar[XB_XGEN(b.x)]) == gen, bar);
            __builtin_amdgcn_fence(__ATOMIC_ACQUIRE, "agent");
            asm volatile("s_waitcnt vmcnt(0)" ::: "memory");
        }
    }
    __syncthreads();
}

namespace pg8 {
constexpr int BM = 256, BK = 64, HALF = 128, HTB = HALF * BK * 2, STAGE_BYTES = 8 * HTB, NXCD = 8, WGM = 8;
__host__ __device__ __forceinline__ int lds_byte(int r, int c) { const int st = (r >> 4) * 2 + (c >> 5), rr = r & 15, cc = c & 31, ob = rr * 64 + cc * 2; return st * 1024 + (ob ^ (((ob >> 9) & 1) << 5)); }
__host__ __device__ __forceinline__ void stage_rc(int b, int& R, int& C) { const int st = b / 1024, sb = b % 1024, swz = sb ^ (((sb >> 9) & 1) << 5); R = (st >> 1) * 16 + swz / 64; C = (st & 1) * 32 + (swz % 64) / 2; }
__host__ __device__ __forceinline__ int perm32(int rho) { const int n = rho >> 4, i = rho & 15; return 8 * (i >> 2) + 4 * n + (i & 3); }

struct Unit { int pm, pn, e, it, cnt; };

struct StaticOrder {
    int nM, nN, nwg, G, c;
    __device__ void init(int M, int N, int G_, int c_) { nM = M / BM; nN = N / BM; nwg = nM * nN; G = G_; c = c_; }
    __device__ bool next(int i, Unit& u) const {
        const long L = (long)i * G + c; if (L >= nwg) return false;
        int wgid = (int)L; { const int q = nwg / NXCD, r = nwg % NXCD, xcd = wgid % NXCD, off = wgid / NXCD; wgid = (xcd < r ? xcd * (q + 1) : r * (q + 1) + (xcd - r) * q) + off; }
        const int nig = WGM * nN, gid = wgid / nig, fm = gid * WGM, gsz = (nM - fm) < WGM ? (nM - fm) : WGM;
        u.pm = fm + ((wgid % nig) % gsz); u.pn = (wgid % nig) / gsz; u.e = 0; u.it = 0; u.cnt = 0; return true;
    }
    __device__ __forceinline__ int arow(const Unit&, int r) const { return r; }
};

template <class Epi, class Sched, bool GATHER>
__device__ __forceinline__ void gemm_phase(LAS unsigned char* lds, const bf16_t* Ap, const bf16_t* Btp, const int K, const Sched& S, const Epi& E) {
    const int tid = threadIdx.x, wid = __builtin_amdgcn_readfirstlane(tid >> 6), lane = tid & 63, wr = wid >> 2, wc = wid & 3, fr = lane & 15, fq = lane >> 4;
    const int nt = K / BK;
    unsigned voffA[2], voffB[2]; int RA[2], CA[2];
#pragma unroll
    for (int i = 0; i < 2; ++i) { int R, C; stage_rc(tid * 16 + i * 8192, R, C); const int Rb = Epi::PERM ? ((R & ~31) + perm32(R & 31)) : R;
        RA[i] = R; CA[i] = C; voffA[i] = (unsigned)(R * K + C) * 2u; voffB[i] = (unsigned)(Rb * K + C) * 2u; }
    const size_t kstep = (size_t)(BK * 2);
    const size_t hstep = (size_t)HALF * K * 2;
    const size_t tstep = 2 * hstep;
    const unsigned ldsw = (unsigned)wid * 1024u;
    const int aoff = lds_byte(wr * 64 + fr, fq * 8), boff = lds_byte(wc * 32 + fr, fq * 8);
    unsigned vC[2][2], vN[2][2], v2[2][2];
#define PG8_SA(b, h) (((b) * 2 + (h)) * HTB)
#define PG8_SB(b, h) ((4 + (b) * 2 + (h)) * HTB)
#define PG8_STAGE(bufoff, gbase, voff) do { _Pragma("unroll") for (int _i = 0; _i < 2; ++_i) \
        __builtin_amdgcn_global_load_lds((const unsigned*)((const char*)(gbase) + (voff)[_i]), (LAS unsigned*)(lds + (bufoff) + ldsw + _i * 8192), 16, 0, 0); } while (0)
#define PG8_STAGE_A(bufoff, gbase, h, vsel) do { if constexpr (GATHER) { PG8_STAGE(bufoff, gbase, (vsel)[h]); } else { PG8_STAGE(bufoff, (gbase) + (h) * hstep, voffA); } } while (0)
#define PG8_GVOFF(u, v) do { _Pragma("unroll") for (int _h = 0; _h < 2; ++_h) _Pragma("unroll") for (int _i = 0; _i < 2; ++_i) \
        (v)[_h][_i] = (unsigned)(S.arow(u, _h * HALF + RA[_i]) * K + CA[_i]) * 2u; } while (0)
#define PG8_LDA(dst, b, h) do { _Pragma("unroll") for (int m = 0; m < 4; ++m) _Pragma("unroll") for (int k = 0; k < 2; ++k) dst[m][k] = *(const LAS bf16x8*)(lds + PG8_SA(b, h) + aoff + m * 2048 + k * 1024); } while (0)
#define PG8_LDB(dst, b, h) do { _Pragma("unroll") for (int n = 0; n < 2; ++n) _Pragma("unroll") for (int k = 0; k < 2; ++k) dst[n][k] = *(const LAS bf16x8*)(lds + PG8_SB(b, h) + boff + n * 2048 + k * 1024); } while (0)
#define PG8_MMA(ai, bj, At, Bt) do { __builtin_amdgcn_s_setprio(1); _Pragma("unroll") for (int m = 0; m < 4; ++m) _Pragma("unroll") for (int n = 0; n < 2; ++n) _Pragma("unroll") for (int k = 0; k < 2; ++k) \
        acc[ai][bj][m][n] = __builtin_amdgcn_mfma_f32_16x16x32_bf16(Bt[n][k], At[m][k], acc[ai][bj][m][n], 0, 0, 0); __builtin_amdgcn_s_setprio(0); } while (0)
#define PG8_WAIT_V(n) asm volatile("s_waitcnt vmcnt(" #n ")" ::: "memory")
#define PG8_WAIT_L(n) asm volatile("s_waitcnt lgkmcnt(" #n ")" ::: "memory")
#define PG8_BAR __builtin_amdgcn_s_barrier()
#define PG8_SCHED __builtin_amdgcn_sched_barrier(0)
    Unit cur, nxt; int ui = 0;
    if (!S.next(0, cur)) return;
    f32x4 acc[2][2][4][2];
#pragma unroll
    for (int a = 0; a < 2; ++a)
#pragma unroll
        for (int b = 0; b < 2; ++b)
#pragma unroll
            for (int m = 0; m < 4; ++m)
#pragma unroll
                for (int n = 0; n < 2; ++n) acc[a][b][m][n] = (f32x4){0.f, 0.f, 0.f, 0.f};
    bf16x8 At[4][2], B0[2][2], B1[2][2];
    const char* cA = GATHER ? (const char*)Ap : (const char*)Ap + (size_t)cur.pm * tstep; const char* cB = (const char*)Btp + (size_t)cur.pn * tstep;
    if constexpr (GATHER) { PG8_GVOFF(cur, vC); }
    PG8_STAGE(PG8_SB(0, 0), cB, voffB); PG8_STAGE(PG8_SB(0, 1), cB + hstep, voffB); PG8_STAGE_A(PG8_SA(0, 0), cA, 0, vC); PG8_STAGE_A(PG8_SA(0, 1), cA, 1, vC);
    if (wr == 1) PG8_BAR;
    PG8_WAIT_V(2); PG8_BAR;
    PG8_STAGE(PG8_SB(1, 0), cB + kstep, voffB); PG8_STAGE_A(PG8_SA(1, 0), cA + kstep, 0, vC); PG8_STAGE(PG8_SB(1, 1), cB + hstep + kstep, voffB);
    PG8_WAIT_V(6); PG8_BAR;
    for (;;) {
        const bool has_next = S.next(ui + 1, nxt);
        const char* nA = GATHER ? (const char*)Ap : (has_next ? (const char*)Ap + (size_t)nxt.pm * tstep : cA);
        const char* nB = has_next ? (const char*)Btp + (size_t)nxt.pn * tstep : cB;
        if constexpr (GATHER) { if (has_next) { PG8_GVOFF(nxt, vN); } else {
#pragma unroll
            for (int h = 0; h < 2; ++h) { vN[h][0] = vC[h][0]; vN[h][1] = vC[h][1]; } } }
        for (int t = 0; t < nt; t += 2) {
            const bool last = (t == nt - 2);
            const char* a1 = cA + (size_t)(t + 1) * kstep;
            const char* a2 = last ? nA : cA + (size_t)(t + 2) * kstep; const char* b2 = last ? nB : cB + (size_t)(t + 2) * kstep;
            const char* a3 = a2 + kstep; const char* b3 = b2 + kstep;
            if constexpr (GATHER) {
#pragma unroll
                for (int h = 0; h < 2; ++h) { v2[h][0] = last ? vN[h][0] : vC[h][0]; v2[h][1] = last ? vN[h][1] : vC[h][1]; } }
            PG8_LDB(B0, 0, 0); PG8_LDB(B1, 0, 1); PG8_SCHED; PG8_LDA(At, 0, 0); PG8_STAGE_A(PG8_SA(1, 1), a1, 1, vC);
            PG8_WAIT_V(8); PG8_WAIT_L(0); PG8_BAR; PG8_MMA(0, 0, At, B0); PG8_MMA(0, 1, At, B1); PG8_BAR; PG8_SCHED;
            PG8_LDA(At, 0, 1); PG8_STAGE(PG8_SB(0, 0), b2, voffB); PG8_STAGE(PG8_SB(0, 1), b2 + hstep, voffB); PG8_STAGE_A(PG8_SA(0, 0), a2, 0, v2);
            PG8_WAIT_V(8); PG8_WAIT_L(0); PG8_BAR; PG8_MMA(1, 0, At, B0); PG8_MMA(1, 1, At, B1); PG8_BAR; PG8_SCHED;
            PG8_LDB(B0, 1, 0); PG8_LDB(B1, 1, 1); PG8_SCHED; PG8_LDA(At, 1, 0); PG8_STAGE_A(PG8_SA(0, 1), a2, 1, v2);
            PG8_WAIT_V(8); PG8_WAIT_L(0); PG8_BAR; PG8_MMA(0, 0, At, B0); PG8_MMA(0, 1, At, B1); PG8_BAR; PG8_SCHED;
            PG8_LDA(At, 1, 1); PG8_STAGE(PG8_SB(1, 0), b3, voffB); PG8_STAGE(PG8_SB(1, 1), b3 + hstep, voffB); PG8_STAGE_A(PG8_SA(1, 0), a3, 0, v2);
            PG8_WAIT_V(8); PG8_WAIT_L(0); PG8_BAR; PG8_MMA(1, 0, At, B0); PG8_MMA(1, 1, At, B1); PG8_BAR; PG8_SCHED;
        }
        if (wr == 0) PG8_BAR;
        E(acc, cur, wr, wc, fr, fq);
        if (!has_next) break;
#pragma unroll
        for (int a = 0; a < 2; ++a)
#pragma unroll
            for (int b = 0; b < 2; ++b)
#pragma unroll
                for (int m = 0; m < 4; ++m)
#pragma unroll
                    for (int n = 0; n < 2; ++n) acc[a][b][m][n] = (f32x4){0.f, 0.f, 0.f, 0.f};
        cur = nxt; cA = nA; cB = nB; ++ui;
        if constexpr (GATHER) {
#pragma unroll
            for (int h = 0; h < 2; ++h) { vC[h][0] = vN[h][0]; vC[h][1] = vN[h][1]; } }
        if (wr == 1) PG8_BAR;
    }
    PG8_WAIT_V(0);
    PG8_BAR;
#undef PG8_SA
#undef PG8_SB
#undef PG8_STAGE
#undef PG8_STAGE_A
#undef PG8_GVOFF
#undef PG8_LDA
#undef PG8_LDB
#undef PG8_MMA
#undef PG8_WAIT_V
#undef PG8_WAIT_L
#undef PG8_BAR
#undef PG8_SCHED
}
}

struct Params { const float* in[25]; float* out; unsigned char* ws; int ph_lo, ph_hi; };
struct Frame {
    LAS unsigned char* lds; int G, bx;
    unsigned char* ws;
    const float *x, *c, *w_ada, *b_ada, *w_in, *b_mgate, *conv_w, *conv_b, *m_norm_g, *w_proj_a, *w_proj_m, *w_gate, *b_gate, *w_out, *ln1_g, *ln1_b, *w_rg, *b_rg, *w_re, *b_re, *w_eg, *w_eu, *w_ed, *ln2_g, *ln2_b;
    float* out;
};
__device__ __forceinline__ int otid() { int t = threadIdx.x; asm volatile("" : "+v"(t)); return t; }
#define FTID otid()
#define FLANE (otid() & 63)
#define FWAVE __builtin_amdgcn_readfirstlane(otid() >> 6)
#define WSP(T_, off) ((T_*)(F.ws + (off)))

#ifndef CVT_SWAP
#define CVT_SWAP 1
#endif
constexpr int N_IT_P0 = 400, N_IT_PX = 112, N_IT_W1 = N_IT_PX + 2048, N_IT_BG = N_IT_W1 + 1024;
constexpr int CVT_P = 544, CVT_BUF = 64 * CVT_P, CVT_RP = 144, CVT_IMG = 2 * CVT_BUF;
constexpr int CW_QHEAD = 4160, CW_QHEAD2 = 4352, CW_DONE2 = 4224, CW_DONE10 = 4288;
struct CvtItem { const float* src; bf16_t* dst; int ld, Kdst, kind, arg, n0, valid; };
__device__ __forceinline__ int cvt_row(int kind, int arg, int n) {
    if (kind == 1) { if (n < 3072) { const int hd = n >> 7, lc = n & 127; return hd * 128 + 2 * (lc & 63) + (lc >> 6); } return n; }
    if (kind == 2) return 256 * (n >> 7) + 128 * arg + (n & 127);
    return n + arg;
}
__device__ __forceinline__ CvtItem cvt_decode_p0(const Frame& F, int item, int lim) {
    CvtItem c; c.valid = (item < lim); c.kind = 0; c.arg = 0;
    if (item < 272) { const int nt = item >> 3, kq = item & 7; c.src = F.w_in + (size_t)(kq * 256) * NIN + nt * 256; c.ld = NIN; c.dst = WSP(bf16_t, WS_WBIG) + kq * 256; c.Kdst = D; c.kind = 1; c.n0 = nt * 256; }
    else if (item < 400) { const int i = item - 272; const int nt = i >> 3, kq = i & 7; c.src = F.w_gate + (size_t)(kq * 256) * 4096 + nt * 256; c.ld = 4096; c.dst = WSP(bf16_t, WS_WBIG) + kq * 256; c.Kdst = D; c.arg = 8704; c.n0 = nt * 256; }
    else if (item < 416) { const int i = item - 400; const int nt = i >> 1, kq = i & 1; c.src = F.w_proj_a + (size_t)(kq * 256) * D + nt * 256; c.ld = D; c.dst = WSP(bf16_t, WS_WPA) + kq * 256; c.Kdst = 512; c.n0 = nt * 256; }
    else if (item < 448) { const int i = item - 416; const int nt = i >> 2, kq = i & 3; c.src = F.w_proj_m + (size_t)(kq * 256) * D + nt * 256; c.ld = D; c.dst = WSP(bf16_t, WS_WPM) + kq * 256; c.Kdst = 1024; c.n0 = nt * 256; }
    else { const int i = (item < 512 ? item : 511) - 448; const int nt = i >> 3, kq = i & 7; c.src = F.w_out + (size_t)(kq * 256) * D + nt * 256; c.ld = D; c.dst = WSP(bf16_t, WS_WO) + kq * 256; c.Kdst = D; c.n0 = nt * 256; }
    return c;
}
__device__ __forceinline__ CvtItem cvt_decode_bg(const Frame& F, int item) {
    if (item < N_IT_PX) return cvt_decode_p0(F, 400 + item, 512);
    CvtItem c; c.valid = (item < N_IT_BG);
    if (item < N_IT_W1) { const int iw = item - N_IT_PX; const int e = iw >> 6, r = iw & 63, mat = r >> 5, kq = (r >> 2) & 7, nt = r & 3;
        c.src = (mat ? F.w_eu : F.w_eg) + (size_t)e * D * FF + (size_t)(kq * 256) * FF + nt * 256; c.ld = FF; c.dst = WSP(bf16_t, WS_W1T) + (size_t)e * 2048 * D + kq * 256; c.Kdst = D; c.kind = 2; c.arg = mat; c.n0 = nt * 256; }
    else { const int i2 = (item < N_IT_BG ? item : N_IT_BG - 1) - N_IT_W1; const int e = i2 >> 5, r = i2 & 31, kq = r >> 3, nt = r & 7;
        c.src = F.w_ed + (size_t)e * FF * D + (size_t)(kq * 256) * D + nt * 256; c.ld = D; c.dst = WSP(bf16_t, WS_W2T) + (size_t)e * D * FF + kq * 256; c.Kdst = FF; c.kind = 0; c.arg = 0; c.n0 = nt * 256; }
    return c;
}
#define CVT_LOAD(R, it, j) do { _Pragma("unroll") for (int _p = 0; _p < 8; ++_p) (R)[_p] = __builtin_nontemporal_load((const f32x4*)((it).src + (size_t)(64 * (j) + kr + 8 * _p) * (it).ld + n4)); } while (0)
template <int MODE>
__device__ __forceinline__ void cvt_stream(const Frame& F, int limit) {
    const int tid = FTID; const int lane = tid & 63, w = __builtin_amdgcn_readfirstlane(tid >> 6), li = lane & 15, g = lane >> 4;
    const int kr = tid >> 6, n4 = 4 * (tid & 63);
    unsigned* qh = (unsigned*)(F.ws + WS_CTL) + (limit <= N_IT_W1 ? CW_QHEAD : CW_QHEAD2); const int ibase = (limit <= N_IT_W1) ? 0 : N_IT_W1;
    volatile LAS int* mb = (volatile LAS int*)(F.lds + LDS_MISC) + 16;
    LAS unsigned char* lbuf = F.lds; LAS unsigned char* wimg = F.lds + CVT_IMG + w * (64 * CVT_RP);
    __syncthreads();
    int i0, i1;
    if (MODE == 0) { i0 = F.bx; i1 = F.bx + F.G; }
    else { if (tid == 0) { const unsigned a0 = atomicAdd(qh, 2u); mb[0] = (int)a0; mb[2] = 0; } __syncthreads(); i0 = ibase + mb[0]; i1 = i0 + 1; if (i0 >= limit) i0 = 0x7fffffff; if (i1 >= limit) i1 = 0x7fffffff; }
    CvtItem cur = (MODE == 0) ? cvt_decode_p0(F, i0, N_IT_P0) : cvt_decode_bg(F, i0), nxt = (MODE == 0) ? cvt_decode_p0(F, i1, N_IT_P0) : cvt_decode_bg(F, i1);
    int inext = i1;
    f32x4 R0[8], R1[8], R2[8], R3[8];
    if (cur.valid) { CVT_LOAD(R0, cur, 0); CVT_LOAD(R1, cur, 1); CVT_LOAD(R2, cur, 2); CVT_LOAD(R3, cur, 3); }
    const unsigned rdbase = (unsigned)(uintptr_t)lbuf + (unsigned)((4 * g + (li >> 2)) * CVT_P + (32 * w + 4 * (li & 3)) * 2);
    while (cur.valid) {
        unsigned cl = 0u;
        if (MODE == 1 && tid == 0) cl = atomicAdd(qh, 1u);
        size_t rofs[4];
#pragma unroll
        for (int i4 = 0; i4 < 4; ++i4) rofs[i4] = (size_t)cvt_row(cur.kind, cur.arg, cur.n0 + 32 * w + 8 * i4 + (lane >> 3)) * cur.Kdst;
#define CVT_PROC2(Ra, Rb, j) do { \
            _Pragma("unroll") for (int _p = 0; _p < 8; ++_p) { u32x2 wv; wv.x = cvt_pk_bf16((Ra)[_p][0], (Ra)[_p][1]); wv.y = cvt_pk_bf16((Ra)[_p][2], (Ra)[_p][3]); *(LAS u32x2*)(lbuf + (kr + 8 * _p) * CVT_P + 2 * n4) = wv; \
                wv.x = cvt_pk_bf16((Rb)[_p][0], (Rb)[_p][1]); wv.y = cvt_pk_bf16((Rb)[_p][2], (Rb)[_p][3]); *(LAS u32x2*)(lbuf + CVT_BUF + (kr + 8 * _p) * CVT_P + 2 * n4) = wv; } \
            asm volatile("s_waitcnt lgkmcnt(0)\n\ts_barrier" ::: "memory"); \
            if (nxt.valid) { CVT_LOAD(Ra, nxt, j); CVT_LOAD(Rb, nxt, (j) + 1); } \
            s16x4 tA[8], tB[8]; \
            _Pragma("unroll") for (int kb = 0; kb < 4; ++kb) { tA[kb] = tr_read_o(rdbase, kb * 16 * CVT_P); tB[kb] = tr_read_o(rdbase, kb * 16 * CVT_P + 32); \
                tA[4 + kb] = tr_read_o(rdbase, CVT_BUF + kb * 16 * CVT_P); tB[4 + kb] = tr_read_o(rdbase, CVT_BUF + kb * 16 * CVT_P + 32); } \
            LGKM_WAIT0(); \
            asm volatile("s_barrier" ::: "memory"); \
            _Pragma("unroll") for (int q8 = 0; q8 < 8; ++q8) { union { s16x4 v; unsigned u[2]; } a, b; a.v = tA[q8]; b.v = tB[q8]; \
                auto r0 = __builtin_amdgcn_permlane16_swap(a.u[0], b.u[0], false, false); auto r1 = __builtin_amdgcn_permlane16_swap(a.u[1], b.u[1], false, false); \
                u32x4 o; o.x = r0[0]; o.y = r1[0]; o.z = r0[1]; o.w = r1[1]; \
                *(LAS u32x4*)(wimg + (q8 >> 2) * (32 * CVT_RP) + (16 * (g & 1) + li) * CVT_RP + (16 * (q8 & 3) + 8 * (g >> 1)) * 2) = o; } \
            asm volatile("s_waitcnt lgkmcnt(0)" ::: "memory"); \
            _Pragma("unroll") for (int q8 = 0; q8 < 8; ++q8) { const u32x4 o = *(const LAS u32x4*)(wimg + (q8 >> 2) * (32 * CVT_RP) + (8 * (q8 & 3) + (lane >> 3)) * CVT_RP + (lane & 7) * 16); \
                __builtin_nontemporal_store(o, (u32x4*)(cur.dst + rofs[q8 & 3] + 64 * ((j) + (q8 >> 2)) + 8 * (lane & 7))); } } while (0)
        CVT_PROC2(R0, R1, 0); CVT_PROC2(R2, R3, 2);
        int i2;
        if (MODE == 0) { i2 = inext + F.G; }
        else { if (tid == 0) mb[0] = (int)cl; asm volatile("s_waitcnt lgkmcnt(0)\n\ts_barrier" ::: "memory"); i2 = ibase + mb[0]; if (i2 >= limit || i2 < 0) i2 = 0x7fffffff; asm volatile("s_waitcnt lgkmcnt(0)\n\ts_barrier" ::: "memory"); }
        cur = nxt; inext = i2; nxt = (MODE == 0) ? cvt_decode_p0(F, i2, N_IT_P0) : cvt_decode_bg(F, i2);
    }
    __syncthreads();
#undef CVT_PROC2
}

__device__ __forceinline__ void p0_prologue(const Frame& F) {
    const int G = F.G, bx = F.bx;
    cvt_stream<0>(F, N_IT_P0);
    __syncthreads();
    {
        LAS float* sc = (LAS float*)F.lds;
        LAS float* red = (LAS float*)(F.lds + 32768);
        float* mod = WSP(float, WS_MOD);
        for (int i = FTID; i < NB * D; i += NTHR) { const float cv = F.c[i]; sc[i] = cv / (1.f + expf(-cv)); }
        __syncthreads();
        for (int cb = bx; cb < 6 * D / 48; cb += G) {
            const int cg = FTID % 12, kl = FTID / 12;
            float a[4][4] = {};
            if (kl < 42) {
                for (int k0 = kl; k0 < D; k0 += 42 * 7) { f32x4 w[7];
#pragma unroll
                    for (int u = 0; u < 7; ++u) { const int k = k0 + 42 * u; w[u] = (k < D) ? *(const f32x4*)(F.w_ada + (size_t)k * (6 * D) + cb * 48 + cg * 4) : (f32x4){0.f, 0.f, 0.f, 0.f}; }
#pragma unroll
                    for (int u = 0; u < 7; ++u) { const int k = (k0 + 42 * u < D) ? k0 + 42 * u : 0;
#pragma unroll
                        for (int b = 0; b < 4; ++b) { const float s = sc[b * D + k];
#pragma unroll
                            for (int j = 0; j < 4; ++j) a[b][j] += s * w[u][j]; } } }
#pragma unroll
                for (int b = 0; b < 4; ++b)
#pragma unroll
                    for (int j = 0; j < 4; ++j) red[(kl * 12 + cg) * 16 + b * 4 + j] = a[b][j];
            }
            __syncthreads();
            if (FTID < 192) { const int cgi = FTID / 16, bj = FTID % 16; float s = 0.f; for (int q = 0; q < 42; ++q) s += red[(q * 12 + cgi) * 16 + bj];
                const int b = bj / 4, j = bj % 4; const int col = cb * 48 + cgi * 4 + j; mod[(size_t)b * 6 * D + col] = s + F.b_ada[col]; }
            __syncthreads();
        }
    }
    {
        float* rope = WSP(float, WS_ROPE);
        for (int i = bx * NTHR + FTID; i < S * 64; i += G * NTHR) { const int pos = i >> 6, fi = i & 63;
            const float inv = powf(10000.f, -(float)(2 * fi) / 128.f); const float ang = (float)pos * inv; rope[2 * i] = cosf(ang); rope[2 * i + 1] = sinf(ang); }
        float* wif = WSP(float, WS_WIF);
        for (int i = bx * NTHR + FTID; i < 8 * D; i += G * NTHR) { const int j = i / D, k = i % D; wif[i] = F.w_in[(size_t)k * NIN + OFF_IF + j]; }
        bf16_t* wrt = WSP(bf16_t, WS_WRT);
        for (int i = bx * NTHR + FTID; i < 48 * D; i += G * NTHR) { const int j = i / D, k = i % D;
            const float w = (j < 4) ? F.w_rg[k * 4 + j] : (j < 36 ? F.w_re[k * 32 + (j - 4)] : 0.f);
            const bf16_t hi = f2bf(w); const bf16_t lo = f2bf(w - bf2f(hi)); wrt[i] = hi; wrt[48 * D + i] = lo; }
    }
}

__device__ __forceinline__ void p1_lnmod(const Frame& F) {
    const float* mod = WSP(float, WS_MOD); const float* wif = WSP(float, WS_WIF); bf16_t* U = WSP(bf16_t, WS_U); float* gpre = WSP(float, WS_GPRE);
    const int tid = FTID; const int lane = tid & 63; const int gw = F.bx * NWAVES + __builtin_amdgcn_readfirstlane(tid >> 6), NGW = F.G * NWAVES;
    LAS float* wl = (LAS float*)F.lds;
    __syncthreads();
#pragma unroll
    for (int i = 0; i < 8; ++i) *(LAS f32x4*)(wl + 4 * (tid + NTHR * i)) = *(const f32x4*)(wif + 4 * (tid + NTHR * i));
    __syncthreads();
    f32x4 v[8], nx[8];
    if (gw < T) {
#pragma unroll
        for (int i = 0; i < 8; ++i) nx[i] = *(const f32x4*)(F.x + (size_t)gw * D + 4 * (lane + 64 * i)); }
    for (int t = gw; t < T; t += NGW) {
        const int b = t / S; float s = 0.f;
#pragma unroll
        for (int i = 0; i < 8; ++i) { v[i] = nx[i]; s += (v[i][0] + v[i][1]) + (v[i][2] + v[i][3]); }
        if (t + NGW < T) {
#pragma unroll
            for (int i = 0; i < 8; ++i) nx[i] = *(const f32x4*)(F.x + (size_t)(t + NGW) * D + 4 * (lane + 64 * i)); }
        const float mu = wave_sum(s) * (1.f / D);
        float q = 0.f;
#pragma unroll
        for (int i = 0; i < 8; ++i) { v[i] = v[i] - mu; q += (v[i][0] * v[i][0] + v[i][1] * v[i][1]) + (v[i][2] * v[i][2] + v[i][3] * v[i][3]); }
        const float rstd = rsqrtf(wave_sum(q) * (1.f / D) + LN_EPS);
        const float* sc = mod + (size_t)b * 6 * D + 1 * D; const float* sf = mod + (size_t)b * 6 * D;
#pragma unroll
        for (int i = 0; i < 8; ++i) { const int d = 4 * (lane + 64 * i); const f32x4 a = *(const f32x4*)(sc + d), bb = *(const f32x4*)(sf + d);
            v[i] = v[i] * rstd * (a + 1.f) + bb;
            u32x2 w; w.x = cvt_pk_bf16(v[i][0], v[i][1]); w.y = cvt_pk_bf16(v[i][2], v[i][3]); *(u32x2*)(U + (size_t)t * D + d) = w; }
        float g[8];
#pragma unroll
        for (int j = 0; j < 8; ++j) { float a = 0.f;
#pragma unroll
            for (int i = 0; i < 8; ++i) { const f32x4 w = *(const LAS f32x4*)(wl + j * D + 4 * (lane + 64 * i)); a += (v[i][0] * w[0] + v[i][1] * w[1]) + (v[i][2] * w[2] + v[i][3] * w[3]); }
            g[j] = wave_sum(a); }
        if (lane < 8) { float val = 0.f;
#pragma unroll
            for (int j = 0; j < 8; ++j) val = (lane == j) ? g[j] : val;
            val += F.b_mgate[lane];
            if (lane >= 4) val = fminf(val, 0.f) - log1pf(expf(-fabsf(val)));
            gpre[(size_t)t * 8 + lane] = val; }
    }
}

struct EpiP2 {
    static constexpr bool PERM = true;
    bf16_t *Q, *Kb, *V, *QKP, *VM, *OG, *GB; const float* rope; const float* b_gate;
    __device__ __forceinline__ void operator()(const f32x4 (&acc)[2][2][4][2], const pg8::Unit& u, int wr, int wc, int fr, int fq) const {
        const int pn = u.pn; int kind, coff, ldc; bf16_t* base;
        if (pn < 6) { kind = 0; base = Q; ldc = 1536; coff = pn * 256; }
        else if (pn < 12) { kind = 1; base = Kb; ldc = 1536; coff = (pn - 6) * 256; }
        else if (pn < 18) { kind = 2; base = V; ldc = 1536; coff = (pn - 12) * 256; }
        else if (pn < 26) { kind = 2; base = QKP; ldc = 2048; coff = (pn - 18) * 256; }
        else if (pn < 30) { kind = 2; base = VM; ldc = 1024; coff = (pn - 26) * 256; }
        else if (pn < 34) { kind = 3; base = OG; ldc = 1024; coff = (pn - 30) * 256; }
        else { kind = 4; base = GB; ldc = 4096; coff = (pn - 34) * 256; }
        const int row0 = u.pm * 256 + wr * 64 + fr, colL = wc * 32 + 8 * fq;
#pragma unroll
        for (int ai = 0; ai < 2; ++ai)
#pragma unroll
            for (int m = 0; m < 4; ++m) { const int r = row0 + ai * 128 + m * 16; const int pos = r & (S - 1);
#pragma unroll
                for (int bj = 0; bj < 2; ++bj) { f32x4 v0 = acc[ai][bj][m][0], v1 = acc[ai][bj][m][1]; const int col = coff + bj * 128 + colL;
                    if (kind <= 1) {
                        const float* rp = rope + ((size_t)pos * 64 + (16 * wc + 4 * fq)) * 2;
                        const f32x4 c0 = *(const f32x4*)rp, c1 = *(const f32x4*)(rp + 4);
                        const float sc = (kind == 0) ? QSCALE : 1.f;
                        f32x4 o0, o1;
                        o0[0] = (v0[0] * c0[0] - v0[1] * c0[1]) * sc; o0[1] = (v0[1] * c0[0] + v0[0] * c0[1]) * sc;
                        o0[2] = (v0[2] * c0[2] - v0[3] * c0[3]) * sc; o0[3] = (v0[3] * c0[2] + v0[2] * c0[3]) * sc;
                        o1[0] = (v1[0] * c1[0] - v1[1] * c1[1]) * sc; o1[1] = (v1[1] * c1[0] + v1[0] * c1[1]) * sc;
                        o1[2] = (v1[2] * c1[2] - v1[3] * c1[3]) * sc; o1[3] = (v1[3] * c1[2] + v1[2] * c1[3]) * sc;
                        v0 = o0; v1 = o1;
                    } else if (kind >= 3) {
                        if (kind == 4) { v0 = v0 + *(const f32x4*)(b_gate + col); v1 = v1 + *(const f32x4*)(b_gate + col + 4); }
#pragma unroll
                        for (int j = 0; j < 4; ++j) { v0[j] = sigmoid_fast(v0[j]); v1[j] = sigmoid_fast(v1[j]); }
                    }
                    u32x4 w; w.x = cvt_pk_bf16(v0[0], v0[1]); w.y = cvt_pk_bf16(v0[2], v0[3]); w.z = cvt_pk_bf16(v1[0], v1[1]); w.w = cvt_pk_bf16(v1[2], v1[3]);
                    *(u32x4*)(base + (size_t)r * ldc + col) = w; } }
    }
};

__device__ __forceinline__ void scan_bh(const Frame& F, int bh) {
    const float* gpre = WSP(float, WS_GPRE); float* bc = WSP(float, WS_BCUM) + (size_t)bh * S; float* mc = WSP(float, WS_MCUM) + (size_t)bh * S;
    const int b = bh >> 2, h = bh & 3, lane = FLANE;
    float lf[32], iv[32];
#pragma unroll
    for (int j = 0; j < 32; ++j) { const size_t t = (size_t)b * S + lane * 32 + j; iv[j] = gpre[t * 8 + h]; lf[j] = gpre[t * 8 + 4 + h]; }
    float run = 0.f;
#pragma unroll
    for (int j = 0; j < 32; ++j) { run += lf[j]; lf[j] = run; }
    float tot = run, incl = run;
#pragma unroll
    for (int o = 1; o < 64; o <<= 1) { const float n = __shfl_up(incl, o); if (lane >= o) incl += n; }
    const float excl = incl - tot;
    float mx = -INFINITY;
#pragma unroll
    for (int j = 0; j < 32; ++j) { lf[j] += excl; mx = fmaxf(mx, iv[j] - lf[j]); iv[j] = mx; }
    float mincl = mx;
#pragma unroll
    for (int o = 1; o < 64; o <<= 1) { const float n = __shfl_up(mincl, o); if (lane >= o) mincl = fmaxf(mincl, n); }
    float mexcl = __shfl_up(mincl, 1); if (lane == 0) mexcl = -INFINITY;
#pragma unroll
    for (int j = 0; j < 32; ++j) { const float cm = fmaxf(0.f, fmaxf(mexcl, iv[j])); bc[lane * 32 + j] = lf[j]; mc[lane * 32 + j] = lf[j] + cm; }
}

__device__ __forceinline__ void p3_conv(const Frame& F) {
    const bf16_t* QKP = WSP(bf16_t, WS_QKP); bf16_t* QM = WSP(bf16_t, WS_QM); bf16_t* KM = WSP(bf16_t, WS_KM);
    for (int item = F.bx * NTHR + FTID; item < 256 * 512; item += F.G * NTHR) {
        const int cc = item & 255, rs = item >> 8; const int c0 = cc * 8, t0 = rs * 16;
        float w[4][8], bias[8];
#pragma unroll
        for (int j = 0; j < 4; ++j) { const f32x4 a = *(const f32x4*)(F.conv_w + j * 2048 + c0), b = *(const f32x4*)(F.conv_w + j * 2048 + c0 + 4);
#pragma unroll
            for (int e = 0; e < 4; ++e) { w[j][e] = a[e]; w[j][4 + e] = b[e]; } }
        { const f32x4 a = *(const f32x4*)(F.conv_b + c0), b = *(const f32x4*)(F.conv_b + c0 + 4);
#pragma unroll
            for (int e = 0; e < 4; ++e) { bias[e] = a[e]; bias[4 + e] = b[e]; } }
        float x1[8], x2[8], x3[8];
        const int pos0 = t0 & (S - 1);
        auto ldrow = [&](int t, float (&dst)[8]) { const u32x4 v = *(const u32x4*)(QKP + (size_t)t * 2048 + c0);
            dst[0] = bf_lo(v.x); dst[1] = bf_hi(v.x); dst[2] = bf_lo(v.y); dst[3] = bf_hi(v.y); dst[4] = bf_lo(v.z); dst[5] = bf_hi(v.z); dst[6] = bf_lo(v.w); dst[7] = bf_hi(v.w); };
        if (pos0 >= 3) { ldrow(t0 - 1, x1); ldrow(t0 - 2, x2); ldrow(t0 - 3, x3); }
        else {
#pragma unroll
            for (int e = 0; e < 8; ++e) { x1[e] = 0.f; x2[e] = 0.f; x3[e] = 0.f; } }
        const bool isk = c0 >= 1024; bf16_t* dst = isk ? (KM + (c0 - 1024)) : (QM + c0); const float osc = isk ? 0.0625f : 1.f;
#pragma unroll 4
        for (int r = 0; r < 16; ++r) { float x0[8]; ldrow(t0 + r, x0); float y[8];
#pragma unroll
            for (int e = 0; e < 8; ++e) { y[e] = bias[e] + w[3][e] * x0[e] + w[2][e] * x1[e] + w[1][e] * x2[e] + w[0][e] * x3[e]; y[e] = silu_fast(y[e]) * osc; x3[e] = x2[e]; x2[e] = x1[e]; x1[e] = x0[e]; }
            u32x4 o; o.x = cvt_pk_bf16(y[0], y[1]); o.y = cvt_pk_bf16(y[2], y[3]); o.z = cvt_pk_bf16(y[4], y[5]); o.w = cvt_pk_bf16(y[6], y[7]);
            *(u32x4*)(dst + (size_t)(t0 + r) * 1024) = o; }
    }
}

constexpr int AT_KP = 272, AT_VP = 288, AT_VOFF = 256 * AT_KP;
struct AttnDec { int b, head, dl, r, n; };
__device__ __forceinline__ AttnDec attn_decode(int unit) {
    AttnDec a; a.b = unit / 192; const int rem = unit % 192; a.head = rem >> 4; const int blk = rem & 15;
    const int g = a.head >> 2; a.dl = (g == 0) ? 0 : (g == 1 ? 2 : 4); const int nbr = 16 >> a.dl; a.r = blk / nbr; a.n = blk % nbr; return a;
}
#define ATTN_PREFETCH(A, kv, vv) do { _Pragma("unroll") for (int i = 0; i < 8; ++i) { const int id = tid + NTHR * i; const int row = id >> 4, ch = id & 15; const int bn = (row < 128) ? (A).n - 1 : (A).n; const int lr = row & 127; \
        const int pos = ((bn * 128 + lr) << (A).dl) + (A).r; const size_t so = (size_t)((A).b * S + pos) * 1536 + (A).head * 128 + ch * 8; \
        (kv)[i] = (bn >= 0) ? *(const u32x4*)(KB + so) : (u32x4){0u, 0u, 0u, 0u}; (vv)[i] = (bn >= 0) ? *(const u32x4*)(VB + so) : (u32x4){0u, 0u, 0u, 0u}; } } while (0)
__device__ __forceinline__ void attn_phase(const Frame& F) {
    const bf16_t* QB = WSP(bf16_t, WS_QB); const bf16_t* KB = WSP(bf16_t, WS_KB); const bf16_t* VB = WSP(bf16_t, WS_VB); bf16_t* OA = WSP(bf16_t, WS_OATT); float* LSE = WSP(float, WS_LSE);
    const int tid = FTID; const int lane = tid & 63, w = __builtin_amdgcn_readfirstlane(tid >> 6), jl = lane & 15, g4 = lane >> 4;
    LAS unsigned char* Ks = F.lds; LAS unsigned char* Vs = F.lds + AT_VOFF;
    int unit = F.bx; if (unit >= 768) return;
    u32x4 kv[8], vv[8];
    { const AttnDec A0 = attn_decode(unit); ATTN_PREFETCH(A0, kv, vv); }
  for (; unit < 768; unit += F.G) {
    const AttnDec A = attn_decode(unit); const int b = A.b, head = A.head, dl = A.dl, r = A.r, n = A.n;
    __syncthreads();
#pragma unroll
    for (int i = 0; i < 8; ++i) { const int id = tid + NTHR * i; const int row = id >> 4, ch = id & 15;
        *(LAS u32x4*)(Ks + row * AT_KP + ch * 16) = kv[i]; *(LAS u32x4*)(Vs + row * AT_VP + ch * 16) = vv[i]; }
    const int posq = (((n * 128 + 16 * w + jl)) << dl) + r;
    const size_t tq = (size_t)b * S + posq;
    bf16x8 qf[4];
#pragma unroll
    for (int ks = 0; ks < 4; ++ks) qf[ks] = *(const bf16x8*)(QB + tq * 1536 + head * 128 + ks * 32 + 8 * g4);
    __syncthreads();
    if (unit + F.G < 768) { const AttnDec A1 = attn_decode(unit + F.G); ATTN_PREFETCH(A1, kv, vv); }
    f32x4 sT[10];
#pragma unroll
    for (int u = 0; u < 9; ++u) { f32x4 a = {0.f, 0.f, 0.f, 0.f};
#pragma unroll
        for (int ks = 0; ks < 4; ++ks) { const bf16x8 kf = *(const LAS bf16x8*)(Ks + (16 * (w + u) + jl) * AT_KP + (ks * 32 + 8 * g4) * 2); a = __builtin_amdgcn_mfma_f32_16x16x32_bf16(kf, qf[ks], a, 0, 0, 0); }
        sT[u] = a; }
    sT[9] = (f32x4){0.f, 0.f, 0.f, 0.f};
    float mx = -INFINITY;
#pragma unroll
    for (int u = 0; u < 9; ++u)
#pragma unroll
        for (int rg = 0; rg < 4; ++rg) { const int kin = 4 * g4 + rg; bool valid;
            if (u == 0) valid = (n > 0) && (kin >= jl); else if (u == 8) valid = (kin <= jl); else valid = (w + u >= 8) || (n > 0);
            const float s = valid ? sT[u][rg] : -INFINITY; sT[u][rg] = s; mx = fmaxf(mx, s); }
    mx = fmaxf(mx, __shfl_xor(mx, 16)); mx = fmaxf(mx, __shfl_xor(mx, 32));
    float den = 0.f;
#pragma unroll
    for (int u = 0; u < 9; ++u)
#pragma unroll
        for (int rg = 0; rg < 4; ++rg) { const float p = fast_exp2(sT[u][rg] - mx); sT[u][rg] = p; den += p; }
    den += __shfl_xor(den, 16); den += __shfl_xor(den, 32);
    f32x4 oT[8];
#pragma unroll
    for (int et = 0; et < 8; ++et) oT[et] = (f32x4){0.f, 0.f, 0.f, 0.f};
    const unsigned vbase = (unsigned)(uintptr_t)(Vs) + (unsigned)((4 * g4 + (jl >> 2)) * AT_VP + (jl & 3) * 8);
#pragma unroll
    for (int c = 0; c < 5; ++c) {
        const int kt0 = w + 2 * c, kt1 = (c == 4) ? kt0 : kt0 + 1;
        union { bf16x8 v; unsigned u[4]; } pf;
        pf.u[0] = cvt_pk_bf16(sT[2 * c][0], sT[2 * c][1]); pf.u[1] = cvt_pk_bf16(sT[2 * c][2], sT[2 * c][3]);
        pf.u[2] = cvt_pk_bf16(sT[2 * c + 1][0], sT[2 * c + 1][1]); pf.u[3] = cvt_pk_bf16(sT[2 * c + 1][2], sT[2 * c + 1][3]);
        s16x4 t0[8], t1[8];
        const unsigned vb0 = vbase + kt0 * 16 * AT_VP, vb1 = vbase + kt1 * 16 * AT_VP;
#pragma unroll
        for (int et = 0; et < 8; ++et) { t0[et] = tr_read_o(vb0, et * 32); t1[et] = tr_read_o(vb1, et * 32); }
        LGKM_WAIT0();
#pragma unroll
        for (int et = 0; et < 8; ++et) oT[et] = __builtin_amdgcn_mfma_f32_16x16x32_bf16(PK8(t0[et], t1[et]), pf.v, oT[et], 0, 0, 0);
    }
    const float inv = 1.f / den;
#pragma unroll
    for (int et = 0; et < 8; ++et) { u32x2 o; o.x = cvt_pk_bf16(oT[et][0] * inv, oT[et][1] * inv); o.y = cvt_pk_bf16(oT[et][2] * inv, oT[et][3] * inv);
        *(u32x2*)(OA + tq * 1536 + head * 128 + 16 * et + 4 * g4) = o; }
    if (g4 == 0) LSE[tq * 12 + head] = (mx + log2f(den)) * LN2;
  }
}

constexpr int ML_P = 544;
__device__ __forceinline__ void mlstm_dc_unit(const Frame& F, int unit) {
    const bf16_t* KM = WSP(bf16_t, WS_KM); const bf16_t* VM = WSP(bf16_t, WS_VMB); const float* gpre = WSP(float, WS_GPRE);
    const float* bcum = WSP(float, WS_BCUM); const float* mcum = WSP(float, WS_MCUM); bf16_t* DC = WSP(bf16_t, WS_DC) + (size_t)unit * 65536; float* DN = WSP(float, WS_DN) + (size_t)unit * 256;
    const int bh = unit >> 4, c = unit & 15, b = bh >> 2, h = bh & 3; const size_t t0 = (size_t)b * S + c * 128;
    const int tid = FTID, lane = FLANE, w = FWAVE, jl = lane & 15, g4 = lane >> 4;
    LAS unsigned char* Ks = F.lds; LAS unsigned char* Vs = F.lds + 128 * ML_P; LAS float* wt = (LAS float*)(F.lds + 2 * 128 * ML_P);
    __syncthreads();
    if (tid < 128) { const float Be = bcum[bh * S + c * 128 + 127], me = mcum[bh * S + c * 128 + 127];
        wt[tid] = expf(Be - bcum[bh * S + c * 128 + tid] + gpre[(t0 + tid) * 8 + h] - me); }
    __syncthreads();
    {
        u32x4 v[8];
#pragma unroll
        for (int i = 0; i < 8; ++i) { const int id = tid + NTHR * i; const int row = id >> 5, ch = id & 31; v[i] = *(const u32x4*)(KM + (t0 + row) * 1024 + h * 256 + ch * 8); }
#pragma unroll
        for (int i = 0; i < 8; ++i) { const int id = tid + NTHR * i; const int row = id >> 5, ch = id & 31; *(LAS u32x4*)(Ks + row * ML_P + ch * 16) = v[i]; }
#pragma unroll
        for (int i = 0; i < 8; ++i) { const int id = tid + NTHR * i; const int row = id >> 5, ch = id & 31; v[i] = *(const u32x4*)(VM + (t0 + row) * 1024 + h * 256 + ch * 8); }
#pragma unroll
        for (int i = 0; i < 8; ++i) { const int id = tid + NTHR * i; const int row = id >> 5, ch = id & 31; const float ws_ = wt[row]; u32x4 o;
            o.x = cvt_pk_bf16(bf_lo(v[i].x) * ws_, bf_hi(v[i].x) * ws_); o.y = cvt_pk_bf16(bf_lo(v[i].y) * ws_, bf_hi(v[i].y) * ws_);
            o.z = cvt_pk_bf16(bf_lo(v[i].z) * ws_, bf_hi(v[i].z) * ws_); o.w = cvt_pk_bf16(bf_lo(v[i].w) * ws_, bf_hi(v[i].w) * ws_);
            *(LAS u32x4*)(Vs + row * ML_P + ch * 16) = o; }
    }
    __syncthreads();
    if (tid < 256) { float a = 0.f; for (int s = 0; s < 128; ++s) a += wt[s] * bf2f(*(const LAS bf16_t*)(Ks + s * ML_P + tid * 2)); DN[tid] = a; }
    const int vr = w >> 1, kr = w & 1;
    f32x4 acc[4][8];
#pragma unroll
    for (int i = 0; i < 4; ++i)
#pragma unroll
        for (int j = 0; j < 8; ++j) acc[i][j] = (f32x4){0.f, 0.f, 0.f, 0.f};
    const unsigned rowoff = (unsigned)((4 * g4 + (jl >> 2)) * ML_P + (jl & 3) * 8);
    const unsigned kb = (unsigned)(uintptr_t)Ks + rowoff + kr * 256, vb = (unsigned)(uintptr_t)Vs + rowoff + vr * 128;
#pragma unroll 1
    for (int ks = 0; ks < 4; ++ks) {
        s16x4 a0[4], a1[4], b0[8], b1[8];
#pragma unroll
        for (int i = 0; i < 4; ++i) { a0[i] = tr_read_o(vb + ks * 32 * ML_P, i * 32); a1[i] = tr_read_o(vb + ks * 32 * ML_P, 16 * ML_P + i * 32); }
#pragma unroll
        for (int j = 0; j < 8; ++j) { b0[j] = tr_read_o(kb + ks * 32 * ML_P, j * 32); b1[j] = tr_read_o(kb + ks * 32 * ML_P, 16 * ML_P + j * 32); }
        LGKM_WAIT0();
#pragma unroll
        for (int i = 0; i < 4; ++i)
#pragma unroll
            for (int j = 0; j < 8; ++j) acc[i][j] = __builtin_amdgcn_mfma_f32_16x16x32_bf16(PK8(b0[j], b1[j]), PK8(a0[i], a1[i]), acc[i][j], 0, 0, 0);
    }
#pragma unroll
    for (int i = 0; i < 4; ++i)
#pragma unroll
        for (int j = 0; j < 8; ++j) { u32x2 o; o.x = cvt_pk_bf16(acc[i][j][0], acc[i][j][1]); o.y = cvt_pk_bf16(acc[i][j][2], acc[i][j][3]);
            *(u32x2*)(DC + (size_t)(16 * (4 * vr + i) + jl) * 256 + 16 * (8 * kr + j) + 4 * g4) = o; }
}

__device__ __forceinline__ float chunk_decay(const float* bcum, const float* mcum, int bh, int c) {
    const float Be = bcum[bh * S + c * 128 + 127], me = mcum[bh * S + c * 128 + 127];
    const float Bp = (c > 0) ? bcum[bh * S + c * 128 - 1] : 0.f, mp = (c > 0) ? mcum[bh * S + c * 128 - 1] : 0.f;
    return expf(Be - Bp + mp - me);
}
__device__ __forceinline__ void p5_scan_mix(const Frame& F) {
    const float* bcum = WSP(float, WS_BCUM); const float* mcum = WSP(float, WS_MCUM);
    const bf16_t* DC = WSP(bf16_t, WS_DC); bf16_t* CST = WSP(bf16_t, WS_CST); const float* DN = WSP(float, WS_DN); float* NST = WSP(float, WS_NST);
    const int gt = F.bx * NTHR + FTID, NG = F.G * NTHR;
    for (int item = gt; item < 16 * 8192; item += NG) {
        const int bh = item >> 13, e8 = item & 8191;
        f32x4 c0 = {0.f, 0.f, 0.f, 0.f}, c1 = {0.f, 0.f, 0.f, 0.f};
#pragma unroll 5
        for (int c = 0; c < 15; ++c) { const float dec = chunk_decay(bcum, mcum, bh, c);
            const u32x4 dq = *(const u32x4*)(DC + (size_t)(bh * 16 + c) * 65536 + e8 * 8); const f32x4 d0 = {bf_lo(dq.x), bf_hi(dq.x), bf_lo(dq.y), bf_hi(dq.y)}, d1 = {bf_lo(dq.z), bf_hi(dq.z), bf_lo(dq.w), bf_hi(dq.w)};
            c0 = c0 * dec + d0; c1 = c1 * dec + d1;
            u32x4 o; o.x = cvt_pk_bf16(c0[0], c0[1]); o.y = cvt_pk_bf16(c0[2], c0[3]); o.z = cvt_pk_bf16(c1[0], c1[1]); o.w = cvt_pk_bf16(c1[2], c1[3]);
            *(u32x4*)(CST + (size_t)(bh * 16 + c + 1) * 65536 + e8 * 8) = o; }
    }
    for (int item = gt; item < 16 * 256; item += NG) { const int bh = item >> 8, k = item & 255; float n = 0.f;
        for (int c = 0; c < 15; ++c) { n = n * chunk_decay(bcum, mcum, bh, c) + DN[(size_t)(bh * 16 + c) * 256 + k]; NST[(size_t)(bh * 16 + c + 1) * 256 + k] = n; } }
    const bf16_t* OA = WSP(bf16_t, WS_OATT); const float* LSE = WSP(float, WS_LSE); bf16_t* YA = WSP(bf16_t, WS_YA);
    for (int item = gt; item < T * 64; item += NG) { const int t = item >> 6, h = (item >> 4) & 3, e8 = item & 15;
        const float l0 = LSE[(size_t)t * 12 + h], l1 = LSE[(size_t)t * 12 + 4 + h], l2 = LSE[(size_t)t * 12 + 8 + h];
        const float ml = fmaxf(l0, fmaxf(l1, l2)); float w0 = expf(l0 - ml), w1 = expf(l1 - ml), w2 = expf(l2 - ml); const float ws_ = 1.f / (w0 + w1 + w2); w0 *= ws_; w1 *= ws_; w2 *= ws_;
        const u32x4 a = *(const u32x4*)(OA + (size_t)t * 1536 + h * 128 + e8 * 8), bq = *(const u32x4*)(OA + (size_t)t * 1536 + (4 + h) * 128 + e8 * 8), cq = *(const u32x4*)(OA + (size_t)t * 1536 + (8 + h) * 128 + e8 * 8);
        u32x4 o;
        o.x = cvt_pk_bf16(w0 * bf_lo(a.x) + w1 * bf_lo(bq.x) + w2 * bf_lo(cq.x), w0 * bf_hi(a.x) + w1 * bf_hi(bq.x) + w2 * bf_hi(cq.x));
        o.y = cvt_pk_bf16(w0 * bf_lo(a.y) + w1 * bf_lo(bq.y) + w2 * bf_lo(cq.y), w0 * bf_hi(a.y) + w1 * bf_hi(bq.y) + w2 * bf_hi(cq.y));
        o.z = cvt_pk_bf16(w0 * bf_lo(a.z) + w1 * bf_lo(bq.z) + w2 * bf_lo(cq.z), w0 * bf_hi(a.z) + w1 * bf_hi(bq.z) + w2 * bf_hi(cq.z));
        o.w = cvt_pk_bf16(w0 * bf_lo(a.w) + w1 * bf_lo(bq.w) + w2 * bf_lo(cq.w), w0 * bf_hi(a.w) + w1 * bf_hi(bq.w) + w2 * bf_hi(cq.w));
        *(u32x4*)(YA + (size_t)t * 512 + h * 128 + e8 * 8) = o; }
}

constexpr int MO_KP = 528, MO_VOFF = 128 * MO_KP, MO_TAB = MO_VOFF + 128 * ML_P;
__device__ __forceinline__ void mlstm_out_unit(const Frame& F, int unit) {
    const bf16_t* QM = WSP(bf16_t, WS_QM); const bf16_t* KM = WSP(bf16_t, WS_KM); const bf16_t* VM = WSP(bf16_t, WS_VMB); const bf16_t* OG = WSP(bf16_t, WS_OGB);
    const bf16_t* CST = WSP(bf16_t, WS_CST) + (size_t)unit * 65536; const float* NST = WSP(float, WS_NST) + (size_t)unit * 256; bf16_t* YM = WSP(bf16_t, WS_YM);
    const float* gpre = WSP(float, WS_GPRE); const float* bcum = WSP(float, WS_BCUM); const float* mcum = WSP(float, WS_MCUM);
    const int bh = unit >> 4, c = unit & 15, b = bh >> 2, h = bh & 3; const size_t t0 = (size_t)b * S + c * 128;
    const int tid = FTID, lane = FLANE, w = FWAVE, jl = lane & 15, g4 = lane >> 4;
    LAS unsigned char* RA = F.lds; LAS unsigned char* RB = F.lds + MO_VOFF; LAS float* cs = (LAS float*)(F.lds + MO_TAB); LAS float* ntab = cs + 128;
    __syncthreads();
    {
        u32x4 v[8];
#pragma unroll
        for (int i = 0; i < 8; ++i) { const int id = tid + NTHR * i; const int row = id >> 5, ch = id & 31; v[i] = *(const u32x4*)(KM + (t0 + row) * 1024 + h * 256 + ch * 8); }
#pragma unroll
        for (int i = 0; i < 8; ++i) { const int id = tid + NTHR * i; const int row = id >> 5, ch = id & 31; *(LAS u32x4*)(RA + row * MO_KP + ch * 16) = v[i]; }
#pragma unroll
        for (int i = 0; i < 8; ++i) { const int id = tid + NTHR * i; const int row = id >> 5, ch = id & 31; v[i] = *(const u32x4*)(VM + (t0 + row) * 1024 + h * 256 + ch * 8); }
#pragma unroll
        for (int i = 0; i < 8; ++i) { const int id = tid + NTHR * i; const int row = id >> 5, ch = id & 31; *(LAS u32x4*)(RB + row * ML_P + ch * 16) = v[i]; }
        if (tid < 128) cs[tid] = (gpre[(t0 + tid) * 8 + h] - bcum[bh * S + c * 128 + tid]) * LOG2E;
        if (tid >= 128 && tid < 384) ntab[tid - 128] = (c > 0) ? NST[tid - 128] : 0.f;
    }
    const int tl = 16 * w + jl; const size_t t = t0 + tl;
    const float Bt = bcum[bh * S + c * 128 + tl], mt = mcum[bh * S + c * 128 + tl];
    const float Bp = (c > 0) ? bcum[bh * S + c * 128 - 1] : 0.f, mp = (c > 0) ? mcum[bh * S + c * 128 - 1] : 0.f;
    const float at = (Bt - mt) * LOG2E; const float inter = fast_exp2((Bt - Bp + mp - mt) * LOG2E);
    union QF { bf16x8 v; unsigned u[4]; }; QF qf[8];
#pragma unroll
    for (int ks = 0; ks < 8; ++ks) qf[ks].v = *(const bf16x8*)(QM + t * 1024 + h * 256 + ks * 32 + 8 * g4);
    __syncthreads();
    f32x4 sT[8];
#pragma unroll
    for (int st = 0; st < 8; ++st) { f32x4 a = {0.f, 0.f, 0.f, 0.f};
        if (st <= w) {
#pragma unroll
            for (int ks = 0; ks < 8; ++ks) { const bf16x8 kf = *(const LAS bf16x8*)(RA + (16 * st + jl) * MO_KP + (ks * 32 + 8 * g4) * 2); a = __builtin_amdgcn_mfma_f32_16x16x32_bf16(kf, qf[ks].v, a, 0, 0, 0); } }
        sT[st] = a; __builtin_amdgcn_sched_barrier(0); }
    float dsum = 0.f;
#pragma unroll
    for (int st = 0; st < 8; ++st) { const f32x4 cv = *(const LAS f32x4*)(cs + 16 * st + 4 * g4);
#pragma unroll
        for (int rg = 0; rg < 4; ++rg) { const bool valid = (st < w) || (st == w && (4 * g4 + rg) <= jl); const float f = valid ? fast_exp2(fminf(at + cv[rg], 0.f)) : 0.f; const float sv = sT[st][rg] * f; sT[st][rg] = sv; dsum += sv; } }
    dsum += __shfl_xor(dsum, 16); dsum += __shfl_xor(dsum, 32);
    float nq = 0.f;
#pragma unroll
    for (int ks = 0; ks < 8; ++ks) { const f32x4 n0 = *(const LAS f32x4*)(ntab + ks * 32 + 8 * g4), n1 = *(const LAS f32x4*)(ntab + ks * 32 + 8 * g4 + 4);
        nq += bf_lo(qf[ks].u[0]) * n0[0] + bf_hi(qf[ks].u[0]) * n0[1] + bf_lo(qf[ks].u[1]) * n0[2] + bf_hi(qf[ks].u[1]) * n0[3]
            + bf_lo(qf[ks].u[2]) * n1[0] + bf_hi(qf[ks].u[2]) * n1[1] + bf_lo(qf[ks].u[3]) * n1[2] + bf_hi(qf[ks].u[3]) * n1[3]; }
    nq += __shfl_xor(nq, 16); nq += __shfl_xor(nq, 32);
    const float den = dsum + inter * nq;
    f32x4 acc[16];
#pragma unroll
    for (int vt = 0; vt < 16; ++vt) acc[vt] = (f32x4){0.f, 0.f, 0.f, 0.f};
    const unsigned vbase = (unsigned)(uintptr_t)RB + (unsigned)((4 * g4 + (jl >> 2)) * ML_P + (jl & 3) * 8);
#pragma unroll
    for (int c4 = 0; c4 < 4; ++c4) {
        if (2 * c4 <= w) {
            union { bf16x8 v; unsigned u[4]; } pf;
            pf.u[0] = cvt_pk_bf16(sT[2 * c4][0], sT[2 * c4][1]); pf.u[1] = cvt_pk_bf16(sT[2 * c4][2], sT[2 * c4][3]);
            pf.u[2] = cvt_pk_bf16(sT[2 * c4 + 1][0], sT[2 * c4 + 1][1]); pf.u[3] = cvt_pk_bf16(sT[2 * c4 + 1][2], sT[2 * c4 + 1][3]);
#pragma unroll
            for (int hb = 0; hb < 2; ++hb) {
                s16x4 a0[8], a1[8];
#pragma unroll
                for (int i = 0; i < 8; ++i) { a0[i] = tr_read_o(vbase, c4 * 32 * ML_P + (hb * 8 + i) * 32); a1[i] = tr_read_o(vbase, (c4 * 32 + 16) * ML_P + (hb * 8 + i) * 32); }
                LGKM_WAIT0();
#pragma unroll
                for (int i = 0; i < 8; ++i) acc[hb * 8 + i] = __builtin_amdgcn_mfma_f32_16x16x32_bf16(PK8(a0[i], a1[i]), pf.v, acc[hb * 8 + i], 0, 0, 0);
            }
        }
    }
    if (c > 0) {
#pragma unroll
        for (int ks = 0; ks < 8; ++ks)
#pragma unroll
            for (int j = 0; j < 4; ++j) qf[ks].u[j] = cvt_pk_bf16(bf_lo(qf[ks].u[j]) * inter, bf_hi(qf[ks].u[j]) * inter);
#pragma unroll
        for (int half = 0; half < 2; ++half) {
            __syncthreads();
            u32x4 v[8];
#pragma unroll
            for (int i = 0; i < 8; ++i) { const int id = tid + NTHR * i; const int row = id >> 5, ch = id & 31; v[i] = *(const u32x4*)(CST + (size_t)(half * 128 + row) * 256 + ch * 8); }
#pragma unroll
            for (int i = 0; i < 8; ++i) { const int id = tid + NTHR * i; const int row = id >> 5, ch = id & 31; *(LAS u32x4*)(RA + row * MO_KP + ch * 16) = v[i]; }
            __syncthreads();
#pragma unroll
            for (int vt = 0; vt < 8; ++vt)
#pragma unroll
                for (int ks = 0; ks < 8; ++ks) { const bf16x8 cf = *(const LAS bf16x8*)(RA + (16 * vt + jl) * MO_KP + (ks * 32 + 8 * g4) * 2);
                    acc[half * 8 + vt] = __builtin_amdgcn_mfma_f32_16x16x32_bf16(cf, qf[ks].v, acc[half * 8 + vt], 0, 0, 0); if (ks == 7) __builtin_amdgcn_sched_barrier(0); }
        }
    }
    const float rden = 1.f / fmaxf(fabsf(den), fast_exp2(-mt * LOG2E));
    float sm = 0.f;
#pragma unroll
    for (int vt = 0; vt < 16; ++vt) { const u32x2 og = *(const u32x2*)(OG + t * 1024 + h * 256 + 16 * vt + 4 * g4);
        acc[vt][0] *= rden * bf_lo(og.x); acc[vt][1] *= rden * bf_hi(og.x); acc[vt][2] *= rden * bf_lo(og.y); acc[vt][3] *= rden * bf_hi(og.y);
        sm += (acc[vt][0] + acc[vt][1]) + (acc[vt][2] + acc[vt][3]); }
    sm += __shfl_xor(sm, 16); sm += __shfl_xor(sm, 32);
    const float mu = sm * (1.f / 256.f); float sq = 0.f;
#pragma unroll
    for (int vt = 0; vt < 16; ++vt) { acc[vt] = acc[vt] - mu; sq += (acc[vt][0] * acc[vt][0] + acc[vt][1] * acc[vt][1]) + (acc[vt][2] * acc[vt][2] + acc[vt][3] * acc[vt][3]); }
    sq += __shfl_xor(sq, 16); sq += __shfl_xor(sq, 32);
    const float rstd = rsqrtf(sq * (1.f / 256.f) + LN_EPS);
#pragma unroll
    for (int vt = 0; vt < 16; ++vt) { const f32x4 gg = *(const f32x4*)(F.m_norm_g + h * 256 + 16 * vt + 4 * g4); const f32x4 o = acc[vt] * rstd * gg;
        u32x2 ow; ow.x = cvt_pk_bf16(o[0], o[1]); ow.y = cvt_pk_bf16(o[2], o[3]); *(u32x2*)(YM + t * 1024 + h * 256 + 16 * vt + 4 * g4) = ow; }
}

struct EpiMerge {
    static constexpr bool PERM = true;
    bf16_t* MG; const bf16_t* GB; int step;
    __device__ __forceinline__ void operator()(const f32x4 (&acc)[2][2][4][2], const pg8::Unit& u, int wr, int wc, int fr, int fq) const {
        const int row0 = u.pm * 256 + wr * 64 + fr, col0 = u.pn * 256 + wc * 32 + 8 * fq;
#pragma unroll
        for (int ai = 0; ai < 2; ++ai)
#pragma unroll
            for (int m = 0; m < 4; ++m) { const size_t r = row0 + ai * 128 + m * 16;
#pragma unroll
                for (int bj = 0; bj < 2; ++bj) { const int col = col0 + bj * 128; const f32x4 v0 = acc[ai][bj][m][0], v1 = acc[ai][bj][m][1];
                    const u32x4 gq = *(const u32x4*)(GB + r * 4096 + step * 2048 + col);
                    float o[8] = {v0[0] * bf_lo(gq.x), v0[1] * bf_hi(gq.x), v0[2] * bf_lo(gq.y), v0[3] * bf_hi(gq.y), v1[0] * bf_lo(gq.z), v1[1] * bf_hi(gq.z), v1[2] * bf_lo(gq.w), v1[3] * bf_hi(gq.w)};
                    if (step) { const u32x4 pq = *(const u32x4*)(MG + r * 2048 + col);
                        o[0] += bf_lo(pq.x); o[1] += bf_hi(pq.x); o[2] += bf_lo(pq.y); o[3] += bf_hi(pq.y); o[4] += bf_lo(pq.z); o[5] += bf_hi(pq.z); o[6] += bf_lo(pq.w); o[7] += bf_hi(pq.w); }
                    u32x4 wv; wv.x = cvt_pk_bf16(o[0], o[1]); wv.y = cvt_pk_bf16(o[2], o[3]); wv.z = cvt_pk_bf16(o[4], o[5]); wv.w = cvt_pk_bf16(o[6], o[7]);
                    *(u32x4*)(MG + r * 2048 + col) = wv; } }
    }
};
struct EpiWout {
    static constexpr bool PERM = true;
    const float* mod; bf16_t* PREb;
    __device__ __forceinline__ void operator()(const f32x4 (&acc)[2][2][4][2], const pg8::Unit& u, int wr, int wc, int fr, int fq) const {
        const int row0 = u.pm * 256 + wr * 64 + fr, col0 = u.pn * 256 + wc * 32 + 8 * fq;
        const float* gate = mod + (size_t)((u.pm * 256) / S) * 6 * D + 2 * D;
        f32x4 gv[2][2];
#pragma unroll
        for (int bj = 0; bj < 2; ++bj)
#pragma unroll
            for (int n = 0; n < 2; ++n) gv[bj][n] = *(const f32x4*)(gate + col0 + bj * 128 + n * 4);
#pragma unroll
        for (int ai = 0; ai < 2; ++ai)
#pragma unroll
            for (int m = 0; m < 4; ++m) { const size_t off = (size_t)(row0 + ai * 128 + m * 16) * D + col0;
#pragma unroll
                for (int bj = 0; bj < 2; ++bj) { const f32x4 v0 = gv[bj][0] * acc[ai][bj][m][0], v1 = gv[bj][1] * acc[ai][bj][m][1];
                    u32x4 wv; wv.x = cvt_pk_bf16(v0[0], v0[1]); wv.y = cvt_pk_bf16(v0[2], v0[3]); wv.z = cvt_pk_bf16(v1[0], v1[1]); wv.w = cvt_pk_bf16(v1[2], v1[3]);
                    *(u32x4*)(PREb + off + bj * 128) = wv; } }
    }
};
struct EpiNull { static constexpr bool PERM = false; float* sink;
    __device__ __forceinline__ void operator()(const f32x4 (&acc)[2][2][4][2], const pg8::Unit& u, int wr, int wc, int fr, int fq) const {
        float s = 0.f;
#pragma unroll
        for (int ai = 0; ai < 2; ++ai)
#pragma unroll
            for (int bj = 0; bj < 2; ++bj)
#pragma unroll
                for (int m = 0; m < 4; ++m)
#pragma unroll
                    for (int n = 0; n < 2; ++n) s += acc[ai][bj][m][n][0] + acc[ai][bj][m][n][1] + acc[ai][bj][m][n][2] + acc[ai][bj][m][n][3];
        if (s == 123.456f) sink[0] = s; } };
constexpr int R_UP = 4112, R_LO = 16 * R_UP, R_PART = 2 * 16 * R_UP, R_LOG = R_PART + 8 * 16 * 48 * 4;
template <bool DRY> __device__ __forceinline__ void p9_ln_router(const Frame& F) {
    const bf16_t* PREb = WSP(bf16_t, WS_PRE); bf16_t* X1b = WSP(bf16_t, WS_PRE + (size_t)T * D * 2); const float* mod = WSP(float, WS_MOD); bf16_t* U2 = WSP(bf16_t, WS_U); const bf16_t* WRT = WSP(bf16_t, WS_WRT);
    int* cnt = (int*)(F.ws + WS_CTL) + CW_CNT; int* idx = WSP(int, WS_IDX); float* wl = WSP(float, WS_WL); int* tok = WSP(int, WS_TOK);
    const int lane = FLANE, w = FWAVE, tid = FTID, jl = lane & 15, g4 = lane >> 4;
    LAS unsigned char* Uhi = F.lds; LAS unsigned char* Ulo = F.lds + R_LO; LAS float* part = (LAS float*)(F.lds + R_PART); LAS float* lg = (LAS float*)(F.lds + R_LOG);
    for (int rgp = F.bx; rgp < T / 16; rgp += F.G) {
        __syncthreads();
#pragma unroll 1
        for (int rr = 0; rr < 2; ++rr) {
            const int lr = 2 * w + rr; const int t = rgp * 16 + lr; const int b = t / S;
            f32x4 v[8]; float s = 0.f;
#pragma unroll
            for (int i = 0; i < 8; ++i) { const int d = 4 * (lane + 64 * i); const f32x4 xv = *(const f32x4*)(F.x + (size_t)t * D + d); const u32x2 pq = *(const u32x2*)(PREb + (size_t)t * D + d);
                v[i] = xv * ALPHA; v[i][0] += bf_lo(pq.x); v[i][1] += bf_hi(pq.x); v[i][2] += bf_lo(pq.y); v[i][3] += bf_hi(pq.y); s += (v[i][0] + v[i][1]) + (v[i][2] + v[i][3]); }
            float mu = wave_sum(s) * (1.f / D); float q = 0.f;
#pragma unroll
            for (int i = 0; i < 8; ++i) { v[i] = v[i] - mu; q += (v[i][0] * v[i][0] + v[i][1] * v[i][1]) + (v[i][2] * v[i][2] + v[i][3] * v[i][3]); }
            float rstd = rsqrtf(wave_sum(q) * (1.f / D) + LN_EPS);
            s = 0.f;
#pragma unroll
            for (int i = 0; i < 8; ++i) { const int d = 4 * (lane + 64 * i); const f32x4 gg = *(const f32x4*)(F.ln1_g + d), bb = *(const f32x4*)(F.ln1_b + d);
                v[i] = v[i] * rstd * gg + bb; { u32x2 xb; xb.x = cvt_pk_bf16(v[i][0], v[i][1]); xb.y = cvt_pk_bf16(v[i][2], v[i][3]); *(u32x2*)(X1b + (size_t)t * D + d) = xb; } s += (v[i][0] + v[i][1]) + (v[i][2] + v[i][3]); }
            mu = wave_sum(s) * (1.f / D); q = 0.f;
#pragma unroll
            for (int i = 0; i < 8; ++i) { v[i] = v[i] - mu; q += (v[i][0] * v[i][0] + v[i][1] * v[i][1]) + (v[i][2] * v[i][2] + v[i][3] * v[i][3]); }
            rstd = rsqrtf(wave_sum(q) * (1.f / D) + LN_EPS);
            const float* sc = mod + (size_t)b * 6 * D + 4 * D; const float* sf = mod + (size_t)b * 6 * D + 3 * D;
#pragma unroll
            for (int i = 0; i < 8; ++i) { const int d = 4 * (lane + 64 * i); const f32x4 a = *(const f32x4*)(sc + d), bb = *(const f32x4*)(sf + d);
                v[i] = v[i] * rstd * (a + 1.f) + bb;
                u32x2 hi; hi.x = cvt_pk_bf16(v[i][0], v[i][1]); hi.y = cvt_pk_bf16(v[i][2], v[i][3]);
                *(u32x2*)(U2 + (size_t)t * D + d) = hi;
                u32x2 lo; lo.x = cvt_pk_bf16(v[i][0] - bf_lo(hi.x), v[i][1] - bf_hi(hi.x)); lo.y = cvt_pk_bf16(v[i][2] - bf_lo(hi.y), v[i][3] - bf_hi(hi.y));
                *(LAS u32x2*)(Uhi + lr * R_UP + d * 2) = hi; *(LAS u32x2*)(Ulo + lr * R_UP + d * 2) = lo; }
        }
        __syncthreads();
        {
            f32x4 a3[3] = {{0.f, 0.f, 0.f, 0.f}, {0.f, 0.f, 0.f, 0.f}, {0.f, 0.f, 0.f, 0.f}};
#pragma unroll 2
            for (int ks = 0; ks < 8; ++ks) { const int k0 = 256 * w + 32 * ks + 8 * g4;
                const bf16x8 ah = *(const LAS bf16x8*)(Uhi + jl * R_UP + k0 * 2), al = *(const LAS bf16x8*)(Ulo + jl * R_UP + k0 * 2);
#pragma unroll
                for (int nt = 0; nt < 3; ++nt) { const bf16x8 bh = *(const bf16x8*)(WRT + (size_t)(16 * nt + jl) * D + k0), bl = *(const bf16x8*)(WRT + (size_t)48 * D + (size_t)(16 * nt + jl) * D + k0);
                    a3[nt] = __builtin_amdgcn_mfma_f32_16x16x32_bf16(ah, bh, a3[nt], 0, 0, 0); a3[nt] = __builtin_amdgcn_mfma_f32_16x16x32_bf16(ah, bl, a3[nt], 0, 0, 0); a3[nt] = __builtin_amdgcn_mfma_f32_16x16x32_bf16(al, bh, a3[nt], 0, 0, 0); } }
#pragma unroll
            for (int nt = 0; nt < 3; ++nt)
#pragma unroll
                for (int rg = 0; rg < 4; ++rg) part[(w * 16 + 4 * g4 + rg) * 48 + 16 * nt + jl] = a3[nt][rg];
        }
        __syncthreads();
        for (int i = tid; i < 16 * 48; i += NTHR) { float s = 0.f;
#pragma unroll
            for (int ww = 0; ww < 8; ++ww) s += part[ww * 768 + i];
            lg[i] = s; }
        __syncthreads();
        if (tid < 16) { const int t = rgp * 16 + tid; const LAS float* l = lg + tid * 48;
            int gt = 0; float lgt = l[0] + F.b_rg[0];
            for (int j = 1; j < 4; ++j) { const float x = l[j] + F.b_rg[j]; if (x > lgt) { lgt = x; gt = j; } }
            float se = 0.f; for (int j = 0; j < 4; ++j) se += expf(l[j] + F.b_rg[j] - lgt);
            const float gw = 1.f / se;
            int a = 0; float la = l[4 + gt * 8] + F.b_re[gt * 8];
            for (int j = 1; j < 8; ++j) { const float x = l[4 + gt * 8 + j] + F.b_re[gt * 8 + j]; if (x > la) { la = x; a = j; } }
            int bb = -1; float lb = -INFINITY;
            for (int j = 0; j < 8; ++j) { const float x = l[4 + gt * 8 + j] + F.b_re[gt * 8 + j]; if (j != a && x > lb) { lb = x; bb = j; } }
            const float wa = 1.f / (1.f + expf(lb - la)), wb = 1.f - wa;
            const int ea = gt * 8 + a, eb = gt * 8 + bb;
            if (!DRY) {
            const int pa = atomicAdd(&cnt[ea], 1); idx[ea * T + pa] = t; wl[ea * T + pa] = gw * wa;
            const int pb = atomicAdd(&cnt[eb], 1); idx[eb * T + pb] = t; wl[eb * T + pb] = gw * wb;
            *(int4*)(tok + (size_t)t * 4) = make_int4(ea, pa, eb, pb); } }
    }
}

struct MoeSched {
    const int* idx; const LAS int* tb; const LAS int* cn; int G, c;
    __device__ bool next(int i, pg8::Unit& u) const {
        const int total = tb[32] * 8; const long L = (long)i * G + c; if (L >= total) return false;
        const int l = (int)L; int e = 0;
        for (int k = 1; k < 32; ++k) if (l >= tb[k] * 8) e = k;
        const int nt = tb[e + 1] - tb[e], r = l - tb[e] * 8; const int j = r / nt, it = r - j * nt;
        u.e = __builtin_amdgcn_readfirstlane(e); u.it = __builtin_amdgcn_readfirstlane(it); u.pm = __builtin_amdgcn_readfirstlane(tb[e] + it); u.pn = __builtin_amdgcn_readfirstlane(e * 8 + j); u.cnt = __builtin_amdgcn_readfirstlane(cn[e]); return true;
    }
    __device__ __forceinline__ int arow(const pg8::Unit& u, int r) const { int p = u.it * 256 + r; p = p < u.cnt ? p : u.cnt - 1; return idx[u.e * T + p]; }
};
__device__ __forceinline__ void moe_tables(const Frame& F, LAS int* tb, LAS int* cn) {
    const int* cnt = (const int*)(F.ws + WS_CTL) + CW_CNT;
    __syncthreads();
    if (FTID == 0) { int acc = 0; for (int e = 0; e < 32; ++e) { const int c = cnt[e]; cn[e] = c; tb[e] = acc; acc += (c + 255) >> 8; } tb[32] = acc; }
    __syncthreads();
}
struct EpiMoe1 {
    static constexpr bool PERM = true;
    bf16_t* H;
    __device__ __forceinline__ void operator()(const f32x4 (&acc)[2][2][4][2], const pg8::Unit& u, int wr, int wc, int fr, int fq) const {
        const int row0 = u.pm * 256 + wr * 64 + fr, col0 = (u.pn & 7) * 128 + wc * 32 + 8 * fq;
#pragma unroll
        for (int ai = 0; ai < 2; ++ai)
#pragma unroll
            for (int m = 0; m < 4; ++m) { const size_t r = row0 + ai * 128 + m * 16; float o[8];
#pragma unroll
                for (int n = 0; n < 2; ++n)
#pragma unroll
                    for (int j = 0; j < 4; ++j) o[4 * n + j] = silu_fast(acc[ai][0][m][n][j]) * acc[ai][1][m][n][j];
                u32x4 wv; wv.x = cvt_pk_bf16(o[0], o[1]); wv.y = cvt_pk_bf16(o[2], o[3]); wv.z = cvt_pk_bf16(o[4], o[5]); wv.w = cvt_pk_bf16(o[6], o[7]);
                *(u32x4*)(H + r * FF + col0) = wv; }
    }
};
struct EpiMoe2 {
    static constexpr bool PERM = true;
    bf16_t* Y2; const float* wl;
    __device__ __forceinline__ void operator()(const f32x4 (&acc)[2][2][4][2], const pg8::Unit& u, int wr, int wc, int fr, int fq) const {
        const int lrow0 = wr * 64 + fr, col0 = (u.pn & 7) * 256 + wc * 32 + 8 * fq;
#pragma unroll
        for (int ai = 0; ai < 2; ++ai)
#pragma unroll
            for (int m = 0; m < 4; ++m) { const int lr = lrow0 + ai * 128 + m * 16; const int p = u.it * 256 + lr; const float cw = (p < u.cnt) ? wl[u.e * T + p] : 0.f; const size_t r = (size_t)u.pm * 256 + lr;
#pragma unroll
                for (int bj = 0; bj < 2; ++bj) { const f32x4 v0 = acc[ai][bj][m][0] * cw, v1 = acc[ai][bj][m][1] * cw;
                    u32x4 wv; wv.x = cvt_pk_bf16(v0[0], v0[1]); wv.y = cvt_pk_bf16(v0[2], v0[3]); wv.z = cvt_pk_bf16(v1[0], v1[1]); wv.w = cvt_pk_bf16(v1[2], v1[3]);
                    *(u32x4*)(Y2 + r * D + col0 + bj * 128) = wv; } }
    }
};

template <bool DRY> __device__ __forceinline__ void p12_final(const Frame& F, const LAS int* tb) {
    float* dst = DRY ? WSP(float, WS_DC) : F.out; const bf16_t* X1b = WSP(bf16_t, WS_PRE + (size_t)T * D * 2);
    const float* mod = WSP(float, WS_MOD); const bf16_t* Y2 = WSP(bf16_t, WS_Y2); const int* tok = WSP(int, WS_TOK);
    const int gw = F.bx * NWAVES + FWAVE, NGW = F.G * NWAVES, lane = FLANE;
    for (int t = gw; t < T; t += NGW) {
        const int b = t / S; const int4 ti = *(const int4*)(tok + (size_t)t * 4);
        const size_t r0 = (size_t)tb[ti.x] * 256 + ti.y, r1 = (size_t)tb[ti.z] * 256 + ti.w;
        const float* gate = mod + (size_t)b * 6 * D + 5 * D;
        f32x4 v[8]; float s = 0.f;
#pragma unroll
        for (int i = 0; i < 8; ++i) { const int d = 4 * (lane + 64 * i); const u32x2 xq = *(const u32x2*)(X1b + (size_t)t * D + d); f32x4 xv; xv[0] = bf_lo(xq.x); xv[1] = bf_hi(xq.x); xv[2] = bf_lo(xq.y); xv[3] = bf_hi(xq.y); const f32x4 gv = *(const f32x4*)(gate + d);
            const u32x2 ya = *(const u32x2*)(Y2 + r0 * D + d), yb = *(const u32x2*)(Y2 + r1 * D + d);
            f32x4 f; f[0] = bf_lo(ya.x) + bf_lo(yb.x); f[1] = bf_hi(ya.x) + bf_hi(yb.x); f[2] = bf_lo(ya.y) + bf_lo(yb.y); f[3] = bf_hi(ya.y) + bf_hi(yb.y);
            v[i] = xv * ALPHA + gv * f; s += (v[i][0] + v[i][1]) + (v[i][2] + v[i][3]); }
        const float mu = wave_sum(s) * (1.f / D); float q = 0.f;
#pragma unroll
        for (int i = 0; i < 8; ++i) { v[i] = v[i] - mu; q += (v[i][0] * v[i][0] + v[i][1] * v[i][1]) + (v[i][2] * v[i][2] + v[i][3] * v[i][3]); }
        const float rstd = rsqrtf(wave_sum(q) * (1.f / D) + LN_EPS);
#pragma unroll
        for (int i = 0; i < 8; ++i) { const int d = 4 * (lane + 64 * i); const f32x4 gg = *(const f32x4*)(F.ln2_g + d), bb = *(const f32x4*)(F.ln2_b + d);
            *(f32x4*)(dst + (size_t)t * D + d) = v[i] * rstd * gg + bb; }
    }
}

#if MK_DEBUG
__device__ __forceinline__ void dbg_acc(float* slot, double num, double den) { atomicAdd(slot, (float)num); atomicAdd(slot + 1, (float)den); }
__global__ void k_chk_u(Params p, float* res) {
    __shared__ float sh[8]; __shared__ float ush[D];
    const int t = (blockIdx.x * 37) % T, b = t / S; const float* x = p.in[0] + (size_t)t * D; const float* mod = (const float*)(p.ws + WS_MOD);
    float s = 0; for (int i = threadIdx.x; i < D; i += 256) s += x[i]; s = wave_sum(s); if ((threadIdx.x & 63) == 0) sh[threadIdx.x >> 6] = s; __syncthreads();
    const float mu = (sh[0] + sh[1] + sh[2] + sh[3]) / D; __syncthreads();
    float q = 0; for (int i = threadIdx.x; i < D; i += 256) { const float d = x[i] - mu; q += d * d; } q = wave_sum(q); if ((threadIdx.x & 63) == 0) sh[threadIdx.x >> 6] = q; __syncthreads();
    const float rstd = rsqrtf((sh[0] + sh[1] + sh[2] + sh[3]) / D + LN_EPS);
    const bf16_t* U = (const bf16_t*)(p.ws + WS_U); double num = 0, den = 0;
    for (int i = threadIdx.x; i < D; i += 256) {
        float sc = p.in[3][1 * D + i], sf = p.in[3][0 * D + i];
        if (i < 64) { for (int k = 0; k < D; ++k) { const float cv = p.in[1][b * D + k]; const float sl = cv / (1.f + expf(-cv)); sc += sl * p.in[2][(size_t)k * 6 * D + D + i]; sf += sl * p.in[2][(size_t)k * 6 * D + i]; } }
        else { sc = mod[(size_t)b * 6 * D + D + i]; sf = mod[(size_t)b * 6 * D + i]; }
        const float ref = (x[i] - mu) * rstd * (1.f + sc) + sf; ush[i] = ref; const float got = bf2f(U[(size_t)t * D + i]); num += (double)(got - ref) * (got - ref); den += (double)ref * ref; }
    __syncthreads();
    if (threadIdx.x < 8) { const int j = threadIdx.x; float a = 0; for (int k = 0; k < D; ++k) a += ush[k] * p.in[4][(size_t)k * NIN + OFF_IF + j]; a += p.in[5][j];
        if (j >= 4) a = fminf(a, 0.f) - log1pf(expf(-fabsf(a))); const float got = ((const float*)(p.ws + WS_GPRE))[(size_t)t * 8 + j]; num += (double)(got - a) * (got - a) * 1000.0; den += (double)a * a * 1000.0; }
    dbg_acc(res, num, den);
}
__global__ void k_chk_p2(Params p, float* res) {
    const int gid = blockIdx.x * blockDim.x + threadIdx.x;
    const int t = (gid * 131 + 7) % T; const int col = (gid * 977 + 13) % (NIN - 8 + 4096);
    const bf16_t* U = (const bf16_t*)(p.ws + WS_U) + (size_t)t * D;
    const int pos = t % S; float ref, got; unsigned char* ws = p.ws;
    auto dot = [&](const float* w, int ld, int c) { float a = 0; for (int k = 0; k < D; ++k) a += bf2f(U[k]) * w[(size_t)k * ld + c]; return a; };
    if (col < 3072) { const int hd = col / 128, lc = col % 128, i = lc % 64; const int c1 = hd * 128 + i, c2 = c1 + 64; const float x1 = dot(p.in[4], NIN, c1), x2 = dot(p.in[4], NIN, c2);
        const float inv = powf(10000.f, -(float)(2 * i) / 128.f), ang = (float)pos * inv, cs = cosf(ang), sn = sinf(ang);
        ref = (lc < 64) ? (x1 * cs - x2 * sn) : (x2 * cs + x1 * sn); const int pc = hd * 128 + 2 * i + (lc >= 64);
        if (col < 1536) { ref *= QSCALE; got = bf2f(((const bf16_t*)(ws + WS_QB))[(size_t)t * 1536 + pc]); } else got = bf2f(((const bf16_t*)(ws + WS_KB))[(size_t)t * 1536 + pc - 1536]); }
    else if (col < 4608) { ref = dot(p.in[4], NIN, col); got = bf2f(((const bf16_t*)(ws + WS_VB))[(size_t)t * 1536 + col - 3072]); }
    else if (col < 6656) { ref = dot(p.in[4], NIN, col); got = bf2f(((const bf16_t*)(ws + WS_QKP))[(size_t)t * 2048 + col - 4608]); }
    else if (col < 7680) { ref = dot(p.in[4], NIN, col); got = bf2f(((const bf16_t*)(ws + WS_VMB))[(size_t)t * 1024 + col - 6656]); }
    else if (col < 8704) { ref = dot(p.in[4], NIN, col); ref = 1.f / (1.f + expf(-ref)); got = bf2f(((const bf16_t*)(ws + WS_OGB))[(size_t)t * 1024 + col - 7680]); }
    else { const int c = col - 8704; ref = dot(p.in[11], 4096, c) + p.in[12][c]; ref = 1.f / (1.f + expf(-ref)); got = bf2f(((const bf16_t*)(ws + WS_GB))[(size_t)t * 4096 + c]); }
    double num = (double)(got - ref) * (got - ref), den = (double)ref * ref;
    for (int o = 32; o >= 1; o >>= 1) { num += __shfl_xor(num, o); den += __shfl_xor(den, o); }
    if ((threadIdx.x & 63) == 0) dbg_acc(res, num, den);
}

__global__ void __launch_bounds__(256) k_chk_attn(Params p, float* res) {
    const int t = (blockIdx.x * 1543 + 11) % T, h = threadIdx.x >> 6, lane = threadIdx.x & 63; const int b = t / S, pos = t % S;
    const bf16_t* QB = (const bf16_t*)(p.ws + WS_QB); const bf16_t* KB = (const bf16_t*)(p.ws + WS_KB); const bf16_t* VB = (const bf16_t*)(p.ws + WS_VB); const bf16_t* YA = (const bf16_t*)(p.ws + WS_YA);
    float og[3][2], lse[3];
    for (int g = 0; g < 3; ++g) { const int d = (g == 0) ? 1 : (g == 1 ? 4 : 16); const int head = 4 * g + h;
        const bf16_t* qp = QB + (size_t)t * 1536 + head * 128; const float q0 = bf2f(qp[lane]), q1 = bf2f(qp[lane + 64]);
        float mx = -INFINITY, den = 0, o0 = 0, o1 = 0;
        for (int j = 0; j <= 128; ++j) { const int tk = pos - j * d; if (tk < 0) break;
            const bf16_t* kp = KB + (size_t)(b * S + tk) * 1536 + head * 128; const bf16_t* vp = VB + (size_t)(b * S + tk) * 1536 + head * 128;
            const float dot = wave_sum(q0 * bf2f(kp[lane]) + q1 * bf2f(kp[lane + 64]));
            const float nm = fmaxf(mx, dot); const float sc = exp2f(mx - nm), pe = exp2f(dot - nm);
            den = den * sc + pe; o0 = o0 * sc + pe * bf2f(vp[lane]); o1 = o1 * sc + pe * bf2f(vp[lane + 64]); mx = nm; }
        og[g][0] = o0 / den; og[g][1] = o1 / den; lse[g] = (mx + log2f(den)) * LN2; }
    const float ml = fmaxf(lse[0], fmaxf(lse[1], lse[2])); const float w0 = expf(lse[0] - ml), w1 = expf(lse[1] - ml), w2 = expf(lse[2] - ml); const float ws_ = 1.f / (w0 + w1 + w2);
    const float r0 = (w0 * og[0][0] + w1 * og[1][0] + w2 * og[2][0]) * ws_, r1 = (w0 * og[0][1] + w1 * og[1][1] + w2 * og[2][1]) * ws_;
    const float g0 = bf2f(YA[(size_t)t * 512 + h * 128 + lane]), g1 = bf2f(YA[(size_t)t * 512 + h * 128 + lane + 64]);
    double num = (double)(g0 - r0) * (g0 - r0) + (double)(g1 - r1) * (g1 - r1), den2 = (double)r0 * r0 + (double)r1 * r1;
    for (int o = 32; o >= 1; o >>= 1) { num += __shfl_xor(num, o); den2 += __shfl_xor(den2, o); }
    if (lane == 0) dbg_acc(res, num, den2);
}
__global__ void __launch_bounds__(1024) k_chk_mlstm(Params p, float* hb) {
    const int b = blockIdx.x / 4, h = blockIdx.x % 4; const int tid = threadIdx.x, v = tid >> 2, kq = tid & 3;
    const bf16_t* QKP = (const bf16_t*)(p.ws + WS_QKP); const bf16_t* VM = (const bf16_t*)(p.ws + WS_VMB);
    const float* gpre = (const float*)(p.ws + WS_GPRE); const float* conv_w = p.in[6]; const float* conv_b = p.in[7];
    __shared__ float qs[256], ks[256], vs[256], ns[256], nq[256];
    float C[64];
#pragma unroll
    for (int i = 0; i < 64; ++i) C[i] = 0.f;
    if (tid < 256) ns[tid] = 0.f;
    float m = 0.f;
    for (int pos = 0; pos < S; ++pos) { const int t = b * S + pos;
        __syncthreads();
        if (tid < 256) { float yq = conv_b[h * 256 + tid], yk = conv_b[1024 + h * 256 + tid];
            for (int j = 0; j < 4; ++j) { const int pp = pos + j - 3; if (pp >= 0) { yq += conv_w[j * 2048 + h * 256 + tid] * bf2f(QKP[(size_t)(t + j - 3) * 2048 + h * 256 + tid]); yk += conv_w[j * 2048 + 1024 + h * 256 + tid] * bf2f(QKP[(size_t)(t + j - 3) * 2048 + 1024 + h * 256 + tid]); } }
            qs[tid] = yq / (1.f + expf(-yq)); ks[tid] = yk / (1.f + expf(-yk)) * 0.0625f; vs[tid] = bf2f(VM[(size_t)t * 1024 + h * 256 + tid]); }
        const float ip = gpre[(size_t)t * 8 + h], lf = gpre[(size_t)t * 8 + 4 + h];
        const float mn = fmaxf(lf + m, ip); const float iw = expf(ip - mn), fw = expf(lf + m - mn); m = mn;
        __syncthreads();
        if (tid < 256) { const float nn = fw * ns[tid] + iw * ks[tid]; ns[tid] = nn; nq[tid] = nn * qs[tid]; }
        __syncthreads();
        const float vv = vs[v] * iw; float nu = 0.f, de = 0.f;
#pragma unroll
        for (int i = 0; i < 64; ++i) { const int k = 4 * i + kq; const float cc = fw * C[i] + vv * ks[k]; C[i] = cc; nu += cc * qs[k]; de += nq[k]; }
        nu += __shfl_xor(nu, 1); nu += __shfl_xor(nu, 2); de += __shfl_xor(de, 1); de += __shfl_xor(de, 2);
        if (kq == 0) hb[(size_t)t * 1024 + h * 256 + v] = nu / fmaxf(fabsf(de), expf(-mn));
    }
}
__global__ void __launch_bounds__(256) k_chk_mnorm(Params p, const float* hb, float* res) {
    __shared__ float red[8];
    const int t = blockIdx.x / 4, h = blockIdx.x % 4, tid = threadIdx.x;
    const bf16_t* OG = (const bf16_t*)(p.ws + WS_OGB); const bf16_t* YM = (const bf16_t*)(p.ws + WS_YM); const float* mg = p.in[8];
    const float val = bf2f(OG[(size_t)t * 1024 + h * 256 + tid]) * hb[(size_t)t * 1024 + h * 256 + tid];
    float s = wave_sum(val); if ((tid & 63) == 0) red[tid >> 6] = s; __syncthreads();
    const float mu = (red[0] + red[1] + red[2] + red[3]) * (1.f / 256.f); const float d = val - mu;
    s = wave_sum(d * d); if ((tid & 63) == 0) red[4 + (tid >> 6)] = s; __syncthreads();
    const float rstd = rsqrtf((red[4] + red[5] + red[6] + red[7]) * (1.f / 256.f) + LN_EPS); const float ref = d * rstd * mg[h * 256 + tid];
    const float got = bf2f(YM[(size_t)t * 1024 + h * 256 + tid]);
    double num = (double)(got - ref) * (got - ref), den = (double)ref * ref;
    for (int o = 32; o >= 1; o >>= 1) { num += __shfl_xor(num, o); den += __shfl_xor(den, o); }
    if ((tid & 63) == 0) dbg_acc(res, num, den);
}
__global__ void k_chk_fin(const float* res, int nchk, float* out, int n) {
    const int i = blockIdx.x * blockDim.x + threadIdx.x; if (i >= n) return;
    float code = 0.f;
    for (int k = 0; k < nchk; ++k) { const float rv = res[2 * k] / fmaxf(res[2 * k + 1], 1e-30f); int s;
        if (!(rv == rv) || !(res[2 * k + 1] > 0.f)) s = 9; else { s = (int)floorf(log10f(fmaxf(rv, 1e-12f)) + 6.f); s = s < 0 ? 0 : (s > 8 ? 8 : s); }
        if (s >= 3 && code == 0.f) code = ((k + 1) * 10 + s) * 100.f; }
    out[i] = (i == 0) ? code : 0.f;
}
#endif

__global__ void __launch_bounds__(NTHR, 2) mk_fwd(Params args) {
    extern __shared__ __attribute__((aligned(16))) unsigned char lds_raw[];
    Frame F;
    F.lds = (LAS unsigned char*)lds_raw; F.G = gridDim.x; F.bx = blockIdx.x; F.ws = args.ws;
    F.x = args.in[0]; F.c = args.in[1]; F.w_ada = args.in[2]; F.b_ada = args.in[3]; F.w_in = args.in[4]; F.b_mgate = args.in[5]; F.conv_w = args.in[6]; F.conv_b = args.in[7];
    F.m_norm_g = args.in[8]; F.w_proj_a = args.in[9]; F.w_proj_m = args.in[10]; F.w_gate = args.in[11]; F.b_gate = args.in[12]; F.w_out = args.in[13]; F.ln1_g = args.in[14]; F.ln1_b = args.in[15];
    F.w_rg = args.in[16]; F.b_rg = args.in[17]; F.w_re = args.in[18]; F.b_re = args.in[19]; F.w_eg = args.in[20]; F.w_eu = args.in[21]; F.w_ed = args.in[22]; F.ln2_g = args.in[23]; F.ln2_b = args.in[24];
    F.out = args.out;
    volatile LAS unsigned* misc = (volatile LAS unsigned*)(F.lds + LDS_MISC);
    if (FTID < 64) misc[FTID] = 0u;
    __syncthreads();
    const int lo = args.ph_lo, hi = args.ph_hi;
    XcdBarrier bar; bar.bar = (unsigned*)(F.ws + WS_CTL) + CW_BAR; bar.x = 0; bar.st = nullptr;
    if (hi - lo > 1) bar = xcd_barrier_post((unsigned*)(F.ws + WS_CTL) + CW_BAR, misc + 8);
#define IN(k) (lo <= (k) && (k) < hi)
#define BOTH(k) (IN(k) && IN((k) + 1))
#define SEAM(k) do { if (BOTH(k)) xcd_barrier(bar); } while (0)

#define DUPRUN(k, BODY) do { BODY; if (MK_DUP & (1 << (k))) { xcd_barrier(bar); BODY; } } while (0)
#define PH0 { p0_prologue(F); }
#define PH1 { p1_lnmod(F); }
#define PH2 { const int GG = (F.G == 256) ? MK_GG2 : F.G; \
        if (F.bx < GG) { pg8::StaticOrder So; So.init(T, NBIG, GG, F.bx); \
            if (MK_STAGGER > 0) { const unsigned long long t0 = __builtin_amdgcn_s_memrealtime(); const unsigned long long dl = (unsigned long long)((F.bx >> 3) & 7) * MK_STAGGER; while (__builtin_amdgcn_s_memrealtime() - t0 < dl) __builtin_amdgcn_s_sleep(8); } \
            EpiP2 E{WSP(bf16_t, WS_QB), WSP(bf16_t, WS_KB), WSP(bf16_t, WS_VB), WSP(bf16_t, WS_QKP), WSP(bf16_t, WS_VMB), WSP(bf16_t, WS_OGB), WSP(bf16_t, WS_GB), WSP(float, WS_ROPE), F.b_gate}; \
            pg8::gemm_phase<EpiP2, pg8::StaticOrder, false>(F.lds, WSP(bf16_t, WS_U), WSP(bf16_t, WS_WBIG), D, So, E); } \
        if (F.bx >= F.G - 16 && FWAVE == 0) scan_bh(F, F.bx - (F.G - 16)); \
        cvt_stream<1>(F, N_IT_W1); cvt_stream<1>(F, N_IT_BG); }
#define PH3 { p3_conv(F); attn_phase(F); }
#define PH4 { for (int u = F.bx; u < 256; u += F.G) mlstm_dc_unit(F, u); }
#define PH5 { p5_scan_mix(F); }
#define PH6 { for (int u = F.bx; u < 256; u += F.G) mlstm_out_unit(F, u); }
#define PH7 { pg8::StaticOrder So; So.init(T, D, F.G, F.bx); \
        EpiMerge E0{WSP(bf16_t, WS_MG), WSP(bf16_t, WS_GB), 0}, E1{WSP(bf16_t, WS_MG), WSP(bf16_t, WS_GB), 1}; \
        pg8::gemm_phase<EpiMerge, pg8::StaticOrder, false>(F.lds, WSP(bf16_t, WS_YA), WSP(bf16_t, WS_WPA), 512, So, E0); \
        pg8::gemm_phase<EpiMerge, pg8::StaticOrder, false>(F.lds, WSP(bf16_t, WS_YM), WSP(bf16_t, WS_WPM), 1024, So, E1); }
#define PH8 { pg8::StaticOrder So; So.init(T, D, F.G, F.bx); EpiWout E{WSP(float, WS_MOD), WSP(bf16_t, WS_PRE)}; \
        pg8::gemm_phase<EpiWout, pg8::StaticOrder, false>(F.lds, WSP(bf16_t, WS_MG), WSP(bf16_t, WS_WO), D, So, E); }
#define PH10 { moe_tables(F, tb, cn); MoeSched Sm{WSP(int, WS_IDX), tb, cn, F.G, vcu}; EpiMoe1 E{WSP(bf16_t, WS_H)}; \
        pg8::gemm_phase<EpiMoe1, MoeSched, true>(F.lds, WSP(bf16_t, WS_U), WSP(bf16_t, WS_W1T), D, Sm, E); }
#define PH11 { moe_tables(F, tb, cn); MoeSched Sm{WSP(int, WS_IDX), tb, cn, F.G, vcu}; EpiMoe2 E{WSP(bf16_t, WS_Y2), WSP(float, WS_WL)}; \
        pg8::gemm_phase<EpiMoe2, MoeSched, false>(F.lds, WSP(bf16_t, WS_H), WSP(bf16_t, WS_W2T), FF, Sm, E); }
    LAS int* tb = (LAS int*)(F.lds + LDS_MISC) + 64; LAS int* cn = tb + 40;
    const int vcu = (F.G % 8 == 0) ? (F.bx % 8) * (F.G / 8) + F.bx / 8 : F.bx;
    if (IN(0)) { DUPRUN(0, PH0); SEAM(0); }
    if (IN(1)) { DUPRUN(1, PH1); SEAM(1); }
    if (IN(2)) { PH2;
        if (MK_DUP & (1 << 21)) { xcd_barrier(bar); const int GG = MK_GG2; if (F.bx < GG) { pg8::StaticOrder So; So.init(T, NBIG, GG, F.bx); EpiNull E{WSP(float, WS_DC)}; pg8::gemm_phase<EpiNull, pg8::StaticOrder, false>(F.lds, WSP(bf16_t, WS_U), WSP(bf16_t, WS_WBIG), D, So, E); } }
        SEAM(2); }
    if (IN(3)) { DUPRUN(3, PH3); SEAM(3); }
    if (IN(4)) { DUPRUN(4, PH4); SEAM(4); }
    if (IN(5)) { DUPRUN(5, PH5); SEAM(5); }
    if (IN(6)) { DUPRUN(6, PH6); SEAM(6); }
    if (IN(7)) { DUPRUN(7, PH7); SEAM(7); }
    if (IN(8)) { DUPRUN(8, PH8);
        if (MK_DUP & (1 << 20)) { xcd_barrier(bar); pg8::StaticOrder So; So.init(T, D, F.G, F.bx); EpiNull E{WSP(float, WS_DC)}; pg8::gemm_phase<EpiNull, pg8::StaticOrder, false>(F.lds, WSP(bf16_t, WS_MG), WSP(bf16_t, WS_WO), D, So, E); }
        SEAM(8); }
    if (IN(9)) { if (MK_DUP & (1 << 9)) { p9_ln_router<true>(F); xcd_barrier(bar); } p9_ln_router<false>(F); SEAM(9); }
    if (IN(10)) { DUPRUN(10, PH10); SEAM(10); }
    if (IN(11)) { DUPRUN(11, PH11); SEAM(11); }
    if (IN(12)) { moe_tables(F, tb, cn); if (MK_DUP & (1 << 12)) { p12_final<true>(F, tb); xcd_barrier(bar); } p12_final<false>(F, tb); }
#undef IN
#undef BOTH
#undef SEAM
}

extern "C" void kernel_launch(void* const* d_in, const int* in_sizes, int n_in, void* d_out, int out_size, void* d_ws, size_t ws_size, hipStream_t stream) {
    static int grid = 0;
    if (grid == 0) {
        size_t need = WS_END;
#if MK_DEBUG
        need += (1 << 20) + (size_t)T * 1024 * 4;
#endif
        if (n_in != 25 || out_size != T * D || ws_size < need) { fprintf(stderr, "kernel_launch: unexpected shapes / workspace (%zu < %zu)\n", ws_size, need); grid = -1; return; }
        int dev = 0, cus = 0, per_cu = 0;
        if (hipGetDevice(&dev) != hipSuccess || hipDeviceGetAttribute(&cus, hipDeviceAttributeMultiprocessorCount, dev) != hipSuccess) { grid = -1; return; }
        if (hipFuncSetAttribute((const void*)mk_fwd, hipFuncAttributeMaxDynamicSharedMemorySize, LDS_BYTES) != hipSuccess) { fprintf(stderr, "kernel_launch: hipFuncSetAttribute failed\n"); grid = -1; return; }
        if (hipOccupancyMaxActiveBlocksPerMultiprocessor(&per_cu, (const void*)mk_fwd, NTHR, LDS_BYTES) != hipSuccess || per_cu < 1) { fprintf(stderr, "kernel_launch: occupancy query says %d\n", per_cu); (void)hipGetLastError(); grid = -1; return; }
        grid = cus;
    }
    if (grid < 0) return;
    (void)hipMemsetAsync((char*)d_ws + WS_CTL, 0, CTL_ZERO_BYTES, stream);
    Params a{};
    for (int i = 0; i < 25; ++i) a.in[i] = (const float*)d_in[i];
    a.out = (float*)d_out; a.ws = (unsigned char*)d_ws;
#if MK_DEBUG
    constexpr int NPH = 7;
#else
    constexpr int NPH = 13;
#endif
#if MK_PER_PHASE
    for (int p = 0; p < NPH; ++p) { a.ph_lo = p; a.ph_hi = p + 1; hipLaunchKernelGGL(mk_fwd, dim3(grid), dim3(NTHR), LDS_BYTES, stream, a); }
#else
    a.ph_lo = 0; a.ph_hi = NPH; hipLaunchKernelGGL(mk_fwd, dim3(grid), dim3(NTHR), LDS_BYTES, stream, a);
#endif
#if MK_DEBUG
    float* res = (float*)((char*)d_ws + WS_DBG0);
    (void)hipMemsetAsync(res, 0, 256, stream);
    k_chk_u<<<64, 256, 0, stream>>>(a, res);
    k_chk_p2<<<32, 64, 0, stream>>>(a, res + 2);
    k_chk_attn<<<256, 256, 0, stream>>>(a, res + 4);
    float* hb = (float*)((char*)d_ws + WS_DBG0 + (1 << 20));
    k_chk_mlstm<<<16, 1024, 0, stream>>>(a, hb);
    k_chk_mnorm<<<T * 4, 256, 0, stream>>>(a, hb, res + 6);
    k_chk_fin<<<(T * D + 255) / 256, 256, 0, stream>>>(res, 4, (float*)d_out, T * D);
#endif
}
```

```cpp
#include <hip/hip_runtime.h>
#include <stdint.h>
#include <math.h>
#include <stdio.h>

#ifndef MK_DEBUG
#define MK_DEBUG 0
#endif
#ifndef MK_DUP
#define MK_DUP 0
#endif
#ifndef MK_GG2
#define MK_GG2 200
#endif
#ifndef MK_STAGGER
#define MK_STAGGER 0
#endif
#ifndef MK_PER_PHASE
#define MK_PER_PHASE 0
#endif

#define LAS __attribute__((address_space(3)))
typedef unsigned short bf16_t;
typedef short bf16x8 __attribute__((ext_vector_type(8)));
typedef short s16x4 __attribute__((ext_vector_type(4)));
typedef float f32x4 __attribute__((ext_vector_type(4)));
typedef float f32x2 __attribute__((ext_vector_type(2)));
typedef unsigned u32x4 __attribute__((ext_vector_type(4)));
typedef unsigned u32x2 __attribute__((ext_vector_type(2)));

constexpr int D = 2048, NB = 4, S = 2048, T = NB * S, NIN = 8712;
constexpr int OFF_QA = 0, OFF_KA = 1536, OFF_VA = 3072, OFF_QKM = 4608, OFF_VM = 6656, OFF_OM = 7680, OFF_IF = 8704;
constexpr int FF = 1024, NEXP = 32, NBIG = 12800;
constexpr float ALPHA = 1.189207115002721f, LN_EPS = 1e-5f;
constexpr float LOG2E = 1.4426950408889634f, LN2 = 0.6931471805599453f;
constexpr float QSCALE = 0.08838834764831845f * 1.4426950408889634f;
constexpr int NTHR = 512, NWAVES = 8;
constexpr int SORT_ROWS = 24576;

constexpr size_t al256(size_t x) { return (x + 255) & ~(size_t)255; }
constexpr size_t WS_CTL = 0, CTL_ZERO_BYTES = 65536;
constexpr int CW_BAR = 0;
constexpr int CW_CNT = 4096;
constexpr int CW_DBG = 4224;
constexpr size_t WS_MOD = 65536;
constexpr size_t WS_ROPE = WS_MOD + al256((size_t)NB * 6 * D * 4);
constexpr size_t WS_WIF = WS_ROPE + (size_t)S * 64 * 2 * 4;
constexpr size_t WS_GPRE = WS_WIF + (size_t)8 * D * 4;
constexpr size_t WS_BCUM = WS_GPRE + (size_t)T * 8 * 4;
constexpr size_t WS_MCUM = WS_BCUM + (size_t)16 * S * 4;
constexpr size_t WS_WRT = WS_MCUM + (size_t)16 * S * 4;
constexpr size_t WS_LSE = WS_WRT + (size_t)2 * 48 * D * 2;
constexpr size_t WS_IDX = WS_LSE + (size_t)T * 12 * 4;
constexpr size_t WS_WL = WS_IDX + (size_t)NEXP * T * 4;
constexpr size_t WS_TOK = WS_WL + (size_t)NEXP * T * 4;
constexpr size_t WS_DN = WS_TOK + (size_t)T * 16;
constexpr size_t WS_NST = WS_DN + (size_t)256 * 256 * 4;
constexpr size_t WS_WBIG = al256(WS_NST + (size_t)256 * 256 * 4);
constexpr size_t WS_WPA = WS_WBIG + (size_t)NBIG * D * 2;
constexpr size_t WS_WPM = WS_WPA + (size_t)D * 512 * 2;
constexpr size_t WS_WO = WS_WPM + (size_t)D * 1024 * 2;
constexpr size_t WS_W1T = WS_WO + (size_t)D * D * 2;
constexpr size_t WS_W2T = WS_W1T + (size_t)NEXP * 2048 * D * 2;
constexpr size_t WS_U = WS_W2T + (size_t)NEXP * D * FF * 2;
constexpr size_t WS_QB = WS_U + (size_t)T * D * 2;
constexpr size_t WS_KB = WS_QB + (size_t)T * 1536 * 2;
constexpr size_t WS_VB = WS_KB + (size_t)T * 1536 * 2;
constexpr size_t WS_QKP = WS_VB + (size_t)T * 1536 * 2;
constexpr size_t WS_VMB = WS_QKP + (size_t)T * 2048 * 2;
constexpr size_t WS_OGB = WS_VMB + (size_t)T * 1024 * 2;
constexpr size_t WS_GB = WS_OGB + (size_t)T * 1024 * 2;
constexpr size_t WS_QM = WS_GB + (size_t)T * 4096 * 2;
constexpr size_t WS_KM = WS_QM + (size_t)T * 1024 * 2;
constexpr size_t WS_OATT = WS_KM + (size_t)T * 1024 * 2;
constexpr size_t WS_YA = WS_OATT + (size_t)T * 1536 * 2;
constexpr size_t WS_YM = WS_YA + (size_t)T * 512 * 2;
constexpr size_t WS_DC = WS_YM + (size_t)T * 1024 * 2;
constexpr size_t WS_CST = WS_DC + (size_t)256 * 65536 * 4;
constexpr size_t WS_MG = WS_CST + (size_t)256 * 65536 * 2;
constexpr size_t WS_PRE = WS_MG + (size_t)T * D * 2;
constexpr size_t WS_END = WS_PRE + (size_t)T * D * 4;
constexpr size_t WS_H = WS_QB;
constexpr size_t WS_Y2 = WS_H + (size_t)SORT_ROWS * FF * 2;
static_assert(WS_Y2 + (size_t)SORT_ROWS * D * 2 <= WS_QM, "overlay");
constexpr size_t WS_DBG0 = WS_END;

constexpr int LDS_MISC = 162816;
constexpr int LDS_BYTES = LDS_MISC + 1024;

__device__ __forceinline__ unsigned cvt_pk_bf16(float lo, float hi) { unsigned r; asm volatile("v_cvt_pk_bf16_f32 %0, %1, %2" : "=v"(r) : "v"(lo), "v"(hi)); return r; }
__device__ __forceinline__ float bf_lo(unsigned w) { return __uint_as_float(w << 16); }
__device__ __forceinline__ float bf_hi(unsigned w) { return __uint_as_float(w & 0xffff0000u); }
__device__ __forceinline__ float bf2f(bf16_t b) { return __uint_as_float(((unsigned)b) << 16); }
__device__ __forceinline__ bf16_t f2bf(float f) { return (bf16_t)(cvt_pk_bf16(f, 0.f) & 0xffffu); }
__device__ __forceinline__ float fast_exp2(float x) { return __builtin_amdgcn_exp2f(x); }
__device__ __forceinline__ float fast_rcp(float x) { return __builtin_amdgcn_rcpf(x); }
__device__ __forceinline__ float sigmoid_fast(float x) { return fast_rcp(1.f + fast_exp2(-x * LOG2E)); }
__device__ __forceinline__ float silu_fast(float x) { return x * sigmoid_fast(x); }
__device__ __forceinline__ float wave_sum(float v) {
#pragma unroll
    for (int o = 32; o >= 1; o >>= 1) v += __shfl_xor(v, o);
    return v; }
__device__ __forceinline__ float wave_max(float v) {
#pragma unroll
    for (int o = 32; o >= 1; o >>= 1) v = fmaxf(v, __shfl_xor(v, o));
    return v; }
__device__ __forceinline__ s16x4 tr_read(unsigned addr) { s16x4 r; asm volatile("ds_read_b64_tr_b16 %0, %1" : "=&v"(r) : "v"(addr) : "memory"); return r; }
__device__ __forceinline__ s16x4 tr_read_o(unsigned base, const int off) { s16x4 r; asm volatile("ds_read_b64_tr_b16 %0, %1 offset:%2" : "=&v"(r) : "v"(base), "n"(off) : "memory"); return r; }
#define LGKM_WAIT0() do { asm volatile("s_waitcnt lgkmcnt(0)" ::: "memory"); __builtin_amdgcn_sched_barrier(0); } while (0)
#define PK8(L, H) ((bf16x8){L[0], L[1], L[2], L[3], H[0], H[1], H[2], H[3]})

#define XB_TMO      128
#define XB_XCNT(j)  (256  + 64 * (j))
#define XB_XSUB(j)  (1280 + 64 * (j))
#define XB_XGEN(j)  (2304 + 64 * (j))
#define XB_TOP      3328
#define XB_TOPGEN   3392
#define XCD_BAR_WORDS 3456
#define XB_SPIN_CAP (1u << 18)
__device__ __forceinline__ unsigned xb_ld(unsigned* p)              { return __hip_atomic_load(p, __ATOMIC_RELAXED, __HIP_MEMORY_SCOPE_AGENT); }
__device__ __forceinline__ unsigned xb_add(unsigned* p, unsigned v) { return __hip_atomic_fetch_add(p, v, __ATOMIC_RELAXED, __HIP_MEMORY_SCOPE_AGENT); }
__device__ __forceinline__ unsigned xb_xcc_id() { return (unsigned)__builtin_amdgcn_s_getreg((3 << 11) | 20) & 0xFu; }
#define XB_SPIN(cond, bar) do { unsigned _sp = 0; while (cond) { __builtin_amdgcn_s_sleep(1); \
    if ((++_sp & 255u) == 0u) { if (xb_ld(&(bar)[XB_TMO])) break; if (_sp > XB_SPIN_CAP) { atomicAdd(&(bar)[XB_TMO], 1u); break; } } } } while (0)
struct XcdBarrier { unsigned* bar; unsigned x; volatile LAS unsigned* st; };
__device__ __forceinline__ XcdBarrier xcd_barrier_post(unsigned* bar, volatile LAS unsigned* st) {
    XcdBarrier b; b.bar = bar; b.x = xb_xcc_id(); b.st = st;
    if (threadIdx.x == 0) (void)xb_add(&bar[XB_XCNT(b.x)], 1u);
    return b;
}
__device__ __forceinline__ void xcd_barrier_complete(unsigned* bar, unsigned x, unsigned& nloc, unsigned& nx) {
    const unsigned G = gridDim.x * gridDim.y * gridDim.z;
    unsigned sum, cnt, mine, sp = 0u;
    for (;;) {
        sum = 0u; cnt = 0u; mine = 0u;
#pragma unroll
        for (unsigned j = 0; j < 16; ++j) { const unsigned c = xb_ld(&bar[XB_XCNT(j)]); sum += c; cnt += (c > 0u) ? 1u : 0u; mine = (j == x) ? c : mine; }
        if (sum == G) break;
        __builtin_amdgcn_s_sleep(1);
        if ((++sp & 255u) == 0u) { if (xb_ld(&bar[XB_TMO])) break; if (sp > XB_SPIN_CAP) { atomicAdd(&bar[XB_TMO], 1u); break; } }
    }
    nloc = mine > 0u ? mine : 1u; nx = cnt > 0u ? cnt : 1u;
}
__device__ __forceinline__ void xcd_barrier(const XcdBarrier& b) {
    asm volatile("s_waitcnt vmcnt(0)" ::: "memory");
    __syncthreads();
    if (threadIdx.x == 0) {
        unsigned* bar = b.bar;
        __builtin_amdgcn_s_waitcnt(0);
        unsigned nloc = b.st[0], nx = b.st[1];
        if (nloc == 0u) { xcd_barrier_complete(bar, b.x, nloc, nx); b.st[0] = nloc; b.st[1] = nx; }
        const unsigned old = xb_add(&bar[XB_XSUB(b.x)], 1u);
        const unsigned gen = old / nloc;
        if (old + 1u == (gen + 1u) * nloc) {
            __builtin_amdgcn_fence(__ATOMIC_RELEASE, "agent");
            asm volatile("s_waitcnt vmcnt(0)" ::: "memory");
            const unsigned og = xb_add(&bar[XB_TOP], 1u);
            const unsigned tg = og / nx;
            if (og + 1u == (tg + 1u) * nx) xb_add(&bar[XB_TOPGEN], 1u);
            else XB_SPIN(xb_ld(&bar[XB_TOPGEN]) == tg, bar);
            __builtin_amdgcn_fence(__ATOMIC_ACQUIRE, "agent");
            xb_add(&bar[XB_XGEN(b.x)], 1u);
            asm volatile("s_waitcnt vmcnt(0)" ::: "memory");
        } else {
            XB_SPIN(xb_ld(&bar[XB_XGEN(b.x)]) == gen, bar);
            __builtin_amdgcn_fence(__ATOMIC_ACQUIRE, "agent");
            asm volatile("s_waitcnt vmcnt(0)" ::: "memory");
        }
    }
    __syncthreads();
}

namespace pg8 {
constexpr int BM = 256, BK = 64, HALF = 128, HTB = HALF * BK * 2, STAGE_BYTES = 8 * HTB, NXCD = 8, WGM = 8;
__host__ __device__ __forceinline__ int lds_byte(int r, int c) { const int st = (r >> 4) * 2 + (c >> 5), rr = r & 15, cc = c & 31, ob = rr * 64 + cc * 2; return st * 1024 + (ob ^ (((ob >> 9) & 1) << 5)); }
__host__ __device__ __forceinline__ void stage_rc(int b, int& R, int& C) { const int st = b / 1024, sb = b % 1024, swz = sb ^ (((sb >> 9) & 1) << 5); R = (st >> 1) * 16 + swz / 64; C = (st & 1) * 32 + (swz % 64) / 2; }
__host__ __device__ __forceinline__ int perm32(int rho) { const int n = rho >> 4, i = rho & 15; return 8 * (i >> 2) + 4 * n + (i & 3); }

struct Unit { int pm, pn, e, it, cnt; };

struct StaticOrder {
    int nM, nN, nwg, G, c;
    __device__ void init(int M, int N, int G_, int c_) { nM = M / BM; nN = N / BM; nwg = nM * nN; G = G_; c = c_; }
    __device__ bool next(int i, Unit& u) const {
        const long L = (long)i * G + c; if (L >= nwg) return false;
        int wgid = (int)L; { const int q = nwg / NXCD, r = nwg % NXCD, xcd = wgid % NXCD, off = wgid / NXCD; wgid = (xcd < r ? xcd * (q + 1) : r * (q + 1) + (xcd - r) * q) + off; }
        const int nig = WGM * nN, gid = wgid / nig, fm = gid * WGM, gsz = (nM - fm) < WGM ? (nM - fm) : WGM;
        u.pm = fm + ((wgid % nig) % gsz); u.pn = (wgid % nig) / gsz; u.e = 0; u.it = 0; u.cnt = 0; return true;
    }
    __device__ __forceinline__ int arow(const Unit&, int r) const { return r; }
};

template <class Epi, class Sched, bool GATHER>
__device__ __forceinline__ void gemm_phase(LAS unsigned char* lds, const bf16_t* Ap, const bf16_t* Btp, const int K, const Sched& S, const Epi& E) {
    const int tid = threadIdx.x, wid = __builtin_amdgcn_readfirstlane(tid >> 6), lane = tid & 63, wr = wid >> 2, wc = wid & 3, fr = lane & 15, fq = lane >> 4;
    const int nt = K / BK;
    unsigned voffA[2], voffB[2]; int RA[2], CA[2];
#pragma unroll
    for (int i = 0; i < 2; ++i) { int R, C; stage_rc(tid * 16 + i * 8192, R, C); const int Rb = Epi::PERM ? ((R & ~31) + perm32(R & 31)) : R;
        RA[i] = R; CA[i] = C; voffA[i] = (unsigned)(R * K + C) * 2u; voffB[i] = (unsigned)(Rb * K + C) * 2u; }
    const size_t kstep = (size_t)(BK * 2);
    const size_t hstep = (size_t)HALF * K * 2;
    const size_t tstep = 2 * hstep;
    const unsigned ldsw = (unsigned)wid * 1024u;
    const int aoff = lds_byte(wr * 64 + fr, fq * 8), boff = lds_byte(wc * 32 + fr, fq * 8);
    unsigned vC[2][2], vN[2][2], v2[2][2];
#define PG8_SA(b, h) (((b) * 2 + (h)) * HTB)
#define PG8_SB(b, h) ((4 + (b) * 2 + (h)) * HTB)
#define PG8_STAGE(bufoff, gbase, voff) do { _Pragma("unroll") for (int _i = 0; _i < 2; ++_i) \
        __builtin_amdgcn_global_load_lds((const unsigned*)((const char*)(gbase) + (voff)[_i]), (LAS unsigned*)(lds + (bufoff) + ldsw + _i * 8192), 16, 0, 0); } while (0)
#define PG8_STAGE_A(bufoff, gbase, h, vsel) do { if constexpr (GATHER) { PG8_STAGE(bufoff, gbase, (vsel)[h]); } else { PG8_STAGE(bufoff, (gbase) + (h) * hstep, voffA); } } while (0)
#define PG8_GVOFF(u, v) do { _Pragma("unroll") for (int _h = 0; _h < 2; ++_h) _Pragma("unroll") for (int _i = 0; _i < 2; ++_i) \
        (v)[_h][_i] = (unsigned)(S.arow(u, _h * HALF + RA[_i]) * K + CA[_i]) * 2u; } while (0)
#define PG8_LDA(dst, b, h) do { _Pragma("unroll") for (int m = 0; m < 4; ++m) _Pragma("unroll") for (int k = 0; k < 2; ++k) dst[m][k] = *(const LAS bf16x8*)(lds + PG8_SA(b, h) + aoff + m * 2048 + k * 1024); } while (0)
#define PG8_LDB(dst, b, h) do { _Pragma("unroll") for (int n = 0; n < 2; ++n) _Pragma("unroll") for (int k = 0; k < 2; ++k) dst[n][k] = *(const LAS bf16x8*)(lds + PG8_SB(b, h) + boff + n * 2048 + k * 1024); } while (0)
#define PG8_MMA(ai, bj, At, Bt) do { __builtin_amdgcn_s_setprio(1); _Pragma("unroll") for (int m = 0; m < 4; ++m) _Pragma("unroll") for (int n = 0; n < 2; ++n) _Pragma("unroll") for (int k = 0; k < 2; ++k) \
        acc[ai][bj][m][n] = __builtin_amdgcn_mfma_f32_16x16x32_bf16(Bt[n][k], At[m][k], acc[ai][bj][m][n], 0, 0, 0); __builtin_amdgcn_s_setprio(0); } while (0)
#define PG8_WAIT_V(n) asm volatile("s_waitcnt vmcnt(" #n ")" ::: "memory")
#define PG8_WAIT_L(n) asm volatile("s_waitcnt lgkmcnt(" #n ")" ::: "memory")
#define PG8_BAR __builtin_amdgcn_s_barrier()
#define PG8_SCHED __builtin_amdgcn_sched_barrier(0)
    Unit cur, nxt; int ui = 0;
    if (!S.next(0, cur)) return;
    f32x4 acc[2][2][4][2];
#pragma unroll
    for (int a = 0; a < 2; ++a)
#pragma unroll
        for (int b = 0; b < 2; ++b)
#pragma unroll
            for (int m = 0; m < 4; ++m)
#pragma unroll
                for (int n = 0; n < 2; ++n) acc[a][b][m][n] = (f32x4){0.f, 0.f, 0.f, 0.f};
    bf16x8 At[4][2], B0[2][2], B1[2][2];
    const char* cA = GATHER ? (const char*)Ap : (const char*)Ap + (size_t)cur.pm * tstep; const char* cB = (const char*)Btp + (size_t)cur.pn * tstep;
    if constexpr (GATHER) { PG8_GVOFF(cur, vC); }
    PG8_STAGE(PG8_SB(0, 0), cB, voffB); PG8_STAGE(PG8_SB(0, 1), cB + hstep, voffB); PG8_STAGE_A(PG8_SA(0, 0), cA, 0, vC); PG8_STAGE_A(PG8_SA(0, 1), cA, 1, vC);
    if (wr == 1) PG8_BAR;
    PG8_WAIT_V(2); PG8_BAR;
    PG8_STAGE(PG8_SB(1, 0), cB + kstep, voffB); PG8_STAGE_A(PG8_SA(1, 0), cA + kstep, 0, vC); PG8_STAGE(PG8_SB(1, 1), cB + hstep + kstep, voffB);
    PG8_WAIT_V(6); PG8_BAR;
    for (;;) {
        const bool has_next = S.next(ui + 1, nxt);
        const char* nA = GATHER ? (const char*)Ap : (has_next ? (const char*)Ap + (size_t)nxt.pm * tstep : cA);
        const char* nB = has_next ? (const char*)Btp + (size_t)nxt.pn * tstep : cB;
        if constexpr (GATHER) { if (has_next) { PG8_GVOFF(nxt, vN); } else {
#pragma unroll
            for (int h = 0; h < 2; ++h) { vN[h][0] = vC[h][0]; vN[h][1] = vC[h][1]; } } }
        for (int t = 0; t < nt; t += 2) {
            const bool last = (t == nt - 2);
            const char* a1 = cA + (size_t)(t + 1) * kstep;
            const char* a2 = last ? nA : cA + (size_t)(t + 2) * kstep; const char* b2 = last ? nB : cB + (size_t)(t + 2) * kstep;
            const char* a3 = a2 + kstep; const char* b3 = b2 + kstep;
            if constexpr (GATHER) {
#pragma unroll
                for (int h = 0; h < 2; ++h) { v2[h][0] = last ? vN[h][0] : vC[h][0]; v2[h][1] = last ? vN[h][1] : vC[h][1]; } }
            PG8_LDB(B0, 0, 0); PG8_LDB(B1, 0, 1); PG8_SCHED; PG8_LDA(At, 0, 0); PG8_STAGE_A(PG8_SA(1, 1), a1, 1, vC);
            PG8_WAIT_V(8); PG8_WAIT_L(0); PG8_BAR; PG8_MMA(0, 0, At, B0); PG8_MMA(0, 1, At, B1); PG8_BAR; PG8_SCHED;
            PG8_LDA(At, 0, 1); PG8_STAGE(PG8_SB(0, 0), b2, voffB); PG8_STAGE(PG8_SB(0, 1), b2 + hstep, voffB); PG8_STAGE_A(PG8_SA(0, 0), a2, 0, v2);
            PG8_WAIT_V(8); PG8_WAIT_L(0); PG8_BAR; PG8_MMA(1, 0, At, B0); PG8_MMA(1, 1, At, B1); PG8_BAR; PG8_SCHED;
            PG8_LDB(B0, 1, 0); PG8_LDB(B1, 1, 1); PG8_SCHED; PG8_LDA(At, 1, 0); PG8_STAGE_A(PG8_SA(0, 1), a2, 1, v2);
            PG8_WAIT_V(8); PG8_WAIT_L(0); PG8_BAR; PG8_MMA(0, 0, At, B0); PG8_MMA(0, 1, At, B1); PG8_BAR; PG8_SCHED;
            PG8_LDA(At, 1, 1); PG8_STAGE(PG8_SB(1, 0), b3, voffB); PG8_STAGE(PG8_SB(1, 1), b3 + hstep, voffB); PG8_STAGE_A(PG8_SA(1, 0), a3, 0, v2);
            PG8_WAIT_V(8); PG8_WAIT_L(0); PG8_BAR; PG8_MMA(1, 0, At, B0); PG8_MMA(1, 1, At, B1); PG8_BAR; PG8_SCHED;
        }
        if (wr == 0) PG8_BAR;
        E(acc, cur, wr, wc, fr, fq);
        if (!has_next) break;
#pragma unroll
        for (int a = 0; a < 2; ++a)
#pragma unroll
            for (int b = 0; b < 2; ++b)
#pragma unroll
                for (int m = 0; m < 4; ++m)
#pragma unroll
                    for (int n = 0; n < 2; ++n) acc[a][b][m][n] = (f32x4){0.f, 0.f, 0.f, 0.f};
        cur = nxt; cA = nA; cB = nB; ++ui;
        if constexpr (GATHER) {
#pragma unroll
            for (int h = 0; h < 2; ++h) { vC[h][0] = vN[h][0]; vC[h][1] = vN[h][1]; } }
        if (wr == 1) PG8_BAR;
    }
    PG8_WAIT_V(0);
    PG8_BAR;
#undef PG8_SA
#undef PG8_SB
#undef PG8_STAGE
#undef PG8_STAGE_A
#undef PG8_GVOFF
#undef PG8_LDA
#undef PG8_LDB
#undef PG8_MMA
#undef PG8_WAIT_V
#undef PG8_WAIT_L
#undef PG8_BAR
#undef PG8_SCHED
}
}

struct Params { const float* in[25]; float* out; unsigned char* ws; int ph_lo, ph_hi; };
struct Frame {
    LAS unsigned char* lds; int G, bx;
    unsigned char* ws;
    const float *x, *c, *w_ada, *b_ada, *w_in, *b_mgate, *conv_w, *conv_b, *m_norm_g, *w_proj_a, *w_proj_m, *w_gate, *b_gate, *w_out, *ln1_g, *ln1_b, *w_rg, *b_rg, *w_re, *b_re, *w_eg, *w_eu, *w_ed, *ln2_g, *ln2_b;
    float* out;
};
__device__ __forceinline__ int otid() { int t = threadIdx.x; asm volatile("" : "+v"(t)); return t; }
#define FTID otid()
#define FLANE (otid() & 63)
#define FWAVE __builtin_amdgcn_readfirstlane(otid() >> 6)
#define WSP(T_, off) ((T_*)(F.ws + (off)))

#ifndef CVT_SWAP
#define CVT_SWAP 1
#endif
constexpr int N_IT_P0 = 400, N_IT_PX = 112, N_IT_W1 = N_IT_PX + 2048, N_IT_BG = N_IT_W1 + 1024;
constexpr int CVT_P = 544, CVT_BUF = 64 * CVT_P, CVT_RP = 144, CVT_IMG = 2 * CVT_BUF;
constexpr int CW_QHEAD = 4160, CW_QHEAD2 = 4352, CW_DONE2 = 4224, CW_DONE10 = 4288;
struct CvtItem { const float* src; bf16_t* dst; int ld, Kdst, kind, arg, n0, valid; };
__device__ __forceinline__ int cvt_row(int kind, int arg, int n) {
    if (kind == 1) { if (n < 3072) { const int hd = n >> 7, lc = n & 127; return hd * 128 + 2 * (lc & 63) + (lc >> 6); } return n; }
    if (kind == 2) return 256 * (n >> 7) + 128 * arg + (n & 127);
    return n + arg;
}
__device__ __forceinline__ CvtItem cvt_decode_p0(const Frame& F, int item, int lim) {
    CvtItem c; c.valid = (item < lim); c.kind = 0; c.arg = 0;
    if (item < 272) { const int nt = item >> 3, kq = item & 7; c.src = F.w_in + (size_t)(kq * 256) * NIN + nt * 256; c.ld = NIN; c.dst = WSP(bf16_t, WS_WBIG) + kq * 256; c.Kdst = D; c.kind = 1; c.n0 = nt * 256; }
    else if (item < 400) { const int i = item - 272; const int nt = i >> 3, kq = i & 7; c.src = F.w_gate + (size_t)(kq * 256) * 4096 + nt * 256; c.ld = 4096; c.dst = WSP(bf16_t, WS_WBIG) + kq * 256; c.Kdst = D; c.arg = 8704; c.n0 = nt * 256; }
    else if (item < 416) { const int i = item - 400; const int nt = i >> 1, kq = i & 1; c.src = F.w_proj_a + (size_t)(kq * 256) * D + nt * 256; c.ld = D; c.dst = WSP(bf16_t, WS_WPA) + kq * 256; c.Kdst = 512; c.n0 = nt * 256; }
    else if (item < 448) { const int i = item - 416; const int nt = i >> 2, kq = i & 3; c.src = F.w_proj_m + (size_t)(kq * 256) * D + nt * 256; c.ld = D; c.dst = WSP(bf16_t, WS_WPM) + kq * 256; c.Kdst = 1024; c.n0 = nt * 256; }
    else { const int i = (item < 512 ? item : 511) - 448; const int nt = i >> 3, kq = i & 7; c.src = F.w_out + (size_t)(kq * 256) * D + nt * 256; c.ld = D; c.dst = WSP(bf16_t, WS_WO) + kq * 256; c.Kdst = D; c.n0 = nt * 256; }
    return c;
}
__device__ __forceinline__ CvtItem cvt_decode_bg(const Frame& F, int item) {
    if (item < N_IT_PX) return cvt_decode_p0(F, 400 + item, 512);
    CvtItem c; c.valid = (item < N_IT_BG);
    if (item < N_IT_W1) { const int iw = item - N_IT_PX; const int e = iw >> 6, r = iw & 63, mat = r >> 5, kq = (r >> 2) & 7, nt = r & 3;
        c.src = (mat ? F.w_eu : F.w_eg) + (size_t)e * D * FF + (size_t)(kq * 256) * FF + nt * 256; c.ld = FF; c.dst = WSP(bf16_t, WS_W1T) + (size_t)e * 2048 * D + kq * 256; c.Kdst = D; c.kind = 2; c.arg = mat; c.n0 = nt * 256; }
    else { const int i2 = (item < N_IT_BG ? item : N_IT_BG - 1) - N_IT_W1; const int e = i2 >> 5, r = i2 & 31, kq = r >> 3, nt = r & 7;
        c.src = F.w_ed + (size_t)e * FF * D + (size_t)(kq * 256) * D + nt * 256; c.ld = D; c.dst = WSP(bf16_t, WS_W2T) + (size_t)e * D * FF + kq * 256; c.Kdst = FF; c.kind = 0; c.arg = 0; c.n0 = nt * 256; }
    return c;
}
#define CVT_LOAD(R, it, j) do { _Pragma("unroll") for (int _p = 0; _p < 8; ++_p) (R)[_p] = __builtin_nontemporal_load((const f32x4*)((it).src + (size_t)(64 * (j) + kr + 8 * _p) * (it).ld + n4)); } while (0)
template <int MODE>
__device__ __forceinline__ void cvt_stream(const Frame& F, int limit) {
    const int tid = FTID; const int lane = tid & 63, w = __builtin_amdgcn_readfirstlane(tid >> 6), li = lane & 15, g = lane >> 4;
    const int kr = tid >> 6, n4 = 4 * (tid & 63);
    unsigned* qh = (unsigned*)(F.ws + WS_CTL) + (limit <= N_IT_W1 ? CW_QHEAD : CW_QHEAD2); const int ibase = (limit <= N_IT_W1) ? 0 : N_IT_W1;
    volatile LAS int* mb = (volatile LAS int*)(F.lds + LDS_MISC) + 16;
    LAS unsigned char* lbuf = F.lds; LAS unsigned char* wimg = F.lds + CVT_IMG + w * (64 * CVT_RP);
    __syncthreads();
    int i0, i1;
    if (MODE == 0) { i0 = F.bx; i1 = F.bx + F.G; }
    else { if (tid == 0) { const unsigned a0 = atomicAdd(qh, 2u); mb[0] = (int)a0; mb[2] = 0; } __syncthreads(); i0 = ibase + mb[0]; i1 = i0 + 1; if (i0 >= limit) i0 = 0x7fffffff; if (i1 >= limit) i1 = 0x7fffffff; }
    CvtItem cur = (MODE == 0) ? cvt_decode_p0(F, i0, N_IT_P0) : cvt_decode_bg(F, i0), nxt = (MODE == 0) ? cvt_decode_p0(F, i1, N_IT_P0) : cvt_decode_bg(F, i1);
    int inext = i1;
    f32x4 R0[8], R1[8], R2[8], R3[8];
    if (cur.valid) { CVT_LOAD(R0, cur, 0); CVT_LOAD(R1, cur, 1); CVT_LOAD(R2, cur, 2); CVT_LOAD(R3, cur, 3); }
    const unsigned rdbase = (unsigned)(uintptr_t)lbuf + (unsigned)((4 * g + (li >> 2)) * CVT_P + (32 * w + 4 * (li & 3)) * 2);
    while (cur.valid) {
        unsigned cl = 0u;
        if (MODE == 1 && tid == 0) cl = atomicAdd(qh, 1u);
        size_t rofs[4];
#pragma unroll
        for (int i4 = 0; i4 < 4; ++i4) rofs[i4] = (size_t)cvt_row(cur.kind, cur.arg, cur.n0 + 32 * w + 8 * i4 + (lane >> 3)) * cur.Kdst;
#define CVT_PROC2(Ra, Rb, j) do { \
            _Pragma("unroll") for (int _p = 0; _p < 8; ++_p) { u32x2 wv; wv.x = cvt_pk_bf16((Ra)[_p][0], (Ra)[_p][1]); wv.y = cvt_pk_bf16((Ra)[_p][2], (Ra)[_p][3]); *(LAS u32x2*)(lbuf + (kr + 8 * _p) * CVT_P + 2 * n4) = wv; \
                wv.x = cvt_pk_bf16((Rb)[_p][0], (Rb)[_p][1]); wv.y = cvt_pk_bf16((Rb)[_p][2], (Rb)[_p][3]); *(LAS u32x2*)(lbuf + CVT_BUF + (kr + 8 * _p) * CVT_P + 2 * n4) = wv; } \
            asm volatile("s_waitcnt lgkmcnt(0)\n\ts_barrier" ::: "memory"); \
            if (nxt.valid) { CVT_LOAD(Ra, nxt, j); CVT_LOAD(Rb, nxt, (j) + 1); } \
            s16x4 tA[8], tB[8]; \
            _Pragma("unroll") for (int kb = 0; kb < 4; ++kb) { tA[kb] = tr_read_o(rdbase, kb * 16 * CVT_P); tB[kb] = tr_read_o(rdbase, kb * 16 * CVT_P + 32); \
                tA[4 + kb] = tr_read_o(rdbase, CVT_BUF + kb * 16 * CVT_P); tB[4 + kb] = tr_read_o(rdbase, CVT_BUF + kb * 16 * CVT_P + 32); } \
            LGKM_WAIT0(); \
            asm volatile("s_barrier" ::: "memory"); \
            _Pragma("unroll") for (int q8 = 0; q8 < 8; ++q8) { union { s16x4 v; unsigned u[2]; } a, b; a.v = tA[q8]; b.v = tB[q8]; \
                auto r0 = __builtin_amdgcn_permlane16_swap(a.u[0], b.u[0], false, false); auto r1 = __builtin_amdgcn_permlane16_swap(a.u[1], b.u[1], false, false); \
                u32x4 o; o.x = r0[0]; o.y = r1[0]; o.z = r0[1]; o.w = r1[1]; \
                *(LAS u32x4*)(wimg + (q8 >> 2) * (32 * CVT_RP) + (16 * (g & 1) + li) * CVT_RP + (16 * (q8 & 3) + 8 * (g >> 1)) * 2) = o; } \
            asm volatile("s_waitcnt lgkmcnt(0)" ::: "memory"); \
            _Pragma("unroll") for (int q8 = 0; q8 < 8; ++q8) { const u32x4 o = *(const LAS u32x4*)(wimg + (q8 >> 2) * (32 * CVT_RP) + (8 * (q8 & 3) + (lane >> 3)) * CVT_RP + (lane & 7) * 16); \
                __builtin_nontemporal_store(o, (u32x4*)(cur.dst + rofs[q8 & 3] + 64 * ((j) + (q8 >> 2)) + 8 * (lane & 7))); } } while (0)
        CVT_PROC2(R0, R1, 0); CVT_PROC2(R2, R3, 2);
        int i2;
        if (MODE == 0) { i2 = inext + F.G; }
        else { if (tid == 0) mb[0] = (int)cl; asm volatile("s_waitcnt lgkmcnt(0)\n\ts_barrier" ::: "memory"); i2 = ibase + mb[0]; if (i2 >= limit || i2 < 0) i2 = 0x7fffffff; asm volatile("s_waitcnt lgkmcnt(0)\n\ts_barrier" ::: "memory"); }
        cur = nxt; inext = i2; nxt = (MODE == 0) ? cvt_decode_p0(F, i2, N_IT_P0) : cvt_decode_bg(F, i2);
    }
    __syncthreads();
#undef CVT_PROC2
}

__device__ __forceinline__ void p0_prologue(const Frame& F) {
    const int G = F.G, bx = F.bx;
    cvt_stream<0>(F, N_IT_P0);
    __syncthreads();
    {
        LAS float* sc = (LAS float*)F.lds;
        LAS float* red = (LAS float*)(F.lds + 32768);
        float* mod = WSP(float, WS_MOD);
        for (int i = FTID; i < NB * D; i += NTHR) { const float cv = F.c[i]; sc[i] = cv / (1.f + expf(-cv)); }
        __syncthreads();
        for (int cb = bx; cb < 6 * D / 48; cb += G) {
            const int cg = FTID % 12, kl = FTID / 12;
            float a[4][4] = {};
            if (kl < 42) {
                for (int k0 = kl; k0 < D; k0 += 42 * 7) { f32x4 w[7];
#pragma unroll
                    for (int u = 0; u < 7; ++u) { const int k = k0 + 42 * u; w[u] = (k < D) ? __builtin_nontemporal_load((const f32x4*)(F.w_ada + (size_t)k * (6 * D) + cb * 48 + cg * 4)) : (f32x4){0.f, 0.f, 0.f, 0.f}; }
#pragma unroll
                    for (int u = 0; u < 7; ++u) { const int k = (k0 + 42 * u < D) ? k0 + 42 * u : 0;
#pragma unroll
                        for (int b = 0; b < 4; ++b) { const float s = sc[b * D + k];
#pragma unroll
                            for (int j = 0; j < 4; ++j) a[b][j] += s * w[u][j]; } } }
#pragma unroll
                for (int b = 0; b < 4; ++b)
#pragma unroll
                    for (int j = 0; j < 4; ++j) red[(kl * 12 + cg) * 16 + b * 4 + j] = a[b][j];
            }
            __syncthreads();
            if (FTID < 192) { const int cgi = FTID / 16, bj = FTID % 16; float s = 0.f; for (int q = 0; q < 42; ++q) s += red[(q * 12 + cgi) * 16 + bj];
                const int b = bj / 4, j = bj % 4; const int col = cb * 48 + cgi * 4 + j; mod[(size_t)b * 6 * D + col] = s + F.b_ada[col]; }
            __syncthreads();
        }
    }
    {
        float* rope = WSP(float, WS_ROPE);
        for (int i = bx * NTHR + FTID; i < S * 64; i += G * NTHR) { const int pos = i >> 6, fi = i & 63;
            const float inv = powf(10000.f, -(float)(2 * fi) / 128.f); const float ang = (float)pos * inv; rope[2 * i] = cosf(ang); rope[2 * i + 1] = sinf(ang); }
        float* wif = WSP(float, WS_WIF);
        for (int i = bx * NTHR + FTID; i < 8 * D; i += G * NTHR) { const int j = i / D, k = i % D; wif[i] = F.w_in[(size_t)k * NIN + OFF_IF + j]; }
        bf16_t* wrt = WSP(bf16_t, WS_WRT);
        for (int i = bx * NTHR + FTID; i < 48 * D; i += G * NTHR) { const int j = i / D, k = i % D;
            const float w = (j < 4) ? F.w_rg[k * 4 + j] : (j < 36 ? F.w_re[k * 32 + (j - 4)] : 0.f);
            const bf16_t hi = f2bf(w); const bf16_t lo = f2bf(w - bf2f(hi)); wrt[i] = hi; wrt[48 * D + i] = lo; }
    }
}

__device__ __forceinline__ void p1_lnmod(const Frame& F) {
    const float* mod = WSP(float, WS_MOD); const float* wif = WSP(float, WS_WIF); bf16_t* U = WSP(bf16_t, WS_U); float* gpre = WSP(float, WS_GPRE);
    const int tid = FTID; const int lane = tid & 63; const int gw = F.bx * NWAVES + __builtin_amdgcn_readfirstlane(tid >> 6), NGW = F.G * NWAVES;
    LAS float* wl = (LAS float*)F.lds;
    __syncthreads();
#pragma unroll
    for (int i = 0; i < 8; ++i) *(LAS f32x4*)(wl + 4 * (tid + NTHR * i)) = *(const f32x4*)(wif + 4 * (tid + NTHR * i));
    __syncthreads();
    f32x4 v[8], nx[8];
    if (gw < T) {
#pragma unroll
        for (int i = 0; i < 8; ++i) nx[i] = __builtin_nontemporal_load((const f32x4*)(F.x + (size_t)gw * D + 4 * (lane + 64 * i))); }
    for (int t = gw; t < T; t += NGW) {
        const int b = t / S; float s = 0.f;
#pragma unroll
        for (int i = 0; i < 8; ++i) { v[i] = nx[i]; s += (v[i][0] + v[i][1]) + (v[i][2] + v[i][3]); }
        if (t + NGW < T) {
#pragma unroll
            for (int i = 0; i < 8; ++i) nx[i] = __builtin_nontemporal_load((const f32x4*)(F.x + (size_t)(t + NGW) * D + 4 * (lane + 64 * i))); }
        const float mu = wave_sum(s) * (1.f / D);
        float q = 0.f;
#pragma unroll
        for (int i = 0; i < 8; ++i) { v[i] = v[i] - mu; q += (v[i][0] * v[i][0] + v[i][1] * v[i][1]) + (v[i][2] * v[i][2] + v[i][3] * v[i][3]); }
        const float rstd = rsqrtf(wave_sum(q) * (1.f / D) + LN_EPS);
        const float* sc = mod + (size_t)b * 6 * D + 1 * D; const float* sf = mod + (size_t)b * 6 * D;
#pragma unroll
        for (int i = 0; i < 8; ++i) { const int d = 4 * (lane + 64 * i); const f32x4 a = *(const f32x4*)(sc + d), bb = *(const f32x4*)(sf + d);
            v[i] = v[i] * rstd * (a + 1.f) + bb;
            u32x2 w; w.x = cvt_pk_bf16(v[i][0], v[i][1]); w.y = cvt_pk_bf16(v[i][2], v[i][3]); *(u32x2*)(U + (size_t)t * D + d) = w; }
        float g[8];
#pragma unroll
        for (int j = 0; j < 8; ++j) { float a = 0.f;
#pragma unroll
            for (int i = 0; i < 8; ++i) { const f32x4 w = *(const LAS f32x4*)(wl + j * D + 4 * (lane + 64 * i)); a += (v[i][0] * w[0] + v[i][1] * w[1]) + (v[i][2] * w[2] + v[i][3] * w[3]); }
            g[j] = wave_sum(a); }
        if (lane < 8) { float val = 0.f;
#pragma unroll
            for (int j = 0; j < 8; ++j) val = (lane == j) ? g[j] : val;
            val += F.b_mgate[lane];
            if (lane >= 4) val = fminf(val, 0.f) - log1pf(expf(-fabsf(val)));
            gpre[(size_t)t * 8 + lane] = val; }
    }
}

struct EpiP2 {
    static constexpr bool PERM = true;
    bf16_t *Q, *Kb, *V, *QKP, *VM, *OG, *GB; const float* rope; const float* b_gate;
    __device__ __forceinline__ void operator()(const f32x4 (&acc)[2][2][4][2], const pg8::Unit& u, int wr, int wc, int fr, int fq) const {
        const int pn = u.pn; int kind, coff, ldc; bf16_t* base;
        if (pn < 6) { kind = 0; base = Q; ldc = 1536; coff = pn * 256; }
        else if (pn < 12) { kind = 1; base = Kb; ldc = 1536; coff = (pn - 6) * 256; }
        else if (pn < 18) { kind = 2; base = V; ldc = 1536; coff = (pn - 12) * 256; }
        else if (pn < 26) { kind = 2; base = QKP; ldc = 2048; coff = (pn - 18) * 256; }
        else if (pn < 30) { kind = 2; base = VM; ldc = 1024; coff = (pn - 26) * 256; }
        else if (pn < 34) { kind = 3; base = OG; ldc = 1024; coff = (pn - 30) * 256; }
        else { kind = 4; base = GB; ldc = 4096; coff = (pn - 34) * 256; }
        const int row0 = u.pm * 256 + wr * 64 + fr, colL = wc * 32 + 8 * fq;
#pragma unroll
        for (int ai = 0; ai < 2; ++ai)
#pragma unroll
            for (int m = 0; m < 4; ++m) { const int r = row0 + ai * 128 + m * 16; const int pos = r & (S - 1);
#pragma unroll
                for (int bj = 0; bj < 2; ++bj) { f32x4 v0 = acc[ai][bj][m][0], v1 = acc[ai][bj][m][1]; const int col = coff + bj * 128 + colL;
                    if (kind <= 1) {
                        const float* rp = rope + ((size_t)pos * 64 + (16 * wc + 4 * fq)) * 2;
                        const f32x4 c0 = *(const f32x4*)rp, c1 = *(const f32x4*)(rp + 4);
                        const float sc = (kind == 0) ? QSCALE : 1.f;
                        f32x4 o0, o1;
                        o0[0] = (v0[0] * c0[0] - v0[1] * c0[1]) * sc; o0[1] = (v0[1] * c0[0] + v0[0] * c0[1]) * sc;
                        o0[2] = (v0[2] * c0[2] - v0[3] * c0[3]) * sc; o0[3] = (v0[3] * c0[2] + v0[2] * c0[3]) * sc;
                        o1[0] = (v1[0] * c1[0] - v1[1] * c1[1]) * sc; o1[1] = (v1[1] * c1[0] + v1[0] * c1[1]) * sc;
                        o1[2] = (v1[2] * c1[2] - v1[3] * c1[3]) * sc; o1[3] = (v1[3] * c1[2] + v1[2] * c1[3]) * sc;
                        v0 = o0; v1 = o1;
                    } else if (kind >= 3) {
                        if (kind == 4) { v0 = v0 + *(const f32x4*)(b_gate + col); v1 = v1 + *(const f32x4*)(b_gate + col + 4); }
#pragma unroll
                        for (int j = 0; j < 4; ++j) { v0[j] = sigmoid_fast(v0[j]); v1[j] = sigmoid_fast(v1[j]); }
                    }
                    u32x4 w; w.x = cvt_pk_bf16(v0[0], v0[1]); w.y = cvt_pk_bf16(v0[2], v0[3]); w.z = cvt_pk_bf16(v1[0], v1[1]); w.w = cvt_pk_bf16(v1[2], v1[3]);
                    *(u32x4*)(base + (size_t)r * ldc + col) = w; } }
    }
};

__device__ __forceinline__ void scan_bh(const Frame& F, int bh) {
    const float* gpre = WSP(float, WS_GPRE); float* bc = WSP(float, WS_BCUM) + (size_t)bh * S; float* mc = WSP(float, WS_MCUM) + (size_t)bh * S;
    const int b = bh >> 2, h = bh & 3, lane = FLANE;
    float lf[32], iv[32];
#pragma unroll
    for (int j = 0; j < 32; ++j) { const size_t t = (size_t)b * S + lane * 32 + j; iv[j] = gpre[t * 8 + h]; lf[j] = gpre[t * 8 + 4 + h]; }
    float run = 0.f;
#pragma unroll
    for (int j = 0; j < 32; ++j) { run += lf[j]; lf[j] = run; }
    float tot = run, incl = run;
#pragma unroll
    for (int o = 1; o < 64; o <<= 1) { const float n = __shfl_up(incl, o); if (lane >= o) incl += n; }
    const float excl = incl - tot;
    float mx = -INFINITY;
#pragma unroll
    for (int j = 0; j < 32; ++j) { lf[j] += excl; mx = fmaxf(mx, iv[j] - lf[j]); iv[j] = mx; }
    float mincl = mx;
#pragma unroll
    for (int o = 1; o < 64; o <<= 1) { const float n = __shfl_up(mincl, o); if (lane >= o) mincl = fmaxf(mincl, n); }
    float mexcl = __shfl_up(mincl, 1); if (lane == 0) mexcl = -INFINITY;
#pragma unroll
    for (int j = 0; j < 32; ++j) { const float cm = fmaxf(0.f, fmaxf(mexcl, iv[j])); bc[lane * 32 + j] = lf[j]; mc[lane * 32 + j] = lf[j] + cm; }
}

__device__ __forceinline__ void p3_conv(const Frame& F) {
    const bf16_t* QKP = WSP(bf16_t, WS_QKP); bf16_t* QM = WSP(bf16_t, WS_QM); bf16_t* KM = WSP(bf16_t, WS_KM);
    for (int item = F.bx * NTHR + FTID; item < 256 * 512; item += F.G * NTHR) {
        const int cc = item & 255, rs = item >> 8; const int c0 = cc * 8, t0 = rs * 16;
        float w[4][8], bias[8];
#pragma unroll
        for (int j = 0; j < 4; ++j) { const f32x4 a = *(const f32x4*)(F.conv_w + j * 2048 + c0), b = *(const f32x4*)(F.conv_w + j * 2048 + c0 + 4);
#pragma unroll
            for (int e = 0; e < 4; ++e) { w[j][e] = a[e]; w[j][4 + e] = b[e]; } }
        { const f32x4 a = *(const f32x4*)(F.conv_b + c0), b = *(const f32x4*)(F.conv_b + c0 + 4);
#pragma unroll
            for (int e = 0; e < 4; ++e) { bias[e] = a[e]; bias[4 + e] = b[e]; } }
        float x1[8], x2[8], x3[8];
        const int pos0 = t0 & (S - 1);
        auto ldrow = [&](int t, float (&dst)[8]) { const u32x4 v = *(const u32x4*)(QKP + (size_t)t * 2048 + c0);
            dst[0] = bf_lo(v.x); dst[1] = bf_hi(v.x); dst[2] = bf_lo(v.y); dst[3] = bf_hi(v.y); dst[4] = bf_lo(v.z); dst[5] = bf_hi(v.z); dst[6] = bf_lo(v.w); dst[7] = bf_hi(v.w); };
        if (pos0 >= 3) { ldrow(t0 - 1, x1); ldrow(t0 - 2, x2); ldrow(t0 - 3, x3); }
        else {
#pragma unroll
            for (int e = 0; e < 8; ++e) { x1[e] = 0.f; x2[e] = 0.f; x3[e] = 0.f; } }
        const bool isk = c0 >= 1024; bf16_t* dst = isk ? (KM + (c0 - 1024)) : (QM + c0); const float osc = isk ? 0.0625f : 1.f;
#pragma unroll 4
        for (int r = 0; r < 16; ++r) { float x0[8]; ldrow(t0 + r, x0); float y[8];
#pragma unroll
            for (int e = 0; e < 8; ++e) { y[e] = bias[e] + w[3][e] * x0[e] + w[2][e] * x1[e] + w[1][e] * x2[e] + w[0][e] * x3[e]; y[e] = silu_fast(y[e]) * osc; x3[e] = x2[e]; x2[e] = x1[e]; x1[e] = x0[e]; }
            u32x4 o; o.x = cvt_pk_bf16(y[0], y[1]); o.y = cvt_pk_bf16(y[2], y[3]); o.z = cvt_pk_bf16(y[4], y[5]); o.w = cvt_pk_bf16(y[6], y[7]);
            *(u32x4*)(dst + (size_t)(t0 + r) * 1024) = o; }
    }
}

constexpr int AT_KP = 272, AT_VP = 288, AT_VOFF = 256 * AT_KP;
struct AttnDec { int b, head, dl, r, n; };
__device__ __forceinline__ AttnDec attn_decode(int unit) {
    AttnDec a; a.b = unit / 192; const int rem = unit % 192; a.head = rem >> 4; const int blk = rem & 15;
    const int g = a.head >> 2; a.dl = (g == 0) ? 0 : (g == 1 ? 2 : 4); const int nbr = 16 >> a.dl; a.r = blk / nbr; a.n = blk % nbr; return a;
}
#define ATTN_PREFETCH(A, kv, vv) do { _Pragma("unroll") for (int i = 0; i < 8; ++i) { const int id = tid + NTHR * i; const int row = id >> 4, ch = id & 15; const int bn = (row < 128) ? (A).n - 1 : (A).n; const int lr = row & 127; \
        const int pos = ((bn * 128 + lr) << (A).dl) + (A).r; const size_t so = (size_t)((A).b * S + pos) * 1536 + (A).head * 128 + ch * 8; \
        (kv)[i] = (bn >= 0) ? *(const u32x4*)(KB + so) : (u32x4){0u, 0u, 0u, 0u}; (vv)[i] = (bn >= 0) ? *(const u32x4*)(VB + so) : (u32x4){0u, 0u, 0u, 0u}; } } while (0)
__device__ __forceinline__ void attn_phase(const Frame& F) {
    const bf16_t* QB = WSP(bf16_t, WS_QB); const bf16_t* KB = WSP(bf16_t, WS_KB); const bf16_t* VB = WSP(bf16_t, WS_VB); bf16_t* OA = WSP(bf16_t, WS_OATT); float* LSE = WSP(float, WS_LSE);
    const int tid = FTID; const int lane = tid & 63, w = __builtin_amdgcn_readfirstlane(tid >> 6), jl = lane & 15, g4 = lane >> 4;
    LAS unsigned char* Ks = F.lds; LAS unsigned char* Vs = F.lds + AT_VOFF;
    int unit = F.bx; if (unit >= 768) return;
    u32x4 kv[8], vv[8];
    { const AttnDec A0 = attn_decode(unit); ATTN_PREFETCH(A0, kv, vv); }
  for (; unit < 768; unit += F.G) {
    const AttnDec A = attn_decode(unit); const int b = A.b, head = A.head, dl = A.dl, r = A.r, n = A.n;
    __syncthreads();
#pragma unroll
    for (int i = 0; i < 8; ++i) { const int id = tid + NTHR * i; const int row = id >> 4, ch = id & 15;
        *(LAS u32x4*)(Ks + row * AT_KP + ch * 16) = kv[i]; *(LAS u32x4*)(Vs + row * AT_VP + ch * 16) = vv[i]; }
    const int posq = (((n * 128 + 16 * w + jl)) << dl) + r;
    const size_t tq = (size_t)b * S + posq;
    bf16x8 qf[4];
#pragma unroll
    for (int ks = 0; ks < 4; ++ks) qf[ks] = *(const bf16x8*)(QB + tq * 1536 + head * 128 + ks * 32 + 8 * g4);
    __syncthreads();
    if (unit + F.G < 768) { const AttnDec A1 = attn_decode(unit + F.G); ATTN_PREFETCH(A1, kv, vv); }
    f32x4 sT[10];
#pragma unroll
    for (int u = 0; u < 9; ++u) { f32x4 a = {0.f, 0.f, 0.f, 0.f};
#pragma unroll
        for (int ks = 0; ks < 4; ++ks) { const bf16x8 kf = *(const LAS bf16x8*)(Ks + (16 * (w + u) + jl) * AT_KP + (ks * 32 + 8 * g4) * 2); a = __builtin_amdgcn_mfma_f32_16x16x32_bf16(kf, qf[ks], a, 0, 0, 0); }
        sT[u] = a; }
    sT[9] = (f32x4){0.f, 0.f, 0.f, 0.f};
    float mx = -INFINITY;
#pragma unroll
    for (int u = 0; u < 9; ++u)
#pragma unroll
        for (int rg = 0; rg < 4; ++rg) { const int kin = 4 * g4 + rg; bool valid;
            if (u == 0) valid = (n > 0) && (kin >= jl); else if (u == 8) valid = (kin <= jl); else valid = (w + u >= 8) || (n > 0);
            const float s = valid ? sT[u][rg] : -INFINITY; sT[u][rg] = s; mx = fmaxf(mx, s); }
    mx = fmaxf(mx, __shfl_xor(mx, 16)); mx = fmaxf(mx, __shfl_xor(mx, 32));
    float den = 0.f;
#pragma unroll
    for (int u = 0; u < 9; ++u)
#pragma unroll
        for (int rg = 0; rg < 4; ++rg) { const float p = fast_exp2(sT[u][rg] - mx); sT[u][rg] = p; den += p; }
    den += __shfl_xor(den, 16); den += __shfl_xor(den, 32);
    f32x4 oT[8];
#pragma unroll
    for (int et = 0; et < 8; ++et) oT[et] = (f32x4){0.f, 0.f, 0.f, 0.f};
    const unsigned vbase = (unsigned)(uintptr_t)(Vs) + (unsigned)((4 * g4 + (jl >> 2)) * AT_VP + (jl & 3) * 8);
#pragma unroll
    for (int c = 0; c < 5; ++c) {
        const int kt0 = w + 2 * c, kt1 = (c == 4) ? kt0 : kt0 + 1;
        union { bf16x8 v; unsigned u[4]; } pf;
        pf.u[0] = cvt_pk_bf16(sT[2 * c][0], sT[2 * c][1]); pf.u[1] = cvt_pk_bf16(sT[2 * c][2], sT[2 * c][3]);
        pf.u[2] = cvt_pk_bf16(sT[2 * c + 1][0], sT[2 * c + 1][1]); pf.u[3] = cvt_pk_bf16(sT[2 * c + 1][2], sT[2 * c + 1][3]);
        s16x4 t0[8], t1[8];
        const unsigned vb0 = vbase + kt0 * 16 * AT_VP, vb1 = vbase + kt1 * 16 * AT_VP;
#pragma unroll
        for (int et = 0; et < 8; ++et) { t0[et] = tr_read_o(vb0, et * 32); t1[et] = tr_read_o(vb1, et * 32); }
        LGKM_WAIT0();
#pragma unroll
        for (int et = 0; et < 8; ++et) oT[et] = __builtin_amdgcn_mfma_f32_16x16x32_bf16(PK8(t0[et], t1[et]), pf.v, oT[et], 0, 0, 0);
    }
    const float inv = 1.f / den;
#pragma unroll
    for (int et = 0; et < 8; ++et) { u32x2 o; o.x = cvt_pk_bf16(oT[et][0] * inv, oT[et][1] * inv); o.y = cvt_pk_bf16(oT[et][2] * inv, oT[et][3] * inv);
        *(u32x2*)(OA + tq * 1536 + head * 128 + 16 * et + 4 * g4) = o; }
    if (g4 == 0) LSE[tq * 12 + head] = (mx + log2f(den)) * LN2;
  }
}

constexpr int ML_P = 544;
__device__ __forceinline__ void mlstm_dc_unit(const Frame& F, int unit) {
    const bf16_t* KM = WSP(bf16_t, WS_KM); const bf16_t* VM = WSP(bf16_t, WS_VMB); const float* gpre = WSP(float, WS_GPRE);
    const float* bcum = WSP(float, WS_BCUM); const float* mcum = WSP(float, WS_MCUM); bf16_t* DC = WSP(bf16_t, WS_DC) + (size_t)unit * 65536; float* DN = WSP(float, WS_DN) + (size_t)unit * 256;
    const int bh = unit >> 4, c = unit & 15, b = bh >> 2, h = bh & 3; const size_t t0 = (size_t)b * S + c * 128;
    const int tid = FTID, lane = FLANE, w = FWAVE, jl = lane & 15, g4 = lane >> 4;
    LAS unsigned char* Ks = F.lds; LAS unsigned char* Vs = F.lds + 128 * ML_P; LAS float* wt = (LAS float*)(F.lds + 2 * 128 * ML_P);
    __syncthreads();
    if (tid < 128) { const float Be = bcum[bh * S + c * 128 + 127], me = mcum[bh * S + c * 128 + 127];
        wt[tid] = expf(Be - bcum[bh * S + c * 128 + tid] + gpre[(t0 + tid) * 8 + h] - me); }
    __syncthreads();
    {
        u32x4 v[8];
#pragma unroll
        for (int i = 0; i < 8; ++i) { const int id = tid + NTHR * i; const int row = id >> 5, ch = id & 31; v[i] = *(const u32x4*)(KM + (t0 + row) * 1024 + h * 256 + ch * 8); }
#pragma unroll
        for (int i = 0; i < 8; ++i) { const int id = tid + NTHR * i; const int row = id >> 5, ch = id & 31; *(LAS u32x4*)(Ks + row * ML_P + ch * 16) = v[i]; }
#pragma unroll
        for (int i = 0; i < 8; ++i) { const int id = tid + NTHR * i; const int row = id >> 5, ch = id & 31; v[i] = *(const u32x4*)(VM + (t0 + row) * 1024 + h * 256 + ch * 8); }
#pragma unroll
        for (int i = 0; i < 8; ++i) { const int id = tid + NTHR * i; const int row = id >> 5, ch = id & 31; const float ws_ = wt[row]; u32x4 o;
            o.x = cvt_pk_bf16(bf_lo(v[i].x) * ws_, bf_hi(v[i].x) * ws_); o.y = cvt_pk_bf16(bf_lo(v[i].y) * ws_, bf_hi(v[i].y) * ws_);
            o.z = cvt_pk_bf16(bf_lo(v[i].z) * ws_, bf_hi(v[i].z) * ws_); o.w = cvt_pk_bf16(bf_lo(v[i].w) * ws_, bf_hi(v[i].w) * ws_);
            *(LAS u32x4*)(Vs + row * ML_P + ch * 16) = o; }
    }
    __syncthreads();
    if (tid < 256) { float a = 0.f; for (int s = 0; s < 128; ++s) a += wt[s] * bf2f(*(const LAS bf16_t*)(Ks + s * ML_P + tid * 2)); DN[tid] = a; }
    const int vr = w >> 1, kr = w & 1;
    f32x4 acc[4][8];
#pragma unroll
    for (int i = 0; i < 4; ++i)
#pragma unroll
        for (int j = 0; j < 8; ++j) acc[i][j] = (f32x4){0.f, 0.f, 0.f, 0.f};
    const unsigned rowoff = (unsigned)((4 * g4 + (jl >> 2)) * ML_P + (jl & 3) * 8);
    const unsigned kb = (unsigned)(uintptr_t)Ks + rowoff + kr * 256, vb = (unsigned)(uintptr_t)Vs + rowoff + vr * 128;
#pragma unroll 1
    for (int ks = 0; ks < 4; ++ks) {
        s16x4 a0[4], a1[4], b0[8], b1[8];
#pragma unroll
        for (int i = 0; i < 4; ++i) { a0[i] = tr_read_o(vb + ks * 32 * ML_P, i * 32); a1[i] = tr_read_o(vb + ks * 32 * ML_P, 16 * ML_P + i * 32); }
#pragma unroll
        for (int j = 0; j < 8; ++j) { b0[j] = tr_read_o(kb + ks * 32 * ML_P, j * 32); b1[j] = tr_read_o(kb + ks * 32 * ML_P, 16 * ML_P + j * 32); }
        LGKM_WAIT0();
#pragma unroll
        for (int i = 0; i < 4; ++i)
#pragma unroll
            for (int j = 0; j < 8; ++j) acc[i][j] = __builtin_amdgcn_mfma_f32_16x16x32_bf16(PK8(b0[j], b1[j]), PK8(a0[i], a1[i]), acc[i][j], 0, 0, 0);
    }
#pragma unroll
    for (int i = 0; i < 4; ++i)
#pragma unroll
        for (int j = 0; j < 8; ++j) { u32x2 o; o.x = cvt_pk_bf16(acc[i][j][0], acc[i][j][1]); o.y = cvt_pk_bf16(acc[i][j][2], acc[i][j][3]);
            *(u32x2*)(DC + (size_t)(16 * (4 * vr + i) + jl) * 256 + 16 * (8 * kr + j) + 4 * g4) = o; }
}

__device__ __forceinline__ float chunk_decay(const float* bcum, const float* mcum, int bh, int c) {
    const float Be = bcum[bh * S + c * 128 + 127], me = mcum[bh * S + c * 128 + 127];
    const float Bp = (c > 0) ? bcum[bh * S + c * 128 - 1] : 0.f, mp = (c > 0) ? mcum[bh * S + c * 128 - 1] : 0.f;
    return expf(Be - Bp + mp - me);
}
__device__ __forceinline__ void p5_scan_mix(const Frame& F) {
    const float* bcum = WSP(float, WS_BCUM); const float* mcum = WSP(float, WS_MCUM);
    const bf16_t* DC = WSP(bf16_t, WS_DC); bf16_t* CST = WSP(bf16_t, WS_CST); const float* DN = WSP(float, WS_DN); float* NST = WSP(float, WS_NST);
    const int gt = F.bx * NTHR + FTID, NG = F.G * NTHR;
    for (int item = gt; item < 16 * 8192; item += NG) {
        const int bh = item >> 13, e8 = item & 8191;
        f32x4 c0 = {0.f, 0.f, 0.f, 0.f}, c1 = {0.f, 0.f, 0.f, 0.f};
#pragma unroll 5
        for (int c = 0; c < 15; ++c) { const float dec = chunk_decay(bcum, mcum, bh, c);
            const u32x4 dq = __builtin_nontemporal_load((const u32x4*)(DC + (size_t)(bh * 16 + c) * 65536 + e8 * 8)); const f32x4 d0 = {bf_lo(dq.x), bf_hi(dq.x), bf_lo(dq.y), bf_hi(dq.y)}, d1 = {bf_lo(dq.z), bf_hi(dq.z), bf_lo(dq.w), bf_hi(dq.w)};
            c0 = c0 * dec + d0; c1 = c1 * dec + d1;
            u32x4 o; o.x = cvt_pk_bf16(c0[0], c0[1]); o.y = cvt_pk_bf16(c0[2], c0[3]); o.z = cvt_pk_bf16(c1[0], c1[1]); o.w = cvt_pk_bf16(c1[2], c1[3]);
            *(u32x4*)(CST + (size_t)(bh * 16 + c + 1) * 65536 + e8 * 8) = o; }
    }
    for (int item = gt; item < 16 * 256; item += NG) { const int bh = item >> 8, k = item & 255; float n = 0.f;
        for (int c = 0; c < 15; ++c) { n = n * chunk_decay(bcum, mcum, bh, c) + DN[(size_t)(bh * 16 + c) * 256 + k]; NST[(size_t)(bh * 16 + c + 1) * 256 + k] = n; } }
    const bf16_t* OA = WSP(bf16_t, WS_OATT); const float* LSE = WSP(float, WS_LSE); bf16_t* YA = WSP(bf16_t, WS_YA);
    for (int item = gt; item < T * 64; item += NG) { const int t = item >> 6, h = (item >> 4) & 3, e8 = item & 15;
        const float l0 = LSE[(size_t)t * 12 + h], l1 = LSE[(size_t)t * 12 + 4 + h], l2 = LSE[(size_t)t * 12 + 8 + h];
        const float ml = fmaxf(l0, fmaxf(l1, l2)); float w0 = expf(l0 - ml), w1 = expf(l1 - ml), w2 = expf(l2 - ml); const float ws_ = 1.f / (w0 + w1 + w2); w0 *= ws_; w1 *= ws_; w2 *= ws_;
        const u32x4 a = *(const u32x4*)(OA + (size_t)t * 1536 + h * 128 + e8 * 8), bq = *(const u32x4*)(OA + (size_t)t * 1536 + (4 + h) * 128 + e8 * 8), cq = *(const u32x4*)(OA + (size_t)t * 1536 + (8 + h) * 128 + e8 * 8);
        u32x4 o;
        o.x = cvt_pk_bf16(w0 * bf_lo(a.x) + w1 * bf_lo(bq.x) + w2 * bf_lo(cq.x), w0 * bf_hi(a.x) + w1 * bf_hi(bq.x) + w2 * bf_hi(cq.x));
        o.y = cvt_pk_bf16(w0 * bf_lo(a.y) + w1 * bf_lo(bq.y) + w2 * bf_lo(cq.y), w0 * bf_hi(a.y) + w1 * bf_hi(bq.y) + w2 * bf_hi(cq.y));
        o.z = cvt_pk_bf16(w0 * bf_lo(a.z) + w1 * bf_lo(bq.z) + w2 * bf_lo(cq.z), w0 * bf_hi(a.z) + w1 * bf_hi(bq.z) + w2 * bf_hi(cq.z));
        o.w = cvt_pk_bf16(w0 * bf_lo(a.w) + w1 * bf_lo(bq.w) + w2 * bf_lo(cq.w), w0 * bf_hi(a.w) + w1 * bf_hi(bq.w) + w2 * bf_hi(cq.w));
        *(u32x4*)(YA + (size_t)t * 512 + h * 128 + e8 * 8) = o; }
}

constexpr int MO_KP = 528, MO_VOFF = 128 * MO_KP, MO_TAB = MO_VOFF + 128 * ML_P;
__device__ __forceinline__ void mlstm_out_unit(const Frame& F, int unit) {
    const bf16_t* QM = WSP(bf16_t, WS_QM); const bf16_t* KM = WSP(bf16_t, WS_KM); const bf16_t* VM = WSP(bf16_t, WS_VMB); const bf16_t* OG = WSP(bf16_t, WS_OGB);
    const bf16_t* CST = WSP(bf16_t, WS_CST) + (size_t)unit * 65536; const float* NST = WSP(float, WS_NST) + (size_t)unit * 256; bf16_t* YM = WSP(bf16_t, WS_YM);
    const float* gpre = WSP(float, WS_GPRE); const float* bcum = WSP(float, WS_BCUM); const float* mcum = WSP(float, WS_MCUM);
    const int bh = unit >> 4, c = unit & 15, b = bh >> 2, h = bh & 3; const size_t t0 = (size_t)b * S + c * 128;
    const int tid = FTID, lane = FLANE, w = FWAVE, jl = lane & 15, g4 = lane >> 4;
    LAS unsigned char* RA = F.lds; LAS unsigned char* RB = F.lds + MO_VOFF; LAS float* cs = (LAS float*)(F.lds + MO_TAB); LAS float* ntab = cs + 128;
    __syncthreads();
    {
        u32x4 v[8];
#pragma unroll
        for (int i = 0; i < 8; ++i) { const int id = tid + NTHR * i; const int row = id >> 5, ch = id & 31; v[i] = *(const u32x4*)(KM + (t0 + row) * 1024 + h * 256 + ch * 8); }
#pragma unroll
        for (int i = 0; i < 8; ++i) { const int id = tid + NTHR * i; const int row = id >> 5, ch = id & 31; *(LAS u32x4*)(RA + row * MO_KP + ch * 16) = v[i]; }
#pragma unroll
        for (int i = 0; i < 8; ++i) { const int id = tid + NTHR * i; const int row = id >> 5, ch = id & 31; v[i] = *(const u32x4*)(VM + (t0 + row) * 1024 + h * 256 + ch * 8); }
#pragma unroll
        for (int i = 0; i < 8; ++i) { const int id = tid + NTHR * i; const int row = id >> 5, ch = id & 31; *(LAS u32x4*)(RB + row * ML_P + ch * 16) = v[i]; }
        if (tid < 128) cs[tid] = (gpre[(t0 + tid) * 8 + h] - bcum[bh * S + c * 128 + tid]) * LOG2E;
        if (tid >= 128 && tid < 384) ntab[tid - 128] = (c > 0) ? NST[tid - 128] : 0.f;
    }
    const int tl = 16 * w + jl; const size_t t = t0 + tl;
    const float Bt = bcum[bh * S + c * 128 + tl], mt = mcum[bh * S + c * 128 + tl];
    const float Bp = (c > 0) ? bcum[bh * S + c * 128 - 1] : 0.f, mp = (c > 0) ? mcum[bh * S + c * 128 - 1] : 0.f;
    const float at = (Bt - mt) * LOG2E; const float inter = fast_exp2((Bt - Bp + mp - mt) * LOG2E);
    union QF { bf16x8 v; unsigned u[4]; }; QF qf[8];
#pragma unroll
    for (int ks = 0; ks < 8; ++ks) qf[ks].v = *(const bf16x8*)(QM + t * 1024 + h * 256 + ks * 32 + 8 * g4);
    __syncthreads();
    f32x4 sT[8];
#pragma unroll
    for (int st = 0; st < 8; ++st) { f32x4 a = {0.f, 0.f, 0.f, 0.f};
        if (st <= w) {
#pragma unroll
            for (int ks = 0; ks < 8; ++ks) { const bf16x8 kf = *(const LAS bf16x8*)(RA + (16 * st + jl) * MO_KP + (ks * 32 + 8 * g4) * 2); a = __builtin_amdgcn_mfma_f32_16x16x32_bf16(kf, qf[ks].v, a, 0, 0, 0); } }
        sT[st] = a; __builtin_amdgcn_sched_barrier(0); }
    float dsum = 0.f;
#pragma unroll
    for (int st = 0; st < 8; ++st) { const f32x4 cv = *(const LAS f32x4*)(cs + 16 * st + 4 * g4);
#pragma unroll
        for (int rg = 0; rg < 4; ++rg) { const bool valid = (st < w) || (st == w && (4 * g4 + rg) <= jl); const float f = valid ? fast_exp2(fminf(at + cv[rg], 0.f)) : 0.f; const float sv = sT[st][rg] * f; sT[st][rg] = sv; dsum += sv; } }
    dsum += __shfl_xor(dsum, 16); dsum += __shfl_xor(dsum, 32);
    float nq = 0.f;
#pragma unroll
    for (int ks = 0; ks < 8; ++ks) { const f32x4 n0 = *(const LAS f32x4*)(ntab + ks * 32 + 8 * g4), n1 = *(const LAS f32x4*)(ntab + ks * 32 + 8 * g4 + 4);
        nq += bf_lo(qf[ks].u[0]) * n0[0] + bf_hi(qf[ks].u[0]) * n0[1] + bf_lo(qf[ks].u[1]) * n0[2] + bf_hi(qf[ks].u[1]) * n0[3]
            + bf_lo(qf[ks].u[2]) * n1[0] + bf_hi(qf[ks].u[2]) * n1[1] + bf_lo(qf[ks].u[3]) * n1[2] + bf_hi(qf[ks].u[3]) * n1[3]; }
    nq += __shfl_xor(nq, 16); nq += __shfl_xor(nq, 32);
    const float den = dsum + inter * nq;
    f32x4 acc[16];
#pragma unroll
    for (int vt = 0; vt < 16; ++vt) acc[vt] = (f32x4){0.f, 0.f, 0.f, 0.f};
    const unsigned vbase = (unsigned)(uintptr_t)RB + (unsigned)((4 * g4 + (jl >> 2)) * ML_P + (jl & 3) * 8);
#pragma unroll
    for (int c4 = 0; c4 < 4; ++c4) {
        if (2 * c4 <= w) {
            union { bf16x8 v; unsigned u[4]; } pf;
            pf.u[0] = cvt_pk_bf16(sT[2 * c4][0], sT[2 * c4][1]); pf.u[1] = cvt_pk_bf16(sT[2 * c4][2], sT[2 * c4][3]);
            pf.u[2] = cvt_pk_bf16(sT[2 * c4 + 1][0], sT[2 * c4 + 1][1]); pf.u[3] = cvt_pk_bf16(sT[2 * c4 + 1][2], sT[2 * c4 + 1][3]);
#pragma unroll
            for (int hb = 0; hb < 2; ++hb) {
                s16x4 a0[8], a1[8];
#pragma unroll
                for (int i = 0; i < 8; ++i) { a0[i] = tr_read_o(vbase, c4 * 32 * ML_P + (hb * 8 + i) * 32); a1[i] = tr_read_o(vbase, (c4 * 32 + 16) * ML_P + (hb * 8 + i) * 32); }
                LGKM_WAIT0();
#pragma unroll
                for (int i = 0; i < 8; ++i) acc[hb * 8 + i] = __builtin_amdgcn_mfma_f32_16x16x32_bf16(PK8(a0[i], a1[i]), pf.v, acc[hb * 8 + i], 0, 0, 0);
            }
        }
    }
    if (c > 0) {
#pragma unroll
        for (int ks = 0; ks < 8; ++ks)
#pragma unroll
            for (int j = 0; j < 4; ++j) qf[ks].u[j] = cvt_pk_bf16(bf_lo(qf[ks].u[j]) * inter, bf_hi(qf[ks].u[j]) * inter);
#pragma unroll
        for (int half = 0; half < 2; ++half) {
            __syncthreads();
            u32x4 v[8];
#pragma unroll
            for (int i = 0; i < 8; ++i) { const int id = tid + NTHR * i; const int row = id >> 5, ch = id & 31; v[i] = *(const u32x4*)(CST + (size_t)(half * 128 + row) * 256 + ch * 8); }
#pragma unroll
            for (int i = 0; i < 8; ++i) { const int id = tid + NTHR * i; const int row = id >> 5, ch = id & 31; *(LAS u32x4*)(RA + row * MO_KP + ch * 16) = v[i]; }
            __syncthreads();
#pragma unroll
            for (int vt = 0; vt < 8; ++vt)
#pragma unroll
                for (int ks = 0; ks < 8; ++ks) { const bf16x8 cf = *(const LAS bf16x8*)(RA + (16 * vt + jl) * MO_KP + (ks * 32 + 8 * g4) * 2);
                    acc[half * 8 + vt] = __builtin_amdgcn_mfma_f32_16x16x32_bf16(cf, qf[ks].v, acc[half * 8 + vt], 0, 0, 0); if (ks == 7) __builtin_amdgcn_sched_barrier(0); }
        }
    }
    const float rden = 1.f / fmaxf(fabsf(den), fast_exp2(-mt * LOG2E));
    float sm = 0.f;
#pragma unroll
    for (int vt = 0; vt < 16; ++vt) { const u32x2 og = *(const u32x2*)(OG + t * 1024 + h * 256 + 16 * vt + 4 * g4);
        acc[vt][0] *= rden * bf_lo(og.x); acc[vt][1] *= rden * bf_hi(og.x); acc[vt][2] *= rden * bf_lo(og.y); acc[vt][3] *= rden * bf_hi(og.y);
        sm += (acc[vt][0] + acc[vt][1]) + (acc[vt][2] + acc[vt][3]); }
    sm += __shfl_xor(sm, 16); sm += __shfl_xor(sm, 32);
    const float mu = sm * (1.f / 256.f); float sq = 0.f;
#pragma unroll
    for (int vt = 0; vt < 16; ++vt) { acc[vt] = acc[vt] - mu; sq += (acc[vt][0] * acc[vt][0] + acc[vt][1] * acc[vt][1]) + (acc[vt][2] * acc[vt][2] + acc[vt][3] * acc[vt][3]); }
    sq += __shfl_xor(sq, 16); sq += __shfl_xor(sq, 32);
    const float rstd = rsqrtf(sq * (1.f / 256.f) + LN_EPS);
#pragma unroll
    for (int vt = 0; vt < 16; ++vt) { const f32x4 gg = *(const f32x4*)(F.m_norm_g + h * 256 + 16 * vt + 4 * g4); const f32x4 o = acc[vt] * rstd * gg;
        u32x2 ow; ow.x = cvt_pk_bf16(o[0], o[1]); ow.y = cvt_pk_bf16(o[2], o[3]); *(u32x2*)(YM + t * 1024 + h * 256 + 16 * vt + 4 * g4) = ow; }
}

struct EpiMerge {
    static constexpr bool PERM = true;
    bf16_t* MG; const bf16_t* GB; int step;
    __device__ __forceinline__ void operator()(const f32x4 (&acc)[2][2][4][2], const pg8::Unit& u, int wr, int wc, int fr, int fq) const {
        const int row0 = u.pm * 256 + wr * 64 + fr, col0 = u.pn * 256 + wc * 32 + 8 * fq;
#pragma unroll
        for (int ai = 0; ai < 2; ++ai)
#pragma unroll
            for (int m = 0; m < 4; ++m) { const size_t r = row0 + ai * 128 + m * 16;
#pragma unroll
                for (int bj = 0; bj < 2; ++bj) { const int col = col0 + bj * 128; const f32x4 v0 = acc[ai][bj][m][0], v1 = acc[ai][bj][m][1];
                    const u32x4 gq = *(const u32x4*)(GB + r * 4096 + step * 2048 + col);
                    float o[8] = {v0[0] * bf_lo(gq.x), v0[1] * bf_hi(gq.x), v0[2] * bf_lo(gq.y), v0[3] * bf_hi(gq.y), v1[0] * bf_lo(gq.z), v1[1] * bf_hi(gq.z), v1[2] * bf_lo(gq.w), v1[3] * bf_hi(gq.w)};
                    if (step) { const u32x4 pq = *(const u32x4*)(MG + r * 2048 + col);
                        o[0] += bf_lo(pq.x); o[1] += bf_hi(pq.x); o[2] += bf_lo(pq.y); o[3] += bf_hi(pq.y); o[4] += bf_lo(pq.z); o[5] += bf_hi(pq.z); o[6] += bf_lo(pq.w); o[7] += bf_hi(pq.w); }
                    u32x4 wv; wv.x = cvt_pk_bf16(o[0], o[1]); wv.y = cvt_pk_bf16(o[2], o[3]); wv.z = cvt_pk_bf16(o[4], o[5]); wv.w = cvt_pk_bf16(o[6], o[7]);
                    *(u32x4*)(MG + r * 2048 + col) = wv; } }
    }
};
struct EpiWout {
    static constexpr bool PERM = true;
    const float* mod; bf16_t* PREb;
    __device__ __forceinline__ void operator()(const f32x4 (&acc)[2][2][4][2], const pg8::Unit& u, int wr, int wc, int fr, int fq) const {
        const int row0 = u.pm * 256 + wr * 64 + fr, col0 = u.pn * 256 + wc * 32 + 8 * fq;
        const float* gate = mod + (size_t)((u.pm * 256) / S) * 6 * D + 2 * D;
        f32x4 gv[2][2];
#pragma unroll
        for (int bj = 0; bj < 2; ++bj)
#pragma unroll
            for (int n = 0; n < 2; ++n) gv[bj][n] = *(const f32x4*)(gate + col0 + bj * 128 + n * 4);
#pragma unroll
        for (int ai = 0; ai < 2; ++ai)
#pragma unroll
            for (int m = 0; m < 4; ++m) { const size_t off = (size_t)(row0 + ai * 128 + m * 16) * D + col0;
#pragma unroll
                for (int bj = 0; bj < 2; ++bj) { const f32x4 v0 = gv[bj][0] * acc[ai][bj][m][0], v1 = gv[bj][1] * acc[ai][bj][m][1];
                    u32x4 wv; wv.x = cvt_pk_bf16(v0[0], v0[1]); wv.y = cvt_pk_bf16(v0[2], v0[3]); wv.z = cvt_pk_bf16(v1[0], v1[1]); wv.w = cvt_pk_bf16(v1[2], v1[3]);
                    *(u32x4*)(PREb + off + bj * 128) = wv; } }
    }
};
struct EpiNull { static constexpr bool PERM = false; float* sink;
    __device__ __forceinline__ void operator()(const f32x4 (&acc)[2][2][4][2], const pg8::Unit& u, int wr, int wc, int fr, int fq) const {
        float s = 0.f;
#pragma unroll
        for (int ai = 0; ai < 2; ++ai)
#pragma unroll
            for (int bj = 0; bj < 2; ++bj)
#pragma unroll
                for (int m = 0; m < 4; ++m)
#pragma unroll
                    for (int n = 0; n < 2; ++n) s += acc[ai][bj][m][n][0] + acc[ai][bj][m][n][1] + acc[ai][bj][m][n][2] + acc[ai][bj][m][n][3];
        if (s == 123.456f) sink[0] = s; } };
constexpr int R_UP = 4112, R_LO = 16 * R_UP, R_PART = 2 * 16 * R_UP, R_LOG = R_PART + 8 * 16 * 48 * 4;
template <bool DRY> __device__ __forceinline__ void p9_ln_router(const Frame& F) {
    const bf16_t* PREb = WSP(bf16_t, WS_PRE); bf16_t* X1b = WSP(bf16_t, WS_PRE + (size_t)T * D * 2); const float* mod = WSP(float, WS_MOD); bf16_t* U2 = WSP(bf16_t, WS_U); const bf16_t* WRT = WSP(bf16_t, WS_WRT);
    int* cnt = (int*)(F.ws + WS_CTL) + CW_CNT; int* idx = WSP(int, WS_IDX); float* wl = WSP(float, WS_WL); int* tok = WSP(int, WS_TOK);
    const int lane = FLANE, w = FWAVE, tid = FTID, jl = lane & 15, g4 = lane >> 4;
    LAS unsigned char* Uhi = F.lds; LAS unsigned char* Ulo = F.lds + R_LO; LAS float* part = (LAS float*)(F.lds + R_PART); LAS float* lg = (LAS float*)(F.lds + R_LOG);
    for (int rgp = F.bx; rgp < T / 16; rgp += F.G) {
        __syncthreads();
#pragma unroll 1
        for (int rr = 0; rr < 2; ++rr) {
            const int lr = 2 * w + rr; const int t = rgp * 16 + lr; const int b = t / S;
            f32x4 v[8]; float s = 0.f;
#pragma unroll
            for (int i = 0; i < 8; ++i) { const int d = 4 * (lane + 64 * i); const f32x4 xv = __builtin_nontemporal_load((const f32x4*)(F.x + (size_t)t * D + d)); const u32x2 pq = __builtin_nontemporal_load((const u32x2*)(PREb + (size_t)t * D + d));
                v[i] = xv * ALPHA; v[i][0] += bf_lo(pq.x); v[i][1] += bf_hi(pq.x); v[i][2] += bf_lo(pq.y); v[i][3] += bf_hi(pq.y); s += (v[i][0] + v[i][1]) + (v[i][2] + v[i][3]); }
            float mu = wave_sum(s) * (1.f / D); float q = 0.f;
#pragma unroll
            for (int i = 0; i < 8; ++i) { v[i] = v[i] - mu; q += (v[i][0] * v[i][0] + v[i][1] * v[i][1]) + (v[i][2] * v[i][2] + v[i][3] * v[i][3]); }
            float rstd = rsqrtf(wave_sum(q) * (1.f / D) + LN_EPS);
            s = 0.f;
#pragma unroll
            for (int i = 0; i < 8; ++i) { const int d = 4 * (lane + 64 * i); const f32x4 gg = *(const f32x4*)(F.ln1_g + d), bb = *(const f32x4*)(F.ln1_b + d);
                v[i] = v[i] * rstd * gg + bb; { u32x2 xb; xb.x = cvt_pk_bf16(v[i][0], v[i][1]); xb.y = cvt_pk_bf16(v[i][2], v[i][3]); __builtin_nontemporal_store(xb, (u32x2*)(X1b + (size_t)t * D + d)); } s += (v[i][0] + v[i][1]) + (v[i][2] + v[i][3]); }
            mu = wave_sum(s) * (1.f / D); q = 0.f;
#pragma unroll
            for (int i = 0; i < 8; ++i) { v[i] = v[i] - mu; q += (v[i][0] * v[i][0] + v[i][1] * v[i][1]) + (v[i][2] * v[i][2] + v[i][3] * v[i][3]); }
            rstd = rsqrtf(wave_sum(q) * (1.f / D) + LN_EPS);
            const float* sc = mod + (size_t)b * 6 * D + 4 * D; const float* sf = mod + (size_t)b * 6 * D + 3 * D;
#pragma unroll
            for (int i = 0; i < 8; ++i) { const int d = 4 * (lane + 64 * i); const f32x4 a = *(const f32x4*)(sc + d), bb = *(const f32x4*)(sf + d);
                v[i] = v[i] * rstd * (a + 1.f) + bb;
                u32x2 hi; hi.x = cvt_pk_bf16(v[i][0], v[i][1]); hi.y = cvt_pk_bf16(v[i][2], v[i][3]);
                *(u32x2*)(U2 + (size_t)t * D + d) = hi;
                u32x2 lo; lo.x = cvt_pk_bf16(v[i][0] - bf_lo(hi.x), v[i][1] - bf_hi(hi.x)); lo.y = cvt_pk_bf16(v[i][2] - bf_lo(hi.y), v[i][3] - bf_hi(hi.y));
                *(LAS u32x2*)(Uhi + lr * R_UP + d * 2) = hi; *(LAS u32x2*)(Ulo + lr * R_UP + d * 2) = lo; }
        }
        __syncthreads();
        {
            f32x4 a3[3] = {{0.f, 0.f, 0.f, 0.f}, {0.f, 0.f, 0.f, 0.f}, {0.f, 0.f, 0.f, 0.f}};
#pragma unroll 2
            for (int ks = 0; ks < 8; ++ks) { const int k0 = 256 * w + 32 * ks + 8 * g4;
                const bf16x8 ah = *(const LAS bf16x8*)(Uhi + jl * R_UP + k0 * 2), al = *(const LAS bf16x8*)(Ulo + jl * R_UP + k0 * 2);
#pragma unroll
                for (int nt = 0; nt < 3; ++nt) { const bf16x8 bh = *(const bf16x8*)(WRT + (size_t)(16 * nt + jl) * D + k0), bl = *(const bf16x8*)(WRT + (size_t)48 * D + (size_t)(16 * nt + jl) * D + k0);
                    a3[nt] = __builtin_amdgcn_mfma_f32_16x16x32_bf16(ah, bh, a3[nt], 0, 0, 0); a3[nt] = __builtin_amdgcn_mfma_f32_16x16x32_bf16(ah, bl, a3[nt], 0, 0, 0); a3[nt] = __builtin_amdgcn_mfma_f32_16x16x32_bf16(al, bh, a3[nt], 0, 0, 0); } }
#pragma unroll
            for (int nt = 0; nt < 3; ++nt)
#pragma unroll
                for (int rg = 0; rg < 4; ++rg) part[(w * 16 + 4 * g4 + rg) * 48 + 16 * nt + jl] = a3[nt][rg];
        }
        __syncthreads();
        for (int i = tid; i < 16 * 48; i += NTHR) { float s = 0.f;
#pragma unroll
            for (int ww = 0; ww < 8; ++ww) s += part[ww * 768 + i];
            lg[i] = s; }
        __syncthreads();
        if (tid < 16) { const int t = rgp * 16 + tid; const LAS float* l = lg + tid * 48;
            int gt = 0; float lgt = l[0] + F.b_rg[0];
            for (int j = 1; j < 4; ++j) { const float x = l[j] + F.b_rg[j]; if (x > lgt) { lgt = x; gt = j; } }
            float se = 0.f; for (int j = 0; j < 4; ++j) se += expf(l[j] + F.b_rg[j] - lgt);
            const float gw = 1.f / se;
            int a = 0; float la = l[4 + gt * 8] + F.b_re[gt * 8];
            for (int j = 1; j < 8; ++j) { const float x = l[4 + gt * 8 + j] + F.b_re[gt * 8 + j]; if (x > la) { la = x; a = j; } }
            int bb = -1; float lb = -INFINITY;
            for (int j = 0; j < 8; ++j) { const float x = l[4 + gt * 8 + j] + F.b_re[gt * 8 + j]; if (j != a && x > lb) { lb = x; bb = j; } }
            const float wa = 1.f / (1.f + expf(lb - la)), wb = 1.f - wa;
            const int ea = gt * 8 + a, eb = gt * 8 + bb;
            if (!DRY) {
            const int pa = atomicAdd(&cnt[ea], 1); idx[ea * T + pa] = t; wl[ea * T + pa] = gw * wa;
            const int pb = atomicAdd(&cnt[eb], 1); idx[eb * T + pb] = t; wl[eb * T + pb] = gw * wb;
            *(int4*)(tok + (size_t)t * 4) = make_int4(ea, pa, eb, pb); } }
    }
}

struct MoeSched {
    const int* idx; const LAS int* tb; const LAS int* cn; int G, c;
    __device__ bool next(int i, pg8::Unit& u) const {
        const int total = tb[32] * 8; const long L = (long)i * G + c; if (L >= total) return false;
        const int l = (int)L; int e = 0;
        for (int k = 1; k < 32; ++k) if (l >= tb[k] * 8) e = k;
        const int nt = tb[e + 1] - tb[e], r = l - tb[e] * 8; const int j = r / nt, it = r - j * nt;
        u.e = __builtin_amdgcn_readfirstlane(e); u.it = __builtin_amdgcn_readfirstlane(it); u.pm = __builtin_amdgcn_readfirstlane(tb[e] + it); u.pn = __builtin_amdgcn_readfirstlane(e * 8 + j); u.cnt = __builtin_amdgcn_readfirstlane(cn[e]); return true;
    }
    __device__ __forceinline__ int arow(const pg8::Unit& u, int r) const { int p = u.it * 256 + r; p = p < u.cnt ? p : u.cnt - 1; return idx[u.e * T + p]; }
};
__device__ __forceinline__ void moe_tables(const Frame& F, LAS int* tb, LAS int* cn) {
    const int* cnt = (const int*)(F.ws + WS_CTL) + CW_CNT;
    __syncthreads();
    if (FTID == 0) { int acc = 0; for (int e = 0; e < 32; ++e) { const int c = cnt[e]; cn[e] = c; tb[e] = acc; acc += (c + 255) >> 8; } tb[32] = acc; }
    __syncthreads();
}
struct EpiMoe1 {
    static constexpr bool PERM = true;
    bf16_t* H;
    __device__ __forceinline__ void operator()(const f32x4 (&acc)[2][2][4][2], const pg8::Unit& u, int wr, int wc, int fr, int fq) const {
        const int row0 = u.pm * 256 + wr * 64 + fr, col0 = (u.pn & 7) * 128 + wc * 32 + 8 * fq;
#pragma unroll
        for (int ai = 0; ai < 2; ++ai)
#pragma unroll
            for (int m = 0; m < 4; ++m) { const size_t r = row0 + ai * 128 + m * 16; float o[8];
#pragma unroll
                for (int n = 0; n < 2; ++n)
#pragma unroll
                    for (int j = 0; j < 4; ++j) o[4 * n + j] = silu_fast(acc[ai][0][m][n][j]) * acc[ai][1][m][n][j];
                u32x4 wv; wv.x = cvt_pk_bf16(o[0], o[1]); wv.y = cvt_pk_bf16(o[2], o[3]); wv.z = cvt_pk_bf16(o[4], o[5]); wv.w = cvt_pk_bf16(o[6], o[7]);
                *(u32x4*)(H + r * FF + col0) = wv; }
    }
};
struct EpiMoe2 {
    static constexpr bool PERM = true;
    bf16_t* Y2; const float* wl;
    __device__ __forceinline__ void operator()(const f32x4 (&acc)[2][2][4][2], const pg8::Unit& u, int wr, int wc, int fr, int fq) const {
        const int lrow0 = wr * 64 + fr, col0 = (u.pn & 7) * 256 + wc * 32 + 8 * fq;
#pragma unroll
        for (int ai = 0; ai < 2; ++ai)
#pragma unroll
            for (int m = 0; m < 4; ++m) { const int lr = lrow0 + ai * 128 + m * 16; const int p = u.it * 256 + lr; const float cw = (p < u.cnt) ? wl[u.e * T + p] : 0.f; const size_t r = (size_t)u.pm * 256 + lr;
#pragma unroll
                for (int bj = 0; bj < 2; ++bj) { const f32x4 v0 = acc[ai][bj][m][0] * cw, v1 = acc[ai][bj][m][1] * cw;
                    u32x4 wv; wv.x = cvt_pk_bf16(v0[0], v0[1]); wv.y = cvt_pk_bf16(v0[2], v0[3]); wv.z = cvt_pk_bf16(v1[0], v1[1]); wv.w = cvt_pk_bf16(v1[2], v1[3]);
                    *(u32x4*)(Y2 + r * D + col0 + bj * 128) = wv; } }
    }
};

template <bool DRY> __device__ __forceinline__ void p12_final(const Frame& F, const LAS int* tb) {
    float* dst = DRY ? WSP(float, WS_DC) : F.out; const bf16_t* X1b = WSP(bf16_t, WS_PRE + (size_t)T * D * 2);
    const float* mod = WSP(float, WS_MOD); const bf16_t* Y2 = WSP(bf16_t, WS_Y2); const int* tok = WSP(int, WS_TOK);
    const int gw = F.bx * NWAVES + FWAVE, NGW = F.G * NWAVES, lane = FLANE;
    for (int t = gw; t < T; t += NGW) {
        const int b = t / S; const int4 ti = *(const int4*)(tok + (size_t)t * 4);
        const size_t r0 = (size_t)tb[ti.x] * 256 + ti.y, r1 = (size_t)tb[ti.z] * 256 + ti.w;
        const float* gate = mod + (size_t)b * 6 * D + 5 * D;
        f32x4 v[8]; float s = 0.f;
#pragma unroll
        for (int i = 0; i < 8; ++i) { const int d = 4 * (lane + 64 * i); const u32x2 xq = __builtin_nontemporal_load((const u32x2*)(X1b + (size_t)t * D + d)); f32x4 xv; xv[0] = bf_lo(xq.x); xv[1] = bf_hi(xq.x); xv[2] = bf_lo(xq.y); xv[3] = bf_hi(xq.y); const f32x4 gv = *(const f32x4*)(gate + d);
            const u32x2 ya = __builtin_nontemporal_load((const u32x2*)(Y2 + r0 * D + d)), yb = __builtin_nontemporal_load((const u32x2*)(Y2 + r1 * D + d));
            f32x4 f; f[0] = bf_lo(ya.x) + bf_lo(yb.x); f[1] = bf_hi(ya.x) + bf_hi(yb.x); f[2] = bf_lo(ya.y) + bf_lo(yb.y); f[3] = bf_hi(ya.y) + bf_hi(yb.y);
            v[i] = xv * ALPHA + gv * f; s += (v[i][0] + v[i][1]) + (v[i][2] + v[i][3]); }
        const float mu = wave_sum(s) * (1.f / D); float q = 0.f;
#pragma unroll
        for (int i = 0; i < 8; ++i) { v[i] = v[i] - mu; q += (v[i][0] * v[i][0] + v[i][1] * v[i][1]) + (v[i][2] * v[i][2] + v[i][3] * v[i][3]); }
        const float rstd = rsqrtf(wave_sum(q) * (1.f / D) + LN_EPS);
#pragma unroll
        for (int i = 0; i < 8; ++i) { const int d = 4 * (lane + 64 * i); const f32x4 gg = *(const f32x4*)(F.ln2_g + d), bb = *(const f32x4*)(F.ln2_b + d);
            __builtin_nontemporal_store(v[i] * rstd * gg + bb, (f32x4*)(dst + (size_t)t * D + d)); }
    }
}

#if MK_DEBUG
__device__ __forceinline__ void dbg_acc(float* slot, double num, double den) { atomicAdd(slot, (float)num); atomicAdd(slot + 1, (float)den); }
__global__ void k_chk_u(Params p, float* res) {
    __shared__ float sh[8]; __shared__ float ush[D];
    const int t = (blockIdx.x * 37) % T, b = t / S; const float* x = p.in[0] + (size_t)t * D; const float* mod = (const float*)(p.ws + WS_MOD);
    float s = 0; for (int i = threadIdx.x; i < D; i += 256) s += x[i]; s = wave_sum(s); if ((threadIdx.x & 63) == 0) sh[threadIdx.x >> 6] = s; __syncthreads();
    const float mu = (sh[0] + sh[1] + sh[2] + sh[3]) / D; __syncthreads();
    float q = 0; for (int i = threadIdx.x; i < D; i += 256) { const float d = x[i] - mu; q += d * d; } q = wave_sum(q); if ((threadIdx.x & 63) == 0) sh[threadIdx.x >> 6] = q; __syncthreads();
    const float rstd = rsqrtf((sh[0] + sh[1] + sh[2] + sh[3]) / D + LN_EPS);
    const bf16_t* U = (const bf16_t*)(p.ws + WS_U); double num = 0, den = 0;
    for (int i = threadIdx.x; i < D; i += 256) {
        float sc = p.in[3][1 * D + i], sf = p.in[3][0 * D + i];
        if (i < 64) { for (int k = 0; k < D; ++k) { const float cv = p.in[1][b * D + k]; const float sl = cv / (1.f + expf(-cv)); sc += sl * p.in[2][(size_t)k * 6 * D + D + i]; sf += sl * p.in[2][(size_t)k * 6 * D + i]; } }
        else { sc = mod[(size_t)b * 6 * D + D + i]; sf = mod[(size_t)b * 6 * D + i]; }
        const float ref = (x[i] - mu) * rstd * (1.f + sc) + sf; ush[i] = ref; const float got = bf2f(U[(size_t)t * D + i]); num += (double)(got - ref) * (got - ref); den += (double)ref * ref; }
    __syncthreads();
    if (threadIdx.x < 8) { const int j = threadIdx.x; float a = 0; for (int k = 0; k < D; ++k) a += ush[k] * p.in[4][(size_t)k * NIN + OFF_IF + j]; a += p.in[5][j];
        if (j >= 4) a = fminf(a, 0.f) - log1pf(expf(-fabsf(a))); const float got = ((const float*)(p.ws + WS_GPRE))[(size_t)t * 8 + j]; num += (double)(got - a) * (got - a) * 1000.0; den += (double)a * a * 1000.0; }
    dbg_acc(res, num, den);
}
__global__ void k_chk_p2(Params p, float* res) {
    const int gid = blockIdx.x * blockDim.x + threadIdx.x;
    const int t = (gid * 131 + 7) % T; const int col = (gid * 977 + 13) % (NIN - 8 + 4096);
    const bf16_t* U = (const bf16_t*)(p.ws + WS_U) + (size_t)t * D;
    const int pos = t % S; float ref, got; unsigned char* ws = p.ws;
    auto dot = [&](const float* w, int ld, int c) { float a = 0; for (int k = 0; k < D; ++k) a += bf2f(U[k]) * w[(size_t)k * ld + c]; return a; };
    if (col < 3072) { const int hd = col / 128, lc = col % 128, i = lc % 64; const int c1 = hd * 128 + i, c2 = c1 + 64; const float x1 = dot(p.in[4], NIN, c1), x2 = dot(p.in[4], NIN, c2);
        const float inv = powf(10000.f, -(float)(2 * i) / 128.f), ang = (float)pos * inv, cs = cosf(ang), sn = sinf(ang);
        ref = (lc < 64) ? (x1 * cs - x2 * sn) : (x2 * cs + x1 * sn); const int pc = hd * 128 + 2 * i + (lc >= 64);
        if (col < 1536) { ref *= QSCALE; got = bf2f(((const bf16_t*)(ws + WS_QB))[(size_t)t * 1536 + pc]); } else got = bf2f(((const bf16_t*)(ws + WS_KB))[(size_t)t * 1536 + pc - 1536]); }
    else if (col < 4608) { ref = dot(p.in[4], NIN, col); got = bf2f(((const bf16_t*)(ws + WS_VB))[(size_t)t * 1536 + col - 3072]); }
    else if (col < 6656) { ref = dot(p.in[4], NIN, col); got = bf2f(((const bf16_t*)(ws + WS_QKP))[(size_t)t * 2048 + col - 4608]); }
    else if (col < 7680) { ref = dot(p.in[4], NIN, col); got = bf2f(((const bf16_t*)(ws + WS_VMB))[(size_t)t * 1024 + col - 6656]); }
    else if (col < 8704) { ref = dot(p.in[4], NIN, col); ref = 1.f / (1.f + expf(-ref)); got = bf2f(((const bf16_t*)(ws + WS_OGB))[(size_t)t * 1024 + col - 7680]); }
    else { const int c = col - 8704; ref = dot(p.in[11], 4096, c) + p.in[12][c]; ref = 1.f / (1.f + expf(-ref)); got = bf2f(((const bf16_t*)(ws + WS_GB))[(size_t)t * 4096 + c]); }
    double num = (double)(got - ref) * (got - ref), den = (double)ref * ref;
    for (int o = 32; o >= 1; o >>= 1) { num += __shfl_xor(num, o); den += __shfl_xor(den, o); }
    if ((threadIdx.x & 63) == 0) dbg_acc(res, num, den);
}

__global__ void __launch_bounds__(256) k_chk_attn(Params p, float* res) {
    const int t = (blockIdx.x * 1543 + 11) % T, h = threadIdx.x >> 6, lane = threadIdx.x & 63; const int b = t / S, pos = t % S;
    const bf16_t* QB = (const bf16_t*)(p.ws + WS_QB); const bf16_t* KB = (const bf16_t*)(p.ws + WS_KB); const bf16_t* VB = (const bf16_t*)(p.ws + WS_VB); const bf16_t* YA = (const bf16_t*)(p.ws + WS_YA);
    float og[3][2], lse[3];
    for (int g = 0; g < 3; ++g) { const int d = (g == 0) ? 1 : (g == 1 ? 4 : 16); const int head = 4 * g + h;
        const bf16_t* qp = QB + (size_t)t * 1536 + head * 128; const float q0 = bf2f(qp[lane]), q1 = bf2f(qp[lane + 64]);
        float mx = -INFINITY, den = 0, o0 = 0, o1 = 0;
        for (int j = 0; j <= 128; ++j) { const int tk = pos - j * d; if (tk < 0) break;
            const bf16_t* kp = KB + (size_t)(b * S + tk) * 1536 + head * 128; const bf16_t* vp = VB + (size_t)(b * S + tk) * 1536 + head * 128;
            const float dot = wave_sum(q0 * bf2f(kp[lane]) + q1 * bf2f(kp[lane + 64]));
            const float nm = fmaxf(mx, dot); const float sc = exp2f(mx - nm), pe = exp2f(dot - nm);
            den = den * sc + pe; o0 = o0 * sc + pe * bf2f(vp[lane]); o1 = o1 * sc + pe * bf2f(vp[lane + 64]); mx = nm; }
        og[g][0] = o0 / den; og[g][1] = o1 / den; lse[g] = (mx + log2f(den)) * LN2; }
    const float ml = fmaxf(lse[0], fmaxf(lse[1], lse[2])); const float w0 = expf(lse[0] - ml), w1 = expf(lse[1] - ml), w2 = expf(lse[2] - ml); const float ws_ = 1.f / (w0 + w1 + w2);
    const float r0 = (w0 * og[0][0] + w1 * og[1][0] + w2 * og[2][0]) * ws_, r1 = (w0 * og[0][1] + w1 * og[1][1] + w2 * og[2][1]) * ws_;
    const float g0 = bf2f(YA[(size_t)t * 512 + h * 128 + lane]), g1 = bf2f(YA[(size_t)t * 512 + h * 128 + lane + 64]);
    double num = (double)(g0 - r0) * (g0 - r0) + (double)(g1 - r1) * (g1 - r1), den2 = (double)r0 * r0 + (double)r1 * r1;
    for (int o = 32; o >= 1; o >>= 1) { num += __shfl_xor(num, o); den2 += __shfl_xor(den2, o); }
    if (lane == 0) dbg_acc(res, num, den2);
}
__global__ void __launch_bounds__(1024) k_chk_mlstm(Params p, float* hb) {
    const int b = blockIdx.x / 4, h = blockIdx.x % 4; const int tid = threadIdx.x, v = tid >> 2, kq = tid & 3;
    const bf16_t* QKP = (const bf16_t*)(p.ws + WS_QKP); const bf16_t* VM = (const bf16_t*)(p.ws + WS_VMB);
    const float* gpre = (const float*)(p.ws + WS_GPRE); const float* conv_w = p.in[6]; const float* conv_b = p.in[7];
    __shared__ float qs[256], ks[256], vs[256], ns[256], nq[256];
    float C[64];
#pragma unroll
    for (int i = 0; i < 64; ++i) C[i] = 0.f;
    if (tid < 256) ns[tid] = 0.f;
    float m = 0.f;
    for (int pos = 0; pos < S; ++pos) { const int t = b * S + pos;
        __syncthreads();
        if (tid < 256) { float yq = conv_b[h * 256 + tid], yk = conv_b[1024 + h * 256 + tid];
            for (int j = 0; j < 4; ++j) { const int pp = pos + j - 3; if (pp >= 0) { yq += conv_w[j * 2048 + h * 256 + tid] * bf2f(QKP[(size_t)(t + j - 3) * 2048 + h * 256 + tid]); yk += conv_w[j * 2048 + 1024 + h * 256 + tid] * bf2f(QKP[(size_t)(t + j - 3) * 2048 + 1024 + h * 256 + tid]); } }
            qs[tid] = yq / (1.f + expf(-yq)); ks[tid] = yk / (1.f + expf(-yk)) * 0.0625f; vs[tid] = bf2f(VM[(size_t)t * 1024 + h * 256 + tid]); }
        const float ip = gpre[(size_t)t * 8 + h], lf = gpre[(size_t)t * 8 + 4 + h];
        const float mn = fmaxf(lf + m, ip); const float iw = expf(ip - mn), fw = expf(lf + m - mn); m = mn;
        __syncthreads();
        if (tid < 256) { const float nn = fw * ns[tid] + iw * ks[tid]; ns[tid] = nn; nq[tid] = nn * qs[tid]; }
        __syncthreads();
        const float vv = vs[v] * iw; float nu = 0.f, de = 0.f;
#pragma unroll
        for (int i = 0; i < 64; ++i) { const int k = 4 * i + kq; const float cc = fw * C[i] + vv * ks[k]; C[i] = cc; nu += cc * qs[k]; de += nq[k]; }
        nu += __shfl_xor(nu, 1); nu += __shfl_xor(nu, 2); de += __shfl_xor(de, 1); de += __shfl_xor(de, 2);
        if (kq == 0) hb[(size_t)t * 1024 + h * 256 + v] = nu / fmaxf(fabsf(de), expf(-mn));
    }
}
__global__ void __launch_bounds__(256) k_chk_mnorm(Params p, const float* hb, float* res) {
    __shared__ float red[8];
    const int t = blockIdx.x / 4, h = blockIdx.x % 4, tid = threadIdx.x;
    const bf16_t* OG = (const bf16_t*)(p.ws + WS_OGB); const bf16_t* YM = (const bf16_t*)(p.ws + WS_YM); const float* mg = p.in[8];
    const float val = bf2f(OG[(size_t)t * 1024 + h * 256 + tid]) * hb[(size_t)t * 1024 + h * 256 + tid];
    float s = wave_sum(val); if ((tid & 63) == 0) red[tid >> 6] = s; __syncthreads();
    const float mu = (red[0] + red[1] + red[2] + red[3]) * (1.f / 256.f); const float d = val - mu;
    s = wave_sum(d * d); if ((tid & 63) == 0) red[4 + (tid >> 6)] = s; __syncthreads();
    const float rstd = rsqrtf((red[4] + red[5] + red[6] + red[7]) * (1.f / 256.f) + LN_EPS); const float ref = d * rstd * mg[h * 256 + tid];
    const float got = bf2f(YM[(size_t)t * 1024 + h * 256 + tid]);
    double num = (double)(got - ref) * (got - ref), den = (double)ref * ref;
    for (int o = 32; o >= 1; o >>= 1) { num += __shfl_xor(num, o); den += __shfl_xor(den, o); }
    if ((tid & 63) == 0) dbg_acc(res, num, den);
}
__global__ void k_chk_fin(const float* res, int nchk, float* out, int n) {
    const int i = blockIdx.x * blockDim.x + threadIdx.x; if (i >= n) return;
    float code = 0.f;
    for (int k = 0; k < nchk; ++k) { const float rv = res[2 * k] / fmaxf(res[2 * k + 1], 1e-30f); int s;
        if (!(rv == rv) || !(res[2 * k + 1] > 0.f)) s = 9; else { s = (int)floorf(log10f(fmaxf(rv, 1e-12f)) + 6.f); s = s < 0 ? 0 : (s > 8 ? 8 : s); }
        if (s >= 3 && code == 0.f) code = ((k + 1) * 10 + s) * 100.f; }
    out[i] = (i == 0) ? code : 0.f;
}
#endif

__global__ void __launch_bounds__(NTHR, 2) mk_fwd(Params args) {
    extern __shared__ __attribute__((aligned(16))) unsigned char lds_raw[];
    Frame F;
    F.lds = (LAS unsigned char*)lds_raw; F.G = gridDim.x; F.bx = blockIdx.x; F.ws = args.ws;
    F.x = args.in[0]; F.c = args.in[1]; F.w_ada = args.in[2]; F.b_ada = args.in[3]; F.w_in = args.in[4]; F.b_mgate = args.in[5]; F.conv_w = args.in[6]; F.conv_b = args.in[7];
    F.m_norm_g = args.in[8]; F.w_proj_a = args.in[9]; F.w_proj_m = args.in[10]; F.w_gate = args.in[11]; F.b_gate = args.in[12]; F.w_out = args.in[13]; F.ln1_g = args.in[14]; F.ln1_b = args.in[15];
    F.w_rg = args.in[16]; F.b_rg = args.in[17]; F.w_re = args.in[18]; F.b_re = args.in[19]; F.w_eg = args.in[20]; F.w_eu = args.in[21]; F.w_ed = args.in[22]; F.ln2_g = args.in[23]; F.ln2_b = args.in[24];
    F.out = args.out;
    volatile LAS unsigned* misc = (volatile LAS unsigned*)(F.lds + LDS_MISC);
    if (FTID < 64) misc[FTID] = 0u;
    __syncthreads();
    const int lo = args.ph_lo, hi = args.ph_hi;
    XcdBarrier bar; bar.bar = (unsigned*)(F.ws + WS_CTL) + CW_BAR; bar.x = 0; bar.st = nullptr;
    if (hi - lo > 1) bar = xcd_barrier_post((unsigned*)(F.ws + WS_CTL) + CW_BAR, misc + 8);
#define IN(k) (lo <= (k) && (k) < hi)
#define BOTH(k) (IN(k) && IN((k) + 1))
#define SEAM(k) do { if (BOTH(k)) xcd_barrier(bar); } while (0)

#define DUPRUN(k, BODY) do { BODY; if (MK_DUP & (1 << (k))) { xcd_barrier(bar); BODY; } } while (0)
#define PH0 { p0_prologue(F); }
#define PH1 { p1_lnmod(F); }
#define PH2 { const int GG = (F.G == 256) ? MK_GG2 : F.G; \
        if (F.bx < GG) { pg8::StaticOrder So; So.init(T, NBIG, GG, F.bx); \
            if (MK_STAGGER > 0) { const unsigned long long t0 = __builtin_amdgcn_s_memrealtime(); const unsigned long long dl = (unsigned long long)((F.bx >> 3) & 7) * MK_STAGGER; while (__builtin_amdgcn_s_memrealtime() - t0 < dl) __builtin_amdgcn_s_sleep(8); } \
            EpiP2 E{WSP(bf16_t, WS_QB), WSP(bf16_t, WS_KB), WSP(bf16_t, WS_VB), WSP(bf16_t, WS_QKP), WSP(bf16_t, WS_VMB), WSP(bf16_t, WS_OGB), WSP(bf16_t, WS_GB), WSP(float, WS_ROPE), F.b_gate}; \
            pg8::gemm_phase<EpiP2, pg8::StaticOrder, false>(F.lds, WSP(bf16_t, WS_U), WSP(bf16_t, WS_WBIG), D, So, E); } \
        if (F.bx >= F.G - 16 && FWAVE == 0) scan_bh(F, F.bx - (F.G - 16)); \
        cvt_stream<1>(F, N_IT_W1); cvt_stream<1>(F, N_IT_BG); }
#define PH3 { p3_conv(F); attn_phase(F); }
#define PH4 { for (int u = F.bx; u < 256; u += F.G) mlstm_dc_unit(F, u); }
#define PH5 { p5_scan_mix(F); }
#define PH6 { for (int u = F.bx; u < 256; u += F.G) mlstm_out_unit(F, u); }
#define PH7 { pg8::StaticOrder So; So.init(T, D, F.G, F.bx); \
        EpiMerge E0{WSP(bf16_t, WS_MG), WSP(bf16_t, WS_GB), 0}, E1{WSP(bf16_t, WS_MG), WSP(bf16_t, WS_GB), 1}; \
        pg8::gemm_phase<EpiMerge, pg8::StaticOrder, false>(F.lds, WSP(bf16_t, WS_YA), WSP(bf16_t, WS_WPA), 512, So, E0); \
        pg8::gemm_phase<EpiMerge, pg8::StaticOrder, false>(F.lds, WSP(bf16_t, WS_YM), WSP(bf16_t, WS_WPM), 1024, So, E1); }
#define PH8 { pg8::StaticOrder So; So.init(T, D, F.G, F.bx); EpiWout E{WSP(float, WS_MOD), WSP(bf16_t, WS_PRE)}; \
        pg8::gemm_phase<EpiWout, pg8::StaticOrder, false>(F.lds, WSP(bf16_t, WS_MG), WSP(bf16_t, WS_WO), D, So, E); }
#define PH10 { moe_tables(F, tb, cn); MoeSched Sm{WSP(int, WS_IDX), tb, cn, F.G, vcu}; EpiMoe1 E{WSP(bf16_t, WS_H)}; \
        pg8::gemm_phase<EpiMoe1, MoeSched, true>(F.lds, WSP(bf16_t, WS_U), WSP(bf16_t, WS_W1T), D, Sm, E); }
#define PH11 { moe_tables(F, tb, cn); MoeSched Sm{WSP(int, WS_IDX), tb, cn, F.G, vcu}; EpiMoe2 E{WSP(bf16_t, WS_Y2), WSP(float, WS_WL)}; \
        pg8::gemm_phase<EpiMoe2, MoeSched, false>(F.lds, WSP(bf16_t, WS_H), WSP(bf16_t, WS_W2T), FF, Sm, E); }
    LAS int* tb = (LAS int*)(F.lds + LDS_MISC) + 64; LAS int* cn = tb + 40;
    const int vcu = (F.G % 8 == 0) ? (F.bx % 8) * (F.G / 8) + F.bx / 8 : F.bx;
    if (IN(0)) { DUPRUN(0, PH0); SEAM(0); }
    if (IN(1)) { DUPRUN(1, PH1); SEAM(1); }
    if (IN(2)) { PH2;
        if (MK_DUP & (1 << 21)) { xcd_barrier(bar); const int GG = MK_GG2; if (F.bx < GG) { pg8::StaticOrder So; So.init(T, NBIG, GG, F.bx); EpiNull E{WSP(float, WS_DC)}; pg8::gemm_phase<EpiNull, pg8::StaticOrder, false>(F.lds, WSP(bf16_t, WS_U), WSP(bf16_t, WS_WBIG), D, So, E); } }
        SEAM(2); }
    if (IN(3)) { DUPRUN(3, PH3); SEAM(3); }
    if (IN(4)) { DUPRUN(4, PH4); SEAM(4); }
    if (IN(5)) { DUPRUN(5, PH5); SEAM(5); }
    if (IN(6)) { DUPRUN(6, PH6); SEAM(6); }
    if (IN(7)) { DUPRUN(7, PH7); SEAM(7); }
    if (IN(8)) { DUPRUN(8, PH8);
        if (MK_DUP & (1 << 20)) { xcd_barrier(bar); pg8::StaticOrder So; So.init(T, D, F.G, F.bx); EpiNull E{WSP(float, WS_DC)}; pg8::gemm_phase<EpiNull, pg8::StaticOrder, false>(F.lds, WSP(bf16_t, WS_MG), WSP(bf16_t, WS_WO), D, So, E); }
        SEAM(8); }
    if (IN(9)) { if (MK_DUP & (1 << 9)) { p9_ln_router<true>(F); xcd_barrier(bar); } p9_ln_router<false>(F); SEAM(9); }
    if (IN(10)) { DUPRUN(10, PH10); SEAM(10); }
    if (IN(11)) { DUPRUN(11, PH11); SEAM(11); }
    if (IN(12)) { moe_tables(F, tb, cn); if (MK_DUP & (1 << 12)) { p12_final<true>(F, tb); xcd_barrier(bar); } p12_final<false>(F, tb); }
#undef IN
#undef BOTH
#undef SEAM
}

extern "C" void kernel_launch(void* const* d_in, const int* in_sizes, int n_in, void* d_out, int out_size, void* d_ws, size_t ws_size, hipStream_t stream) {
    static int grid = 0;
    if (grid == 0) {
        size_t need = WS_END;
#if MK_DEBUG
        need += (1 << 20) + (size_t)T * 1024 * 4;
#endif
        if (n_in != 25 || out_size != T * D || ws_size < need) { fprintf(stderr, "kernel_launch: unexpected shapes / workspace (%zu < %zu)\n", ws_size, need); grid = -1; return; }
        int dev = 0, cus = 0, per_cu = 0;
        if (hipGetDevice(&dev) != hipSuccess || hipDeviceGetAttribute(&cus, hipDeviceAttributeMultiprocessorCount, dev) != hipSuccess) { grid = -1; return; }
        if (hipFuncSetAttribute((const void*)mk_fwd, hipFuncAttributeMaxDynamicSharedMemorySize, LDS_BYTES) != hipSuccess) { fprintf(stderr, "kernel_launch: hipFuncSetAttribute failed\n"); grid = -1; return; }
        if (hipOccupancyMaxActiveBlocksPerMultiprocessor(&per_cu, (const void*)mk_fwd, NTHR, LDS_BYTES) != hipSuccess || per_cu < 1) { fprintf(stderr, "kernel_launch: occupancy query says %d\n", per_cu); (void)hipGetLastError(); grid = -1; return; }
        grid = cus;
    }
    if (grid < 0) return;
    (void)hipMemsetAsync((char*)d_ws + WS_CTL, 0, CTL_ZERO_BYTES, stream);
    Params a{};
    for (int i = 0; i < 25; ++i) a.in[i] = (const float*)d_in[i];
    a.out = (float*)d_out; a.ws = (unsigned char*)d_ws;
#if MK_DEBUG
    constexpr int NPH = 7;
#else
    constexpr int NPH = 13;
#endif
#if MK_PER_PHASE
    for (int p = 0; p < NPH; ++p) { a.ph_lo = p; a.ph_hi = p + 1; hipLaunchKernelGGL(mk_fwd, dim3(grid), dim3(NTHR), LDS_BYTES, stream, a); }
#else
    a.ph_lo = 0; a.ph_hi = NPH; hipLaunchKernelGGL(mk_fwd, dim3(grid), dim3(NTHR), LDS_BYTES, stream, a);
#endif
#if MK_DEBUG
    float* res = (float*)((char*)d_ws + WS_DBG0);
    (void)hipMemsetAsync(res, 0, 256, stream);
    k_chk_u<<<64, 256, 0, stream>>>(a, res);
    k_chk_p2<<<32, 64, 0, stream>>>(a, res + 2);
    k_chk_attn<<<256, 256, 0, stream>>>(a, res + 4);
    float* hb = (float*)((char*)d_ws + WS_DBG0 + (1 << 20));
    k_chk_mlstm<<<16, 1024, 0, stream>>>(a, hb);
    k_chk_mnorm<<<T * 4, 256, 0, stream>>>(a, hb, res + 6);
    k_chk_fin<<<(T * D + 255) / 256, 256, 0, stream>>>(res, 4, (float*)d_out, T * D);
#endif
}
```
